# Optimizing an MI355X kernel written in HIP

```python
import jax
import jax.numpy as jnp
from jax import lax
import numpy as np

D_MODEL = 1024
BATCH = 2
SEQ = 8192
DEPTH = 4

N_MIXERS = 3
N_MLA_LAYERS = (DEPTH + N_MIXERS - 1) // N_MIXERS
N_MLSTM_LAYERS = (DEPTH + N_MIXERS - 2) // N_MIXERS
N_RWKV_LAYERS = DEPTH // N_MIXERS

RMS_EPS = 1e-6
FFN_HIDDEN = 2816
MLA_HEADS = 8
MLA_Q_RANK = 512
MLA_KV_RANK = 256
MLA_NOPE = 128
MLA_ROPE = 64
MLA_V = 128
ROPE_THETA = 10000.0
Q_BLOCK = 128
MLSTM_HEADS = 8
MLSTM_QK = 64
MLSTM_V = 128
MLSTM_CONV = 4
MLSTM_CHUNK = 64
RWKV_HEAD = 64
RWKV_HEADS = D_MODEL // RWKV_HEAD
RWKV_DECAY_LORA = 64
RWKV_A_LORA = 64
RWKV_GATE_LORA = 128
RWKV_GN_EPS = 64e-5

kernel_name = 'hybrid_mla_mlstm_rwkv7_macaron'

F32 = jnp.float32


def rmsnorm(x, g, eps=RMS_EPS):
    xf = x.astype(F32)
    y = xf * lax.rsqrt(jnp.mean(xf * xf, axis=-1, keepdims=True) + eps)
    return (y * g.astype(F32)).astype(x.dtype)


def swiglu(h, w_gate, w_up, w_down):
    return (jax.nn.silu(h @ w_gate) * (h @ w_up)) @ w_down


def rope(t, cos, sin):
    t1, t2 = jnp.split(t, 2, axis=-1)
    out = jnp.concatenate([t1 * cos - t2 * sin, t1 * sin + t2 * cos], axis=-1)
    return out.astype(t.dtype)


def causal_block_attention(q, k, v, scale):
    B, S, H, Dk = q.shape
    Dv = v.shape[-1]
    nb = S // Q_BLOCK
    qb = q.reshape(B, nb, Q_BLOCK, H, Dk).transpose(1, 0, 3, 2, 4)
    kpos = jnp.arange(S)

    def one_block(args):
        q_blk, bi = args
        s = jnp.einsum('bhqd,bkhd->bhqk', q_blk, k).astype(F32) * scale
        qpos = bi * Q_BLOCK + jnp.arange(Q_BLOCK)
        mask = kpos[None, :] <= qpos[:, None]
        s = jnp.where(mask[None, None], s, -jnp.inf)
        p = jax.nn.softmax(s, axis=-1).astype(v.dtype)
        return jnp.einsum('bhqk,bkhd->bqhd', p, v)

    out = lax.map(one_block, (qb, jnp.arange(nb)))
    return out.transpose(1, 0, 2, 3, 4).reshape(B, S, H, Dv)


def mla(h, positions, w_a, q_norm, w_qb, kv_norm, w_kvb, w_o):
    B, S, _ = h.shape
    H = MLA_HEADS
    lat = h @ w_a
    c_q = lat[..., :MLA_Q_RANK]
    c_kv = lat[..., MLA_Q_RANK:MLA_Q_RANK + MLA_KV_RANK]
    k_pe = lat[..., MLA_Q_RANK + MLA_KV_RANK:]
    q = (rmsnorm(c_q, q_norm) @ w_qb).reshape(B, S, H, MLA_NOPE + MLA_ROPE)
    kv = (rmsnorm(c_kv, kv_norm) @ w_kvb).reshape(B, S, H, MLA_NOPE + MLA_V)
    q_nope, q_pe = q[..., :MLA_NOPE], q[..., MLA_NOPE:]
    k_nope, v = kv[..., :MLA_NOPE], kv[..., MLA_NOPE:]
    inv_freq = 1.0 / (ROPE_THETA ** (jnp.arange(0, MLA_ROPE, 2, dtype=F32) / MLA_ROPE))
    ang = positions.astype(F32)[..., None] * inv_freq
    cos, sin = jnp.cos(ang), jnp.sin(ang)
    q_pe = rope(q_pe, cos[:, :, None], sin[:, :, None])
    k_pe = rope(k_pe, cos, sin)
    q = jnp.concatenate([q_nope, q_pe], axis=-1)
    k = jnp.concatenate([k_nope, jnp.broadcast_to(k_pe[:, :, None], (B, S, H, MLA_ROPE))], axis=-1)
    o = causal_block_attention(q, k, v, (MLA_NOPE + MLA_ROPE) ** -0.5)
    return o.reshape(B, S, H * MLA_V) @ w_o


def causal_depthwise_conv(x, w, b):
    K, C = w.shape
    y = lax.conv_general_dilated(x, w[:, None, :].astype(x.dtype), window_strides=(1,),
                                 padding=((K - 1, 0),), dimension_numbers=('NWC', 'WIO', 'NWC'),
                                 feature_group_count=C)
    return y + b


def mlstm_chunkwise(q, k, v, i_pre, log_f):
    B, S, H, DK = q.shape
    DV = v.shape[-1]
    L = MLSTM_CHUNK
    nc = S // L
    to_c = lambda t: t.astype(F32).reshape(B, nc, L, H, -1).transpose(1, 0, 3, 2, 4)
    to_cg = lambda t: t.astype(F32).reshape(B, nc, L, H).transpose(1, 0, 3, 2)
    causal = jnp.tril(jnp.ones((L, L), dtype=bool))

    def step(carry, inp):
        C, n, m = carry
        q_, k_, v_, i_, lf = inp
        Fc = jnp.cumsum(lf, axis=-1)
        D = Fc[..., :, None] - Fc[..., None, :] + i_[..., None, :]
        D = jnp.where(causal, D, -jnp.inf)
        inter = Fc + m[..., None]
        m_t = jnp.maximum(inter, jnp.max(D, axis=-1))
        Dw = jnp.exp(D - m_t[..., None])
        inter_w = jnp.exp(inter - m_t)
        s = jnp.einsum('bhtd,bhsd->bhts', q_, k_) * Dw
        num = jnp.einsum('bhts,bhsv->bhtv', s, v_) + inter_w[..., None] * jnp.einsum('bhtd,bhdv->bhtv', q_, C)
        den = jnp.sum(s, axis=-1) + inter_w * jnp.einsum('bhtd,bhd->bht', q_, n)
        h = num / jnp.maximum(jnp.abs(den), jnp.exp(-m_t))[..., None]
        m_new = m_t[..., -1]
        carry_decay = jnp.exp(Fc[..., -1] + m - m_new)
        w_s = jnp.exp(Fc[..., -1:] - Fc + i_ - m_new[..., None])
        C_new = carry_decay[..., None, None] * C + jnp.einsum('bhs,bhsd,bhsv->bhdv', w_s, k_, v_)
        n_new = carry_decay[..., None] * n + jnp.einsum('bhs,bhsd->bhd', w_s, k_)
        return (C_new, n_new, m_new), h

    init = (jnp.zeros((B, H, DK, DV), F32), jnp.zeros((B, H, DK), F32), jnp.zeros((B, H), F32))
    _, hs = lax.scan(step, init, (to_c(q), to_c(k), to_c(v), to_cg(i_pre), to_cg(log_f)))
    return hs.transpose(1, 0, 3, 2, 4).reshape(B, S, H, DV)


def mlstm(h, w_in, b_if, conv_w, conv_b, out_norm, w_o):
    B, S, _ = h.shape
    H, DK, DV = MLSTM_HEADS, MLSTM_QK, MLSTM_V
    QK = 2 * H * DK
    V = H * DV
    p = h @ w_in
    qk = jax.nn.silu(causal_depthwise_conv(p[..., :QK], conv_w, conv_b))
    v = p[..., QK:QK + V].reshape(B, S, H, DV)
    o = p[..., QK + V:QK + 2 * V]
    gates = p[..., QK + 2 * V:].astype(F32) + b_if.astype(F32)
    q = qk[..., :H * DK].reshape(B, S, H, DK)
    k = qk[..., H * DK:].reshape(B, S, H, DK) * (DK ** -0.5)
    i_pre = gates[..., :H]
    log_f = jax.nn.log_sigmoid(gates[..., H:])
    hid = mlstm_chunkwise(q, k, v, i_pre, log_f)
    hid = hid * lax.rsqrt(jnp.mean(hid * hid, axis=-1, keepdims=True) + RMS_EPS)
    hid = hid.reshape(B, S, V) * out_norm.astype(F32) * jax.nn.sigmoid(o.astype(F32))
    return hid.astype(h.dtype) @ w_o


def rwkv7_recurrence(r, decay, k, v, a, b):
    B, S, H, N = r.shape

    def step(state, inp):
        r_, w_, k_, v_, a_, b_ = inp
        sa = jnp.einsum('bhij,bhj->bhi', state, a_)
        state = (state * w_[:, :, None, :] + sa[..., :, None] * b_[:, :, None, :]
                 + v_[..., :, None] * k_[:, :, None, :])
        return state, jnp.einsum('bhij,bhj->bhi', state, r_)

    tm = lambda t: jnp.moveaxis(t, 1, 0)
    _, ys = lax.scan(step, jnp.zeros((B, H, N, N), F32), (tm(r), tm(decay), tm(k), tm(v), tm(a), tm(b)))
    return jnp.moveaxis(ys, 0, 1)


def rwkv7(h, mu, w_r, w_k, w_v, w0, w1, w2, a0, a1, a2, g1, g2, k_k, k_a, r_k, ln_w, ln_b, w_o):
    B, S, D = h.shape
    H, N = RWKV_HEADS, RWKV_HEAD
    xx = jnp.pad(h, ((0, 0), (1, 0), (0, 0)))[:, :S] - h
    xr, xw, xk, xv, xa, xg = [h + xx * mu[j] for j in range(6)]
    r = (xr @ w_r).astype(F32)
    k = (xk @ w_k).astype(F32)
    v = (xv @ w_v).astype(F32)
    w_log = -jax.nn.softplus(-(w0 + jnp.tanh(xw @ w1) @ w2).astype(F32)) - 0.5
    decay = jnp.exp(-jnp.exp(w_log))
    a = jax.nn.sigmoid((a0 + (xa @ a1) @ a2).astype(F32))
    g = (jax.nn.sigmoid(xg @ g1) @ g2).astype(F32)
    kk = (k * k_k.astype(F32)).reshape(B, S, H, N)
    kk = kk / jnp.maximum(jnp.sqrt(jnp.sum(kk * kk, axis=-1, keepdims=True)), 1e-12)
    k = k * (1.0 + (a - 1.0) * k_a.astype(F32))
    rh, kh, vh = r.reshape(B, S, H, N), k.reshape(B, S, H, N), v.reshape(B, S, H, N)
    ah = a.reshape(B, S, H, N)
    y = rwkv7_recurrence(rh, decay.reshape(B, S, H, N), kh, vh, -kk, kk * ah)
    mean = jnp.mean(y, axis=-1, keepdims=True)
    var = jnp.mean(jnp.square(y - mean), axis=-1, keepdims=True)
    y = ((y - mean) * lax.rsqrt(var + RWKV_GN_EPS)).reshape(B, S, D) * ln_w.astype(F32) + ln_b.astype(F32)
    bonus = jnp.sum(rh * kh * r_k.astype(F32), axis=-1, keepdims=True) * vh
    y = y + bonus.reshape(B, S, D)
    return (y * g).astype(h.dtype) @ w_o


def setup_inputs(seed: int = 0) -> dict:
    key = jax.random.key(seed)
    keys = list(jax.random.split(key, 48))
    nk = lambda: keys.pop()
    D, F = D_MODEL, FFN_HIDDEN
    nA, nB, nC = N_MLA_LAYERS, N_MLSTM_LAYERS, N_RWKV_LAYERS

    def dense(shape, fan_in, scale=1.0):
        return jax.random.normal(nk(), shape, F32) * (scale * fan_in ** -0.5)

    def gain(shape):
        return 1.0 + 0.02 * jax.random.normal(nk(), shape, F32)

    def small(shape, s=0.02, c=0.0):
        return c + s * jax.random.normal(nk(), shape, F32)

    x = jax.random.normal(nk(), (BATCH, SEQ, D), F32)
    positions = (jnp.arange(SEQ, dtype=jnp.int32)[None, :]
                 + jax.random.randint(nk(), (BATCH, 1), 0, 4096, dtype=jnp.int32))
    Hm, DK, DV = MLSTM_HEADS, MLSTM_QK, MLSTM_V
    b_if = jnp.concatenate([small((nB, Hm), 0.1),
                            jnp.linspace(3.0, 6.0, Hm, dtype=F32)[None] + small((nB, Hm), 0.1)], axis=-1)
    return {
        'x': x,
        'positions': positions,
        'ffn_norm': gain((DEPTH, 2, D)),
        'ffn_w_gate': dense((DEPTH, 2, D, F), D),
        'ffn_w_up': dense((DEPTH, 2, D, F), D),
        'ffn_w_down': dense((DEPTH, 2, F, D), F),
        'mix_norm': gain((DEPTH, D)),
        'final_norm': gain((D,)),
        'mla_w_a': dense((nA, D, MLA_Q_RANK + MLA_KV_RANK + MLA_ROPE), D),
        'mla_q_norm': gain((nA, MLA_Q_RANK)),
        'mla_w_qb': dense((nA, MLA_Q_RANK, MLA_HEADS * (MLA_NOPE + MLA_ROPE)), MLA_Q_RANK),
        'mla_kv_norm': gain((nA, MLA_KV_RANK)),
        'mla_w_kvb': dense((nA, MLA_KV_RANK, MLA_HEADS * (MLA_NOPE + MLA_V)), MLA_KV_RANK),
        'mla_w_o': dense((nA, MLA_HEADS * MLA_V, D), MLA_HEADS * MLA_V),
        'ml_w_in': dense((nB, D, 2 * Hm * DK + 2 * Hm * DV + 2 * Hm), D),
        'ml_b_if': b_if,
        'ml_conv_w': dense((nB, MLSTM_CONV, 2 * Hm * DK), MLSTM_CONV),
        'ml_conv_b': small((nB, 2 * Hm * DK)),
        'ml_out_norm': gain((nB, Hm * DV)),
        'ml_w_o': dense((nB, Hm * DV, D), Hm * DV),
        'rw_mu': jax.random.uniform(nk(), (nC, 6, D), F32),
        'rw_w_r': dense((nC, D, D), D),
        'rw_w_k': dense((nC, D, D), D),
        'rw_w_v': dense((nC, D, D), D),
        'rw_w0': jnp.linspace(-6.0, 1.0, D, dtype=F32)[None] + small((nC, D), 0.1),
        'rw_w1': dense((nC, D, RWKV_DECAY_LORA), D),
        'rw_w2': dense((nC, RWKV_DECAY_LORA, D), RWKV_DECAY_LORA, 0.1),
        'rw_a0': small((nC, D), 0.1),
        'rw_a1': dense((nC, D, RWKV_A_LORA), D),
        'rw_a2': dense((nC, RWKV_A_LORA, D), RWKV_A_LORA, 0.1),
        'rw_g1': dense((nC, D, RWKV_GATE_LORA), D),
        'rw_g2': dense((nC, RWKV_GATE_LORA, D), RWKV_GATE_LORA),
        'rw_k_k': small((nC, D), 0.05, 0.85),
        'rw_k_a': small((nC, D), 0.05, 1.0),
        'rw_r_k': small((nC, RWKV_HEADS, RWKV_HEAD), 0.1, -0.04),
        'rw_ln_w': gain((nC, D)),
        'rw_ln_b': small((nC, D)),
        'rw_w_o': dense((nC, D, D), D),
    }


def reference(x, positions, ffn_norm, ffn_w_gate, ffn_w_up, ffn_w_down, mix_norm, final_norm,
              mla_w_a, mla_q_norm, mla_w_qb, mla_kv_norm, mla_w_kvb, mla_w_o,
              ml_w_in, ml_b_if, ml_conv_w, ml_conv_b, ml_out_norm, ml_w_o,
              rw_mu, rw_w_r, rw_w_k, rw_w_v, rw_w0, rw_w1, rw_w2, rw_a0, rw_a1, rw_a2,
              rw_g1, rw_g2, rw_k_k, rw_k_a, rw_r_k, rw_ln_w, rw_ln_b, rw_w_o):
    for layer in range(DEPTH):
        x = x + 0.5 * swiglu(rmsnorm(x, ffn_norm[layer, 0]), ffn_w_gate[layer, 0],
                             ffn_w_up[layer, 0], ffn_w_down[layer, 0])
        h = rmsnorm(x, mix_norm[layer])
        kind = layer % N_MIXERS
        j = layer // N_MIXERS
        if kind == 0:
            y = mla(h, positions, mla_w_a[j], mla_q_norm[j], mla_w_qb[j], mla_kv_norm[j],
                    mla_w_kvb[j], mla_w_o[j])
        elif kind == 1:
            y = mlstm(h, ml_w_in[j], ml_b_if[j], ml_conv_w[j], ml_conv_b[j], ml_out_norm[j], ml_w_o[j])
        else:
            y = rwkv7(h, rw_mu[j], rw_w_r[j], rw_w_k[j], rw_w_v[j], rw_w0[j], rw_w1[j], rw_w2[j],
                      rw_a0[j], rw_a1[j], rw_a2[j], rw_g1[j], rw_g2[j], rw_k_k[j], rw_k_a[j],
                      rw_r_k[j], rw_ln_w[j], rw_ln_b[j], rw_w_o[j])
        x = x + y.astype(x.dtype)
        x = x + 0.5 * swiglu(rmsnorm(x, ffn_norm[layer, 1]), ffn_w_gate[layer, 1],
                             ffn_w_up[layer, 1], ffn_w_down[layer, 1])
    return rmsnorm(x, final_norm)
```

```cpp
#include <hip/hip_runtime.h>
#include <cstdio>
#include <cstdint>

__device__ __forceinline__ int fresh_lane() { int l; asm volatile("v_mbcnt_lo_u32_b32 %0, -1, 0\n\tv_mbcnt_hi_u32_b32 %0, -1, %0" : "=v"(l)); return l; }
namespace pg8 {
#define PG8_LAS __attribute__((address_space(3)))
typedef unsigned short bf16_t;
typedef short bf16x8 __attribute__((ext_vector_type(8)));
typedef float f32x4 __attribute__((ext_vector_type(4)));
typedef unsigned u32x4 __attribute__((ext_vector_type(4)));
typedef unsigned u32x2 __attribute__((ext_vector_type(2)));
constexpr int BM = 256, BK = 64, HALF = 128, HTB = HALF * BK * 2  , STAGE_BYTES = 8 * HTB, NXCD = 8, WGM = 8;

__host__ __device__ __forceinline__ int lds_byte(int r, int c) { const int st = (r >> 4) * 2 + (c >> 5), rr = r & 15, cc = c & 31, ob = rr * 64 + cc * 2; return st * 1024 + (ob ^ (((ob >> 9) & 1) << 5)); }
__host__ __device__ __forceinline__ void stage_rc(int b, int& R, int& C) { const int st = b / 1024, sb = b % 1024, swz = sb ^ (((sb >> 9) & 1) << 5); R = (st >> 1) * 16 + swz / 64; C = (st & 1) * 32 + (swz % 64) / 2; }
__host__ __device__ __forceinline__ int perm32(int rho) { const int n = rho >> 4, i = rho & 15; return 8 * (i >> 2) + 4 * n + (i & 3); }

struct Unit { int pm, pn; };
struct Gemm { const bf16_t* A; const bf16_t* Bt; int M, N, K, lda, ldb, wave; };

struct StaticOrder {
    int nM, nN, nwg, G, c;
    __host__ __device__ void init(int M, int N, int G_, int c_) { nM = M / BM; nN = N / BM; nwg = nM * nN; G = G_; c = c_; }
    __host__ __device__ bool next(int i, Unit& u) const {
        const long L = (long)i * G + c; if (L >= nwg) return false;
        int wgid = (int)L; { const int q = nwg / NXCD, r = nwg % NXCD, xcd = wgid % NXCD, off = wgid / NXCD; wgid = (xcd < r ? xcd * (q + 1) : r * (q + 1) + (xcd - r) * q) + off; }
        const int nig = WGM * nN, gid = wgid / nig, fm = gid * WGM, gsz = (nM - fm) < WGM ? (nM - fm) : WGM;
        u.pm = fm + ((wgid % nig) % gsz); u.pn = (wgid % nig) / gsz; return true;
    }
    __device__ __forceinline__ void a_ready(const Unit&) const {}
    __device__ __forceinline__ void done(const Unit&) const {}
};

template <class Epi, class Sched, bool ALIGN_EPI = false, bool SP2 = false>
__device__ __forceinline__ void gemm_phase(PG8_LAS unsigned char* lds, const Gemm g, const Sched& S, const Epi& E) {
    const int wid = g.wave; const int tid = wid * 64 + fresh_lane(), lane = tid & 63, wr = wid >> 2, wc = wid & 3, fr = lane & 15, fq = lane >> 4;
    const int K = g.K, nt = K / BK;
    unsigned voffA[2], voffB[2];
#pragma unroll
    for (int i = 0; i < 2; ++i) { int R, C; stage_rc(tid * 16 + i * 8192, R, C); const int Rb = Epi::PERM ? ((R & ~31) + perm32(R & 31)) : R;
        voffA[i] = (unsigned)(R * g.lda + C) * 2u; voffB[i] = (unsigned)(Rb * g.ldb + C) * 2u; }
    const size_t kstep = (size_t)(BK * 2);
    const size_t hstepA = (size_t)HALF * g.lda * 2, hstepB = (size_t)HALF * g.ldb * 2;
    const size_t tstepA = 2 * hstepA, tstepB = 2 * hstepB;
    const unsigned ldsw = (unsigned)wid * 1024u;
    const int aoff = lds_byte(wr * 64 + fr, fq * 8), boff = lds_byte(wc * 32 + fr, fq * 8);
#define PG8_SA(b, h) (((b) * 2 + (h)) * HTB)
#define PG8_SB(b, h) ((4 + (b) * 2 + (h)) * HTB)
#define PG8_STAGE(bufoff, gbase, voff) do { _Pragma("unroll") for (int _i = 0; _i < 2; ++_i) \
        __builtin_amdgcn_global_load_lds((const unsigned*)((const char*)(gbase) + (voff)[_i]), (PG8_LAS unsigned*)(lds + (bufoff) + ldsw + _i * 8192), 16, 0, 0); } while (0)
#define PG8_LDA(dst, b, h) do { _Pragma("unroll") for (int m = 0; m < 4; ++m) _Pragma("unroll") for (int k = 0; k < 2; ++k) dst[m][k] = *(const PG8_LAS bf16x8*)(lds + PG8_SA(b, h) + aoff + m * 2048 + k * 1024); } while (0)
#define PG8_LDB(dst, b, h) do { _Pragma("unroll") for (int n = 0; n < 2; ++n) _Pragma("unroll") for (int k = 0; k < 2; ++k) dst[n][k] = *(const PG8_LAS bf16x8*)(lds + PG8_SB(b, h) + boff + n * 2048 + k * 1024); } while (0)
#define PG8_MMA(ai, bj, At, Bt) do { __builtin_amdgcn_s_setprio(1); _Pragma("unroll") for (int m = 0; m < 4; ++m) _Pragma("unroll") for (int n = 0; n < 2; ++n) _Pragma("unroll") for (int k = 0; k < 2; ++k) \
        acc[ai][bj][m][n] = __builtin_amdgcn_mfma_f32_16x16x32_bf16(Bt[n][k], At[m][k], acc[ai][bj][m][n], 0, 0, 0); __builtin_amdgcn_s_setprio(0); } while (0)
#define PG8_WAIT_V(n) asm volatile("s_waitcnt vmcnt(" #n ")" ::: "memory")
#define PG8_WAIT_L(n) asm volatile("s_waitcnt lgkmcnt(" #n ")" ::: "memory")
#define PG8_BAR __builtin_amdgcn_s_barrier()
#define PG8_SCHED __builtin_amdgcn_sched_barrier(0)
    Unit cur, nxt; int ui = 0;
    if (!S.next(0, cur)) return;
    f32x4 acc[2][2][4][2];
#pragma unroll
    for (int a = 0; a < 2; ++a)
#pragma unroll
        for (int b = 0; b < 2; ++b)
#pragma unroll
            for (int m = 0; m < 4; ++m)
#pragma unroll
                for (int n = 0; n < 2; ++n) acc[a][b][m][n] = (f32x4){0.f, 0.f, 0.f, 0.f};
    bf16x8 At[4][2], B0[2][2], B1[2][2];
    const char* cA = (const char*)g.A + (size_t)cur.pm * tstepA; const char* cB = (const char*)g.Bt + (size_t)cur.pn * tstepB;
    S.a_ready(cur);
    if constexpr (SP2) {
        PG8_STAGE(PG8_SB(0, 0), cB, voffB); PG8_STAGE(PG8_SB(0, 1), cB + hstepB, voffB); PG8_STAGE(PG8_SA(0, 0), cA, voffA); PG8_STAGE(PG8_SA(0, 1), cA + hstepA, voffA);
        if (wr == 1) PG8_BAR;
        PG8_WAIT_V(2); PG8_BAR;
        PG8_STAGE(PG8_SB(1, 0), cB + kstep, voffB); PG8_STAGE(PG8_SA(1, 0), cA + kstep, voffA); PG8_STAGE(PG8_SB(1, 1), cB + hstepB + kstep, voffB);
        PG8_WAIT_V(6); PG8_BAR;
    } else {
        PG8_STAGE(PG8_SB(0, 0), cB, voffB); PG8_STAGE(PG8_SA(0, 0), cA, voffA); PG8_STAGE(PG8_SB(0, 1), cB + hstepB, voffB); PG8_STAGE(PG8_SA(0, 1), cA + hstepA, voffA);
        if (wr == 1) PG8_BAR;
        PG8_WAIT_V(4); PG8_BAR;
        PG8_STAGE(PG8_SB(1, 0), cB + kstep, voffB); PG8_STAGE(PG8_SA(1, 0), cA + kstep, voffA); PG8_STAGE(PG8_SB(1, 1), cB + hstepB + kstep, voffB);
        PG8_WAIT_V(6); PG8_BAR;
    }
    for (;;) {
        const bool has_next = S.next(ui + 1, nxt);
        const char* nA = has_next ? (const char*)g.A + (size_t)nxt.pm * tstepA : cA; const char* nB = has_next ? (const char*)g.Bt + (size_t)nxt.pn * tstepB : cB;
#pragma nounroll
        for (int t = 0; t < nt; t += 2) {
            const bool last = (t == nt - 2);
            const char* a1 = cA + (size_t)(t + 1) * kstep;
            const char* a2 = last ? nA : cA + (size_t)(t + 2) * kstep; const char* b2 = last ? nB : cB + (size_t)(t + 2) * kstep;
            const char* a3 = a2 + kstep; const char* b3 = b2 + kstep;
            if (last && has_next) S.a_ready(nxt);
            if constexpr (SP2) {
            PG8_LDB(B0, 0, 0); PG8_LDB(B1, 0, 1); PG8_SCHED; PG8_LDA(At, 0, 0); PG8_STAGE(PG8_SA(1, 1), a1 + hstepA, voffA);
            PG8_WAIT_V(8); PG8_WAIT_L(0); PG8_BAR; PG8_MMA(0, 0, At, B0); PG8_MMA(0, 1, At, B1); PG8_BAR; PG8_SCHED;
            PG8_LDA(At, 0, 1); PG8_STAGE(PG8_SB(0, 0), b2, voffB); PG8_STAGE(PG8_SB(0, 1), b2 + hstepB, voffB); PG8_STAGE(PG8_SA(0, 0), a2, voffA);
            PG8_WAIT_V(8); PG8_WAIT_L(0); PG8_BAR; PG8_MMA(1, 0, At, B0); PG8_MMA(1, 1, At, B1); PG8_BAR; PG8_SCHED;
            PG8_LDB(B0, 1, 0); PG8_LDB(B1, 1, 1); PG8_SCHED; PG8_LDA(At, 1, 0); PG8_STAGE(PG8_SA(0, 1), a2 + hstepA, voffA);
            PG8_WAIT_V(8); PG8_WAIT_L(0); PG8_BAR; PG8_MMA(0, 0, At, B0); PG8_MMA(0, 1, At, B1); PG8_BAR; PG8_SCHED;
            PG8_LDA(At, 1, 1); PG8_STAGE(PG8_SB(1, 0), b3, voffB); PG8_STAGE(PG8_SB(1, 1), b3 + hstepB, voffB); PG8_STAGE(PG8_SA(1, 0), a3, voffA);
            PG8_WAIT_V(8); PG8_WAIT_L(0); PG8_BAR; PG8_MMA(1, 0, At, B0); PG8_MMA(1, 1, At, B1); PG8_BAR; PG8_SCHED;
            } else {
            PG8_LDB(B0, 0, 0); PG8_SCHED; PG8_LDA(At, 0, 0); PG8_STAGE(PG8_SA(1, 1), a1 + hstepA, voffA);
            PG8_WAIT_L(8); PG8_BAR; PG8_WAIT_L(0); PG8_MMA(0, 0, At, B0); PG8_BAR; PG8_SCHED;
            PG8_LDB(B1, 0, 1); PG8_STAGE(PG8_SB(0, 0), b2, voffB);
            PG8_BAR; PG8_WAIT_L(0); PG8_MMA(0, 1, At, B1); PG8_BAR;
            PG8_LDA(At, 0, 1); PG8_STAGE(PG8_SA(0, 0), a2, voffA);
            PG8_BAR; PG8_WAIT_L(0); PG8_MMA(1, 0, At, B0); PG8_BAR; PG8_SCHED;
            PG8_STAGE(PG8_SB(0, 1), b2 + hstepB, voffB);
            PG8_WAIT_V(6); PG8_BAR; PG8_MMA(1, 1, At, B1); PG8_BAR;
            PG8_LDB(B0, 1, 0); PG8_SCHED; PG8_LDA(At, 1, 0); PG8_STAGE(PG8_SA(0, 1), a2 + hstepA, voffA);
            PG8_WAIT_L(8); PG8_BAR; PG8_WAIT_L(0); PG8_MMA(0, 0, At, B0); PG8_BAR; PG8_SCHED;
            PG8_LDB(B1, 1, 1); PG8_STAGE(PG8_SB(1, 0), b3, voffB);
            PG8_BAR; PG8_WAIT_L(0); PG8_MMA(0, 1, At, B1); PG8_BAR;
            PG8_LDA(At, 1, 1); PG8_STAGE(PG8_SA(1, 0), a3, voffA);
            PG8_BAR; PG8_WAIT_L(0); PG8_MMA(1, 0, At, B0); PG8_BAR; PG8_SCHED;
            PG8_STAGE(PG8_SB(1, 1), b3 + hstepB, voffB);
            PG8_WAIT_V(6); PG8_BAR; PG8_MMA(1, 1, At, B1); PG8_BAR;
            }
        }
        if constexpr (ALIGN_EPI) { if (wr == 0) PG8_BAR; }
        if constexpr (!Epi::AFTER_DRAIN) { E(acc, cur, wr, wc, fr, fq); S.done(cur); }
        if (!has_next) break;
#pragma unroll
        for (int a = 0; a < 2; ++a)
#pragma unroll
            for (int b = 0; b < 2; ++b)
#pragma unroll
                for (int m = 0; m < 4; ++m)
#pragma unroll
                    for (int n = 0; n < 2; ++n) acc[a][b][m][n] = (f32x4){0.f, 0.f, 0.f, 0.f};
        cur = nxt; cA = nA; cB = nB; ++ui;
        if constexpr (ALIGN_EPI) { if (wr == 1) PG8_BAR; }
    }
    PG8_WAIT_V(0);
    if constexpr (!ALIGN_EPI) { if (wr == 0) PG8_BAR; }
    PG8_BAR;
    if constexpr (Epi::AFTER_DRAIN) { E.fused(acc, cur, wr, wc, fr, fq, lds, wid, lane); S.done(cur); }
#undef PG8_SA
#undef PG8_SB
#undef PG8_STAGE
#undef PG8_LDA
#undef PG8_LDB
#undef PG8_MMA
#undef PG8_WAIT_V
#undef PG8_WAIT_L
#undef PG8_BAR
#undef PG8_SCHED
}
}

constexpr int NWAVES = 8;
constexpr int BATCH = 2, SEQ = 8192, D = 1024, T = BATCH * SEQ, FF = 2816, DEPTH = 4;
constexpr float RMS_EPS = 1e-6f;
constexpr int MLA_H = 8, QRANK = 512, KVRANK = 256, NOPE = 128, ROPE = 64, DVH = 128, DQK = NOPE + ROPE;
constexpr int LATN = QRANK + KVRANK + ROPE;
constexpr int ML_H = 8, ML_DK = 64, ML_DV = 128, ML_NIN = 3088;
constexpr int RW_H = 16, RW_N = 64;

constexpr size_t MiB = 1u << 20;
constexpr size_t WS_CTL = 0, CTL_ZERO_BYTES = 1 * MiB;
constexpr size_t WS_COS = 1 * MiB, WS_SIN = 3 * MiB;
constexpr size_t WS_SS = 5 * MiB;
constexpr size_t WS_SSQ = 6 * MiB;
constexpr size_t WS_SSKV = 6 * MiB + 512 * 1024;
constexpr size_t WS_W = 8 * MiB;
constexpr size_t WS_XB = 68 * MiB;
constexpr size_t WS_ARENA = 100 * MiB;
constexpr size_t WS_END = 352 * MiB;
constexpr size_t WO_GU0 = 0, WO_D0 = WO_GU0 + (size_t)2 * FF * D, WO_GU1 = WO_D0 + (size_t)D * FF, WO_D1 = WO_GU1 + (size_t)2 * FF * D, WO_MIX = WO_D1 + (size_t)D * FF;
constexpr size_t WM_A = WO_MIX, WM_QB = WM_A + (size_t)1024 * 1024, WM_KVB = WM_QB + (size_t)1536 * 512, WM_O = WM_KVB + (size_t)2048 * 256;
constexpr size_t WL_IN = WO_MIX, WL_O = WL_IN + (size_t)3328 * 1024;
constexpr size_t WR_BIG = WO_MIX, WR_UP = WR_BIG + (size_t)3328 * 2048, WR_O = WR_UP + (size_t)3072 * 256;
static_assert((WR_O + (size_t)1024 * 1024) * 2 <= 60 * MiB, "weight region");
constexpr size_t A_ACT = 0;
constexpr size_t A_LAT = 0, A_Q = 32 * MiB, A_KV = 80 * MiB, A_O = 144 * MiB, A_KPE = 176 * MiB;
constexpr size_t A_P = 0, A_GATES = 96 * MiB, A_QKC = 97 * MiB, A_IGLF = 161 * MiB, A_HRAW = 162 * MiB, A_HM = A_QKC;
constexpr size_t A_HX = 0, A_RKV = 64 * MiB, A_LOR = 160 * MiB, A_LW = 0, A_GG = 168 * MiB, A_YG = 200 * MiB;
static_assert(WS_ARENA + A_HRAW + (size_t)T * 1024 * 4 <= WS_END && WS_ARENA + A_YG + (size_t)T * 1024 * 2 <= WS_END && WS_ARENA + A_KPE + (size_t)T * 64 * 2 <= WS_END, "arena");

constexpr int CW_TMO = 0, CW_CODE = 1, CW_BAR = 4096;
constexpr size_t WS_PTRS = 512 * 1024;

constexpr int RING_BYTES = 131072;
constexpr int LDSCTL_OFF = RING_BYTES, MISC_OFF = LDSCTL_OFF + 320;
constexpr int LDS_BYTES = 147456;

#define GAS __attribute__((address_space(1)))
#define LAS __attribute__((address_space(3)))
typedef unsigned short bf16;
typedef unsigned v4u __attribute__((ext_vector_type(4)));
typedef unsigned v2u __attribute__((ext_vector_type(2)));
typedef float f32x4 __attribute__((ext_vector_type(4)));
typedef float f32x16 __attribute__((ext_vector_type(16)));
typedef short bf16x8 __attribute__((ext_vector_type(8)));
typedef short s16x4 __attribute__((ext_vector_type(4)));
typedef GAS unsigned gu32;
#define RLX_AGENT __ATOMIC_RELAXED, __HIP_MEMORY_SCOPE_AGENT
#define LDS_WAIT() asm volatile("s_waitcnt lgkmcnt(0)" ::: "memory")
#define VM_WAIT() asm volatile("s_waitcnt vmcnt(0)" ::: "memory")
typedef float f32x2_t __attribute__((ext_vector_type(2))); typedef __bf16 bf16x2_t __attribute__((ext_vector_type(2)));
__device__ __forceinline__ unsigned cvtpk(float lo, float hi) { f32x2_t v = {lo, hi}; bf16x2_t b = __builtin_convertvector(v, bf16x2_t); return __builtin_bit_cast(unsigned, b); }
__device__ __forceinline__ float bf_lo(unsigned w) { return __builtin_bit_cast(float, w << 16); }
__device__ __forceinline__ float bf_hi(unsigned w) { return __builtin_bit_cast(float, w & 0xffff0000u); }
__device__ __forceinline__ float bf1(bf16 h) { return __builtin_bit_cast(float, (unsigned)h << 16); }
__device__ __forceinline__ v4u pack8f(const float* v) { v4u w; w.x = cvtpk(v[0], v[1]); w.y = cvtpk(v[2], v[3]); w.z = cvtpk(v[4], v[5]); w.w = cvtpk(v[6], v[7]); return w; }
__device__ __forceinline__ v4u pack8v(f32x4 a, f32x4 b) { v4u w; w.x = cvtpk(a[0], a[1]); w.y = cvtpk(a[2], a[3]); w.z = cvtpk(b[0], b[1]); w.w = cvtpk(b[2], b[3]); return w; }
__device__ __forceinline__ void unpack8(v4u w, float* v) { v[0] = bf_lo(w.x); v[1] = bf_hi(w.x); v[2] = bf_lo(w.y); v[3] = bf_hi(w.y); v[4] = bf_lo(w.z); v[5] = bf_hi(w.z); v[6] = bf_lo(w.w); v[7] = bf_hi(w.w); }
__device__ __forceinline__ float fexp(float x) { return __builtin_amdgcn_exp2f(x * 1.4426950408889634f); }
__device__ __forceinline__ float frcp(float x) { return __builtin_amdgcn_rcpf(x); }
__device__ __forceinline__ float flog(float x) { return __builtin_amdgcn_logf(x) * 0.6931471805599453f; }
__device__ __forceinline__ float ftanh(float x) { const float t = fexp(-2.f * fabsf(x)); const float r = (1.f - t) * frcp(1.f + t); return x < 0.f ? -r : r; }
__device__ __forceinline__ float fsigmoid(float x) { return frcp(1.f + fexp(-x)); }
__device__ __forceinline__ float frsq(float x) { return __builtin_amdgcn_rsqf(x); }
__device__ __forceinline__ float fsqrt(float x) { return __builtin_amdgcn_sqrtf(x); }
__device__ __forceinline__ void fsincos_big(float a, float& s, float& c) {
    const float k = __builtin_rintf(a * 0.15915494309189535f);
    float r = __builtin_fmaf(-k, 6.28125f, a); r = __builtin_fmaf(-k, 1.9353071795864769e-3f, r);
    const float rev = r * 0.15915494309189535f;
    s = __builtin_amdgcn_sinf(rev); c = __builtin_amdgcn_cosf(rev);
}
__device__ __forceinline__ float fsilu(float x) { return x * frcp(1.f + fexp(-x)); }
__device__ __forceinline__ float wave_sum(float v) {
#pragma unroll
    for (int o = 1; o < 64; o <<= 1) v += __shfl_xor(v, o);
    return v;
}

#define XB_TMO      128
#define XB_XCNT(j)  (256  + 64 * (j))
#define XB_XSUB(j)  (1280 + 64 * (j))
#define XB_XGEN(j)  (2304 + 64 * (j))
#define XB_TOP      3328
#define XB_TOPGEN   3392
#define XCD_BAR_WORDS 3456
#define XB_SPIN_CAP (1u << 18)

__device__ __forceinline__ unsigned xb_ld(unsigned* p)              { return __hip_atomic_load(p, __ATOMIC_RELAXED, __HIP_MEMORY_SCOPE_AGENT); }
__device__ __forceinline__ unsigned xb_add(unsigned* p, unsigned v) { return __hip_atomic_fetch_add(p, v, __ATOMIC_RELAXED, __HIP_MEMORY_SCOPE_AGENT); }
__device__ __forceinline__ unsigned xb_xcc_id() { return (unsigned)__builtin_amdgcn_s_getreg((3 << 11) | 20) & 0xFu; }
#define XB_SPIN(cond, bar) do { unsigned _sp = 0; while (cond) { __builtin_amdgcn_s_sleep(1); \
    if ((++_sp & 255u) == 0u) { if (xb_ld(&(bar)[XB_TMO])) break; if (_sp > XB_SPIN_CAP) { atomicAdd(&(bar)[XB_TMO], 1u); break; } } } } while (0)

struct XcdBarrier {
    unsigned* bar; unsigned x;
    volatile LAS unsigned* st;
};

__device__ __forceinline__ XcdBarrier xcd_barrier_post(unsigned* bar, volatile LAS unsigned* st) {
    XcdBarrier b; b.bar = bar; b.x = xb_xcc_id(); b.st = st;
    if (threadIdx.x == 0) (void)xb_add(&bar[XB_XCNT(b.x)], 1u);
    return b;
}
__device__ __forceinline__ void xcd_barrier_complete(unsigned* bar, unsigned x, unsigned& nloc, unsigned& nx) {
    const unsigned G = gridDim.x * gridDim.y * gridDim.z;
    unsigned sum, cnt, mine, sp = 0u;
    for (;;) {
        sum = 0u; cnt = 0u; mine = 0u;
#pragma unroll
        for (unsigned j = 0; j < 16; ++j) { const unsigned c = xb_ld(&bar[XB_XCNT(j)]); sum += c; cnt += (c > 0u) ? 1u : 0u; mine = (j == x) ? c : mine; }
        if (sum == G) break;
        __builtin_amdgcn_s_sleep(1);
        if ((++sp & 255u) == 0u) { if (xb_ld(&bar[XB_TMO])) break; if (sp > XB_SPIN_CAP) { atomicAdd(&bar[XB_TMO], 1u); break; } }
    }
    nloc = mine > 0u ? mine : 1u; nx = cnt > 0u ? cnt : 1u;
}

__device__ __forceinline__ void xcd_barrier(const XcdBarrier& b) {
    asm volatile("s_waitcnt vmcnt(0)" ::: "memory");
    __syncthreads();
    if (threadIdx.x == 0) {
        unsigned* bar = b.bar;
        __builtin_amdgcn_s_waitcnt(0);
        unsigned nloc = b.st[0], nx = b.st[1];
        if (nloc == 0u) { xcd_barrier_complete(bar, b.x, nloc, nx); b.st[0] = nloc; b.st[1] = nx; }
        const unsigned old = xb_add(&bar[XB_XSUB(b.x)], 1u);
        const unsigned gen = old / nloc;
        if (old + 1u == (gen + 1u) * nloc) {
            __builtin_amdgcn_fence(__ATOMIC_RELEASE, "agent");
            asm volatile("s_waitcnt vmcnt(0)" ::: "memory");
            const unsigned og = xb_add(&bar[XB_TOP], 1u);
            const unsigned tg = og / nx;
            if (og + 1u == (tg + 1u) * nx) xb_add(&bar[XB_TOPGEN], 1u);
            else XB_SPIN(xb_ld(&bar[XB_TOPGEN]) == tg, bar);
            __builtin_amdgcn_fence(__ATOMIC_ACQUIRE, "agent");
            xb_add(&bar[XB_XGEN(b.x)], 1u);
            asm volatile("s_waitcnt vmcnt(0)" ::: "memory");
        } else {
            XB_SPIN(xb_ld(&bar[XB_XGEN(b.x)]) == gen, bar);
            __builtin_amdgcn_fence(__ATOMIC_ACQUIRE, "agent");
            asm volatile("s_waitcnt vmcnt(0)" ::: "memory");
        }
    }
    __syncthreads();
}

struct Inputs {
    const float* x; const int* positions; const float* ffn_norm; const float* ffn_w_gate; const float* ffn_w_up; const float* ffn_w_down; const float* mix_norm; const float* final_norm;
    const float* mla_w_a; const float* mla_q_norm; const float* mla_w_qb; const float* mla_kv_norm; const float* mla_w_kvb; const float* mla_w_o;
    const float* ml_w_in; const float* ml_b_if; const float* ml_conv_w; const float* ml_conv_b; const float* ml_out_norm; const float* ml_w_o;
    const float* rw_mu; const float* rw_w_r; const float* rw_w_k; const float* rw_w_v; const float* rw_w0; const float* rw_w1; const float* rw_w2; const float* rw_a0; const float* rw_a1; const float* rw_a2;
    const float* rw_g1; const float* rw_g2; const float* rw_k_k; const float* rw_k_a; const float* rw_r_k; const float* rw_ln_w; const float* rw_ln_b; const float* rw_w_o;
};
struct Args { Inputs in; float* out; unsigned char* ws; int ph_lo, ph_hi; };

struct Frame {
    LAS unsigned char* lds;
    gu32* ctl;
    int tid, lane, wave, G, gw, NGW;
    float* X;
    bf16* XB;
    float* SS;
    unsigned char* ws;
};

__device__ __forceinline__ void cv_item(const float* Wp, int ld, int ks0, const float* g1, const float* g2, bf16* dst, int ldd, int kd0, int n0, LAS float* scr, int lane) {
    const int nl = lane & 31, kh = lane >> 5;
#pragma unroll 8
    for (int i = 0; i < 32; ++i) { const int kk = 2 * i + kh, k = ks0 + kk; float v = 0.f;
        if (Wp) { v = Wp[(size_t)k * ld]; if (g1) v *= g1[k]; if (g2) v *= g2[k]; }
        scr[kk * 33 + nl] = v; }
    LDS_WAIT(); asm volatile("" ::: "memory");
    const int c = lane & 7;
#pragma unroll
    for (int j = 0; j < 4; ++j) { const int n = (lane >> 3) + 8 * j; const LAS float* s = scr + (8 * c) * 33 + n;
        v4u o; o.x = cvtpk(s[0 * 33], s[1 * 33]); o.y = cvtpk(s[2 * 33], s[3 * 33]); o.z = cvtpk(s[4 * 33], s[5 * 33]); o.w = cvtpk(s[6 * 33], s[7 * 33]);
        *(GAS v4u*)(dst + (size_t)(n0 + n) * ldd + kd0 + 8 * c) = o; }
    LDS_WAIT(); asm volatile("" ::: "memory");
}

__device__ __forceinline__ void conv_layer(Frame& F, const Inputs& in, int layer) {
    LAS float* scr = (LAS float*)(F.lds + F.wave * 16384);
    bf16* WB = (bf16*)(F.ws + WS_W);
    const int kind = layer % 3, j = layer / 3, lane = F.lane, nl = lane & 31;
    constexpr int I_GU = (D / 64) * (2 * FF / 32), I_DN = (FF / 64) * (D / 32);
    constexpr int I_FFN = 2 * (I_GU + I_DN);
    constexpr int I_MLA = (1024 / 64) * (1024 / 32) + (512 / 64) * (1536 / 32) + (256 / 64) * (2048 / 32) + (1024 / 64) * (1024 / 32);
    constexpr int I_ML = (1024 / 64) * (3328 / 32) + (1024 / 64) * (1024 / 32);
    constexpr int I_RW = (2048 / 64) * (3328 / 32) + (256 / 64) * (3072 / 32) + (1024 / 64) * (1024 / 32);
    const int n_items = I_FFN + (kind == 0 ? I_MLA : kind == 1 ? I_ML : I_RW);
    for (int it = F.gw; it < n_items; it += F.NGW) {
        int r = it;
        if (r < I_FFN) {
            const int half = r / (I_GU + I_DN); r -= half * (I_GU + I_DN);
            const size_t wsel = (size_t)(layer * 2 + half);
            if (r < I_GU) {
                const int nb = r % (2 * FF / 32), kb = r / (2 * FF / 32), n = nb * 32 + nl, tile = n >> 8, w = n & 255;
                const float* W = (w < 128 ? in.ffn_w_gate : in.ffn_w_up) + wsel * D * FF + (tile * 128 + (w & 127));
                cv_item(W, FF, kb * 64, in.ffn_norm + wsel * D, nullptr, WB + (half ? WO_GU1 : WO_GU0), D, kb * 64, nb * 32, scr, lane);
            } else { r -= I_GU;
                const int nb = r % (D / 32), kb = r / (D / 32), n = nb * 32 + nl;
                cv_item(in.ffn_w_down + wsel * FF * D + n, D, kb * 64, nullptr, nullptr, WB + (half ? WO_D1 : WO_D0), FF, kb * 64, nb * 32, scr, lane);
            }
            continue;
        }
        r -= I_FFN;
        if (kind == 0) {
            const float* gmix = in.mix_norm + (size_t)layer * D;
            if (r < 16 * 32) {
                const int nb = r % 32, kb = r / 32, n = nb * 32 + nl; int col = n;
                if (n >= 768 && n < 832) { const int jj = n - 768; col = 768 + (jj >> 1) + 32 * (jj & 1); }
                const float* W = (n < LATN) ? in.mla_w_a + (size_t)j * D * LATN + col : nullptr;
                cv_item(W, LATN, kb * 64, gmix, nullptr, WB + WM_A, 1024, kb * 64, nb * 32, scr, lane); continue; }
            r -= 16 * 32;
            if (r < 8 * 48) {
                const int nb = r % 48, kb = r / 48, n = nb * 32 + nl, hd = n / DQK, w = n - hd * DQK; int col = n;
                if (w >= NOPE) { const int jj = w - NOPE; col = hd * DQK + NOPE + (jj >> 1) + 32 * (jj & 1); }
                cv_item(in.mla_w_qb + (size_t)j * QRANK * 1536 + col, 1536, kb * 64, in.mla_q_norm + (size_t)j * QRANK, nullptr, WB + WM_QB, 512, kb * 64, nb * 32, scr, lane); continue; }
            r -= 8 * 48;
            if (r < 4 * 64) {
                const int nb = r % 64, kb = r / 64, n = nb * 32 + nl;
                cv_item(in.mla_w_kvb + (size_t)j * KVRANK * 2048 + n, 2048, kb * 64, in.mla_kv_norm + (size_t)j * KVRANK, nullptr, WB + WM_KVB, 256, kb * 64, nb * 32, scr, lane); continue; }
            r -= 4 * 64;
            { const int nb = r % 32, kb = r / 32, n = nb * 32 + nl;
              cv_item(in.mla_w_o + (size_t)j * 1024 * 1024 + n, 1024, kb * 64, nullptr, nullptr, WB + WM_O, 1024, kb * 64, nb * 32, scr, lane); }
        } else if (kind == 1) {
            const float* gmix = in.mix_norm + (size_t)layer * D;
            if (r < 16 * 104) {
                const int nb = r % 104, kb = r / 104, n = nb * 32 + nl;
                const float* W = (n < ML_NIN) ? in.ml_w_in + (size_t)j * D * ML_NIN + n : nullptr;
                cv_item(W, ML_NIN, kb * 64, gmix, nullptr, WB + WL_IN, 1024, kb * 64, nb * 32, scr, lane); continue; }
            r -= 16 * 104;
            { const int nb = r % 32, kb = r / 32, n = nb * 32 + nl;
              cv_item(in.ml_w_o + (size_t)j * 1024 * 1024 + n, 1024, kb * 64, nullptr, nullptr, WB + WL_O, 1024, kb * 64, nb * 32, scr, lane); }
        } else {
            const float* gmix = in.mix_norm + (size_t)layer * D;
            const float* mu = in.rw_mu + (size_t)j * 6 * D;
            if (r < 32 * 104) {
                const int nb = r % 104, kb = r / 104, n = nb * 32 + nl; const float* W; int ld; const float* m;
                if (n < 1024) { W = in.rw_w_r + (size_t)j * D * D + n; ld = D; m = mu + 0 * D; }
                else if (n < 2048) { W = in.rw_w_k + (size_t)j * D * D + (n - 1024); ld = D; m = mu + 2 * D; }
                else if (n < 3072) { W = in.rw_w_v + (size_t)j * D * D + (n - 2048); ld = D; m = mu + 3 * D; }
                else if (n < 3136) { W = in.rw_w1 + (size_t)j * D * 64 + (n - 3072); ld = 64; m = mu + 1 * D; }
                else if (n < 3200) { W = in.rw_a1 + (size_t)j * D * 64 + (n - 3136); ld = 64; m = mu + 4 * D; }
                else { W = in.rw_g1 + (size_t)j * D * 128 + (n - 3200); ld = 128; m = mu + 5 * D; }
                const int ks0 = (kb & 15) * 64;
                cv_item(W, ld, ks0, gmix, (kb >= 16) ? m : nullptr, WB + WR_BIG, 2048, kb * 64, nb * 32, scr, lane); continue; }
            r -= 32 * 104;
            if (r < 4 * 96) {
                const int nb = r % 96, kb = r / 96, n = nb * 32 + nl; const float* W = nullptr; int ld = 1024, ks0 = 0;
                if (n < 1024) { if (kb == 0) { W = in.rw_w2 + (size_t)j * 64 * D + n; ks0 = 0; } }
                else if (n < 2048) { if (kb == 1) { W = in.rw_a2 + (size_t)j * 64 * D + (n - 1024); ks0 = 0; } }
                else { if (kb >= 2) { W = in.rw_g2 + (size_t)j * 128 * D + (n - 2048); ks0 = (kb - 2) * 64; } }
                cv_item(W, ld, ks0, nullptr, nullptr, WB + WR_UP, 256, kb * 64, nb * 32, scr, lane); continue; }
            r -= 4 * 96;
            { const int nb = r % 32, kb = r / 32, n = nb * 32 + nl;
              cv_item(in.rw_w_o + (size_t)j * 1024 * 1024 + n, 1024, kb * 64, nullptr, nullptr, WB + WR_O, 1024, kb * 64, nb * 32, scr, lane); }
        }
    }
}

__device__ __forceinline__ void prologue(Frame& F, const Inputs& in) {
    for (int m = F.gw; m < T; m += F.NGW) {
        const GAS f32x4* xr = (const GAS f32x4*)(in.x + (size_t)m * D) + F.lane;
        GAS f32x4* xo = (GAS f32x4*)(F.X + (size_t)m * D) + F.lane;
        GAS v2u* xb = (GAS v2u*)(F.XB + (size_t)m * D) + F.lane;
        float s = 0.f;
#pragma unroll
        for (int jj = 0; jj < 4; ++jj) { const f32x4 v = xr[64 * jj]; xo[64 * jj] = v; s += (v.x * v.x + v.y * v.y) + (v.z * v.z + v.w * v.w);
            v2u w; w.x = cvtpk(v.x, v.y); w.y = cvtpk(v.z, v.w); xb[64 * jj] = w; }
        s = wave_sum(s);
        if (F.lane < 16) F.SS[(size_t)m * 16 + F.lane] = (F.lane == 0) ? s : 0.f;
    }
    float* COS = (float*)(F.ws + WS_COS); float* SIN = (float*)(F.ws + WS_SIN);
    for (int e = F.gw * 64 + F.lane; e < T * 32; e += F.NGW * 64) {
        const int t = e >> 5, i = e & 31;
        const float inv_freq = __builtin_amdgcn_exp2f(-(float)i * 0.41524101186092029f);
        const float ang = (float)in.positions[t] * inv_freq;
        float sn, cs; fsincos_big(ang, sn, cs);
        COS[e] = cs; SIN[e] = sn;
    }
}

__device__ __forceinline__ float rstd16(const float* SS, int row) {
    const GAS f32x4* p = (const GAS f32x4*)(SS + (size_t)row * 16);
    const f32x4 a = p[0], b = p[1], c = p[2], d = p[3];
    const float s = ((a.x + a.y) + (a.z + a.w)) + ((b.x + b.y) + (b.z + b.w)) + ((c.x + c.y) + (c.z + c.w)) + ((d.x + d.y) + (d.z + d.w));
    return frsq(s * (1.f / D) + RMS_EPS);
}

#define EPI_ROWS(ai, m) (u.pm * 256 + (ai) * 128 + wr * 64 + (m) * 16 + fr)
typedef const f32x4 (&AccT)[2][2][4][2];
using pg8::Unit;

struct EpiSwiGLU { static constexpr bool PERM = true, AFTER_DRAIN = false; const float* SS; bf16* ACT;
    __device__ __forceinline__ void operator()(AccT acc, const Unit& u, int wr, int wc, int fr, int fq) const {
        const int col = u.pn * 128 + wc * 32 + fq * 8;
#pragma unroll
        for (int ai = 0; ai < 2; ++ai)
#pragma unroll
            for (int m = 0; m < 4; ++m) { asm volatile("" ::: "memory"); const int row = EPI_ROWS(ai, m); const float r = rstd16(SS, row);
                float o[8];
#pragma unroll
                for (int n = 0; n < 2; ++n)
#pragma unroll
                    for (int e = 0; e < 4; ++e) { const float g = acc[ai][0][m][n][e] * r, up = acc[ai][1][m][n][e] * r; o[4 * n + e] = fsilu(g) * up; }
                *(GAS v4u*)(ACT + (size_t)row * FF + col) = pack8f(o); }
    }
};
struct EpiResidual { static constexpr bool PERM = true, AFTER_DRAIN = false; float* X; bf16* XB; float* SS; float scale;
    __device__ __forceinline__ void operator()(AccT acc, const Unit& u, int wr, int wc, int fr, int fq) const {
#pragma unroll
        for (int ai = 0; ai < 2; ++ai)
#pragma unroll
            for (int m = 0; m < 4; ++m) { asm volatile("" ::: "memory"); const int row = EPI_ROWS(ai, m); float ss = 0.f;
#pragma unroll
                for (int bj = 0; bj < 2; ++bj) { const int col = u.pn * 256 + bj * 128 + wc * 32 + fq * 8;
                    GAS f32x4* xp = (GAS f32x4*)(X + (size_t)row * D + col);
                    f32x4 x0 = xp[0], x1 = xp[1];
                    x0 = x0 + acc[ai][bj][m][0] * scale; x1 = x1 + acc[ai][bj][m][1] * scale;
                    xp[0] = x0; xp[1] = x1;
                    *(GAS v4u*)(XB + (size_t)row * D + col) = pack8v(x0, x1);
                    ss += (x0.x * x0.x + x0.y * x0.y) + (x0.z * x0.z + x0.w * x0.w) + (x1.x * x1.x + x1.y * x1.y) + (x1.z * x1.z + x1.w * x1.w); }
                ss += __shfl_xor(ss, 16); ss += __shfl_xor(ss, 32);
                if (fq == 0) SS[(size_t)row * 16 + u.pn * 4 + wc] = ss; }
    }
};
__device__ __forceinline__ void rope8(float* v, const float* COS, const float* SIN, int row, int p0) {
    const f32x4 c = *(const GAS f32x4*)(COS + (size_t)row * 32 + p0), s = *(const GAS f32x4*)(SIN + (size_t)row * 32 + p0);
#pragma unroll
    for (int p = 0; p < 4; ++p) { const float x1 = v[2 * p], x2 = v[2 * p + 1]; v[2 * p] = x1 * c[p] - x2 * s[p]; v[2 * p + 1] = x1 * s[p] + x2 * c[p]; }
}
struct EpiMlaA { static constexpr bool PERM = true, AFTER_DRAIN = false; const float* SS; bf16* LAT; float* SSQ; float* SSKV; bf16* KPE; const float* COS; const float* SIN;
    __device__ __forceinline__ void operator()(AccT acc, const Unit& u, int wr, int wc, int fr, int fq) const {
#pragma unroll
        for (int ai = 0; ai < 2; ++ai)
#pragma unroll
            for (int m = 0; m < 4; ++m) { asm volatile("" ::: "memory"); const int row = EPI_ROWS(ai, m); const float r = rstd16(SS, row); float ss = 0.f;
#pragma unroll
                for (int bj = 0; bj < 2; ++bj) { const int col = u.pn * 256 + bj * 128 + wc * 32 + fq * 8;
                    float v[8];
#pragma unroll
                    for (int n = 0; n < 2; ++n)
#pragma unroll
                        for (int e = 0; e < 4; ++e) { v[4 * n + e] = acc[ai][bj][m][n][e] * r; ss += v[4 * n + e] * v[4 * n + e]; }
                    *(GAS v4u*)(LAT + (size_t)row * 1024 + col) = pack8f(v);
                    if (u.pn == 3 && bj == 0 && wc < 2) { rope8(v, COS, SIN, row, wc * 16 + fq * 4); *(GAS v4u*)(KPE + (size_t)row * 64 + wc * 32 + fq * 8) = pack8f(v); } }
                ss += __shfl_xor(ss, 16); ss += __shfl_xor(ss, 32);
                if (fq == 0) { if (u.pn < 2) SSQ[(size_t)row * 8 + u.pn * 4 + wc] = ss; else if (u.pn == 2) SSKV[(size_t)row * 4 + wc] = ss; } }
    }
};
struct EpiMlaQ { static constexpr bool PERM = true, AFTER_DRAIN = false; const float* SSQ; bf16* Q; const float* COS; const float* SIN; float qscale;
    __device__ __forceinline__ void operator()(AccT acc, const Unit& u, int wr, int wc, int fr, int fq) const {
#pragma unroll
        for (int ai = 0; ai < 2; ++ai)
#pragma unroll
            for (int m = 0; m < 4; ++m) { asm volatile("" ::: "memory"); const int row = EPI_ROWS(ai, m);
                const GAS f32x4* p = (const GAS f32x4*)(SSQ + (size_t)row * 8); const f32x4 a = p[0], b = p[1];
                const float r = frsq((((a.x + a.y) + (a.z + a.w)) + ((b.x + b.y) + (b.z + b.w))) * (1.f / QRANK) + RMS_EPS) * qscale;
#pragma unroll
                for (int bj = 0; bj < 2; ++bj) { const int col = u.pn * 256 + bj * 128 + wc * 32 + fq * 8, hd = col / DQK, w = col - hd * DQK;
                    float v[8];
#pragma unroll
                    for (int n = 0; n < 2; ++n)
#pragma unroll
                        for (int e = 0; e < 4; ++e) v[4 * n + e] = acc[ai][bj][m][n][e] * r;
                    if (w >= NOPE) rope8(v, COS, SIN, row, (w - NOPE) >> 1);
                    *(GAS v4u*)(Q + (size_t)row * 1536 + col) = pack8f(v); } }
    }
};
struct EpiMlaKV { static constexpr bool PERM = true, AFTER_DRAIN = false; const float* SSKV; bf16* KV;
    __device__ __forceinline__ void operator()(AccT acc, const Unit& u, int wr, int wc, int fr, int fq) const {
#pragma unroll
        for (int ai = 0; ai < 2; ++ai)
#pragma unroll
            for (int m = 0; m < 4; ++m) { asm volatile("" ::: "memory"); const int row = EPI_ROWS(ai, m);
                const f32x4 a = *(const GAS f32x4*)(SSKV + (size_t)row * 4);
                const float r = frsq(((a.x + a.y) + (a.z + a.w)) * (1.f / KVRANK) + RMS_EPS);
#pragma unroll
                for (int bj = 0; bj < 2; ++bj) { const int col = u.pn * 256 + bj * 128 + wc * 32 + fq * 8;
                    *(GAS v4u*)(KV + (size_t)row * 2048 + col) = pack8v(acc[ai][bj][m][0] * r, acc[ai][bj][m][1] * r); } }
    }
};
struct EpiMlIn { static constexpr bool PERM = true, AFTER_DRAIN = false; const float* SS; bf16* P; float* GATES;
    __device__ __forceinline__ void operator()(AccT acc, const Unit& u, int wr, int wc, int fr, int fq) const {
#pragma unroll
        for (int ai = 0; ai < 2; ++ai)
#pragma unroll
            for (int m = 0; m < 4; ++m) { asm volatile("" ::: "memory"); const int row = EPI_ROWS(ai, m); const float r = rstd16(SS, row);
                if (u.pn < 12) {
#pragma unroll
                    for (int bj = 0; bj < 2; ++bj) { const int col = u.pn * 256 + bj * 128 + wc * 32 + fq * 8;
                        *(GAS v4u*)(P + (size_t)row * 3072 + col) = pack8v(acc[ai][bj][m][0] * r, acc[ai][bj][m][1] * r); }
                } else if (wc == 0 && fq < 2) {
                    GAS f32x4* g = (GAS f32x4*)(GATES + (size_t)row * 16 + fq * 8); g[0] = acc[ai][0][m][0] * r; g[1] = acc[ai][0][m][1] * r; } }
    }
};
struct EpiRwBig { static constexpr bool PERM = true, AFTER_DRAIN = false; bf16* RKV; bf16* LOR;
    __device__ __forceinline__ void operator()(AccT acc, const Unit& u, int wr, int wc, int fr, int fq) const {
#pragma unroll
        for (int ai = 0; ai < 2; ++ai)
#pragma unroll
            for (int m = 0; m < 4; ++m) { asm volatile("" ::: "memory"); const int row = EPI_ROWS(ai, m);
#pragma unroll
                for (int bj = 0; bj < 2; ++bj) { const int cl = bj * 128 + wc * 32 + fq * 8;
                    if (u.pn < 12) { *(GAS v4u*)(RKV + (size_t)row * 3072 + u.pn * 256 + cl) = pack8v(acc[ai][bj][m][0], acc[ai][bj][m][1]); }
                    else { float v[8];
#pragma unroll
                        for (int n = 0; n < 2; ++n)
#pragma unroll
                            for (int e = 0; e < 4; ++e) { const float a = acc[ai][bj][m][n][e]; v[4 * n + e] = (cl < 64) ? ftanh(a) : (cl < 128) ? a : fsigmoid(a); }
                        *(GAS v4u*)(LOR + (size_t)row * 256 + cl) = pack8f(v); } } }
    }
};
struct EpiRwUp { static constexpr bool PERM = true, AFTER_DRAIN = false; float* LW; bf16* AA; bf16* GG; const float* w0; const float* a0;
    __device__ __forceinline__ void operator()(AccT acc, const Unit& u, int wr, int wc, int fr, int fq) const {
        const int sec = u.pn >> 2;
#pragma unroll
        for (int ai = 0; ai < 2; ++ai)
#pragma unroll
            for (int m = 0; m < 4; ++m) { asm volatile("" ::: "memory"); const int row = EPI_ROWS(ai, m);
#pragma unroll
                for (int bj = 0; bj < 2; ++bj) { const int col = (u.pn & 3) * 256 + bj * 128 + wc * 32 + fq * 8;
                    if (sec == 0) {
#pragma unroll
                        for (int n = 0; n < 2; ++n) { const f32x4 b = *(const GAS f32x4*)(w0 + col + 4 * n); f32x4 o;
#pragma unroll
                            for (int e = 0; e < 4; ++e) { const float z = -(acc[ai][bj][m][n][e] + b[e]); const float sp = fmaxf(z, 0.f) + flog(1.f + fexp(-fabsf(z))); o[e] = -fexp(-sp - 0.5f); }
                            *(GAS f32x4*)(LW + (size_t)row * 1024 + col + 4 * n) = o; } }
                    else if (sec == 1) { const f32x4 b0 = *(const GAS f32x4*)(a0 + col), b1 = *(const GAS f32x4*)(a0 + col + 4); float v[8];
#pragma unroll
                        for (int e = 0; e < 4; ++e) { v[e] = fsigmoid(acc[ai][bj][m][0][e] + b0[e]); v[4 + e] = fsigmoid(acc[ai][bj][m][1][e] + b1[e]); }
                        *(GAS v4u*)(AA + (size_t)row * 1024 + col) = pack8f(v); }
                    else { *(GAS v4u*)(GG + (size_t)row * 1024 + col) = pack8v(acc[ai][bj][m][0], acc[ai][bj][m][1]); } } }
    }
};

namespace att {
constexpr int SHM_K = 64 * DQK * 2  , SHM_V = 64 * DVH * 2  ;
constexpr int OFF_V = 0, OFF_K = 2 * SHM_V, OFF_WS = OFF_K + 2 * SHM_K, ATT_LDS = OFF_WS + NWAVES * 64 * 4;
static_assert(ATT_LDS <= RING_BYTES, "attention LDS");
#define KSWZ(row, colB) ((row) * 384 + ((colB) ^ (((row) & 7) << 4)))
#define SBAR() __builtin_amdgcn_sched_barrier(0)
__device__ __forceinline__ int v_st(int k, int c) { const int kk = (k & ~0xC) | ((k & 4) << 1) | ((k & 8) >> 1); return ((kk >> 3) * 4 + (c >> 5)) * 512 + ((kk & 7) * 32 + (c & 31)) * 2; }
__device__ __forceinline__ int v_rd_base(int lane) { return ((lane & 3) << 3) | (((lane >> 2) & 3) << 6) | (((lane >> 4) & 1) << 5) | (((lane >> 5) & 1) << 8); }
constexpr int v_rd_off(int d0, int ks, int half) { return d0 * 512 + ks * 4096 + half * 2048; }
__device__ __forceinline__ int crow(int r, int hi) { return (r & 3) + 8 * (r >> 2) + 4 * hi; }
__device__ __forceinline__ void mask_tile(f32x16& p0, f32x16& p1, int dq) {
    const float NEG = -__builtin_inff();
#pragma unroll
    for (int r = 0; r < 16; ++r) { const int c = (r & 3) + 8 * (r >> 2);
        if (dq - c < 0) p0[r] = NEG;
        if (dq - c - 32 < 0) p1[r] = NEG; }
}
constexpr float THR2 = 11.5f;
__device__ __forceinline__ void partialSM(f32x16& p0, f32x16& p1, float& m_reg, float& alpha) {
    float pmax = p0[0];
#pragma unroll
    for (int r = 1; r < 16; ++r) pmax = fmaxf(pmax, p0[r]);
#pragma unroll
    for (int r = 0; r < 16; ++r) pmax = fmaxf(pmax, p1[r]);
    { auto rr = __builtin_amdgcn_permlane32_swap(__float_as_uint(pmax), __float_as_uint(pmax), false, false);
      pmax = fmaxf(__uint_as_float(rr[0]), __uint_as_float(rr[1])); }
    float mn;
    if (__builtin_expect(__all((pmax - m_reg) <= THR2), 1)) { mn = m_reg; alpha = 1.f; }
    else { mn = fmaxf(m_reg, pmax); alpha = __builtin_amdgcn_exp2f(m_reg - mn); m_reg = mn; }
#pragma unroll
    for (int r = 0; r < 16; ++r) { p0[r] = __builtin_amdgcn_exp2f(p0[r] - mn); p1[r] = __builtin_amdgcn_exp2f(p1[r] - mn); }
}
__device__ __forceinline__ void finishSM(f32x16& p0, f32x16& p1, float alpha, float& l_reg, bf16x8& pa0, bf16x8& pa1, bf16x8& pa2, bf16x8& pa3) {
    float ps = 0;
#pragma unroll
    for (int r = 0; r < 16; ++r) ps += p0[r];
#pragma unroll
    for (int r = 0; r < 16; ++r) ps += p1[r];
    { auto rr = __builtin_amdgcn_permlane32_swap(__float_as_uint(ps), __float_as_uint(ps), false, false);
      ps = __uint_as_float(rr[0]) + __uint_as_float(rr[1]); }
    l_reg = l_reg * alpha + ps;
#define PK4(P, B_, OUT) do { unsigned a0 = cvtpk(P[B_+0], P[B_+1]), a1 = cvtpk(P[B_+2], P[B_+3]);                          \
        unsigned b0 = cvtpk(P[B_+4], P[B_+5]), b1 = cvtpk(P[B_+6], P[B_+7]);                                             \
        auto r0 = __builtin_amdgcn_permlane32_swap(a0, b0, false, false); auto r1 = __builtin_amdgcn_permlane32_swap(a1, b1, false, false); \
        v4u w = {r0[0], r1[0], r0[1], r1[1]}; OUT = __builtin_bit_cast(bf16x8, w); } while (0)
    PK4(p0, 0, pa0); PK4(p0, 8, pa1); PK4(p1, 0, pa2); PK4(p1, 8, pa3);
#undef PK4
}
__device__ __forceinline__ void qkt(f32x16& p0, f32x16& p1, const LAS char* Kb, int r32, int hi, const bf16x8* qr) {
    p0 = f32x16{}; p1 = f32x16{};
    const LAS char* kb[4];
#pragma unroll
    for (int dd = 0; dd < 4; ++dd) kb[dd] = Kb + r32 * 384 + ((dd * 32 + hi * 16) ^ ((r32 & 7) << 4));
#pragma unroll
    for (int d0 = 0; d0 < 12; ++d0) { const LAS char* a = kb[d0 & 3] + (d0 >> 2) * 128;
        const bf16x8 b0 = *(const LAS bf16x8*)(a);
        const bf16x8 b1 = *(const LAS bf16x8*)(a + 32 * 384);
        p0 = __builtin_amdgcn_mfma_f32_32x32x16_bf16(b0, qr[d0], p0, 0, 0, 0);
        p1 = __builtin_amdgcn_mfma_f32_32x32x16_bf16(b1, qr[d0], p1, 0, 0, 0); }
}
__device__ __forceinline__ void pv_tile(f32x16* o, int vb0, bf16x8 pa0, bf16x8 pa1, bf16x8 pa2, bf16x8 pa3) {
#define TRRD(dst, off) asm volatile("ds_read_b64_tr_b16 %0, %1 offset:%2" : "=&v"(dst) : "v"(vb0), "i"(off) : "memory")
#define PV_D0(d0) do { s16x4 l0, l1, l2, l3, h0, h1, h2, h3; constexpr int b_ = v_rd_off(d0, 0, 0); \
        TRRD(l0, b_); TRRD(h0, b_ + 2048); TRRD(l1, b_ + 4096); TRRD(h1, b_ + 6144); TRRD(l2, b_ + 8192); TRRD(h2, b_ + 10240); TRRD(l3, b_ + 12288); TRRD(h3, b_ + 14336); \
        asm volatile("s_waitcnt lgkmcnt(0)" ::: "memory"); SBAR(); \
        o[d0] = __builtin_amdgcn_mfma_f32_32x32x16_bf16(pa0, (bf16x8){l0[0], l0[1], l0[2], l0[3], h0[0], h0[1], h0[2], h0[3]}, o[d0], 0, 0, 0);   \
        o[d0] = __builtin_amdgcn_mfma_f32_32x32x16_bf16(pa1, (bf16x8){l1[0], l1[1], l1[2], l1[3], h1[0], h1[1], h1[2], h1[3]}, o[d0], 0, 0, 0);   \
        o[d0] = __builtin_amdgcn_mfma_f32_32x32x16_bf16(pa2, (bf16x8){l2[0], l2[1], l2[2], l2[3], h2[0], h2[1], h2[2], h2[3]}, o[d0], 0, 0, 0);   \
        o[d0] = __builtin_amdgcn_mfma_f32_32x32x16_bf16(pa3, (bf16x8){l3[0], l3[1], l3[2], l3[3], h3[0], h3[1], h3[2], h3[3]}, o[d0], 0, 0, 0); } while (0)
    PV_D0(0); PV_D0(1); PV_D0(2); PV_D0(3);
#undef PV_D0
#undef TRRD
}
__device__ __forceinline__ void attn_unit(int wid, int b, int h, int qb, const bf16* Q, const bf16* KV, const bf16* KPE, bf16* O, LAS char* lds) {
    const int lane = fresh_lane(), tid = wid * 64 + lane, r32 = lane & 31, hi = lane >> 5;
    const size_t rowbase = (size_t)b * SEQ; const int q0 = qb * 256;
    LAS char* V_lds = lds + OFF_V; LAS char* K_lds = lds + OFF_K;
    LAS float* wsf = (LAS float*)(lds + OFF_WS) + wid * 64; LAS float* li_l = wsf; LAS float* al_l = wsf + 32;
    bf16x8 qr[12];
    { const bf16* Qw = Q + (rowbase + q0 + wid * 32 + r32) * 1536 + h * DQK + hi * 8;
#pragma unroll
      for (int d0 = 0; d0 < 12; ++d0) qr[d0] = *(const GAS bf16x8*)(Qw + d0 * 16); }
    const int NT = 4 * (qb + 1);
    const bf16* ksrc[3]; int kdst[3]; int kstr[3];
#pragma unroll
    for (int i = 0; i < 3; ++i) { const int id = tid + 512 * i, row = id / 24, ch = id - row * 24;
        if (ch < 16) { ksrc[i] = KV + (rowbase + row) * 2048 + h * 256 + ch * 8; kstr[i] = 2048; }
        else { ksrc[i] = KPE + (rowbase + row) * 64 + (ch - 16) * 8; kstr[i] = 64; }
        kdst[i] = KSWZ(row, ch * 16); }
    const int sr = tid >> 4, sc = (tid & 15) * 8;
    const bf16* vsrc = KV + (rowbase + sr) * 2048 + h * 256 + 128 + sc;
    const int vst0 = v_st(sr, sc), vst1 = v_st(32 + sr, sc);
    const int vb0 = (int)(uintptr_t)V_lds + v_rd_base(lane);
    bf16x8 sk0, sk1, sk2, sv0, sv1;
#define SLOAD(t) do { sk0 = *(const GAS bf16x8*)(ksrc[0] + (size_t)(t) * 64 * kstr[0]); sk1 = *(const GAS bf16x8*)(ksrc[1] + (size_t)(t) * 64 * kstr[1]); sk2 = *(const GAS bf16x8*)(ksrc[2] + (size_t)(t) * 64 * kstr[2]); \
                      sv0 = *(const GAS bf16x8*)(vsrc + (size_t)(t) * 64 * 2048); sv1 = *(const GAS bf16x8*)(vsrc + (size_t)((t) * 64 + 32) * 2048); } while (0)
#define SWRITE(bf) do { *(LAS bf16x8*)(K_lds + (bf) * SHM_K + kdst[0]) = sk0; *(LAS bf16x8*)(K_lds + (bf) * SHM_K + kdst[1]) = sk1; *(LAS bf16x8*)(K_lds + (bf) * SHM_K + kdst[2]) = sk2; \
                        *(LAS bf16x8*)(V_lds + (bf) * SHM_V + vst0) = sv0; *(LAS bf16x8*)(V_lds + (bf) * SHM_V + vst1) = sv1; } while (0)
    float m_reg = -1e30f, l_reg = 0.f; f32x16 o[4] = {};
    const int qlo = q0 + wid * 32, qm = qlo + r32 - 4 * hi;
    SLOAD(0); SWRITE(0);
    __syncthreads();
    for (int t = 0; t < NT; ++t) {
        const int bf = t & 1;
        if (t + 1 < NT) SLOAD(t + 1);
        f32x16 p0, p1; float alpha; bf16x8 pa0, pa1, pa2, pa3;
        SBAR();
        qkt(p0, p1, K_lds + bf * SHM_K, r32, hi, qr);
        const int kb = t * 64;
        if (kb + 63 > qlo) mask_tile(p0, p1, qm - kb);
        partialSM(p0, p1, m_reg, alpha);
        if (__any(alpha < 1.f)) { if (hi == 0) al_l[r32] = alpha; LDS_WAIT();
#pragma unroll
            for (int d_ = 0; d_ < 4; ++d_)
#pragma unroll
                for (int r = 0; r < 16; ++r) o[d_][r] *= al_l[crow(r, hi)]; }
        finishSM(p0, p1, alpha, l_reg, pa0, pa1, pa2, pa3);
        SBAR();
        pv_tile(o, vb0 + bf * SHM_V, pa0, pa1, pa2, pa3);
        if (t + 1 < NT) SWRITE(bf ^ 1);
        __syncthreads();
    }
    if (hi == 0) li_l[r32] = l_reg; LDS_WAIT();
    bf16* Ow = O + (rowbase + q0 + wid * 32) * 1024 + h * DVH;
#pragma unroll
    for (int r = 0; r < 16; ++r) { const int orow = crow(r, hi); const float rl = frcp(li_l[orow]);
#pragma unroll
        for (int d0 = 0; d0 < 4; ++d0) { const float v = o[d0][r] * rl; const float vn = __shfl_xor(v, 1);
            if ((r32 & 1) == 0) *(GAS unsigned*)(Ow + (size_t)orow * 1024 + d0 * 32 + r32) = cvtpk(v, vn); } }
    __syncthreads();
#undef SLOAD
#undef SWRITE
}
#undef KSWZ
}

__device__ __forceinline__ void ml_conv_phase(Frame& F, const Inputs& in, int j) {
    const bf16* P = (const bf16*)(F.ws + WS_ARENA + A_P); const float* GATES = (const float*)(F.ws + WS_ARENA + A_GATES);
    float* QKC = (float*)(F.ws + WS_ARENA + A_QKC); float* IGLF = (float*)(F.ws + WS_ARENA + A_IGLF);
    const float* cw = in.ml_conv_w + (size_t)j * 4 * 1024; const float* cb = in.ml_conv_b + (size_t)j * 1024; const float* bif = in.ml_b_if + (size_t)j * 16;
    const int gt = F.gw * 64 + F.lane, NT_ = F.NGW * 64;
    for (int e = gt; e < T * 128; e += NT_) {
        const int t = e >> 7, c = (e & 127) * 8, s = t & (SEQ - 1);
        float acc[8];
        { const f32x4 b0 = *(const GAS f32x4*)(cb + c), b1 = *(const GAS f32x4*)(cb + c + 4);
#pragma unroll
          for (int q = 0; q < 4; ++q) { acc[q] = b0[q]; acc[4 + q] = b1[q]; } }
#pragma unroll
        for (int k = 0; k < 4; ++k) { const int dt = 3 - k;
            if (s - dt >= 0) { float pv[8]; unpack8(*(const GAS v4u*)(P + (size_t)(t - dt) * 3072 + c), pv);
                const f32x4 w0 = *(const GAS f32x4*)(cw + k * 1024 + c), w1 = *(const GAS f32x4*)(cw + k * 1024 + c + 4);
#pragma unroll
                for (int q = 0; q < 4; ++q) { acc[q] += w0[q] * pv[q]; acc[4 + q] += w1[q] * pv[4 + q]; } } }
        const float sc = (c >= 512) ? 0.125f : 1.f;
        f32x4 o0, o1;
#pragma unroll
        for (int q = 0; q < 4; ++q) { o0[q] = fsilu(acc[q]) * sc; o1[q] = fsilu(acc[4 + q]) * sc; }
        GAS f32x4* op = (GAS f32x4*)(QKC + (size_t)t * 1024 + c); op[0] = o0; op[1] = o1;
    }
    for (int e = gt; e < T * 16; e += NT_) { const int hcol = e & 15; const float g = GATES[e] + bif[hcol];
        float r = g;
        if (hcol >= 8) r = fminf(g, 0.f) - flog(1.f + fexp(-fabsf(g)));
        IGLF[e] = r; }
}
__device__ __forceinline__ void ml_seq_phase(Frame& F) {
    if ((int)blockIdx.x >= BATCH * ML_H) return;
    const int bh = blockIdx.x, b = bh >> 3, h = bh & 7, tid = F.tid, v = tid >> 2, kq = tid & 3;
    const bf16* P = (const bf16*)(F.ws + WS_ARENA + A_P); const float* QKC = (const float*)(F.ws + WS_ARENA + A_QKC); const float* IGLF = (const float*)(F.ws + WS_ARENA + A_IGLF);
    float* HRAW = (float*)(F.ws + WS_ARENA + A_HRAW);
    LAS float* s_q = (LAS float*)F.lds; LAS float* s_k = s_q + 64 * 64; LAS float* s_v = s_k + 64 * 64; LAS float* s_h = s_v + 64 * 128; LAS float* s_ig = s_h + 64 * 128; LAS float* s_lf = s_ig + 64;
    float C[16], n[16]; float mst = 0.f;
#pragma unroll
    for (int d = 0; d < 16; ++d) { C[d] = 0.f; n[d] = 0.f; }
    for (int blk = 0; blk < SEQ / 64; ++blk) {
        const size_t t0 = (size_t)b * SEQ + (size_t)blk * 64;
        __syncthreads();
        for (int e = tid; e < 64 * 16; e += 512) { const int tt = e >> 4, c4 = (e & 15) * 4;
            *(LAS f32x4*)(s_q + tt * 64 + c4) = *(const GAS f32x4*)(QKC + (t0 + tt) * 1024 + h * 64 + c4);
            *(LAS f32x4*)(s_k + tt * 64 + c4) = *(const GAS f32x4*)(QKC + (t0 + tt) * 1024 + 512 + h * 64 + c4); }
        for (int e = tid; e < 64 * 16; e += 512) { const int tt = e >> 4, c8 = (e & 15) * 8; float pv[8];
            unpack8(*(const GAS v4u*)(P + (t0 + tt) * 3072 + 1024 + h * 128 + c8), pv);
#pragma unroll
            for (int q = 0; q < 8; ++q) s_v[tt * 128 + c8 + q] = pv[q]; }
        if (tid < 64) { s_ig[tid] = IGLF[(t0 + tid) * 16 + h]; s_lf[tid] = IGLF[(t0 + tid) * 16 + 8 + h]; }
        __syncthreads();
        for (int tt = 0; tt < 64; ++tt) {
            const float lf = s_lf[tt], ig = s_ig[tt];
            const float mn = fmaxf(lf + mst, ig), fw = fexp(lf + mst - mn), iw = fexp(ig - mn); mst = mn;
            const float vv = s_v[tt * 128 + v] * iw;
            float num = 0.f, den = 0.f;
#pragma unroll
            for (int d4 = 0; d4 < 4; ++d4) { const f32x4 kk = *(const LAS f32x4*)(s_k + tt * 64 + kq * 16 + d4 * 4), qq = *(const LAS f32x4*)(s_q + tt * 64 + kq * 16 + d4 * 4);
#pragma unroll
                for (int q = 0; q < 4; ++q) { const int d = d4 * 4 + q; C[d] = fw * C[d] + vv * kk[q]; n[d] = fw * n[d] + iw * kk[q]; num += C[d] * qq[q]; den += n[d] * qq[q]; } }
            num += __shfl_xor(num, 1); num += __shfl_xor(num, 2); den += __shfl_xor(den, 1); den += __shfl_xor(den, 2);
            const float hv = num * frcp(fmaxf(fabsf(den), fexp(-mn)));
            if (kq == 0) s_h[tt * 128 + v] = hv;
        }
        __syncthreads();
        for (int e = tid; e < 64 * 32; e += 512) { const int tt = e >> 5, c4 = (e & 31) * 4;
            *(GAS f32x4*)(HRAW + (t0 + tt) * 1024 + h * 128 + c4) = *(const LAS f32x4*)(s_h + tt * 128 + c4); }
    }
}
__device__ __forceinline__ void ml_out_phase(Frame& F, const Inputs& in, int j) {
    const bf16* P = (const bf16*)(F.ws + WS_ARENA + A_P); const float* HRAW = (const float*)(F.ws + WS_ARENA + A_HRAW); bf16* HM = (bf16*)(F.ws + WS_ARENA + A_HM);
    const float* gn = in.ml_out_norm + (size_t)j * 1024;
    for (int m = F.gw; m < T; m += F.NGW) { const int c = F.lane * 16;
        float hv[16]; float ss = 0.f;
#pragma unroll
        for (int q = 0; q < 4; ++q) { const f32x4 x = *(const GAS f32x4*)(HRAW + (size_t)m * 1024 + c + 4 * q);
#pragma unroll
            for (int e = 0; e < 4; ++e) { hv[4 * q + e] = x[e]; ss += x[e] * x[e]; } }
        ss += __shfl_xor(ss, 1); ss += __shfl_xor(ss, 2); ss += __shfl_xor(ss, 4);
        const float r = frsq(ss * (1.f / 128.f) + RMS_EPS);
        float ov[16]; unpack8(*(const GAS v4u*)(P + (size_t)m * 3072 + 2048 + c), ov); unpack8(*(const GAS v4u*)(P + (size_t)m * 3072 + 2048 + c + 8), ov + 8);
        float res[16];
#pragma unroll
        for (int e = 0; e < 16; ++e) res[e] = hv[e] * r * gn[c + e] * fsigmoid(ov[e]);
        GAS v4u* op = (GAS v4u*)(HM + (size_t)m * 1024 + c); op[0] = pack8f(res); op[1] = pack8f(res + 8);
    }
}

__device__ __forceinline__ void rw_shift_phase(Frame& F) {
    bf16* HX = (bf16*)(F.ws + WS_ARENA + A_HX);
    for (int m = F.gw; m < T; m += F.NGW) { const int c = F.lane * 16, s = m & (SEQ - 1);
        const float r = rstd16(F.SS, m), rp = (s > 0) ? rstd16(F.SS, m - 1) : 0.f;
        float hv[16], xv[16];
#pragma unroll
        for (int q = 0; q < 4; ++q) { const f32x4 x = *(const GAS f32x4*)(F.X + (size_t)m * D + c + 4 * q);
            f32x4 xp = {0.f, 0.f, 0.f, 0.f}; if (s > 0) xp = *(const GAS f32x4*)(F.X + (size_t)(m - 1) * D + c + 4 * q);
#pragma unroll
            for (int e = 0; e < 4; ++e) { hv[4 * q + e] = x[e] * r; xv[4 * q + e] = xp[e] * rp - x[e] * r; } }
        GAS v4u* o1 = (GAS v4u*)(HX + (size_t)m * 2048 + c); o1[0] = pack8f(hv); o1[1] = pack8f(hv + 8);
        GAS v4u* o2 = (GAS v4u*)(HX + (size_t)m * 2048 + 1024 + c); o2[0] = pack8f(xv); o2[1] = pack8f(xv + 8);
    }
}
__device__ __forceinline__ void rw_seq_phase(Frame& F, const Inputs& in, int j) {
    if ((int)blockIdx.x >= BATCH * RW_H) return;
    const int bh = blockIdx.x, b = bh >> 4, h = bh & 15, tid = F.tid, i = tid >> 3, jr = tid & 7;
    const bf16* RKV = (const bf16*)(F.ws + WS_ARENA + A_RKV); const bf16* AA = (const bf16*)(F.ws + WS_XB); float* LW = (float*)(F.ws + WS_ARENA + A_LW);
    LAS float* s_r = (LAS float*)F.lds; LAS float* s_w = s_r + 4096; LAS float* s_k = s_w + 4096; LAS float* s_v = s_k + 4096; LAS float* s_a = s_v + 4096; LAS float* s_b = s_a + 4096; LAS float* s_y = s_b + 4096;
    float kkc[8], kac[8];
#pragma unroll
    for (int q = 0; q < 8; ++q) { kkc[q] = in.rw_k_k[(size_t)j * 1024 + h * 64 + jr * 8 + q]; kac[q] = in.rw_k_a[(size_t)j * 1024 + h * 64 + jr * 8 + q]; }
    float S[8];
#pragma unroll
    for (int q = 0; q < 8; ++q) S[q] = 0.f;
    for (int blk = 0; blk < SEQ / 64; ++blk) {
        const size_t t0 = (size_t)b * SEQ + (size_t)blk * 64;
        __syncthreads();
        { const int tt = tid >> 3; const size_t t = t0 + tt; const int c = h * 64 + jr * 8;
          float rv[8], kv[8], vv[8], av[8];
          unpack8(*(const GAS v4u*)(RKV + t * 3072 + c), rv); unpack8(*(const GAS v4u*)(RKV + t * 3072 + 1024 + c), kv); unpack8(*(const GAS v4u*)(RKV + t * 3072 + 2048 + c), vv);
          unpack8(*(const GAS v4u*)(AA + t * 1024 + c), av);
          const f32x4 l0 = *(const GAS f32x4*)(LW + t * 1024 + c), l1 = *(const GAS f32x4*)(LW + t * 1024 + c + 4);
          float kk[8]; float ss = 0.f;
#pragma unroll
          for (int q = 0; q < 8; ++q) { kk[q] = kv[q] * kkc[q]; ss += kk[q] * kk[q]; }
          ss += __shfl_xor(ss, 1); ss += __shfl_xor(ss, 2); ss += __shfl_xor(ss, 4);
          const float inv = frcp(fmaxf(fsqrt(ss), 1e-12f));
#pragma unroll
          for (int q = 0; q < 8; ++q) { const float kn = kk[q] * inv; const int o = tt * 64 + jr * 8 + q;
              s_r[o] = rv[q]; s_w[o] = fexp(q < 4 ? l0[q] : l1[q - 4]); s_k[o] = kv[q] * (1.f + (av[q] - 1.f) * kac[q]); s_v[o] = vv[q]; s_a[o] = -kn; s_b[o] = kn * av[q]; } }
        __syncthreads();
        for (int tt = 0; tt < 64; ++tt) {
            const int o = tt * 64 + jr * 8;
            const f32x4 a0 = *(const LAS f32x4*)(s_a + o), a1 = *(const LAS f32x4*)(s_a + o + 4), w0 = *(const LAS f32x4*)(s_w + o), w1 = *(const LAS f32x4*)(s_w + o + 4);
            const f32x4 b0 = *(const LAS f32x4*)(s_b + o), b1 = *(const LAS f32x4*)(s_b + o + 4), k0 = *(const LAS f32x4*)(s_k + o), k1 = *(const LAS f32x4*)(s_k + o + 4);
            const f32x4 r0 = *(const LAS f32x4*)(s_r + o), r1 = *(const LAS f32x4*)(s_r + o + 4);
            const float vi = s_v[tt * 64 + i];
            float sa = 0.f;
#pragma unroll
            for (int q = 0; q < 4; ++q) { sa += S[q] * a0[q]; sa += S[4 + q] * a1[q]; }
            sa += __shfl_xor(sa, 1); sa += __shfl_xor(sa, 2); sa += __shfl_xor(sa, 4);
            float y = 0.f;
#pragma unroll
            for (int q = 0; q < 4; ++q) { S[q] = S[q] * w0[q] + sa * b0[q] + vi * k0[q]; S[4 + q] = S[4 + q] * w1[q] + sa * b1[q] + vi * k1[q]; y += S[q] * r0[q]; y += S[4 + q] * r1[q]; }
            y += __shfl_xor(y, 1); y += __shfl_xor(y, 2); y += __shfl_xor(y, 4);
            if (jr == 0) s_y[tt * 64 + i] = y;
        }
        __syncthreads();
        for (int e = tid; e < 64 * 16; e += 512) { const int tt = e >> 4, c4 = (e & 15) * 4;
            *(GAS f32x4*)(LW + (t0 + tt) * 1024 + h * 64 + c4) = *(const LAS f32x4*)(s_y + tt * 64 + c4); }
    }
}
__device__ __forceinline__ void rw_out_phase(Frame& F, const Inputs& in, int j) {
    const bf16* RKV = (const bf16*)(F.ws + WS_ARENA + A_RKV); const bf16* AA = (const bf16*)(F.ws + WS_XB); const float* Y = (const float*)(F.ws + WS_ARENA + A_LW);
    const bf16* GG = (const bf16*)(F.ws + WS_ARENA + A_GG); bf16* YG = (bf16*)(F.ws + WS_ARENA + A_YG);
    const float* ka = in.rw_k_a + (size_t)j * 1024; const float* rk = in.rw_r_k + (size_t)j * 1024; const float* lnw = in.rw_ln_w + (size_t)j * 1024; const float* lnb = in.rw_ln_b + (size_t)j * 1024;
    for (int m = F.gw; m < T; m += F.NGW) { const int c = F.lane * 16;
        float yv[16]; float s1 = 0.f;
#pragma unroll
        for (int q = 0; q < 4; ++q) { const f32x4 x = *(const GAS f32x4*)(Y + (size_t)m * 1024 + c + 4 * q);
#pragma unroll
            for (int e = 0; e < 4; ++e) { yv[4 * q + e] = x[e]; s1 += x[e]; } }
        s1 += __shfl_xor(s1, 1); s1 += __shfl_xor(s1, 2); const float mean = s1 * (1.f / 64.f);
        float s2 = 0.f;
#pragma unroll
        for (int e = 0; e < 16; ++e) { yv[e] -= mean; s2 += yv[e] * yv[e]; }
        s2 += __shfl_xor(s2, 1); s2 += __shfl_xor(s2, 2); const float rs = frsq(s2 * (1.f / 64.f) + 64e-5f);
        float rv[16], kv[16], vv[16], av[16], gv[16];
        unpack8(*(const GAS v4u*)(RKV + (size_t)m * 3072 + c), rv); unpack8(*(const GAS v4u*)(RKV + (size_t)m * 3072 + c + 8), rv + 8);
        unpack8(*(const GAS v4u*)(RKV + (size_t)m * 3072 + 1024 + c), kv); unpack8(*(const GAS v4u*)(RKV + (size_t)m * 3072 + 1024 + c + 8), kv + 8);
        unpack8(*(const GAS v4u*)(RKV + (size_t)m * 3072 + 2048 + c), vv); unpack8(*(const GAS v4u*)(RKV + (size_t)m * 3072 + 2048 + c + 8), vv + 8);
        unpack8(*(const GAS v4u*)(AA + (size_t)m * 1024 + c), av); unpack8(*(const GAS v4u*)(AA + (size_t)m * 1024 + c + 8), av + 8);
        unpack8(*(const GAS v4u*)(GG + (size_t)m * 1024 + c), gv); unpack8(*(const GAS v4u*)(GG + (size_t)m * 1024 + c + 8), gv + 8);
        float bs = 0.f;
#pragma unroll
        for (int e = 0; e < 16; ++e) { const float kp = kv[e] * (1.f + (av[e] - 1.f) * ka[c + e]); bs += rv[e] * kp * rk[c + e]; }
        bs += __shfl_xor(bs, 1); bs += __shfl_xor(bs, 2);
        float res[16];
#pragma unroll
        for (int e = 0; e < 16; ++e) res[e] = (yv[e] * rs * lnw[c + e] + lnb[c + e] + bs * vv[e]) * gv[e];
        GAS v4u* op = (GAS v4u*)(YG + (size_t)m * 1024 + c); op[0] = pack8f(res); op[1] = pack8f(res + 8);
    }
}
__device__ __forceinline__ void final_norm_phase(Frame& F, const Inputs& in) {
    for (int m = F.gw; m < T; m += F.NGW) { const float r = rstd16(F.SS, m);
        GAS f32x4* xp = (GAS f32x4*)(F.X + (size_t)m * D) + F.lane; const GAS f32x4* gp = (const GAS f32x4*)in.final_norm + F.lane;
#pragma unroll
        for (int q = 0; q < 4; ++q) { f32x4 x = xp[64 * q]; const f32x4 g = gp[64 * q]; x = x * r * g; xp[64 * q] = x; } }
}

#ifndef MK_ONE_LAUNCH
#define MK_ONE_LAUNCH 0
#endif
template <class Epi> __device__ __forceinline__ void run_gemm(Frame& F, const bf16* A, int lda, const bf16* Bt, int ldb, int N, int K, const Epi& E) {
    pg8::Gemm g{A, Bt, T, N, K, lda, ldb, F.wave}; pg8::StaticOrder S; S.init(T, N, F.G, (int)blockIdx.x);
    pg8::gemm_phase<Epi, pg8::StaticOrder, true, true>(F.lds, g, S, E);
}
__host__ __device__ constexpr int mixer_phases(int kind) { return kind == 0 ? 4 : kind == 1 ? 5 : 6; }
constexpr int NPH = 4 * 3 + (mixer_phases(0) + 2) + (mixer_phases(1) + 2) + (mixer_phases(2) + 2) + (mixer_phases(0) + 2) + 1;

__global__ void __launch_bounds__(NWAVES * 64, 2) fwd(Args args) {
    extern __shared__ __attribute__((aligned(16))) unsigned char lds[];
    Frame F;
    F.lds = (LAS unsigned char*)lds;
    F.tid = threadIdx.x; F.lane = F.tid & 63; const int wave0 = __builtin_amdgcn_readfirstlane(F.tid >> 6); F.wave = wave0;
    F.G = gridDim.x; F.gw = (int)blockIdx.x * NWAVES + F.wave; F.NGW = F.G * NWAVES;
    F.ws = args.ws; F.ctl = (gu32*)(args.ws + WS_CTL);
    const Inputs& in = args.in;
    volatile LAS unsigned* MISC = (volatile LAS unsigned*)(F.lds + MISC_OFF);
    for (int u = F.tid; u < (LDS_BYTES - LDSCTL_OFF) / 4; u += NWAVES * 64) ((LAS unsigned*)(F.lds + LDSCTL_OFF))[u] = 0u;
    __syncthreads();
#if MK_ONE_LAUNCH
    XcdBarrier bar = xcd_barrier_post((unsigned*)(F.ctl + CW_BAR), MISC + 8);
#define GRID_BAR() xcd_barrier(bar)
#else
#define GRID_BAR() do { } while (0)
#endif
    const int lo = args.ph_lo, hi = args.ph_hi;
    int ph = 0;
#ifndef PHMASK
#define PHMASK 0xffffffffu
#endif
#define PH_BEGIN(id) if (ph >= lo && ph < hi) { if ((PHMASK >> (id)) & 1u) { { int w_ = wave0; asm volatile("" : "+s"(w_)); F.wave = w_; F.lane = fresh_lane(); F.tid = w_ * 64 + F.lane; F.gw = (int)blockIdx.x * NWAVES + w_; } unsigned char* ws = args.ws; asm volatile("" : "+s"(ws)); { float* xo_ = args.out; asm volatile("" : "+s"(xo_)); F.X = xo_; } F.ws = ws; F.ctl = (gu32*)(ws + WS_CTL); F.XB = (bf16*)(ws + WS_XB); F.SS = (float*)(ws + WS_SS); \
    bf16* const WB = (bf16*)(ws + WS_W); unsigned char* const AR = ws + WS_ARENA; float* const COS = (float*)(ws + WS_COS); float* const SIN = (float*)(ws + WS_SIN); float* const SSQ = (float*)(ws + WS_SSQ); float* const SSKV = (float*)(ws + WS_SSKV); (void)WB; (void)AR; (void)COS; (void)SIN; (void)SSQ; (void)SSKV;
#define PH_END } if (ph + 1 < hi) GRID_BAR(); } ++ph;

#ifdef DUMP
    if (lo == 1000) { unsigned char* ws = args.ws; unsigned char* const AR = ws + WS_ARENA; F.X = args.out; F.lane = fresh_lane();
#define HX ((bf16*)(AR + A_HX))
#define RKV ((bf16*)(AR + A_RKV))
#define LOR ((bf16*)(AR + A_LOR))
#define LW ((float*)(AR + A_LW))
#define AA ((bf16*)(ws + WS_XB))
#define GG ((bf16*)(AR + A_GG))
#define YG ((bf16*)(AR + A_YG))
        for (int e = F.gw * 64 + F.lane; e < T * 1024; e += F.NGW * 64) { const int t = e >> 10, c = e & 1023; float v = 0.f;
            if (DUMP == 1) v = bf1(HX[(size_t)t * 2048 + c]) + bf1(HX[(size_t)t * 2048 + 1024 + c]);
            if (DUMP == 2) v = bf1(RKV[(size_t)t * 3072 + c]) + bf1(RKV[(size_t)t * 3072 + 1024 + c]) + bf1(RKV[(size_t)t * 3072 + 2048 + c]) + bf1(LOR[(size_t)t * 256 + (c & 255)]);
            if (DUMP == 3) v = LW[(size_t)t * 1024 + c] + bf1(AA[(size_t)t * 1024 + c]) + bf1(GG[(size_t)t * 1024 + c]);
            if (DUMP == 4) v = bf1(YG[(size_t)t * 1024 + c]);
            if (DUMP == 5) v = ((size_t)e < (size_t)3328 * 2048) ? bf1(((const bf16*)(ws + WS_W))[WR_BIG + e]) : 0.f;
            F.X[e] = v; }
#undef HX
#undef RKV
#undef LOR
#undef LW
#undef AA
#undef GG
#undef YG
        return; }
#endif
#pragma unroll
    for (int s = 0; s < 2 * DEPTH; ++s) {
        const int layer = s >> 1, half = s & 1, kind = layer % 3, j = layer / 3;
        if (half == 0) {
            PH_BEGIN(0)
                if (layer == 0) prologue(F, in);
                conv_layer(F, in, layer);
            PH_END
        } else if (kind == 0) {
#define LAT ((bf16*)(AR + A_LAT))
#define Q ((bf16*)(AR + A_Q))
#define KV ((bf16*)(AR + A_KV))
#define O ((bf16*)(AR + A_O))
#define KPE ((bf16*)(AR + A_KPE))
            PH_BEGIN(1)
                EpiMlaA E{F.SS, LAT, SSQ, SSKV, KPE, COS, SIN};
                run_gemm(F, F.XB, D, WB + WM_A, 1024, 1024, 1024, E);
            PH_END
            PH_BEGIN(2)
                { EpiMlaQ E{SSQ, Q, COS, SIN, 0.07216878364870322f * 1.4426950408889634f};
                  run_gemm(F, LAT, 1024, WB + WM_QB, 512, 1536, 512, E); }
                { EpiMlaKV E{SSKV, KV};
                  run_gemm(F, LAT + 512, 1024, WB + WM_KVB, 256, 2048, 256, E); }
            PH_END
            PH_BEGIN(3)
                for (int it = (int)blockIdx.x; it < BATCH * MLA_H * 16; it += F.G) { const int bh = it >> 4, xq = it & 15;
                    att::attn_unit(F.wave, bh >> 3, bh & 7, xq, Q, KV, KPE, O, (LAS char*)F.lds);
                    att::attn_unit(F.wave, bh >> 3, bh & 7, 31 - xq, Q, KV, KPE, O, (LAS char*)F.lds); }
            PH_END
            PH_BEGIN(4)
                EpiResidual E{F.X, F.XB, F.SS, 1.0f};
                run_gemm(F, O, 1024, WB + WM_O, 1024, 1024, 1024, E);
            PH_END
        } else if (kind == 1) {
#define P ((bf16*)(AR + A_P))
#define GATES ((float*)(AR + A_GATES))
#define HM ((bf16*)(AR + A_HM))
            PH_BEGIN(5)
                EpiMlIn E{F.SS, P, GATES};
                run_gemm(F, F.XB, D, WB + WL_IN, 1024, 3328, 1024, E);
            PH_END
            PH_BEGIN(6)
                ml_conv_phase(F, in, j);
            PH_END
            PH_BEGIN(7)
                ml_seq_phase(F);
            PH_END
            PH_BEGIN(8)
                ml_out_phase(F, in, j);
            PH_END
            PH_BEGIN(9)
                EpiResidual E{F.X, F.XB, F.SS, 1.0f};
                run_gemm(F, HM, 1024, WB + WL_O, 1024, 1024, 1024, E);
            PH_END
        } else {
#define HX ((bf16*)(AR + A_HX))
#define RKV ((bf16*)(AR + A_RKV))
#define LOR ((bf16*)(AR + A_LOR))
#define LW ((float*)(AR + A_LW))
#define AA ((bf16*)(ws + WS_XB))
#define GG ((bf16*)(AR + A_GG))
#define YG ((bf16*)(AR + A_YG))
            PH_BEGIN(10)
                rw_shift_phase(F);
            PH_END
            PH_BEGIN(11)
                EpiRwBig E{RKV, LOR};
                run_gemm(F, HX, 2048, WB + WR_BIG, 2048, 3328, 2048, E);
            PH_END
            PH_BEGIN(12)
                EpiRwUp E{LW, AA, GG, in.rw_w0 + (size_t)j * 1024, in.rw_a0 + (size_t)j * 1024};
                run_gemm(F, LOR, 256, WB + WR_UP, 256, 3072, 256, E);
            PH_END
            PH_BEGIN(13)
                rw_seq_phase(F, in, j);
            PH_END
            PH_BEGIN(14)
                rw_out_phase(F, in, j);
            PH_END
            PH_BEGIN(15)
                EpiResidual E{F.X, F.XB, F.SS, 1.0f};
                run_gemm(F, YG, 1024, WB + WR_O, 1024, 1024, 1024, E);
            PH_END
        }
#define ACT ((bf16*)(AR + A_ACT))
        PH_BEGIN(16)
            EpiSwiGLU E{F.SS, ACT};
            run_gemm(F, F.XB, D, WB + (half ? WO_GU1 : WO_GU0), D, 2 * FF, D, E);
        PH_END
        PH_BEGIN(17)
            EpiResidual E{F.X, F.XB, F.SS, 0.5f};
            run_gemm(F, ACT, FF, WB + (half ? WO_D1 : WO_D0), FF, D, FF, E);
        PH_END
    }
    PH_BEGIN(18)
        final_norm_phase(F, in);
    PH_END
}

extern "C" void kernel_launch(void* const* d_in, const int* in_sizes, int n_in, void* d_out, int out_size, void* d_ws, size_t ws_size, hipStream_t stream) {
    static int grid = 0;
    if (grid == 0) {
        if (n_in != 38 || in_sizes[0] != T * D || out_size != T * D || ws_size < WS_END) { fprintf(stderr, "kernel_launch: unexpected shapes (n_in %d, in0 %d, out %d, ws %zu)\n", n_in, n_in > 0 ? in_sizes[0] : -1, out_size, ws_size); grid = -1; return; }
        int dev = 0, cus = 0, per_cu = 0;
        if (hipGetDevice(&dev) != hipSuccess || hipDeviceGetAttribute(&cus, hipDeviceAttributeMultiprocessorCount, dev) != hipSuccess) { grid = -1; return; }
        if (hipFuncSetAttribute((const void*)fwd, hipFuncAttributeMaxDynamicSharedMemorySize, LDS_BYTES) != hipSuccess) { fprintf(stderr, "kernel_launch: hipFuncSetAttribute failed\n"); grid = -1; return; }
        if (hipOccupancyMaxActiveBlocksPerMultiprocessor(&per_cu, (const void*)fwd, NWAVES * 64, LDS_BYTES) != hipSuccess || per_cu < 1)
            fprintf(stderr, "kernel_launch: occupancy query reports %d workgroups per CU\n", per_cu);
        (void)hipGetLastError();
        grid = cus;
    }
    if (grid < 0) return;
    if (hipMemsetAsync((char*)d_ws + WS_CTL, 0, CTL_ZERO_BYTES, stream) != hipSuccess) return;
    Args a{};
    const void** ip = (const void**)&a.in;
    for (int i = 0; i < 38; ++i) ip[i] = d_in[i];
    a.out = (float*)d_out; a.ws = (unsigned char*)d_ws;
#if MK_ONE_LAUNCH
    a.ph_lo = 0; a.ph_hi = NPH;
    hipLaunchKernelGGL(fwd, dim3(grid), dim3(NWAVES * 64), LDS_BYTES, stream, a);
#else
#ifdef DUMP
    for (int p = 0; p <= DUMP_LAST; ++p) { a.ph_lo = p; a.ph_hi = p + 1;
        hipLaunchKernelGGL(fwd, dim3(grid), dim3(NWAVES * 64), LDS_BYTES, stream, a); }
    a.ph_lo = 1000; a.ph_hi = 1001;
    hipLaunchKernelGGL(fwd, dim3(grid), dim3(NWAVES * 64), LDS_BYTES, stream, a);
#else
    for (int p = 0; p < NPH; ++p) { a.ph_lo = p; a.ph_hi = p + 1;
        hipLaunchKernelGGL(fwd, dim3(grid), dim3(NWAVES * 64), LDS_BYTES, stream, a); }
#endif
#endif
}
```

```cpp
#include <hip/hip_runtime.h>
#include <cstdio>
#include <cstdint>

__device__ __forceinline__ int fresh_lane() { int l; asm volatile("v_mbcnt_lo_u32_b32 %0, -1, 0\n\tv_mbcnt_hi_u32_b32 %0, -1, %0" : "=v"(l)); return l; }
namespace pg8 {
#define PG8_LAS __attribute__((address_space(3)))
typedef unsigned short bf16_t;
typedef short bf16x8 __attribute__((ext_vector_type(8)));
typedef float f32x4 __attribute__((ext_vector_type(4)));
typedef unsigned u32x4 __attribute__((ext_vector_type(4)));
typedef unsigned u32x2 __attribute__((ext_vector_type(2)));
constexpr int BM = 256, BK = 64, HALF = 128, HTB = HALF * BK * 2  , STAGE_BYTES = 8 * HTB, NXCD = 8, WGM = 8;

__host__ __device__ __forceinline__ int lds_byte(int r, int c) { const int st = (r >> 4) * 2 + (c >> 5), rr = r & 15, cc = c & 31, ob = rr * 64 + cc * 2; return st * 1024 + (ob ^ (((ob >> 9) & 1) << 5)); }
__host__ __device__ __forceinline__ void stage_rc(int b, int& R, int& C) { const int st = b / 1024, sb = b % 1024, swz = sb ^ (((sb >> 9) & 1) << 5); R = (st >> 1) * 16 + swz / 64; C = (st & 1) * 32 + (swz % 64) / 2; }
__host__ __device__ __forceinline__ int perm32(int rho) { const int n = rho >> 4, i = rho & 15; return 8 * (i >> 2) + 4 * n + (i & 3); }

struct Unit { int pm, pn; };
struct Gemm { const bf16_t* A; const bf16_t* Bt; int M, N, K, lda, ldb, wave; };

struct StaticOrder {
    int nM, nN, nwg, G, c;
    __host__ __device__ void init(int M, int N, int G_, int c_) { nM = M / BM; nN = N / BM; nwg = nM * nN; G = G_; c = c_; }
    __host__ __device__ bool next(int i, Unit& u) const {
        const long L = (long)i * G + c; if (L >= nwg) return false;
        int wgid = (int)L; { const int q = nwg / NXCD, r = nwg % NXCD, xcd = wgid % NXCD, off = wgid / NXCD; wgid = (xcd < r ? xcd * (q + 1) : r * (q + 1) + (xcd - r) * q) + off; }
        const int nig = WGM * nN, gid = wgid / nig, fm = gid * WGM, gsz = (nM - fm) < WGM ? (nM - fm) : WGM;
        u.pm = fm + ((wgid % nig) % gsz); u.pn = (wgid % nig) / gsz; return true;
    }
    __device__ __forceinline__ void a_ready(const Unit&) const {}
    __device__ __forceinline__ void done(const Unit&) const {}
};

template <class Epi, class Sched, bool ALIGN_EPI = false, bool SP2 = false>
__device__ __forceinline__ void gemm_phase(PG8_LAS unsigned char* lds, const Gemm g, const Sched& S, const Epi& E) {
    const int wid = g.wave; const int tid = wid * 64 + fresh_lane(), lane = tid & 63, wr = wid >> 2, wc = wid & 3, fr = lane & 15, fq = lane >> 4;
    const int K = g.K, nt = K / BK;
    unsigned voffA[2], voffB[2];
#pragma unroll
    for (int i = 0; i < 2; ++i) { int R, C; stage_rc(tid * 16 + i * 8192, R, C); const int Rb = Epi::PERM ? ((R & ~31) + perm32(R & 31)) : R;
        voffA[i] = (unsigned)(R * g.lda + C) * 2u; voffB[i] = (unsigned)(Rb * g.ldb + C) * 2u; }
    const size_t kstep = (size_t)(BK * 2);
    const size_t hstepA = (size_t)HALF * g.lda * 2, hstepB = (size_t)HALF * g.ldb * 2;
    const size_t tstepA = 2 * hstepA, tstepB = 2 * hstepB;
    const unsigned ldsw = (unsigned)wid * 1024u;
    const int aoff = lds_byte(wr * 64 + fr, fq * 8), boff = lds_byte(wc * 32 + fr, fq * 8);
#define PG8_SA(b, h) (((b) * 2 + (h)) * HTB)
#define PG8_SB(b, h) ((4 + (b) * 2 + (h)) * HTB)
#define PG8_STAGE(bufoff, gbase, voff) do { _Pragma("unroll") for (int _i = 0; _i < 2; ++_i) \
        __builtin_amdgcn_global_load_lds((const unsigned*)((const char*)(gbase) + (voff)[_i]), (PG8_LAS unsigned*)(lds + (bufoff) + ldsw + _i * 8192), 16, 0, 0); } while (0)
#define PG8_LDA(dst, b, h) do { _Pragma("unroll") for (int m = 0; m < 4; ++m) _Pragma("unroll") for (int k = 0; k < 2; ++k) dst[m][k] = *(const PG8_LAS bf16x8*)(lds + PG8_SA(b, h) + aoff + m * 2048 + k * 1024); } while (0)
#define PG8_LDB(dst, b, h) do { _Pragma("unroll") for (int n = 0; n < 2; ++n) _Pragma("unroll") for (int k = 0; k < 2; ++k) dst[n][k] = *(const PG8_LAS bf16x8*)(lds + PG8_SB(b, h) + boff + n * 2048 + k * 1024); } while (0)
#define PG8_MMA(ai, bj, At, Bt) do { __builtin_amdgcn_s_setprio(1); _Pragma("unroll") for (int m = 0; m < 4; ++m) _Pragma("unroll") for (int n = 0; n < 2; ++n) _Pragma("unroll") for (int k = 0; k < 2; ++k) \
        acc[ai][bj][m][n] = __builtin_amdgcn_mfma_f32_16x16x32_bf16(Bt[n][k], At[m][k], acc[ai][bj][m][n], 0, 0, 0); __builtin_amdgcn_s_setprio(0); } while (0)
#define PG8_WAIT_V(n) asm volatile("s_waitcnt vmcnt(" #n ")" ::: "memory")
#define PG8_WAIT_L(n) asm volatile("s_waitcnt lgkmcnt(" #n ")" ::: "memory")
#define PG8_BAR __builtin_amdgcn_s_barrier()
#define PG8_SCHED __builtin_amdgcn_sched_barrier(0)
    Unit cur, nxt; int ui = 0;
    if (!S.next(0, cur)) return;
    f32x4 acc[2][2][4][2];
#pragma unroll
    for (int a = 0; a < 2; ++a)
#pragma unroll
        for (int b = 0; b < 2; ++b)
#pragma unroll
            for (int m = 0; m < 4; ++m)
#pragma unroll
                for (int n = 0; n < 2; ++n) acc[a][b][m][n] = (f32x4){0.f, 0.f, 0.f, 0.f};
    bf16x8 At[4][2], B0[2][2], B1[2][2];
    const char* cA = (const char*)g.A + (size_t)cur.pm * tstepA; const char* cB = (const char*)g.Bt + (size_t)cur.pn * tstepB;
    S.a_ready(cur);
    if constexpr (SP2) {
        PG8_STAGE(PG8_SB(0, 0), cB, voffB); PG8_STAGE(PG8_SB(0, 1), cB + hstepB, voffB); PG8_STAGE(PG8_SA(0, 0), cA, voffA); PG8_STAGE(PG8_SA(0, 1), cA + hstepA, voffA);
        if (wr == 1) PG8_BAR;
        PG8_WAIT_V(2); PG8_BAR;
        PG8_STAGE(PG8_SB(1, 0), cB + kstep, voffB); PG8_STAGE(PG8_SA(1, 0), cA + kstep, voffA); PG8_STAGE(PG8_SB(1, 1), cB + hstepB + kstep, voffB);
        PG8_WAIT_V(6); PG8_BAR;
    } else {
        PG8_STAGE(PG8_SB(0, 0), cB, voffB); PG8_STAGE(PG8_SA(0, 0), cA, voffA); PG8_STAGE(PG8_SB(0, 1), cB + hstepB, voffB); PG8_STAGE(PG8_SA(0, 1), cA + hstepA, voffA);
        if (wr == 1) PG8_BAR;
        PG8_WAIT_V(4); PG8_BAR;
        PG8_STAGE(PG8_SB(1, 0), cB + kstep, voffB); PG8_STAGE(PG8_SA(1, 0), cA + kstep, voffA); PG8_STAGE(PG8_SB(1, 1), cB + hstepB + kstep, voffB);
        PG8_WAIT_V(6); PG8_BAR;
    }
    for (;;) {
        const bool has_next = S.next(ui + 1, nxt);
        const char* nA = has_next ? (const char*)g.A + (size_t)nxt.pm * tstepA : cA; const char* nB = has_next ? (const char*)g.Bt + (size_t)nxt.pn * tstepB : cB;
#pragma nounroll
        for (int t = 0; t < nt; t += 2) {
            const bool last = (t == nt - 2);
            const char* a1 = cA + (size_t)(t + 1) * kstep;
            const char* a2 = last ? nA : cA + (size_t)(t + 2) * kstep; const char* b2 = last ? nB : cB + (size_t)(t + 2) * kstep;
            const char* a3 = a2 + kstep; const char* b3 = b2 + kstep;
            if (last && has_next) S.a_ready(nxt);
            if constexpr (SP2) {
            PG8_LDB(B0, 0, 0); PG8_LDB(B1, 0, 1); PG8_SCHED; PG8_LDA(At, 0, 0); PG8_STAGE(PG8_SA(1, 1), a1 + hstepA, voffA);
            PG8_WAIT_V(8); PG8_WAIT_L(0); PG8_BAR; PG8_MMA(0, 0, At, B0); PG8_MMA(0, 1, At, B1); PG8_BAR; PG8_SCHED;
            PG8_LDA(At, 0, 1); PG8_STAGE(PG8_SB(0, 0), b2, voffB); PG8_STAGE(PG8_SB(0, 1), b2 + hstepB, voffB); PG8_STAGE(PG8_SA(0, 0), a2, voffA);
            PG8_WAIT_V(8); PG8_WAIT_L(0); PG8_BAR; PG8_MMA(1, 0, At, B0); PG8_MMA(1, 1, At, B1); PG8_BAR; PG8_SCHED;
            PG8_LDB(B0, 1, 0); PG8_LDB(B1, 1, 1); PG8_SCHED; PG8_LDA(At, 1, 0); PG8_STAGE(PG8_SA(0, 1), a2 + hstepA, voffA);
            PG8_WAIT_V(8); PG8_WAIT_L(0); PG8_BAR; PG8_MMA(0, 0, At, B0); PG8_MMA(0, 1, At, B1); PG8_BAR; PG8_SCHED;
            PG8_LDA(At, 1, 1); PG8_STAGE(PG8_SB(1, 0), b3, voffB); PG8_STAGE(PG8_SB(1, 1), b3 + hstepB, voffB); PG8_STAGE(PG8_SA(1, 0), a3, voffA);
            PG8_WAIT_V(8); PG8_WAIT_L(0); PG8_BAR; PG8_MMA(1, 0, At, B0); PG8_MMA(1, 1, At, B1); PG8_BAR; PG8_SCHED;
            } else {
            PG8_LDB(B0, 0, 0); PG8_SCHED; PG8_LDA(At, 0, 0); PG8_STAGE(PG8_SA(1, 1), a1 + hstepA, voffA);
            PG8_WAIT_L(8); PG8_BAR; PG8_WAIT_L(0); PG8_MMA(0, 0, At, B0); PG8_BAR; PG8_SCHED;
            PG8_LDB(B1, 0, 1); PG8_STAGE(PG8_SB(0, 0), b2, voffB);
            PG8_BAR; PG8_WAIT_L(0); PG8_MMA(0, 1, At, B1); PG8_BAR;
            PG8_LDA(At, 0, 1); PG8_STAGE(PG8_SA(0, 0), a2, voffA);
            PG8_BAR; PG8_WAIT_L(0); PG8_MMA(1, 0, At, B0); PG8_BAR; PG8_SCHED;
            PG8_STAGE(PG8_SB(0, 1), b2 + hstepB, voffB);
            PG8_WAIT_V(6); PG8_BAR; PG8_MMA(1, 1, At, B1); PG8_BAR;
            PG8_LDB(B0, 1, 0); PG8_SCHED; PG8_LDA(At, 1, 0); PG8_STAGE(PG8_SA(0, 1), a2 + hstepA, voffA);
            PG8_WAIT_L(8); PG8_BAR; PG8_WAIT_L(0); PG8_MMA(0, 0, At, B0); PG8_BAR; PG8_SCHED;
            PG8_LDB(B1, 1, 1); PG8_STAGE(PG8_SB(1, 0), b3, voffB);
            PG8_BAR; PG8_WAIT_L(0); PG8_MMA(0, 1, At, B1); PG8_BAR;
            PG8_LDA(At, 1, 1); PG8_STAGE(PG8_SA(1, 0), a3, voffA);
            PG8_BAR; PG8_WAIT_L(0); PG8_MMA(1, 0, At, B0); PG8_BAR; PG8_SCHED;
            PG8_STAGE(PG8_SB(1, 1), b3 + hstepB, voffB);
            PG8_WAIT_V(6); PG8_BAR; PG8_MMA(1, 1, At, B1); PG8_BAR;
            }
        }
        if constexpr (ALIGN_EPI) { if (wr == 0) PG8_BAR; }
        if constexpr (!Epi::AFTER_DRAIN) { E(acc, cur, wr, wc, fr, fq); S.done(cur); }
        if (!has_next) break;
#pragma unroll
        for (int a = 0; a < 2; ++a)
#pragma unroll
            for (int b = 0; b < 2; ++b)
#pragma unroll
                for (int m = 0; m < 4; ++m)
#pragma unroll
                    for (int n = 0; n < 2; ++n) acc[a][b][m][n] = (f32x4){0.f, 0.f, 0.f, 0.f};
        cur = nxt; cA = nA; cB = nB; ++ui;
        if constexpr (ALIGN_EPI) { if (wr == 1) PG8_BAR; }
    }
    PG8_WAIT_V(0);
    if constexpr (!ALIGN_EPI) { if (wr == 0) PG8_BAR; }
    PG8_BAR;
    if constexpr (Epi::AFTER_DRAIN) { E.fused(acc, cur, wr, wc, fr, fq, lds, wid, lane); S.done(cur); }
#undef PG8_SA
#undef PG8_SB
#undef PG8_STAGE
#undef PG8_LDA
#undef PG8_LDB
#undef PG8_MMA
#undef PG8_WAIT_V
#undef PG8_WAIT_L
#undef PG8_BAR
#undef PG8_SCHED
}
}

constexpr int NWAVES = 8;
constexpr int BATCH = 2, SEQ = 8192, D = 1024, T = BATCH * SEQ, FF = 2816, DEPTH = 4;
constexpr float RMS_EPS = 1e-6f;
constexpr int MLA_H = 8, QRANK = 512, KVRANK = 256, NOPE = 128, ROPE = 64, DVH = 128, DQK = NOPE + ROPE;
constexpr int LATN = QRANK + KVRANK + ROPE;
constexpr int ML_H = 8, ML_DK = 64, ML_DV = 128, ML_NIN = 3088;
constexpr int RW_H = 16, RW_N = 64;

constexpr size_t MiB = 1u << 20;
constexpr size_t WS_CTL = 0, CTL_ZERO_BYTES = 1 * MiB;
constexpr size_t WS_COS = 1 * MiB, WS_SIN = 3 * MiB;
constexpr size_t WS_SS = 5 * MiB;
constexpr size_t WS_SSQ = 6 * MiB;
constexpr size_t WS_SSKV = 6 * MiB + 512 * 1024;
constexpr size_t WS_W = 8 * MiB;
constexpr size_t WS_XB = 68 * MiB;
constexpr size_t WS_ARENA = 100 * MiB;
constexpr size_t WS_END = 352 * MiB;
constexpr size_t WO_GU0 = 0, WO_D0 = WO_GU0 + (size_t)2 * FF * D, WO_GU1 = WO_D0 + (size_t)D * FF, WO_D1 = WO_GU1 + (size_t)2 * FF * D, WO_MIX = WO_D1 + (size_t)D * FF;
constexpr size_t WM_A = WO_MIX, WM_QB = WM_A + (size_t)1024 * 1024, WM_KVB = WM_QB + (size_t)1536 * 512, WM_O = WM_KVB + (size_t)2048 * 256;
constexpr size_t WL_IN = WO_MIX, WL_O = WL_IN + (size_t)3328 * 1024;
constexpr size_t WR_BIG = WO_MIX, WR_UP = WR_BIG + (size_t)3328 * 2048, WR_O = WR_UP + (size_t)3072 * 256;
static_assert((WR_O + (size_t)1024 * 1024) * 2 <= 60 * MiB, "weight region");
constexpr size_t A_ACT = 0;
constexpr size_t A_LAT = 0, A_Q = 32 * MiB, A_KV = 80 * MiB, A_O = 144 * MiB, A_KPE = 176 * MiB;
constexpr size_t A_P = 0, A_GATES = 96 * MiB, A_QKC = 97 * MiB, A_IGLF = 161 * MiB, A_HRAW = 162 * MiB, A_HM = A_QKC;
constexpr size_t A_HX = 0, A_RKV = 64 * MiB, A_LOR = 160 * MiB, A_LW = 0, A_GG = 168 * MiB, A_YG = 200 * MiB;
static_assert(WS_ARENA + A_HRAW + (size_t)T * 1024 * 4 <= WS_END && WS_ARENA + A_YG + (size_t)T * 1024 * 2 <= WS_END && WS_ARENA + A_KPE + (size_t)T * 64 * 2 <= WS_END, "arena");

constexpr int CW_TMO = 0, CW_CODE = 1, CW_BAR = 4096;
constexpr size_t WS_PTRS = 512 * 1024;

constexpr int RING_BYTES = 131072;
constexpr int LDSCTL_OFF = RING_BYTES, MISC_OFF = LDSCTL_OFF + 320;
constexpr int LDS_BYTES = 147456;

#define GAS __attribute__((address_space(1)))
#define LAS __attribute__((address_space(3)))
typedef unsigned short bf16;
typedef unsigned v4u __attribute__((ext_vector_type(4)));
typedef unsigned v2u __attribute__((ext_vector_type(2)));
typedef float f32x4 __attribute__((ext_vector_type(4)));
typedef float f32x16 __attribute__((ext_vector_type(16)));
typedef short bf16x8 __attribute__((ext_vector_type(8)));
typedef short s16x4 __attribute__((ext_vector_type(4)));
typedef GAS unsigned gu32;
#define RLX_AGENT __ATOMIC_RELAXED, __HIP_MEMORY_SCOPE_AGENT
#define LDS_WAIT() asm volatile("s_waitcnt lgkmcnt(0)" ::: "memory")
#define VM_WAIT() asm volatile("s_waitcnt vmcnt(0)" ::: "memory")
typedef float f32x2_t __attribute__((ext_vector_type(2))); typedef __bf16 bf16x2_t __attribute__((ext_vector_type(2)));
__device__ __forceinline__ unsigned cvtpk(float lo, float hi) { f32x2_t v = {lo, hi}; bf16x2_t b = __builtin_convertvector(v, bf16x2_t); return __builtin_bit_cast(unsigned, b); }
__device__ __forceinline__ float bf_lo(unsigned w) { return __builtin_bit_cast(float, w << 16); }
__device__ __forceinline__ float bf_hi(unsigned w) { return __builtin_bit_cast(float, w & 0xffff0000u); }
__device__ __forceinline__ float bf1(bf16 h) { return __builtin_bit_cast(float, (unsigned)h << 16); }
__device__ __forceinline__ v4u pack8f(const float* v) { v4u w; w.x = cvtpk(v[0], v[1]); w.y = cvtpk(v[2], v[3]); w.z = cvtpk(v[4], v[5]); w.w = cvtpk(v[6], v[7]); return w; }
__device__ __forceinline__ v4u pack8v(f32x4 a, f32x4 b) { v4u w; w.x = cvtpk(a[0], a[1]); w.y = cvtpk(a[2], a[3]); w.z = cvtpk(b[0], b[1]); w.w = cvtpk(b[2], b[3]); return w; }
__device__ __forceinline__ void unpack8(v4u w, float* v) { v[0] = bf_lo(w.x); v[1] = bf_hi(w.x); v[2] = bf_lo(w.y); v[3] = bf_hi(w.y); v[4] = bf_lo(w.z); v[5] = bf_hi(w.z); v[6] = bf_lo(w.w); v[7] = bf_hi(w.w); }
__device__ __forceinline__ float fexp(float x) { return __builtin_amdgcn_exp2f(x * 1.4426950408889634f); }
__device__ __forceinline__ float frcp(float x) { return __builtin_amdgcn_rcpf(x); }
__device__ __forceinline__ float flog(float x) { return __builtin_amdgcn_logf(x) * 0.6931471805599453f; }
__device__ __forceinline__ float ftanh(float x) { const float t = fexp(-2.f * fabsf(x)); const float r = (1.f - t) * frcp(1.f + t); return x < 0.f ? -r : r; }
__device__ __forceinline__ float fsigmoid(float x) { return frcp(1.f + fexp(-x)); }
__device__ __forceinline__ float frsq(float x) { return __builtin_amdgcn_rsqf(x); }
__device__ __forceinline__ float fsqrt(float x) { return __builtin_amdgcn_sqrtf(x); }
__device__ __forceinline__ void fsincos_big(float a, float& s, float& c) {
    const float k = __builtin_rintf(a * 0.15915494309189535f);
    float r = __builtin_fmaf(-k, 6.28125f, a); r = __builtin_fmaf(-k, 1.9353071795864769e-3f, r);
    const float rev = r * 0.15915494309189535f;
    s = __builtin_amdgcn_sinf(rev); c = __builtin_amdgcn_cosf(rev);
}
__device__ __forceinline__ float fsilu(float x) { return x * frcp(1.f + fexp(-x)); }
__device__ __forceinline__ float wave_sum(float v) {
#pragma unroll
    for (int o = 1; o < 64; o <<= 1) v += __shfl_xor(v, o);
    return v;
}

#define XB_TMO      128
#define XB_XCNT(j)  (256  + 64 * (j))
#define XB_XSUB(j)  (1280 + 64 * (j))
#define XB_XGEN(j)  (2304 + 64 * (j))
#define XB_TOP      3328
#define XB_TOPGEN   3392
#define XCD_BAR_WORDS 3456
#define XB_SPIN_CAP (1u << 18)

__device__ __forceinline__ unsigned xb_ld(unsigned* p)              { return __hip_atomic_load(p, __ATOMIC_RELAXED, __HIP_MEMORY_SCOPE_AGENT); }
__device__ __forceinline__ unsigned xb_add(unsigned* p, unsigned v) { return __hip_atomic_fetch_add(p, v, __ATOMIC_RELAXED, __HIP_MEMORY_SCOPE_AGENT); }
__device__ __forceinline__ unsigned xb_xcc_id() { return (unsigned)__builtin_amdgcn_s_getreg((3 << 11) | 20) & 0xFu; }
#define XB_SPIN(cond, bar) do { unsigned _sp = 0; while (cond) { __builtin_amdgcn_s_sleep(1); \
    if ((++_sp & 255u) == 0u) { if (xb_ld(&(bar)[XB_TMO])) break; if (_sp > XB_SPIN_CAP) { atomicAdd(&(bar)[XB_TMO], 1u); break; } } } } while (0)

struct XcdBarrier {
    unsigned* bar; unsigned x;
    volatile LAS unsigned* st;
};

__device__ __forceinline__ XcdBarrier xcd_barrier_post(unsigned* bar, volatile LAS unsigned* st) {
    XcdBarrier b; b.bar = bar; b.x = xb_xcc_id(); b.st = st;
    if (threadIdx.x == 0) (void)xb_add(&bar[XB_XCNT(b.x)], 1u);
    return b;
}
__device__ __forceinline__ void xcd_barrier_complete(unsigned* bar, unsigned x, unsigned& nloc, unsigned& nx) {
    const unsigned G = gridDim.x * gridDim.y * gridDim.z;
    unsigned sum, cnt, mine, sp = 0u;
    for (;;) {
        sum = 0u; cnt = 0u; mine = 0u;
#pragma unroll
        for (unsigned j = 0; j < 16; ++j) { const unsigned c = xb_ld(&bar[XB_XCNT(j)]); sum += c; cnt += (c > 0u) ? 1u : 0u; mine = (j == x) ? c : mine; }
        if (sum == G) break;
        __builtin_amdgcn_s_sleep(1);
        if ((++sp & 255u) == 0u) { if (xb_ld(&bar[XB_TMO])) break; if (sp > XB_SPIN_CAP) { atomicAdd(&bar[XB_TMO], 1u); break; } }
    }
    nloc = mine > 0u ? mine : 1u; nx = cnt > 0u ? cnt : 1u;
}

__device__ __forceinline__ void xcd_barrier(const XcdBarrier& b) {
    asm volatile("s_waitcnt vmcnt(0)" ::: "memory");
    __syncthreads();
    if (threadIdx.x == 0) {
        unsigned* bar = b.bar;
        __builtin_amdgcn_s_waitcnt(0);
        unsigned nloc = b.st[0], nx = b.st[1];
        if (nloc == 0u) { xcd_barrier_complete(bar, b.x, nloc, nx); b.st[0] = nloc; b.st[1] = nx; }
        const unsigned old = xb_add(&bar[XB_XSUB(b.x)], 1u);
        const unsigned gen = old / nloc;
        if (old + 1u == (gen + 1u) * nloc) {
            __builtin_amdgcn_fence(__ATOMIC_RELEASE, "agent");
            asm volatile("s_waitcnt vmcnt(0)" ::: "memory");
            const unsigned og = xb_add(&bar[XB_TOP], 1u);
            const unsigned tg = og / nx;
            if (og + 1u == (tg + 1u) * nx) xb_add(&bar[XB_TOPGEN], 1u);
            else XB_SPIN(xb_ld(&bar[XB_TOPGEN]) == tg, bar);
            __builtin_amdgcn_fence(__ATOMIC_ACQUIRE, "agent");
            xb_add(&bar[XB_XGEN(b.x)], 1u);
            asm volatile("s_waitcnt vmcnt(0)" ::: "memory");
        } else {
            XB_SPIN(xb_ld(&bar[XB_XGEN(b.x)]) == gen, bar);
            __builtin_amdgcn_fence(__ATOMIC_ACQUIRE, "agent");
            asm volatile("s_waitcnt vmcnt(0)" ::: "memory");
        }
    }
    __syncthreads();
}

struct Inputs {
    const float* x; const int* positions; const float* ffn_norm; const float* ffn_w_gate; const float* ffn_w_up; const float* ffn_w_down; const float* mix_norm; const float* final_norm;
    const float* mla_w_a; const float* mla_q_norm; const float* mla_w_qb; const float* mla_kv_norm; const float* mla_w_kvb; const float* mla_w_o;
    const float* ml_w_in; const float* ml_b_if; const float* ml_conv_w; const float* ml_conv_b; const float* ml_out_norm; const float* ml_w_o;
    const float* rw_mu; const float* rw_w_r; const float* rw_w_k; const float* rw_w_v; const float* rw_w0; const float* rw_w1; const float* rw_w2; const float* rw_a0; const float* rw_a1; const float* rw_a2;
    const float* rw_g1; const float* rw_g2; const float* rw_k_k; const float* rw_k_a; const float* rw_r_k; const float* rw_ln_w; const float* rw_ln_b; const float* rw_w_o;
};
struct Args { Inputs in; float* out; unsigned char* ws; int ph_lo, ph_hi; };

struct Frame {
    LAS unsigned char* lds;
    gu32* ctl;
    int tid, lane, wave, G, gw, NGW;
    float* X;
    bf16* XB;
    float* SS;
    unsigned char* ws;
};

__device__ __forceinline__ void cv_item(const float* Wp, int ld, int ks0, const float* g1, const float* g2, bf16* dst, int ldd, int kd0, int n0, LAS float* scr, int lane) {
    const int nl = lane & 31, kh = lane >> 5;
#pragma unroll 8
    for (int i = 0; i < 32; ++i) { const int kk = 2 * i + kh, k = ks0 + kk; float v = 0.f;
        if (Wp) { v = Wp[(size_t)k * ld]; if (g1) v *= g1[k]; if (g2) v *= g2[k]; }
        scr[kk * 33 + nl] = v; }
    LDS_WAIT(); asm volatile("" ::: "memory");
    const int c = lane & 7;
#pragma unroll
    for (int j = 0; j < 4; ++j) { const int n = (lane >> 3) + 8 * j; const LAS float* s = scr + (8 * c) * 33 + n;
        v4u o; o.x = cvtpk(s[0 * 33], s[1 * 33]); o.y = cvtpk(s[2 * 33], s[3 * 33]); o.z = cvtpk(s[4 * 33], s[5 * 33]); o.w = cvtpk(s[6 * 33], s[7 * 33]);
        *(GAS v4u*)(dst + (size_t)(n0 + n) * ldd + kd0 + 8 * c) = o; }
    LDS_WAIT(); asm volatile("" ::: "memory");
}

__device__ __forceinline__ void conv_layer(Frame& F, const Inputs& in, int layer) {
    LAS float* scr = (LAS float*)(F.lds + F.wave * 16384);
    bf16* WB = (bf16*)(F.ws + WS_W);
    const int kind = layer % 3, j = layer / 3, lane = F.lane, nl = lane & 31;
    constexpr int I_GU = (D / 64) * (2 * FF / 32), I_DN = (FF / 64) * (D / 32);
    constexpr int I_FFN = 2 * (I_GU + I_DN);
    constexpr int I_MLA = (1024 / 64) * (1024 / 32) + (512 / 64) * (1536 / 32) + (256 / 64) * (2048 / 32) + (1024 / 64) * (1024 / 32);
    constexpr int I_ML = (1024 / 64) * (3328 / 32) + (1024 / 64) * (1024 / 32);
    constexpr int I_RW = (2048 / 64) * (3328 / 32) + (256 / 64) * (3072 / 32) + (1024 / 64) * (1024 / 32);
    const int n_items = I_FFN + (kind == 0 ? I_MLA : kind == 1 ? I_ML : I_RW);
    for (int it = F.gw; it < n_items; it += F.NGW) {
        int r = it;
        if (r < I_FFN) {
            const int half = r / (I_GU + I_DN); r -= half * (I_GU + I_DN);
            const size_t wsel = (size_t)(layer * 2 + half);
            if (r < I_GU) {
                const int nb = r % (2 * FF / 32), kb = r / (2 * FF / 32), n = nb * 32 + nl, tile = n >> 8, w = n & 255;
                const float* W = (w < 128 ? in.ffn_w_gate : in.ffn_w_up) + wsel * D * FF + (tile * 128 + (w & 127));
                cv_item(W, FF, kb * 64, in.ffn_norm + wsel * D, nullptr, WB + (half ? WO_GU1 : WO_GU0), D, kb * 64, nb * 32, scr, lane);
            } else { r -= I_GU;
                const int nb = r % (D / 32), kb = r / (D / 32), n = nb * 32 + nl;
                cv_item(in.ffn_w_down + wsel * FF * D + n, D, kb * 64, nullptr, nullptr, WB + (half ? WO_D1 : WO_D0), FF, kb * 64, nb * 32, scr, lane);
            }
            continue;
        }
        r -= I_FFN;
        if (kind == 0) {
            const float* gmix = in.mix_norm + (size_t)layer * D;
            if (r < 16 * 32) {
                const int nb = r % 32, kb = r / 32, n = nb * 32 + nl; int col = n;
                if (n >= 768 && n < 832) { const int jj = n - 768; col = 768 + (jj >> 1) + 32 * (jj & 1); }
                const float* W = (n < LATN) ? in.mla_w_a + (size_t)j * D * LATN + col : nullptr;
                cv_item(W, LATN, kb * 64, gmix, nullptr, WB + WM_A, 1024, kb * 64, nb * 32, scr, lane); continue; }
            r -= 16 * 32;
            if (r < 8 * 48) {
                const int nb = r % 48, kb = r / 48, n = nb * 32 + nl, hd = n / DQK, w = n - hd * DQK; int col = n;
                if (w >= NOPE) { const int jj = w - NOPE; col = hd * DQK + NOPE + (jj >> 1) + 32 * (jj & 1); }
                cv_item(in.mla_w_qb + (size_t)j * QRANK * 1536 + col, 1536, kb * 64, in.mla_q_norm + (size_t)j * QRANK, nullptr, WB + WM_QB, 512, kb * 64, nb * 32, scr, lane); continue; }
            r -= 8 * 48;
            if (r < 4 * 64) {
                const int nb = r % 64, kb = r / 64, n = nb * 32 + nl;
                cv_item(in.mla_w_kvb + (size_t)j * KVRANK * 2048 + n, 2048, kb * 64, in.mla_kv_norm + (size_t)j * KVRANK, nullptr, WB + WM_KVB, 256, kb * 64, nb * 32, scr, lane); continue; }
            r -= 4 * 64;
            { const int nb = r % 32, kb = r / 32, n = nb * 32 + nl;
              cv_item(in.mla_w_o + (size_t)j * 1024 * 1024 + n, 1024, kb * 64, nullptr, nullptr, WB + WM_O, 1024, kb * 64, nb * 32, scr, lane); }
        } else if (kind == 1) {
            const float* gmix = in.mix_norm + (size_t)layer * D;
            if (r < 16 * 104) {
                const int nb = r % 104, kb = r / 104, n = nb * 32 + nl;
                const float* W = (n < ML_NIN) ? in.ml_w_in + (size_t)j * D * ML_NIN + n : nullptr;
                cv_item(W, ML_NIN, kb * 64, gmix, nullptr, WB + WL_IN, 1024, kb * 64, nb * 32, scr, lane); continue; }
            r -= 16 * 104;
            { const int nb = r % 32, kb = r / 32, n = nb * 32 + nl;
              cv_item(in.ml_w_o + (size_t)j * 1024 * 1024 + n, 1024, kb * 64, nullptr, nullptr, WB + WL_O, 1024, kb * 64, nb * 32, scr, lane); }
        } else {
            const float* gmix = in.mix_norm + (size_t)layer * D;
            const float* mu = in.rw_mu + (size_t)j * 6 * D;
            if (r < 32 * 104) {
                const int nb = r % 104, kb = r / 104, n = nb * 32 + nl; const float* W; int ld; const float* m;
                if (n < 1024) { W = in.rw_w_r + (size_t)j * D * D + n; ld = D; m = mu + 0 * D; }
                else if (n < 2048) { W = in.rw_w_k + (size_t)j * D * D + (n - 1024); ld = D; m = mu + 2 * D; }
                else if (n < 3072) { W = in.rw_w_v + (size_t)j * D * D + (n - 2048); ld = D; m = mu + 3 * D; }
                else if (n < 3136) { W = in.rw_w1 + (size_t)j * D * 64 + (n - 3072); ld = 64; m = mu + 1 * D; }
                else if (n < 3200) { W = in.rw_a1 + (size_t)j * D * 64 + (n - 3136); ld = 64; m = mu + 4 * D; }
                else { W = in.rw_g1 + (size_t)j * D * 128 + (n - 3200); ld = 128; m = mu + 5 * D; }
                const int ks0 = (kb & 15) * 64;
                cv_item(W, ld, ks0, gmix, (kb >= 16) ? m : nullptr, WB + WR_BIG, 2048, kb * 64, nb * 32, scr, lane); continue; }
            r -= 32 * 104;
            if (r < 4 * 96) {
                const int nb = r % 96, kb = r / 96, n = nb * 32 + nl; const float* W = nullptr; int ld = 1024, ks0 = 0;
                if (n < 1024) { if (kb == 0) { W = in.rw_w2 + (size_t)j * 64 * D + n; ks0 = 0; } }
                else if (n < 2048) { if (kb == 1) { W = in.rw_a2 + (size_t)j * 64 * D + (n - 1024); ks0 = 0; } }
                else { if (kb >= 2) { W = in.rw_g2 + (size_t)j * 128 * D + (n - 2048); ks0 = (kb - 2) * 64; } }
                cv_item(W, ld, ks0, nullptr, nullptr, WB + WR_UP, 256, kb * 64, nb * 32, scr, lane); continue; }
            r -= 4 * 96;
            { const int nb = r % 32, kb = r / 32, n = nb * 32 + nl;
              cv_item(in.rw_w_o + (size_t)j * 1024 * 1024 + n, 1024, kb * 64, nullptr, nullptr, WB + WR_O, 1024, kb * 64, nb * 32, scr, lane); }
        }
    }
}

__device__ __forceinline__ void prologue(Frame& F, const Inputs& in) {
    for (int m = F.gw; m < T; m += F.NGW) {
        const GAS f32x4* xr = (const GAS f32x4*)(in.x + (size_t)m * D) + F.lane;
        GAS f32x4* xo = (GAS f32x4*)(F.X + (size_t)m * D) + F.lane;
        GAS v2u* xb = (GAS v2u*)(F.XB + (size_t)m * D) + F.lane;
        float s = 0.f;
#pragma unroll
        for (int jj = 0; jj < 4; ++jj) { const f32x4 v = xr[64 * jj]; xo[64 * jj] = v; s += (v.x * v.x + v.y * v.y) + (v.z * v.z + v.w * v.w);
            v2u w; w.x = cvtpk(v.x, v.y); w.y = cvtpk(v.z, v.w); xb[64 * jj] = w; }
        s = wave_sum(s);
        if (F.lane < 16) F.SS[(size_t)m * 16 + F.lane] = (F.lane == 0) ? s : 0.f;
    }
    float* COS = (float*)(F.ws + WS_COS); float* SIN = (float*)(F.ws + WS_SIN);
    for (int e = F.gw * 64 + F.lane; e < T * 32; e += F.NGW * 64) {
        const int t = e >> 5, i = e & 31;
        const float inv_freq = __builtin_amdgcn_exp2f(-(float)i * 0.41524101186092029f);
        const float ang = (float)in.positions[t] * inv_freq;
        float sn, cs; fsincos_big(ang, sn, cs);
        COS[e] = cs; SIN[e] = sn;
    }
}

__device__ __forceinline__ float rstd16(const float* SS, int row) {
    const GAS f32x4* p = (const GAS f32x4*)(SS + (size_t)row * 16);
    const f32x4 a = p[0], b = p[1], c = p[2], d = p[3];
    const float s = ((a.x + a.y) + (a.z + a.w)) + ((b.x + b.y) + (b.z + b.w)) + ((c.x + c.y) + (c.z + c.w)) + ((d.x + d.y) + (d.z + d.w));
    return frsq(s * (1.f / D) + RMS_EPS);
}

#define EPI_ROWS(ai, m) (u.pm * 256 + (ai) * 128 + wr * 64 + (m) * 16 + fr)
typedef const f32x4 (&AccT)[2][2][4][2];
using pg8::Unit;

struct EpiSwiGLU { static constexpr bool PERM = true, AFTER_DRAIN = false; const float* SS; bf16* ACT;
    __device__ __forceinline__ void operator()(AccT acc, const Unit& u, int wr, int wc, int fr, int fq) const {
        const int col = u.pn * 128 + wc * 32 + fq * 8;
#pragma unroll
        for (int ai = 0; ai < 2; ++ai)
#pragma unroll
            for (int m = 0; m < 4; ++m) { asm volatile("" ::: "memory"); const int row = EPI_ROWS(ai, m); const float r = rstd16(SS, row);
                float o[8];
#pragma unroll
                for (int n = 0; n < 2; ++n)
#pragma unroll
                    for (int e = 0; e < 4; ++e) { const float g = acc[ai][0][m][n][e] * r, up = acc[ai][1][m][n][e] * r; o[4 * n + e] = fsilu(g) * up; }
                *(GAS v4u*)(ACT + (size_t)row * FF + col) = pack8f(o); }
    }
};
struct EpiResidual { static constexpr bool PERM = true, AFTER_DRAIN = false; float* X; bf16* XB; float* SS; float scale;
    __device__ __forceinline__ void operator()(AccT acc, const Unit& u, int wr, int wc, int fr, int fq) const {
#pragma unroll
        for (int ai = 0; ai < 2; ++ai)
#pragma unroll
            for (int m = 0; m < 4; ++m) { asm volatile("" ::: "memory"); const int row = EPI_ROWS(ai, m); float ss = 0.f;
#pragma unroll
                for (int bj = 0; bj < 2; ++bj) { const int col = u.pn * 256 + bj * 128 + wc * 32 + fq * 8;
                    GAS f32x4* xp = (GAS f32x4*)(X + (size_t)row * D + col);
                    f32x4 x0 = xp[0], x1 = xp[1];
                    x0 = x0 + acc[ai][bj][m][0] * scale; x1 = x1 + acc[ai][bj][m][1] * scale;
                    xp[0] = x0; xp[1] = x1;
                    *(GAS v4u*)(XB + (size_t)row * D + col) = pack8v(x0, x1);
                    ss += (x0.x * x0.x + x0.y * x0.y) + (x0.z * x0.z + x0.w * x0.w) + (x1.x * x1.x + x1.y * x1.y) + (x1.z * x1.z + x1.w * x1.w); }
                ss += __shfl_xor(ss, 16); ss += __shfl_xor(ss, 32);
                if (fq == 0) SS[(size_t)row * 16 + u.pn * 4 + wc] = ss; }
    }
};
__device__ __forceinline__ void rope8(float* v, const float* COS, const float* SIN, int row, int p0) {
    const f32x4 c = *(const GAS f32x4*)(COS + (size_t)row * 32 + p0), s = *(const GAS f32x4*)(SIN + (size_t)row * 32 + p0);
#pragma unroll
    for (int p = 0; p < 4; ++p) { const float x1 = v[2 * p], x2 = v[2 * p + 1]; v[2 * p] = x1 * c[p] - x2 * s[p]; v[2 * p + 1] = x1 * s[p] + x2 * c[p]; }
}
struct EpiMlaA { static constexpr bool PERM = true, AFTER_DRAIN = false; const float* SS; bf16* LAT; float* SSQ; float* SSKV; bf16* KPE; const float* COS; const float* SIN;
    __device__ __forceinline__ void operator()(AccT acc, const Unit& u, int wr, int wc, int fr, int fq) const {
#pragma unroll
        for (int ai = 0; ai < 2; ++ai)
#pragma unroll
            for (int m = 0; m < 4; ++m) { asm volatile("" ::: "memory"); const int row = EPI_ROWS(ai, m); const float r = rstd16(SS, row); float ss = 0.f;
#pragma unroll
                for (int bj = 0; bj < 2; ++bj) { const int col = u.pn * 256 + bj * 128 + wc * 32 + fq * 8;
                    float v[8];
#pragma unroll
                    for (int n = 0; n < 2; ++n)
#pragma unroll
                        for (int e = 0; e < 4; ++e) { v[4 * n + e] = acc[ai][bj][m][n][e] * r; ss += v[4 * n + e] * v[4 * n + e]; }
                    *(GAS v4u*)(LAT + (size_t)row * 1024 + col) = pack8f(v);
                    if (u.pn == 3 && bj == 0 && wc < 2) { rope8(v, COS, SIN, row, wc * 16 + fq * 4); *(GAS v4u*)(KPE + (size_t)row * 64 + wc * 32 + fq * 8) = pack8f(v); } }
                ss += __shfl_xor(ss, 16); ss += __shfl_xor(ss, 32);
                if (fq == 0) { if (u.pn < 2) SSQ[(size_t)row * 8 + u.pn * 4 + wc] = ss; else if (u.pn == 2) SSKV[(size_t)row * 4 + wc] = ss; } }
    }
};
struct EpiMlaQ { static constexpr bool PERM = true, AFTER_DRAIN = false; const float* SSQ; bf16* Q; const float* COS; const float* SIN; float qscale;
    __device__ __forceinline__ void operator()(AccT acc, const Unit& u, int wr, int wc, int fr, int fq) const {
#pragma unroll
        for (int ai = 0; ai < 2; ++ai)
#pragma unroll
            for (int m = 0; m < 4; ++m) { asm volatile("" ::: "memory"); const int row = EPI_ROWS(ai, m);
                const GAS f32x4* p = (const GAS f32x4*)(SSQ + (size_t)row * 8); const f32x4 a = p[0], b = p[1];
                const float r = frsq((((a.x + a.y) + (a.z + a.w)) + ((b.x + b.y) + (b.z + b.w))) * (1.f / QRANK) + RMS_EPS) * qscale;
#pragma unroll
                for (int bj = 0; bj < 2; ++bj) { const int col = u.pn * 256 + bj * 128 + wc * 32 + fq * 8, hd = col / DQK, w = col - hd * DQK;
                    float v[8];
#pragma unroll
                    for (int n = 0; n < 2; ++n)
#pragma unroll
                        for (int e = 0; e < 4; ++e) v[4 * n + e] = acc[ai][bj][m][n][e] * r;
                    if (w >= NOPE) rope8(v, COS, SIN, row, (w - NOPE) >> 1);
                    *(GAS v4u*)(Q + (size_t)row * 1536 + col) = pack8f(v); } }
    }
};
struct EpiMlaKV { static constexpr bool PERM = true, AFTER_DRAIN = false; const float* SSKV; bf16* KV;
    __device__ __forceinline__ void operator()(AccT acc, const Unit& u, int wr, int wc, int fr, int fq) const {
#pragma unroll
        for (int ai = 0; ai < 2; ++ai)
#pragma unroll
            for (int m = 0; m < 4; ++m) { asm volatile("" ::: "memory"); const int row = EPI_ROWS(ai, m);
                const f32x4 a = *(const GAS f32x4*)(SSKV + (size_t)row * 4);
                const float r = frsq(((a.x + a.y) + (a.z + a.w)) * (1.f / KVRANK) + RMS_EPS);
#pragma unroll
                for (int bj = 0; bj < 2; ++bj) { const int col = u.pn * 256 + bj * 128 + wc * 32 + fq * 8;
                    *(GAS v4u*)(KV + (size_t)row * 2048 + col) = pack8v(acc[ai][bj][m][0] * r, acc[ai][bj][m][1] * r); } }
    }
};
struct EpiMlIn { static constexpr bool PERM = true, AFTER_DRAIN = false; const float* SS; bf16* P; float* GATES;
    __device__ __forceinline__ void operator()(AccT acc, const Unit& u, int wr, int wc, int fr, int fq) const {
#pragma unroll
        for (int ai = 0; ai < 2; ++ai)
#pragma unroll
            for (int m = 0; m < 4; ++m) { asm volatile("" ::: "memory"); const int row = EPI_ROWS(ai, m); const float r = rstd16(SS, row);
                if (u.pn < 12) {
#pragma unroll
                    for (int bj = 0; bj < 2; ++bj) { const int col = u.pn * 256 + bj * 128 + wc * 32 + fq * 8;
                        *(GAS v4u*)(P + (size_t)row * 3072 + col) = pack8v(acc[ai][bj][m][0] * r, acc[ai][bj][m][1] * r); }
                } else if (wc == 0 && fq < 2) {
                    GAS f32x4* g = (GAS f32x4*)(GATES + (size_t)row * 16 + fq * 8); g[0] = acc[ai][0][m][0] * r; g[1] = acc[ai][0][m][1] * r; } }
    }
};
struct EpiRwBig { static constexpr bool PERM = true, AFTER_DRAIN = false; bf16* RKV; bf16* LOR;
    __device__ __forceinline__ void operator()(AccT acc, const Unit& u, int wr, int wc, int fr, int fq) const {
#pragma unroll
        for (int ai = 0; ai < 2; ++ai)
#pragma unroll
            for (int m = 0; m < 4; ++m) { asm volatile("" ::: "memory"); const int row = EPI_ROWS(ai, m);
#pragma unroll
                for (int bj = 0; bj < 2; ++bj) { const int cl = bj * 128 + wc * 32 + fq * 8;
                    if (u.pn < 12) { *(GAS v4u*)(RKV + (size_t)row * 3072 + u.pn * 256 + cl) = pack8v(acc[ai][bj][m][0], acc[ai][bj][m][1]); }
                    else { float v[8];
#pragma unroll
                        for (int n = 0; n < 2; ++n)
#pragma unroll
                            for (int e = 0; e < 4; ++e) { const float a = acc[ai][bj][m][n][e]; v[4 * n + e] = (cl < 64) ? ftanh(a) : (cl < 128) ? a : fsigmoid(a); }
                        *(GAS v4u*)(LOR + (size_t)row * 256 + cl) = pack8f(v); } } }
    }
};
struct EpiRwUp { static constexpr bool PERM = true, AFTER_DRAIN = false; float* LW; bf16* AA; bf16* GG; const float* w0; const float* a0;
    __device__ __forceinline__ void operator()(AccT acc, const Unit& u, int wr, int wc, int fr, int fq) const {
        const int sec = u.pn >> 2;
#pragma unroll
        for (int ai = 0; ai < 2; ++ai)
#pragma unroll
            for (int m = 0; m < 4; ++m) { asm volatile("" ::: "memory"); const int row = EPI_ROWS(ai, m);
#pragma unroll
                for (int bj = 0; bj < 2; ++bj) { const int col = (u.pn & 3) * 256 + bj * 128 + wc * 32 + fq * 8;
                    if (sec == 0) {
#pragma unroll
                        for (int n = 0; n < 2; ++n) { const f32x4 b = *(const GAS f32x4*)(w0 + col + 4 * n); f32x4 o;
#pragma unroll
                            for (int e = 0; e < 4; ++e) { const float z = -(acc[ai][bj][m][n][e] + b[e]); const float sp = fmaxf(z, 0.f) + flog(1.f + fexp(-fabsf(z))); o[e] = -fexp(-sp - 0.5f); }
                            *(GAS f32x4*)(LW + (size_t)row * 1024 + col + 4 * n) = o; } }
                    else if (sec == 1) { const f32x4 b0 = *(const GAS f32x4*)(a0 + col), b1 = *(const GAS f32x4*)(a0 + col + 4); float v[8];
#pragma unroll
                        for (int e = 0; e < 4; ++e) { v[e] = fsigmoid(acc[ai][bj][m][0][e] + b0[e]); v[4 + e] = fsigmoid(acc[ai][bj][m][1][e] + b1[e]); }
                        *(GAS v4u*)(AA + (size_t)row * 1024 + col) = pack8f(v); }
                    else { *(GAS v4u*)(GG + (size_t)row * 1024 + col) = pack8v(acc[ai][bj][m][0], acc[ai][bj][m][1]); } } }
    }
};

namespace att {
constexpr int SHM_K = 64 * DQK * 2  , SHM_V = 64 * DVH * 2  ;
constexpr int OFF_V = 0, OFF_K = 2 * SHM_V, OFF_WS = OFF_K + 2 * SHM_K, ATT_LDS = OFF_WS + NWAVES * 64 * 4;
static_assert(ATT_LDS <= RING_BYTES, "attention LDS");
#define KSWZ(row, colB) ((row) * 384 + ((colB) ^ (((row) & 7) << 4)))
#define SBAR() __builtin_amdgcn_sched_barrier(0)
__device__ __forceinline__ int v_st(int k, int c) { const int kk = (k & ~0xC) | ((k & 4) << 1) | ((k & 8) >> 1); return ((kk >> 3) * 4 + (c >> 5)) * 512 + ((kk & 7) * 32 + (c & 31)) * 2; }
__device__ __forceinline__ int v_rd_base(int lane) { return ((lane & 3) << 3) | (((lane >> 2) & 3) << 6) | (((lane >> 4) & 1) << 5) | (((lane >> 5) & 1) << 8); }
constexpr int v_rd_off(int d0, int ks, int half) { return d0 * 512 + ks * 4096 + half * 2048; }
__device__ __forceinline__ int crow(int r, int hi) { return (r & 3) + 8 * (r >> 2) + 4 * hi; }
__device__ __forceinline__ void mask_tile(f32x16& p0, f32x16& p1, int dq) {
    const float NEG = -__builtin_inff();
#pragma unroll
    for (int r = 0; r < 16; ++r) { const int c = (r & 3) + 8 * (r >> 2);
        if (dq - c < 0) p0[r] = NEG;
        if (dq - c - 32 < 0) p1[r] = NEG; }
}
constexpr float THR2 = 11.5f;
__device__ __forceinline__ void partialSM(f32x16& p0, f32x16& p1, float& m_reg, float& alpha) {
    float pmax = p0[0];
#pragma unroll
    for (int r = 1; r < 16; ++r) pmax = fmaxf(pmax, p0[r]);
#pragma unroll
    for (int r = 0; r < 16; ++r) pmax = fmaxf(pmax, p1[r]);
    { auto rr = __builtin_amdgcn_permlane32_swap(__float_as_uint(pmax), __float_as_uint(pmax), false, false);
      pmax = fmaxf(__uint_as_float(rr[0]), __uint_as_float(rr[1])); }
    float mn;
    if (__builtin_expect(__all((pmax - m_reg) <= THR2), 1)) { mn = m_reg; alpha = 1.f; }
    else { mn = fmaxf(m_reg, pmax); alpha = __builtin_amdgcn_exp2f(m_reg - mn); m_reg = mn; }
#pragma unroll
    for (int r = 0; r < 16; ++r) { p0[r] = __builtin_amdgcn_exp2f(p0[r] - mn); p1[r] = __builtin_amdgcn_exp2f(p1[r] - mn); }
}
__device__ __forceinline__ void finishSM(f32x16& p0, f32x16& p1, float alpha, float& l_reg, bf16x8& pa0, bf16x8& pa1, bf16x8& pa2, bf16x8& pa3) {
    float ps = 0;
#pragma unroll
    for (int r = 0; r < 16; ++r) ps += p0[r];
#pragma unroll
    for (int r = 0; r < 16; ++r) ps += p1[r];
    { auto rr = __builtin_amdgcn_permlane32_swap(__float_as_uint(ps), __float_as_uint(ps), false, false);
      ps = __uint_as_float(rr[0]) + __uint_as_float(rr[1]); }
    l_reg = l_reg * alpha + ps;
#define PK4(P, B_, OUT) do { unsigned a0 = cvtpk(P[B_+0], P[B_+1]), a1 = cvtpk(P[B_+2], P[B_+3]);                          \
        unsigned b0 = cvtpk(P[B_+4], P[B_+5]), b1 = cvtpk(P[B_+6], P[B_+7]);                                             \
        auto r0 = __builtin_amdgcn_permlane32_swap(a0, b0, false, false); auto r1 = __builtin_amdgcn_permlane32_swap(a1, b1, false, false); \
        v4u w = {r0[0], r1[0], r0[1], r1[1]}; OUT = __builtin_bit_cast(bf16x8, w); } while (0)
    PK4(p0, 0, pa0); PK4(p0, 8, pa1); PK4(p1, 0, pa2); PK4(p1, 8, pa3);
#undef PK4
}
__device__ __forceinline__ void qkt(f32x16& p0, f32x16& p1, const LAS char* Kb, int r32, int hi, const bf16x8* qr) {
    p0 = f32x16{}; p1 = f32x16{};
    const LAS char* kb[4];
#pragma unroll
    for (int dd = 0; dd < 4; ++dd) kb[dd] = Kb + r32 * 384 + ((dd * 32 + hi * 16) ^ ((r32 & 7) << 4));
#pragma unroll
    for (int d0 = 0; d0 < 12; ++d0) { const LAS char* a = kb[d0 & 3] + (d0 >> 2) * 128;
        const bf16x8 b0 = *(const LAS bf16x8*)(a);
        const bf16x8 b1 = *(const LAS bf16x8*)(a + 32 * 384);
        p0 = __builtin_amdgcn_mfma_f32_32x32x16_bf16(b0, qr[d0], p0, 0, 0, 0);
        p1 = __builtin_amdgcn_mfma_f32_32x32x16_bf16(b1, qr[d0], p1, 0, 0, 0); }
}
__device__ __forceinline__ void pv_tile(f32x16* o, int vb0, bf16x8 pa0, bf16x8 pa1, bf16x8 pa2, bf16x8 pa3) {
#define TRRD(dst, off) asm volatile("ds_read_b64_tr_b16 %0, %1 offset:%2" : "=&v"(dst) : "v"(vb0), "i"(off) : "memory")
#define PV_D0(d0) do { s16x4 l0, l1, l2, l3, h0, h1, h2, h3; constexpr int b_ = v_rd_off(d0, 0, 0); \
        TRRD(l0, b_); TRRD(h0, b_ + 2048); TRRD(l1, b_ + 4096); TRRD(h1, b_ + 6144); TRRD(l2, b_ + 8192); TRRD(h2, b_ + 10240); TRRD(l3, b_ + 12288); TRRD(h3, b_ + 14336); \
        asm volatile("s_waitcnt lgkmcnt(0)" ::: "memory"); SBAR(); \
        o[d0] = __builtin_amdgcn_mfma_f32_32x32x16_bf16(pa0, (bf16x8){l0[0], l0[1], l0[2], l0[3], h0[0], h0[1], h0[2], h0[3]}, o[d0], 0, 0, 0);   \
        o[d0] = __builtin_amdgcn_mfma_f32_32x32x16_bf16(pa1, (bf16x8){l1[0], l1[1], l1[2], l1[3], h1[0], h1[1], h1[2], h1[3]}, o[d0], 0, 0, 0);   \
        o[d0] = __builtin_amdgcn_mfma_f32_32x32x16_bf16(pa2, (bf16x8){l2[0], l2[1], l2[2], l2[3], h2[0], h2[1], h2[2], h2[3]}, o[d0], 0, 0, 0);   \
        o[d0] = __builtin_amdgcn_mfma_f32_32x32x16_bf16(pa3, (bf16x8){l3[0], l3[1], l3[2], l3[3], h3[0], h3[1], h3[2], h3[3]}, o[d0], 0, 0, 0); } while (0)
    PV_D0(0); PV_D0(1); PV_D0(2); PV_D0(3);
#undef PV_D0
#undef TRRD
}
__device__ __forceinline__ void attn_unit(int wid, int b, int h, int qb, const bf16* Q, const bf16* KV, const bf16* KPE, bf16* O, LAS char* lds) {
    const int lane = fresh_lane(), tid = wid * 64 + lane, r32 = lane & 31, hi = lane >> 5;
    const size_t rowbase = (size_t)b * SEQ; const int q0 = qb * 256;
    LAS char* V_lds = lds + OFF_V; LAS char* K_lds = lds + OFF_K;
    LAS float* wsf = (LAS float*)(lds + OFF_WS) + wid * 64; LAS float* li_l = wsf; LAS float* al_l = wsf + 32;
    bf16x8 qr[12];
    { const bf16* Qw = Q + (rowbase + q0 + wid * 32 + r32) * 1536 + h * DQK + hi * 8;
#pragma unroll
      for (int d0 = 0; d0 < 12; ++d0) qr[d0] = *(const GAS bf16x8*)(Qw + d0 * 16); }
    const int NT = 4 * (qb + 1);
    const bf16* ksrc[3]; int kdst[3]; int kstr[3];
#pragma unroll
    for (int i = 0; i < 3; ++i) { const int id = tid + 512 * i, row = id / 24, ch = id - row * 24;
        if (ch < 16) { ksrc[i] = KV + (rowbase + row) * 2048 + h * 256 + ch * 8; kstr[i] = 2048; }
        else { ksrc[i] = KPE + (rowbase + row) * 64 + (ch - 16) * 8; kstr[i] = 64; }
        kdst[i] = KSWZ(row, ch * 16); }
    const int sr = tid >> 4, sc = (tid & 15) * 8;
    const bf16* vsrc = KV + (rowbase + sr) * 2048 + h * 256 + 128 + sc;
    const int vst0 = v_st(sr, sc), vst1 = v_st(32 + sr, sc);
    const int vb0 = (int)(uintptr_t)V_lds + v_rd_base(lane);
    bf16x8 sk0, sk1, sk2, sv0, sv1;
#define SLOAD(t) do { sk0 = *(const GAS bf16x8*)(ksrc[0] + (size_t)(t) * 64 * kstr[0]); sk1 = *(const GAS bf16x8*)(ksrc[1] + (size_t)(t) * 64 * kstr[1]); sk2 = *(const GAS bf16x8*)(ksrc[2] + (size_t)(t) * 64 * kstr[2]); \
                      sv0 = *(const GAS bf16x8*)(vsrc + (size_t)(t) * 64 * 2048); sv1 = *(const GAS bf16x8*)(vsrc + (size_t)((t) * 64 + 32) * 2048); } while (0)
#define SWRITE(bf) do { *(LAS bf16x8*)(K_lds + (bf) * SHM_K + kdst[0]) = sk0; *(LAS bf16x8*)(K_lds + (bf) * SHM_K + kdst[1]) = sk1; *(LAS bf16x8*)(K_lds + (bf) * SHM_K + kdst[2]) = sk2; \
                        *(LAS bf16x8*)(V_lds + (bf) * SHM_V + vst0) = sv0; *(LAS bf16x8*)(V_lds + (bf) * SHM_V + vst1) = sv1; } while (0)
    float m_reg = -1e30f, l_reg = 0.f; f32x16 o[4] = {};
    const int qlo = q0 + wid * 32, qm = qlo + r32 - 4 * hi;
    SLOAD(0); SWRITE(0);
    __syncthreads();
    for (int t = 0; t < NT; ++t) {
        const int bf = t & 1;
        if (t + 1 < NT) SLOAD(t + 1);
        f32x16 p0, p1; float alpha; bf16x8 pa0, pa1, pa2, pa3;
        SBAR();
        qkt(p0, p1, K_lds + bf * SHM_K, r32, hi, qr);
        const int kb = t * 64;
        if (kb + 63 > qlo) mask_tile(p0, p1, qm - kb);
        partialSM(p0, p1, m_reg, alpha);
        if (__any(alpha < 1.f)) { if (hi == 0) al_l[r32] = alpha; LDS_WAIT();
#pragma unroll
            for (int d_ = 0; d_ < 4; ++d_)
#pragma unroll
                for (int r = 0; r < 16; ++r) o[d_][r] *= al_l[crow(r, hi)]; }
        finishSM(p0, p1, alpha, l_reg, pa0, pa1, pa2, pa3);
        SBAR();
        pv_tile(o, vb0 + bf * SHM_V, pa0, pa1, pa2, pa3);
        if (t + 1 < NT) SWRITE(bf ^ 1);
        __syncthreads();
    }
    if (hi == 0) li_l[r32] = l_reg; LDS_WAIT();
    bf16* Ow = O + (rowbase + q0 + wid * 32) * 1024 + h * DVH;
#pragma unroll
    for (int r = 0; r < 16; ++r) { const int orow = crow(r, hi); const float rl = frcp(li_l[orow]);
#pragma unroll
        for (int d0 = 0; d0 < 4; ++d0) { const float v = o[d0][r] * rl; const float vn = __shfl_xor(v, 1);
            if ((r32 & 1) == 0) *(GAS unsigned*)(Ow + (size_t)orow * 1024 + d0 * 32 + r32) = cvtpk(v, vn); } }
    __syncthreads();
#undef SLOAD
#undef SWRITE
}
#undef KSWZ
}

__device__ __forceinline__ void ml_conv_phase(Frame& F, const Inputs& in, int j) {
    const bf16* P = (const bf16*)(F.ws + WS_ARENA + A_P); const float* GATES = (const float*)(F.ws + WS_ARENA + A_GATES);
    float* QKC = (float*)(F.ws + WS_ARENA + A_QKC); float* IGLF = (float*)(F.ws + WS_ARENA + A_IGLF);
    const float* cw = in.ml_conv_w + (size_t)j * 4 * 1024; const float* cb = in.ml_conv_b + (size_t)j * 1024; const float* bif = in.ml_b_if + (size_t)j * 16;
    const int gt = F.gw * 64 + F.lane, NT_ = F.NGW * 64;
    for (int e = gt; e < T * 128; e += NT_) {
        const int t = e >> 7, c = (e & 127) * 8, s = t & (SEQ - 1);
        float acc[8];
        { const f32x4 b0 = *(const GAS f32x4*)(cb + c), b1 = *(const GAS f32x4*)(cb + c + 4);
#pragma unroll
          for (int q = 0; q < 4; ++q) { acc[q] = b0[q]; acc[4 + q] = b1[q]; } }
#pragma unroll
        for (int k = 0; k < 4; ++k) { const int dt = 3 - k;
            if (s - dt >= 0) { float pv[8]; unpack8(*(const GAS v4u*)(P + (size_t)(t - dt) * 3072 + c), pv);
                const f32x4 w0 = *(const GAS f32x4*)(cw + k * 1024 + c), w1 = *(const GAS f32x4*)(cw + k * 1024 + c + 4);
#pragma unroll
                for (int q = 0; q < 4; ++q) { acc[q] += w0[q] * pv[q]; acc[4 + q] += w1[q] * pv[4 + q]; } } }
        const float sc = (c >= 512) ? 0.125f : 1.f;
        f32x4 o0, o1;
#pragma unroll
        for (int q = 0; q < 4; ++q) { o0[q] = fsilu(acc[q]) * sc; o1[q] = fsilu(acc[4 + q]) * sc; }
        GAS f32x4* op = (GAS f32x4*)(QKC + (size_t)t * 1024 + c); op[0] = o0; op[1] = o1;
    }
    for (int e = gt; e < T * 16; e += NT_) { const int hcol = e & 15; const float g = GATES[e] + bif[hcol];
        float r = g;
        if (hcol >= 8) r = fminf(g, 0.f) - flog(1.f + fexp(-fabsf(g)));
        IGLF[e] = r; }
}
__device__ __forceinline__ void ml_seq_phase(Frame& F) {
    if ((int)blockIdx.x >= BATCH * ML_H) return;
    const int bh = blockIdx.x, b = bh >> 3, h = bh & 7, tid = F.tid, v = tid >> 2, kq = tid & 3;
    const bf16* P = (const bf16*)(F.ws + WS_ARENA + A_P); const float* QKC = (const float*)(F.ws + WS_ARENA + A_QKC); const float* IGLF = (const float*)(F.ws + WS_ARENA + A_IGLF);
    float* HRAW = (float*)(F.ws + WS_ARENA + A_HRAW);
    LAS float* s_q = (LAS float*)F.lds; LAS float* s_k = s_q + 64 * 64; LAS float* s_v = s_k + 64 * 64; LAS float* s_h = s_v + 64 * 128; LAS float* s_ig = s_h + 64 * 128; LAS float* s_lf = s_ig + 64;
    float C[16], n[16]; float mst = 0.f;
#pragma unroll
    for (int d = 0; d < 16; ++d) { C[d] = 0.f; n[d] = 0.f; }
    for (int blk = 0; blk < SEQ / 64; ++blk) {
        const size_t t0 = (size_t)b * SEQ + (size_t)blk * 64;
        __syncthreads();
        for (int e = tid; e < 64 * 16; e += 512) { const int tt = e >> 4, c4 = (e & 15) * 4;
            *(LAS f32x4*)(s_q + tt * 64 + c4) = *(const GAS f32x4*)(QKC + (t0 + tt) * 1024 + h * 64 + c4);
            *(LAS f32x4*)(s_k + tt * 64 + c4) = *(const GAS f32x4*)(QKC + (t0 + tt) * 1024 + 512 + h * 64 + c4); }
        for (int e = tid; e < 64 * 16; e += 512) { const int tt = e >> 4, c8 = (e & 15) * 8; float pv[8];
            unpack8(*(const GAS v4u*)(P + (t0 + tt) * 3072 + 1024 + h * 128 + c8), pv);
#pragma unroll
            for (int q = 0; q < 8; ++q) s_v[tt * 128 + c8 + q] = pv[q]; }
        if (tid < 64) { s_ig[tid] = IGLF[(t0 + tid) * 16 + h]; s_lf[tid] = IGLF[(t0 + tid) * 16 + 8 + h]; }
        __syncthreads();
        for (int tt = 0; tt < 64; ++tt) {
            const float lf = s_lf[tt], ig = s_ig[tt];
            const float mn = fmaxf(lf + mst, ig), fw = fexp(lf + mst - mn), iw = fexp(ig - mn); mst = mn;
            const float vv = s_v[tt * 128 + v] * iw;
            float num = 0.f, den = 0.f;
#pragma unroll
            for (int d4 = 0; d4 < 4; ++d4) { const f32x4 kk = *(const LAS f32x4*)(s_k + tt * 64 + kq * 16 + d4 * 4), qq = *(const LAS f32x4*)(s_q + tt * 64 + kq * 16 + d4 * 4);
#pragma unroll
                for (int q = 0; q < 4; ++q) { const int d = d4 * 4 + q; C[d] = fw * C[d] + vv * kk[q]; n[d] = fw * n[d] + iw * kk[q]; num += C[d] * qq[q]; den += n[d] * qq[q]; } }
            num += __shfl_xor(num, 1); num += __shfl_xor(num, 2); den += __shfl_xor(den, 1); den += __shfl_xor(den, 2);
            const float hv = num * frcp(fmaxf(fabsf(den), fexp(-mn)));
            if (kq == 0) s_h[tt * 128 + v] = hv;
        }
        __syncthreads();
        for (int e = tid; e < 64 * 32; e += 512) { const int tt = e >> 5, c4 = (e & 31) * 4;
            *(GAS f32x4*)(HRAW + (t0 + tt) * 1024 + h * 128 + c4) = *(const LAS f32x4*)(s_h + tt * 128 + c4); }
    }
}
__device__ __forceinline__ void ml_out_phase(Frame& F, const Inputs& in, int j) {
    const bf16* P = (const bf16*)(F.ws + WS_ARENA + A_P); const float* HRAW = (const float*)(F.ws + WS_ARENA + A_HRAW); bf16* HM = (bf16*)(F.ws + WS_ARENA + A_HM);
    const float* gn = in.ml_out_norm + (size_t)j * 1024;
    for (int m = F.gw; m < T; m += F.NGW) { const int c = F.lane * 16;
        float hv[16]; float ss = 0.f;
#pragma unroll
        for (int q = 0; q < 4; ++q) { const f32x4 x = *(const GAS f32x4*)(HRAW + (size_t)m * 1024 + c + 4 * q);
#pragma unroll
            for (int e = 0; e < 4; ++e) { hv[4 * q + e] = x[e]; ss += x[e] * x[e]; } }
        ss += __shfl_xor(ss, 1); ss += __shfl_xor(ss, 2); ss += __shfl_xor(ss, 4);
        const float r = frsq(ss * (1.f / 128.f) + RMS_EPS);
        float ov[16]; unpack8(*(const GAS v4u*)(P + (size_t)m * 3072 + 2048 + c), ov); unpack8(*(const GAS v4u*)(P + (size_t)m * 3072 + 2048 + c + 8), ov + 8);
        float res[16];
#pragma unroll
        for (int e = 0; e < 16; ++e) res[e] = hv[e] * r * gn[c + e] * fsigmoid(ov[e]);
        GAS v4u* op = (GAS v4u*)(HM + (size_t)m * 1024 + c); op[0] = pack8f(res); op[1] = pack8f(res + 8);
    }
}

__device__ __forceinline__ void rw_shift_phase(Frame& F) {
    bf16* HX = (bf16*)(F.ws + WS_ARENA + A_HX);
    for (int m = F.gw; m < T; m += F.NGW) { const int c = F.lane * 16, s = m & (SEQ - 1);
        const float r = rstd16(F.SS, m), rp = (s > 0) ? rstd16(F.SS, m - 1) : 0.f;
        float hv[16], xv[16];
#pragma unroll
        for (int q = 0; q < 4; ++q) { const f32x4 x = *(const GAS f32x4*)(F.X + (size_t)m * D + c + 4 * q);
            f32x4 xp = {0.f, 0.f, 0.f, 0.f}; if (s > 0) xp = *(const GAS f32x4*)(F.X + (size_t)(m - 1) * D + c + 4 * q);
#pragma unroll
            for (int e = 0; e < 4; ++e) { hv[4 * q + e] = x[e] * r; xv[4 * q + e] = xp[e] * rp - x[e] * r; } }
        GAS v4u* o1 = (GAS v4u*)(HX + (size_t)m * 2048 + c); o1[0] = pack8f(hv); o1[1] = pack8f(hv + 8);
        GAS v4u* o2 = (GAS v4u*)(HX + (size_t)m * 2048 + 1024 + c); o2[0] = pack8f(xv); o2[1] = pack8f(xv + 8);
    }
}
__device__ __forceinline__ void rw_seq_phase(Frame& F, const Inputs& in, int j) {
    if ((int)blockIdx.x >= BATCH * RW_H) return;
    const int bh = blockIdx.x, b = bh >> 4, h = bh & 15, tid = F.tid, i = tid >> 3, jr = tid & 7;
    const bf16* RKV = (const bf16*)(F.ws + WS_ARENA + A_RKV); const bf16* AA = (const bf16*)(F.ws + WS_XB); float* LW = (float*)(F.ws + WS_ARENA + A_LW);
    LAS float* s_r = (LAS float*)F.lds; LAS float* s_w = s_r + 4096; LAS float* s_k = s_w + 4096; LAS float* s_v = s_k + 4096; LAS float* s_a = s_v + 4096; LAS float* s_b = s_a + 4096; LAS float* s_y = s_b + 4096;
    float kkc[8], kac[8];
#pragma unroll
    for (int q = 0; q < 8; ++q) { kkc[q] = in.rw_k_k[(size_t)j * 1024 + h * 64 + jr * 8 + q]; kac[q] = in.rw_k_a[(size_t)j * 1024 + h * 64 + jr * 8 + q]; }
    float S[8];
#pragma unroll
    for (int q = 0; q < 8; ++q) S[q] = 0.f;
    for (int blk = 0; blk < SEQ / 64; ++blk) {
        const size_t t0 = (size_t)b * SEQ + (size_t)blk * 64;
        __syncthreads();
        { const int tt = tid >> 3; const size_t t = t0 + tt; const int c = h * 64 + jr * 8;
          float rv[8], kv[8], vv[8], av[8];
          unpack8(*(const GAS v4u*)(RKV + t * 3072 + c), rv); unpack8(*(const GAS v4u*)(RKV + t * 3072 + 1024 + c), kv); unpack8(*(const GAS v4u*)(RKV + t * 3072 + 2048 + c), vv);
          unpack8(*(const GAS v4u*)(AA + t * 1024 + c), av);
          const f32x4 l0 = *(const GAS f32x4*)(LW + t * 1024 + c), l1 = *(const GAS f32x4*)(LW + t * 1024 + c + 4);
          float kk[8]; float ss = 0.f;
#pragma unroll
          for (int q = 0; q < 8; ++q) { kk[q] = kv[q] * kkc[q]; ss += kk[q] * kk[q]; }
          ss += __shfl_xor(ss, 1); ss += __shfl_xor(ss, 2); ss += __shfl_xor(ss, 4);
          const float inv = frcp(fmaxf(fsqrt(ss), 1e-12f));
#pragma unroll
          for (int q = 0; q < 8; ++q) { const float kn = kk[q] * inv; const int o = tt * 64 + jr * 8 + q;
              s_r[o] = rv[q]; s_w[o] = fexp(q < 4 ? l0[q] : l1[q - 4]); s_k[o] = kv[q] * (1.f + (av[q] - 1.f) * kac[q]); s_v[o] = vv[q]; s_a[o] = -kn; s_b[o] = kn * av[q]; } }
        __syncthreads();
        for (int tt = 0; tt < 64; ++tt) {
            const int o = tt * 64 + jr * 8;
            const f32x4 a0 = *(const LAS f32x4*)(s_a + o), a1 = *(const LAS f32x4*)(s_a + o + 4), w0 = *(const LAS f32x4*)(s_w + o), w1 = *(const LAS f32x4*)(s_w + o + 4);
            const f32x4 b0 = *(const LAS f32x4*)(s_b + o), b1 = *(const LAS f32x4*)(s_b + o + 4), k0 = *(const LAS f32x4*)(s_k + o), k1 = *(const LAS f32x4*)(s_k + o + 4);
            const f32x4 r0 = *(const LAS f32x4*)(s_r + o), r1 = *(const LAS f32x4*)(s_r + o + 4);
            const float vi = s_v[tt * 64 + i];
            float sa = 0.f;
#pragma unroll
            for (int q = 0; q < 4; ++q) { sa += S[q] * a0[q]; sa += S[4 + q] * a1[q]; }
            sa += __shfl_xor(sa, 1); sa += __shfl_xor(sa, 2); sa += __shfl_xor(sa, 4);
            float y = 0.f;
#pragma unroll
            for (int q = 0; q < 4; ++q) { S[q] = S[q] * w0[q] + sa * b0[q] + vi * k0[q]; S[4 + q] = S[4 + q] * w1[q] + sa * b1[q] + vi * k1[q]; y += S[q] * r0[q]; y += S[4 + q] * r1[q]; }
            y += __shfl_xor(y, 1); y += __shfl_xor(y, 2); y += __shfl_xor(y, 4);
            if (jr == 0) s_y[tt * 64 + i] = y;
        }
        __syncthreads();
        for (int e = tid; e < 64 * 16; e += 512) { const int tt = e >> 4, c4 = (e & 15) * 4;
            *(GAS f32x4*)(LW + (t0 + tt) * 1024 + h * 64 + c4) = *(const LAS f32x4*)(s_y + tt * 64 + c4); }
    }
}
__device__ __forceinline__ void rw_out_phase(Frame& F, const Inputs& in, int j) {
    const bf16* RKV = (const bf16*)(F.ws + WS_ARENA + A_RKV); const bf16* AA = (const bf16*)(F.ws + WS_XB); const float* Y = (const float*)(F.ws + WS_ARENA + A_LW);
    const bf16* GG = (const bf16*)(F.ws + WS_ARENA + A_GG); bf16* YG = (bf16*)(F.ws + WS_ARENA + A_YG);
    const float* ka = in.rw_k_a + (size_t)j * 1024; const float* rk = in.rw_r_k + (size_t)j * 1024; const float* lnw = in.rw_ln_w + (size_t)j * 1024; const float* lnb = in.rw_ln_b + (size_t)j * 1024;
    for (int m = F.gw; m < T; m += F.NGW) { const int c = F.lane * 16;
        float yv[16]; float s1 = 0.f;
#pragma unroll
        for (int q = 0; q < 4; ++q) { const f32x4 x = *(const GAS f32x4*)(Y + (size_t)m * 1024 + c + 4 * q);
#pragma unroll
            for (int e = 0; e < 4; ++e) { yv[4 * q + e] = x[e]; s1 += x[e]; } }
        s1 += __shfl_xor(s1, 1); s1 += __shfl_xor(s1, 2); const float mean = s1 * (1.f / 64.f);
        float s2 = 0.f;
#pragma unroll
        for (int e = 0; e < 16; ++e) { yv[e] -= mean; s2 += yv[e] * yv[e]; }
        s2 += __shfl_xor(s2, 1); s2 += __shfl_xor(s2, 2); const float rs = frsq(s2 * (1.f / 64.f) + 64e-5f);
        float rv[16], kv[16], vv[16], av[16], gv[16];
        unpack8(*(const GAS v4u*)(RKV + (size_t)m * 3072 + c), rv); unpack8(*(const GAS v4u*)(RKV + (size_t)m * 3072 + c + 8), rv + 8);
        unpack8(*(const GAS v4u*)(RKV + (size_t)m * 3072 + 1024 + c), kv); unpack8(*(const GAS v4u*)(RKV + (size_t)m * 3072 + 1024 + c + 8), kv + 8);
        unpack8(*(const GAS v4u*)(RKV + (size_t)m * 3072 + 2048 + c), vv); unpack8(*(const GAS v4u*)(RKV + (size_t)m * 3072 + 2048 + c + 8), vv + 8);
        unpack8(*(const GAS v4u*)(AA + (size_t)m * 1024 + c), av); unpack8(*(const GAS v4u*)(AA + (size_t)m * 1024 + c + 8), av + 8);
        unpack8(*(const GAS v4u*)(GG + (size_t)m * 1024 + c), gv); unpack8(*(const GAS v4u*)(GG + (size_t)m * 1024 + c + 8), gv + 8);
        float bs = 0.f;
#pragma unroll
        for (int e = 0; e < 16; ++e) { const float kp = kv[e] * (1.f + (av[e] - 1.f) * ka[c + e]); bs += rv[e] * kp * rk[c + e]; }
        bs += __shfl_xor(bs, 1); bs += __shfl_xor(bs, 2);
        float res[16];
#pragma unroll
        for (int e = 0; e < 16; ++e) res[e] = (yv[e] * rs * lnw[c + e] + lnb[c + e] + bs * vv[e]) * gv[e];
        GAS v4u* op = (GAS v4u*)(YG + (size_t)m * 1024 + c); op[0] = pack8f(res); op[1] = pack8f(res + 8);
    }
}
__device__ __forceinline__ void final_norm_phase(Frame& F, const Inputs& in) {
    for (int m = F.gw; m < T; m += F.NGW) { const float r = rstd16(F.SS, m);
        GAS f32x4* xp = (GAS f32x4*)(F.X + (size_t)m * D) + F.lane; const GAS f32x4* gp = (const GAS f32x4*)in.final_norm + F.lane;
#pragma unroll
        for (int q = 0; q < 4; ++q) { f32x4 x = xp[64 * q]; const f32x4 g = gp[64 * q]; x = x * r * g; xp[64 * q] = x; } }
}

#ifndef MK_ONE_LAUNCH
#define MK_ONE_LAUNCH 1
#endif
template <class Epi> __device__ __forceinline__ void run_gemm(Frame& F, const bf16* A, int lda, const bf16* Bt, int ldb, int N, int K, const Epi& E) {
    pg8::Gemm g{A, Bt, T, N, K, lda, ldb, F.wave}; pg8::StaticOrder S; S.init(T, N, F.G, (int)blockIdx.x);
    pg8::gemm_phase<Epi, pg8::StaticOrder, true, true>(F.lds, g, S, E);
}
__host__ __device__ constexpr int mixer_phases(int kind) { return kind == 0 ? 4 : kind == 1 ? 5 : 6; }
constexpr int NPH = 4 * 3 + (mixer_phases(0) + 2) + (mixer_phases(1) + 2) + (mixer_phases(2) + 2) + (mixer_phases(0) + 2) + 1;

__global__ void __launch_bounds__(NWAVES * 64, 2) fwd(Args args) {
    extern __shared__ __attribute__((aligned(16))) unsigned char lds[];
    Frame F;
    F.lds = (LAS unsigned char*)lds;
    F.tid = threadIdx.x; F.lane = F.tid & 63; const int wave0 = __builtin_amdgcn_readfirstlane(F.tid >> 6); F.wave = wave0;
    F.G = gridDim.x; F.gw = (int)blockIdx.x * NWAVES + F.wave; F.NGW = F.G * NWAVES;
    F.ws = args.ws; F.ctl = (gu32*)(args.ws + WS_CTL);
    const Inputs& in = args.in;
    volatile LAS unsigned* MISC = (volatile LAS unsigned*)(F.lds + MISC_OFF);
    for (int u = F.tid; u < (LDS_BYTES - LDSCTL_OFF) / 4; u += NWAVES * 64) ((LAS unsigned*)(F.lds + LDSCTL_OFF))[u] = 0u;
    __syncthreads();
#if MK_ONE_LAUNCH
    XcdBarrier bar = xcd_barrier_post((unsigned*)(F.ctl + CW_BAR), MISC + 8);
#define GRID_BAR() xcd_barrier(bar)
#else
#define GRID_BAR() do { } while (0)
#endif
    const int lo = args.ph_lo, hi = args.ph_hi;
    int ph = 0;
#ifndef PHMASK
#define PHMASK 0xffffffffu
#endif
#define PH_BEGIN(id) if (ph >= lo && ph < hi) { if ((PHMASK >> (id)) & 1u) { { int w_ = wave0; asm volatile("" : "+s"(w_)); F.wave = w_; F.lane = fresh_lane(); F.tid = w_ * 64 + F.lane; F.gw = (int)blockIdx.x * NWAVES + w_; } unsigned char* ws = args.ws; asm volatile("" : "+s"(ws)); { float* xo_ = args.out; asm volatile("" : "+s"(xo_)); F.X = xo_; } F.ws = ws; F.ctl = (gu32*)(ws + WS_CTL); F.XB = (bf16*)(ws + WS_XB); F.SS = (float*)(ws + WS_SS); \
    bf16* const WB = (bf16*)(ws + WS_W); unsigned char* const AR = ws + WS_ARENA; float* const COS = (float*)(ws + WS_COS); float* const SIN = (float*)(ws + WS_SIN); float* const SSQ = (float*)(ws + WS_SSQ); float* const SSKV = (float*)(ws + WS_SSKV); (void)WB; (void)AR; (void)COS; (void)SIN; (void)SSQ; (void)SSKV;
#define PH_END } if (ph + 1 < hi) GRID_BAR(); } ++ph;

#ifdef DUMP
    if (lo == 1000) { unsigned char* ws = args.ws; unsigned char* const AR = ws + WS_ARENA; F.X = args.out; F.lane = fresh_lane();
#define HX ((bf16*)(AR + A_HX))
#define RKV ((bf16*)(AR + A_RKV))
#define LOR ((bf16*)(AR + A_LOR))
#define LW ((float*)(AR + A_LW))
#define AA ((bf16*)(ws + WS_XB))
#define GG ((bf16*)(AR + A_GG))
#define YG ((bf16*)(AR + A_YG))
        for (int e = F.gw * 64 + F.lane; e < T * 1024; e += F.NGW * 64) { const int t = e >> 10, c = e & 1023; float v = 0.f;
            if (DUMP == 1) v = bf1(HX[(size_t)t * 2048 + c]) + bf1(HX[(size_t)t * 2048 + 1024 + c]);
            if (DUMP == 2) v = bf1(RKV[(size_t)t * 3072 + c]) + bf1(RKV[(size_t)t * 3072 + 1024 + c]) + bf1(RKV[(size_t)t * 3072 + 2048 + c]) + bf1(LOR[(size_t)t * 256 + (c & 255)]);
            if (DUMP == 3) v = LW[(size_t)t * 1024 + c] + bf1(AA[(size_t)t * 1024 + c]) + bf1(GG[(size_t)t * 1024 + c]);
            if (DUMP == 4) v = bf1(YG[(size_t)t * 1024 + c]);
            if (DUMP == 5) v = ((size_t)e < (size_t)3328 * 2048) ? bf1(((const bf16*)(ws + WS_W))[WR_BIG + e]) : 0.f;
            F.X[e] = v; }
#undef HX
#undef RKV
#undef LOR
#undef LW
#undef AA
#undef GG
#undef YG
        return; }
#endif
#pragma unroll
    for (int s = 0; s < 2 * DEPTH; ++s) {
        const int layer = s >> 1, half = s & 1, kind = layer % 3, j = layer / 3;
        if (half == 0) {
            PH_BEGIN(0)
                if (layer == 0) prologue(F, in);
                conv_layer(F, in, layer);
            PH_END
        } else if (kind == 0) {
#define LAT ((bf16*)(AR + A_LAT))
#define Q ((bf16*)(AR + A_Q))
#define KV ((bf16*)(AR + A_KV))
#define O ((bf16*)(AR + A_O))
#define KPE ((bf16*)(AR + A_KPE))
            PH_BEGIN(1)
                EpiMlaA E{F.SS, LAT, SSQ, SSKV, KPE, COS, SIN};
                run_gemm(F, F.XB, D, WB + WM_A, 1024, 1024, 1024, E);
            PH_END
            PH_BEGIN(2)
                { EpiMlaQ E{SSQ, Q, COS, SIN, 0.07216878364870322f * 1.4426950408889634f};
                  run_gemm(F, LAT, 1024, WB + WM_QB, 512, 1536, 512, E); }
                { EpiMlaKV E{SSKV, KV};
                  run_gemm(F, LAT + 512, 1024, WB + WM_KVB, 256, 2048, 256, E); }
            PH_END
            PH_BEGIN(3)
                for (int it = (int)blockIdx.x; it < BATCH * MLA_H * 16; it += F.G) { const int bh = it >> 4, xq = it & 15;
                    att::attn_unit(F.wave, bh >> 3, bh & 7, xq, Q, KV, KPE, O, (LAS char*)F.lds);
                    att::attn_unit(F.wave, bh >> 3, bh & 7, 31 - xq, Q, KV, KPE, O, (LAS char*)F.lds); }
            PH_END
            PH_BEGIN(4)
                EpiResidual E{F.X, F.XB, F.SS, 1.0f};
                run_gemm(F, O, 1024, WB + WM_O, 1024, 1024, 1024, E);
            PH_END
        } else if (kind == 1) {
#define P ((bf16*)(AR + A_P))
#define GATES ((float*)(AR + A_GATES))
#define HM ((bf16*)(AR + A_HM))
            PH_BEGIN(5)
                EpiMlIn E{F.SS, P, GATES};
                run_gemm(F, F.XB, D, WB + WL_IN, 1024, 3328, 1024, E);
            PH_END
            PH_BEGIN(6)
                ml_conv_phase(F, in, j);
            PH_END
            PH_BEGIN(7)
                ml_seq_phase(F);
            PH_END
            PH_BEGIN(8)
                ml_out_phase(F, in, j);
            PH_END
            PH_BEGIN(9)
                EpiResidual E{F.X, F.XB, F.SS, 1.0f};
                run_gemm(F, HM, 1024, WB + WL_O, 1024, 1024, 1024, E);
            PH_END
        } else {
#define HX ((bf16*)(AR + A_HX))
#define RKV ((bf16*)(AR + A_RKV))
#define LOR ((bf16*)(AR + A_LOR))
#define LW ((float*)(AR + A_LW))
#define AA ((bf16*)(ws + WS_XB))
#define GG ((bf16*)(AR + A_GG))
#define YG ((bf16*)(AR + A_YG))
            PH_BEGIN(10)
                rw_shift_phase(F);
            PH_END
            PH_BEGIN(11)
                EpiRwBig E{RKV, LOR};
                run_gemm(F, HX, 2048, WB + WR_BIG, 2048, 3328, 2048, E);
            PH_END
            PH_BEGIN(12)
                EpiRwUp E{LW, AA, GG, in.rw_w0 + (size_t)j * 1024, in.rw_a0 + (size_t)j * 1024};
                run_gemm(F, LOR, 256, WB + WR_UP, 256, 3072, 256, E);
            PH_END
            PH_BEGIN(13)
                rw_seq_phase(F, in, j);
            PH_END
            PH_BEGIN(14)
                rw_out_phase(F, in, j);
            PH_END
            PH_BEGIN(15)
                EpiResidual E{F.X, F.XB, F.SS, 1.0f};
                run_gemm(F, YG, 1024, WB + WR_O, 1024, 1024, 1024, E);
            PH_END
        }
#define ACT ((bf16*)(AR + A_ACT))
        PH_BEGIN(16)
            EpiSwiGLU E{F.SS, ACT};
            run_gemm(F, F.XB, D, WB + (half ? WO_GU1 : WO_GU0), D, 2 * FF, D, E);
        PH_END
        PH_BEGIN(17)
            EpiResidual E{F.X, F.XB, F.SS, 0.5f};
            run_gemm(F, ACT, FF, WB + (half ? WO_D1 : WO_D0), FF, D, FF, E);
        PH_END
    }
    PH_BEGIN(18)
        final_norm_phase(F, in);
    PH_END
}

extern "C" void kernel_launch(void* const* d_in, const int* in_sizes, int n_in, void* d_out, int out_size, void* d_ws, size_t ws_size, hipStream_t stream) {
    static int grid = 0;
    if (grid == 0) {
        if (n_in != 38 || in_sizes[0] != T * D || out_size != T * D || ws_size < WS_END) { fprintf(stderr, "kernel_launch: unexpected shapes (n_in %d, in0 %d, out %d, ws %zu)\n", n_in, n_in > 0 ? in_sizes[0] : -1, out_size, ws_size); grid = -1; return; }
        int dev = 0, cus = 0, per_cu = 0;
        if (hipGetDevice(&dev) != hipSuccess || hipDeviceGetAttribute(&cus, hipDeviceAttributeMultiprocessorCount, dev) != hipSuccess) { grid = -1; return; }
        if (hipFuncSetAttribute((const void*)fwd, hipFuncAttributeMaxDynamicSharedMemorySize, LDS_BYTES) != hipSuccess) { fprintf(stderr, "kernel_launch: hipFuncSetAttribute failed\n"); grid = -1; return; }
        if (hipOccupancyMaxActiveBlocksPerMultiprocessor(&per_cu, (const void*)fwd, NWAVES * 64, LDS_BYTES) != hipSuccess || per_cu < 1)
            fprintf(stderr, "kernel_launch: occupancy query reports %d workgroups per CU\n", per_cu);
        (void)hipGetLastError();
        grid = cus;
    }
    if (grid < 0) return;
    if (hipMemsetAsync((char*)d_ws + WS_CTL, 0, CTL_ZERO_BYTES, stream) != hipSuccess) return;
    Args a{};
    const void** ip = (const void**)&a.in;
    for (int i = 0; i < 38; ++i) ip[i] = d_in[i];
    a.out = (float*)d_out; a.ws = (unsigned char*)d_ws;
#if MK_ONE_LAUNCH
    a.ph_lo = 0; a.ph_hi = NPH;
    hipLaunchKernelGGL(fwd, dim3(grid), dim3(NWAVES * 64), LDS_BYTES, stream, a);
#else
#ifdef DUMP
    for (int p = 0; p <= DUMP_LAST; ++p) { a.ph_lo = p; a.ph_hi = p + 1;
        hipLaunchKernelGGL(fwd, dim3(grid), dim3(NWAVES * 64), LDS_BYTES, stream, a); }
    a.ph_lo = 1000; a.ph_hi = 1001;
    hipLaunchKernelGGL(fwd, dim3(grid), dim3(NWAVES * 64), LDS_BYTES, stream, a);
#else
    for (int p = 0; p < NPH; ++p) { a.ph_lo = p; a.ph_hi = p + 1;
        hipLaunchKernelGGL(fwd, dim3(grid), dim3(NWAVES * 64), LDS_BYTES, stream, a); }
#endif
#endif
}
```

```cpp
#include <hip/hip_runtime.h>
#include <cstdio>
#include <cstdint>

__device__ __forceinline__ int fresh_lane() { int l; asm volatile("v_mbcnt_lo_u32_b32 %0, -1, 0\n\tv_mbcnt_hi_u32_b32 %0, -1, %0" : "=v"(l)); return l; }
namespace pg8 {
#define PG8_LAS __attribute__((address_space(3)))
typedef unsigned short bf16_t;
typedef short bf16x8 __attribute__((ext_vector_type(8)));
typedef float f32x4 __attribute__((ext_vector_type(4)));
typedef unsigned u32x4 __attribute__((ext_vector_type(4)));
typedef unsigned u32x2 __attribute__((ext_vector_type(2)));
constexpr int BM = 256, BK = 64, HALF = 128, HTB = HALF * BK * 2  , STAGE_BYTES = 8 * HTB, NXCD = 8, WGM = 8;

__host__ __device__ __forceinline__ int lds_byte(int r, int c) { const int st = (r >> 4) * 2 + (c >> 5), rr = r & 15, cc = c & 31, ob = rr * 64 + cc * 2; return st * 1024 + (ob ^ (((ob >> 9) & 1) << 5)); }
__host__ __device__ __forceinline__ void stage_rc(int b, int& R, int& C) { const int st = b / 1024, sb = b % 1024, swz = sb ^ (((sb >> 9) & 1) << 5); R = (st >> 1) * 16 + swz / 64; C = (st & 1) * 32 + (swz % 64) / 2; }
__host__ __device__ __forceinline__ int perm32(int rho) { const int n = rho >> 4, i = rho & 15; return 8 * (i >> 2) + 4 * n + (i & 3); }

struct Unit { int pm, pn; };
struct Gemm { const bf16_t* A; const bf16_t* Bt; int M, N, K, lda, ldb, wave; };

struct StaticOrder {
    int nM, nN, nwg, G, c;
    __host__ __device__ void init(int M, int N, int G_, int c_) { nM = M / BM; nN = N / BM; nwg = nM * nN; G = G_; c = c_; }
    __host__ __device__ bool next(int i, Unit& u) const {
        const long L = (long)i * G + c; if (L >= nwg) return false;
        int wgid = (int)L; { const int q = nwg / NXCD, r = nwg % NXCD, xcd = wgid % NXCD, off = wgid / NXCD; wgid = (xcd < r ? xcd * (q + 1) : r * (q + 1) + (xcd - r) * q) + off; }
        const int nig = WGM * nN, gid = wgid / nig, fm = gid * WGM, gsz = (nM - fm) < WGM ? (nM - fm) : WGM;
        u.pm = fm + ((wgid % nig) % gsz); u.pn = (wgid % nig) / gsz; return true;
    }
    __device__ __forceinline__ void a_ready(const Unit&) const {}
    __device__ __forceinline__ void done(const Unit&) const {}
};

template <class Epi, class Sched, bool ALIGN_EPI = false, bool SP2 = false>
__device__ __forceinline__ void gemm_phase(PG8_LAS unsigned char* lds, const Gemm g, const Sched& S, const Epi& E) {
    const int wid = g.wave; const int tid = wid * 64 + fresh_lane(), lane = tid & 63, wr = wid >> 2, wc = wid & 3, fr = lane & 15, fq = lane >> 4;
    const int K = g.K, nt = K / BK;
    unsigned voffA[2], voffB[2];
#pragma unroll
    for (int i = 0; i < 2; ++i) { int R, C; stage_rc(tid * 16 + i * 8192, R, C); const int Rb = Epi::PERM ? ((R & ~31) + perm32(R & 31)) : R;
        voffA[i] = (unsigned)(R * g.lda + C) * 2u; voffB[i] = (unsigned)(Rb * g.ldb + C) * 2u; }
    const size_t kstep = (size_t)(BK * 2);
    const size_t hstepA = (size_t)HALF * g.lda * 2, hstepB = (size_t)HALF * g.ldb * 2;
    const size_t tstepA = 2 * hstepA, tstepB = 2 * hstepB;
    const unsigned ldsw = (unsigned)wid * 1024u;
    const int aoff = lds_byte(wr * 64 + fr, fq * 8), boff = lds_byte(wc * 32 + fr, fq * 8);
#define PG8_SA(b, h) (((b) * 2 + (h)) * HTB)
#define PG8_SB(b, h) ((4 + (b) * 2 + (h)) * HTB)
#define PG8_STAGE(bufoff, gbase, voff) do { _Pragma("unroll") for (int _i = 0; _i < 2; ++_i) \
        __builtin_amdgcn_global_load_lds((const unsigned*)((const char*)(gbase) + (voff)[_i]), (PG8_LAS unsigned*)(lds + (bufoff) + ldsw + _i * 8192), 16, 0, 0); } while (0)
#define PG8_LDA(dst, b, h) do { _Pragma("unroll") for (int m = 0; m < 4; ++m) _Pragma("unroll") for (int k = 0; k < 2; ++k) dst[m][k] = *(const PG8_LAS bf16x8*)(lds + PG8_SA(b, h) + aoff + m * 2048 + k * 1024); } while (0)
#define PG8_LDB(dst, b, h) do { _Pragma("unroll") for (int n = 0; n < 2; ++n) _Pragma("unroll") for (int k = 0; k < 2; ++k) dst[n][k] = *(const PG8_LAS bf16x8*)(lds + PG8_SB(b, h) + boff + n * 2048 + k * 1024); } while (0)
#define PG8_MMA(ai, bj, At, Bt) do { __builtin_amdgcn_s_setprio(1); _Pragma("unroll") for (int m = 0; m < 4; ++m) _Pragma("unroll") for (int n = 0; n < 2; ++n) _Pragma("unroll") for (int k = 0; k < 2; ++k) \
        acc[ai][bj][m][n] = __builtin_amdgcn_mfma_f32_16x16x32_bf16(Bt[n][k], At[m][k], acc[ai][bj][m][n], 0, 0, 0); __builtin_amdgcn_s_setprio(0); } while (0)
#define PG8_WAIT_V(n) asm volatile("s_waitcnt vmcnt(" #n ")" ::: "memory")
#define PG8_WAIT_L(n) asm volatile("s_waitcnt lgkmcnt(" #n ")" ::: "memory")
#define PG8_BAR __builtin_amdgcn_s_barrier()
#define PG8_SCHED __builtin_amdgcn_sched_barrier(0)
    Unit cur, nxt; int ui = 0;
    if (!S.next(0, cur)) return;
    f32x4 acc[2][2][4][2];
#pragma unroll
    for (int a = 0; a < 2; ++a)
#pragma unroll
        for (int b = 0; b < 2; ++b)
#pragma unroll
            for (int m = 0; m < 4; ++m)
#pragma unroll
                for (int n = 0; n < 2; ++n) acc[a][b][m][n] = (f32x4){0.f, 0.f, 0.f, 0.f};
    bf16x8 At[4][2], B0[2][2], B1[2][2];
    const char* cA = (const char*)g.A + (size_t)cur.pm * tstepA; const char* cB = (const char*)g.Bt + (size_t)cur.pn * tstepB;
    S.a_ready(cur);
    if constexpr (SP2) {
        PG8_STAGE(PG8_SB(0, 0), cB, voffB); PG8_STAGE(PG8_SB(0, 1), cB + hstepB, voffB); PG8_STAGE(PG8_SA(0, 0), cA, voffA); PG8_STAGE(PG8_SA(0, 1), cA + hstepA, voffA);
        if (wr == 1) PG8_BAR;
        PG8_WAIT_V(2); PG8_BAR;
        PG8_STAGE(PG8_SB(1, 0), cB + kstep, voffB); PG8_STAGE(PG8_SA(1, 0), cA + kstep, voffA); PG8_STAGE(PG8_SB(1, 1), cB + hstepB + kstep, voffB);
        PG8_WAIT_V(6); PG8_BAR;
    } else {
        PG8_STAGE(PG8_SB(0, 0), cB, voffB); PG8_STAGE(PG8_SA(0, 0), cA, voffA); PG8_STAGE(PG8_SB(0, 1), cB + hstepB, voffB); PG8_STAGE(PG8_SA(0, 1), cA + hstepA, voffA);
        if (wr == 1) PG8_BAR;
        PG8_WAIT_V(4); PG8_BAR;
        PG8_STAGE(PG8_SB(1, 0), cB + kstep, voffB); PG8_STAGE(PG8_SA(1, 0), cA + kstep, voffA); PG8_STAGE(PG8_SB(1, 1), cB + hstepB + kstep, voffB);
        PG8_WAIT_V(6); PG8_BAR;
    }
    for (;;) {
        const bool has_next = S.next(ui + 1, nxt);
        const char* nA = has_next ? (const char*)g.A + (size_t)nxt.pm * tstepA : cA; const char* nB = has_next ? (const char*)g.Bt + (size_t)nxt.pn * tstepB : cB;
#pragma nounroll
        for (int t = 0; t < nt; t += 2) {
            const bool last = (t == nt - 2);
            const char* a1 = cA + (size_t)(t + 1) * kstep;
            const char* a2 = last ? nA : cA + (size_t)(t + 2) * kstep; const char* b2 = last ? nB : cB + (size_t)(t + 2) * kstep;
            const char* a3 = a2 + kstep; const char* b3 = b2 + kstep;
            if (last && has_next) S.a_ready(nxt);
            if constexpr (SP2) {
            PG8_LDB(B0, 0, 0); PG8_LDB(B1, 0, 1); PG8_SCHED; PG8_LDA(At, 0, 0); PG8_STAGE(PG8_SA(1, 1), a1 + hstepA, voffA);
            PG8_WAIT_V(8); PG8_WAIT_L(0); PG8_BAR; PG8_MMA(0, 0, At, B0); PG8_MMA(0, 1, At, B1); PG8_BAR; PG8_SCHED;
            PG8_LDA(At, 0, 1); PG8_STAGE(PG8_SB(0, 0), b2, voffB); PG8_STAGE(PG8_SB(0, 1), b2 + hstepB, voffB); PG8_STAGE(PG8_SA(0, 0), a2, voffA);
            PG8_WAIT_V(8); PG8_WAIT_L(0); PG8_BAR; PG8_MMA(1, 0, At, B0); PG8_MMA(1, 1, At, B1); PG8_BAR; PG8_SCHED;
            PG8_LDB(B0, 1, 0); PG8_LDB(B1, 1, 1); PG8_SCHED; PG8_LDA(At, 1, 0); PG8_STAGE(PG8_SA(0, 1), a2 + hstepA, voffA);
            PG8_WAIT_V(8); PG8_WAIT_L(0); PG8_BAR; PG8_MMA(0, 0, At, B0); PG8_MMA(0, 1, At, B1); PG8_BAR; PG8_SCHED;
            PG8_LDA(At, 1, 1); PG8_STAGE(PG8_SB(1, 0), b3, voffB); PG8_STAGE(PG8_SB(1, 1), b3 + hstepB, voffB); PG8_STAGE(PG8_SA(1, 0), a3, voffA);
            PG8_WAIT_V(8); PG8_WAIT_L(0); PG8_BAR; PG8_MMA(1, 0, At, B0); PG8_MMA(1, 1, At, B1); PG8_BAR; PG8_SCHED;
            } else {
            PG8_LDB(B0, 0, 0); PG8_SCHED; PG8_LDA(At, 0, 0); PG8_STAGE(PG8_SA(1, 1), a1 + hstepA, voffA);
            PG8_WAIT_L(8); PG8_BAR; PG8_WAIT_L(0); PG8_MMA(0, 0, At, B0); PG8_BAR; PG8_SCHED;
            PG8_LDB(B1, 0, 1); PG8_STAGE(PG8_SB(0, 0), b2, voffB);
            PG8_BAR; PG8_WAIT_L(0); PG8_MMA(0, 1, At, B1); PG8_BAR;
            PG8_LDA(At, 0, 1); PG8_STAGE(PG8_SA(0, 0), a2, voffA);
            PG8_BAR; PG8_WAIT_L(0); PG8_MMA(1, 0, At, B0); PG8_BAR; PG8_SCHED;
            PG8_STAGE(PG8_SB(0, 1), b2 + hstepB, voffB);
            PG8_WAIT_V(6); PG8_BAR; PG8_MMA(1, 1, At, B1); PG8_BAR;
            PG8_LDB(B0, 1, 0); PG8_SCHED; PG8_LDA(At, 1, 0); PG8_STAGE(PG8_SA(0, 1), a2 + hstepA, voffA);
            PG8_WAIT_L(8); PG8_BAR; PG8_WAIT_L(0); PG8_MMA(0, 0, At, B0); PG8_BAR; PG8_SCHED;
            PG8_LDB(B1, 1, 1); PG8_STAGE(PG8_SB(1, 0), b3, voffB);
            PG8_BAR; PG8_WAIT_L(0); PG8_MMA(0, 1, At, B1); PG8_BAR;
            PG8_LDA(At, 1, 1); PG8_STAGE(PG8_SA(1, 0), a3, voffA);
            PG8_BAR; PG8_WAIT_L(0); PG8_MMA(1, 0, At, B0); PG8_BAR; PG8_SCHED;
            PG8_STAGE(PG8_SB(1, 1), b3 + hstepB, voffB);
            PG8_WAIT_V(6); PG8_BAR; PG8_MMA(1, 1, At, B1); PG8_BAR;
            }
        }
        if constexpr (ALIGN_EPI) { if (wr == 0) PG8_BAR; }
        if constexpr (!Epi::AFTER_DRAIN) { E(acc, cur, wr, wc, fr, fq); S.done(cur); }
        if (!has_next) break;
#pragma unroll
        for (int a = 0; a < 2; ++a)
#pragma unroll
            for (int b = 0; b < 2; ++b)
#pragma unroll
                for (int m = 0; m < 4; ++m)
#pragma unroll
                    for (int n = 0; n < 2; ++n) acc[a][b][m][n] = (f32x4){0.f, 0.f, 0.f, 0.f};
        cur = nxt; cA = nA; cB = nB; ++ui;
        if constexpr (ALIGN_EPI) { if (wr == 1) PG8_BAR; }
    }
    PG8_WAIT_V(0);
    if constexpr (!ALIGN_EPI) { if (wr == 0) PG8_BAR; }
    PG8_BAR;
    if constexpr (Epi::AFTER_DRAIN) { E.fused(acc, cur, wr, wc, fr, fq, lds, wid, lane); S.done(cur); }
#undef PG8_SA
#undef PG8_SB
#undef PG8_STAGE
#undef PG8_LDA
#undef PG8_LDB
#undef PG8_MMA
#undef PG8_WAIT_V
#undef PG8_WAIT_L
#undef PG8_BAR
#undef PG8_SCHED
}
}

constexpr int NWAVES = 8;
constexpr int BATCH = 2, SEQ = 8192, D = 1024, T = BATCH * SEQ, FF = 2816, DEPTH = 4;
constexpr float RMS_EPS = 1e-6f;
constexpr int MLA_H = 8, QRANK = 512, KVRANK = 256, NOPE = 128, ROPE = 64, DVH = 128, DQK = NOPE + ROPE;
constexpr int LATN = QRANK + KVRANK + ROPE;
constexpr int ML_H = 8, ML_DK = 64, ML_DV = 128, ML_NIN = 3088;
constexpr int RW_H = 16, RW_N = 64;

constexpr size_t MiB = 1u << 20;
constexpr size_t WS_CTL = 0, CTL_ZERO_BYTES = 1 * MiB;
constexpr size_t WS_COS = 1 * MiB, WS_SIN = 3 * MiB;
constexpr size_t WS_SS = 5 * MiB;
constexpr size_t WS_SSQ = 6 * MiB;
constexpr size_t WS_SSKV = 6 * MiB + 512 * 1024;
constexpr size_t WS_W = 8 * MiB;
constexpr size_t WS_XB = 68 * MiB;
constexpr size_t WS_ARENA = 100 * MiB;
constexpr size_t WS_END = 352 * MiB;
constexpr size_t WO_GU0 = 0, WO_D0 = WO_GU0 + (size_t)2 * FF * D, WO_GU1 = WO_D0 + (size_t)D * FF, WO_D1 = WO_GU1 + (size_t)2 * FF * D, WO_MIX = WO_D1 + (size_t)D * FF;
constexpr size_t WM_A = WO_MIX, WM_QB = WM_A + (size_t)1024 * 1024, WM_KVB = WM_QB + (size_t)1536 * 512, WM_O = WM_KVB + (size_t)2048 * 256;
constexpr size_t WL_IN = WO_MIX, WL_O = WL_IN + (size_t)3328 * 1024;
constexpr size_t WR_BIG = WO_MIX, WR_UP = WR_BIG + (size_t)3328 * 2048, WR_O = WR_UP + (size_t)3072 * 256;
static_assert((WR_O + (size_t)1024 * 1024) * 2 <= 60 * MiB, "weight region");
constexpr size_t A_ACT = 0;
constexpr size_t A_LAT = 0, A_Q = 32 * MiB, A_KV = 80 * MiB, A_O = 144 * MiB, A_KPE = 176 * MiB;
constexpr size_t A_P = 0, A_GATES = 96 * MiB, A_QKC = 97 * MiB, A_IGLF = 161 * MiB, A_HRAW = 162 * MiB, A_HM = A_QKC;
constexpr size_t A_HX = 0, A_RKV = 64 * MiB, A_LOR = 160 * MiB, A_LW = 0, A_GG = 168 * MiB, A_YG = 200 * MiB;
static_assert(WS_ARENA + A_HRAW + (size_t)T * 1024 * 4 <= WS_END && WS_ARENA + A_YG + (size_t)T * 1024 * 2 <= WS_END && WS_ARENA + A_KPE + (size_t)T * 64 * 2 <= WS_END, "arena");

constexpr int CW_TMO = 0, CW_CODE = 1, CW_BAR = 4096;
constexpr size_t WS_PTRS = 512 * 1024;

constexpr int RING_BYTES = 131072;
constexpr int LDSCTL_OFF = 146432, MISC_OFF = LDSCTL_OFF + 320;
constexpr int LDS_BYTES = 147456;

#define GAS __attribute__((address_space(1)))
#define LAS __attribute__((address_space(3)))
typedef unsigned short bf16;
typedef unsigned v4u __attribute__((ext_vector_type(4)));
typedef unsigned v2u __attribute__((ext_vector_type(2)));
typedef float f32x4 __attribute__((ext_vector_type(4)));
typedef float f32x16 __attribute__((ext_vector_type(16)));
typedef short bf16x8 __attribute__((ext_vector_type(8)));
typedef short s16x4 __attribute__((ext_vector_type(4)));
typedef GAS unsigned gu32;
#define RLX_AGENT __ATOMIC_RELAXED, __HIP_MEMORY_SCOPE_AGENT
#define LDS_WAIT() asm volatile("s_waitcnt lgkmcnt(0)" ::: "memory")
#define VM_WAIT() asm volatile("s_waitcnt vmcnt(0)" ::: "memory")
typedef float f32x2_t __attribute__((ext_vector_type(2))); typedef __bf16 bf16x2_t __attribute__((ext_vector_type(2)));
__device__ __forceinline__ unsigned cvtpk(float lo, float hi) { f32x2_t v = {lo, hi}; bf16x2_t b = __builtin_convertvector(v, bf16x2_t); return __builtin_bit_cast(unsigned, b); }
__device__ __forceinline__ float bf_lo(unsigned w) { return __builtin_bit_cast(float, w << 16); }
__device__ __forceinline__ float bf_hi(unsigned w) { return __builtin_bit_cast(float, w & 0xffff0000u); }
__device__ __forceinline__ float bf1(bf16 h) { return __builtin_bit_cast(float, (unsigned)h << 16); }
__device__ __forceinline__ v4u pack8f(const float* v) { v4u w; w.x = cvtpk(v[0], v[1]); w.y = cvtpk(v[2], v[3]); w.z = cvtpk(v[4], v[5]); w.w = cvtpk(v[6], v[7]); return w; }
__device__ __forceinline__ v4u pack8v(f32x4 a, f32x4 b) { v4u w; w.x = cvtpk(a[0], a[1]); w.y = cvtpk(a[2], a[3]); w.z = cvtpk(b[0], b[1]); w.w = cvtpk(b[2], b[3]); return w; }
__device__ __forceinline__ void unpack8(v4u w, float* v) { v[0] = bf_lo(w.x); v[1] = bf_hi(w.x); v[2] = bf_lo(w.y); v[3] = bf_hi(w.y); v[4] = bf_lo(w.z); v[5] = bf_hi(w.z); v[6] = bf_lo(w.w); v[7] = bf_hi(w.w); }
__device__ __forceinline__ float fexp(float x) { return __builtin_amdgcn_exp2f(x * 1.4426950408889634f); }
__device__ __forceinline__ float frcp(float x) { return __builtin_amdgcn_rcpf(x); }
__device__ __forceinline__ float flog(float x) { return __builtin_amdgcn_logf(x) * 0.6931471805599453f; }
__device__ __forceinline__ float ftanh(float x) { const float t = fexp(-2.f * fabsf(x)); const float r = (1.f - t) * frcp(1.f + t); return x < 0.f ? -r : r; }
__device__ __forceinline__ float fsigmoid(float x) { return frcp(1.f + fexp(-x)); }
__device__ __forceinline__ float frsq(float x) { return __builtin_amdgcn_rsqf(x); }
__device__ __forceinline__ float fsqrt(float x) { return __builtin_amdgcn_sqrtf(x); }
__device__ __forceinline__ void fsincos_big(float a, float& s, float& c) {
    const float k = __builtin_rintf(a * 0.15915494309189535f);
    float r = __builtin_fmaf(-k, 6.28125f, a); r = __builtin_fmaf(-k, 1.9353071795864769e-3f, r);
    const float rev = r * 0.15915494309189535f;
    s = __builtin_amdgcn_sinf(rev); c = __builtin_amdgcn_cosf(rev);
}
__device__ __forceinline__ float fsilu(float x) { return x * frcp(1.f + fexp(-x)); }
__device__ __forceinline__ float wave_sum(float v) {
#pragma unroll
    for (int o = 1; o < 64; o <<= 1) v += __shfl_xor(v, o);
    return v;
}

#define XB_TMO      128
#define XB_XCNT(j)  (256  + 64 * (j))
#define XB_XSUB(j)  (1280 + 64 * (j))
#define XB_XGEN(j)  (2304 + 64 * (j))
#define XB_TOP      3328
#define XB_TOPGEN   3392
#define XCD_BAR_WORDS 3456
#define XB_SPIN_CAP (1u << 18)

__device__ __forceinline__ unsigned xb_ld(unsigned* p)              { return __hip_atomic_load(p, __ATOMIC_RELAXED, __HIP_MEMORY_SCOPE_AGENT); }
__device__ __forceinline__ unsigned xb_add(unsigned* p, unsigned v) { return __hip_atomic_fetch_add(p, v, __ATOMIC_RELAXED, __HIP_MEMORY_SCOPE_AGENT); }
__device__ __forceinline__ unsigned xb_xcc_id() { return (unsigned)__builtin_amdgcn_s_getreg((3 << 11) | 20) & 0xFu; }
#define XB_SPIN(cond, bar) do { unsigned _sp = 0; while (cond) { __builtin_amdgcn_s_sleep(1); \
    if ((++_sp & 255u) == 0u) { if (xb_ld(&(bar)[XB_TMO])) break; if (_sp > XB_SPIN_CAP) { atomicAdd(&(bar)[XB_TMO], 1u); break; } } } } while (0)

struct XcdBarrier {
    unsigned* bar; unsigned x;
    volatile LAS unsigned* st;
};

__device__ __forceinline__ XcdBarrier xcd_barrier_post(unsigned* bar, volatile LAS unsigned* st) {
    XcdBarrier b; b.bar = bar; b.x = xb_xcc_id(); b.st = st;
    if (threadIdx.x == 0) (void)xb_add(&bar[XB_XCNT(b.x)], 1u);
    return b;
}
__device__ __forceinline__ void xcd_barrier_complete(unsigned* bar, unsigned x, unsigned& nloc, unsigned& nx) {
    const unsigned G = gridDim.x * gridDim.y * gridDim.z;
    unsigned sum, cnt, mine, sp = 0u;
    for (;;) {
        sum = 0u; cnt = 0u; mine = 0u;
#pragma unroll
        for (unsigned j = 0; j < 16; ++j) { const unsigned c = xb_ld(&bar[XB_XCNT(j)]); sum += c; cnt += (c > 0u) ? 1u : 0u; mine = (j == x) ? c : mine; }
        if (sum == G) break;
        __builtin_amdgcn_s_sleep(1);
        if ((++sp & 255u) == 0u) { if (xb_ld(&bar[XB_TMO])) break; if (sp > XB_SPIN_CAP) { atomicAdd(&bar[XB_TMO], 1u); break; } }
    }
    nloc = mine > 0u ? mine : 1u; nx = cnt > 0u ? cnt : 1u;
}

__device__ __forceinline__ void xcd_barrier(const XcdBarrier& b) {
    asm volatile("s_waitcnt vmcnt(0)" ::: "memory");
    __syncthreads();
    if (threadIdx.x == 0) {
        unsigned* bar = b.bar;
        __builtin_amdgcn_s_waitcnt(0);
        unsigned nloc = b.st[0], nx = b.st[1];
        if (nloc == 0u) { xcd_barrier_complete(bar, b.x, nloc, nx); b.st[0] = nloc; b.st[1] = nx; }
        const unsigned old = xb_add(&bar[XB_XSUB(b.x)], 1u);
        const unsigned gen = old / nloc;
        if (old + 1u == (gen + 1u) * nloc) {
            __builtin_amdgcn_fence(__ATOMIC_RELEASE, "agent");
            asm volatile("s_waitcnt vmcnt(0)" ::: "memory");
            const unsigned og = xb_add(&bar[XB_TOP], 1u);
            const unsigned tg = og / nx;
            if (og + 1u == (tg + 1u) * nx) xb_add(&bar[XB_TOPGEN], 1u);
            else XB_SPIN(xb_ld(&bar[XB_TOPGEN]) == tg, bar);
            __builtin_amdgcn_fence(__ATOMIC_ACQUIRE, "agent");
            xb_add(&bar[XB_XGEN(b.x)], 1u);
            asm volatile("s_waitcnt vmcnt(0)" ::: "memory");
        } else {
            XB_SPIN(xb_ld(&bar[XB_XGEN(b.x)]) == gen, bar);
            __builtin_amdgcn_fence(__ATOMIC_ACQUIRE, "agent");
            asm volatile("s_waitcnt vmcnt(0)" ::: "memory");
        }
    }
    __syncthreads();
}

struct Inputs {
    const float* x; const int* positions; const float* ffn_norm; const float* ffn_w_gate; const float* ffn_w_up; const float* ffn_w_down; const float* mix_norm; const float* final_norm;
    const float* mla_w_a; const float* mla_q_norm; const float* mla_w_qb; const float* mla_kv_norm; const float* mla_w_kvb; const float* mla_w_o;
    const float* ml_w_in; const float* ml_b_if; const float* ml_conv_w; const float* ml_conv_b; const float* ml_out_norm; const float* ml_w_o;
    const float* rw_mu; const float* rw_w_r; const float* rw_w_k; const float* rw_w_v; const float* rw_w0; const float* rw_w1; const float* rw_w2; const float* rw_a0; const float* rw_a1; const float* rw_a2;
    const float* rw_g1; const float* rw_g2; const float* rw_k_k; const float* rw_k_a; const float* rw_r_k; const float* rw_ln_w; const float* rw_ln_b; const float* rw_w_o;
};
struct Args { Inputs in; float* out; unsigned char* ws; int ph_lo, ph_hi; };

struct Frame {
    LAS unsigned char* lds;
    gu32* ctl;
    int tid, lane, wave, G, gw, NGW;
    float* X;
    bf16* XB;
    float* SS;
    unsigned char* ws;
};

__device__ __forceinline__ void cv_item(const float* Wp, int ld, int ks0, const float* g1, const float* g2, bf16* dst, int ldd, int kd0, int n0, LAS float* scr, int lane) {
    const int nl = lane & 31, kh = lane >> 5;
#pragma unroll 8
    for (int i = 0; i < 32; ++i) { const int kk = 2 * i + kh, k = ks0 + kk; float v = 0.f;
        if (Wp) { v = Wp[(size_t)k * ld]; if (g1) v *= g1[k]; if (g2) v *= g2[k]; }
        scr[kk * 33 + nl] = v; }
    LDS_WAIT(); asm volatile("" ::: "memory");
    const int c = lane & 7;
#pragma unroll
    for (int j = 0; j < 4; ++j) { const int n = (lane >> 3) + 8 * j; const LAS float* s = scr + (8 * c) * 33 + n;
        v4u o; o.x = cvtpk(s[0 * 33], s[1 * 33]); o.y = cvtpk(s[2 * 33], s[3 * 33]); o.z = cvtpk(s[4 * 33], s[5 * 33]); o.w = cvtpk(s[6 * 33], s[7 * 33]);
        *(GAS v4u*)(dst + (size_t)(n0 + n) * ldd + kd0 + 8 * c) = o; }
    LDS_WAIT(); asm volatile("" ::: "memory");
}

__device__ __forceinline__ void conv_layer(Frame& F, const Inputs& in, int layer) {
    LAS float* scr = (LAS float*)(F.lds + F.wave * 16384);
    bf16* WB = (bf16*)(F.ws + WS_W);
    const int kind = layer % 3, j = layer / 3, lane = F.lane, nl = lane & 31;
    constexpr int I_GU = (D / 64) * (2 * FF / 32), I_DN = (FF / 64) * (D / 32);
    constexpr int I_FFN = 2 * (I_GU + I_DN);
    constexpr int I_MLA = (1024 / 64) * (1024 / 32) + (512 / 64) * (1536 / 32) + (256 / 64) * (2048 / 32) + (1024 / 64) * (1024 / 32);
    constexpr int I_ML = (1024 / 64) * (3328 / 32) + (1024 / 64) * (1024 / 32);
    constexpr int I_RW = (2048 / 64) * (3328 / 32) + (256 / 64) * (3072 / 32) + (1024 / 64) * (1024 / 32);
    const int n_items = I_FFN + (kind == 0 ? I_MLA : kind == 1 ? I_ML : I_RW);
    for (int it = F.gw; it < n_items; it += F.NGW) {
        int r = it;
        if (r < I_FFN) {
            const int half = r / (I_GU + I_DN); r -= half * (I_GU + I_DN);
            const size_t wsel = (size_t)(layer * 2 + half);
            if (r < I_GU) {
                const int nb = r % (2 * FF / 32), kb = r / (2 * FF / 32), n = nb * 32 + nl, tile = n >> 8, w = n & 255;
                const float* W = (w < 128 ? in.ffn_w_gate : in.ffn_w_up) + wsel * D * FF + (tile * 128 + (w & 127));
                cv_item(W, FF, kb * 64, in.ffn_norm + wsel * D, nullptr, WB + (half ? WO_GU1 : WO_GU0), D, kb * 64, nb * 32, scr, lane);
            } else { r -= I_GU;
                const int nb = r % (D / 32), kb = r / (D / 32), n = nb * 32 + nl;
                cv_item(in.ffn_w_down + wsel * FF * D + n, D, kb * 64, nullptr, nullptr, WB + (half ? WO_D1 : WO_D0), FF, kb * 64, nb * 32, scr, lane);
            }
            continue;
        }
        r -= I_FFN;
        if (kind == 0) {
            const float* gmix = in.mix_norm + (size_t)layer * D;
            if (r < 16 * 32) {
                const int nb = r % 32, kb = r / 32, n = nb * 32 + nl; int col = n;
                if (n >= 768 && n < 832) { const int jj = n - 768; col = 768 + (jj >> 1) + 32 * (jj & 1); }
                const float* W = (n < LATN) ? in.mla_w_a + (size_t)j * D * LATN + col : nullptr;
                cv_item(W, LATN, kb * 64, gmix, nullptr, WB + WM_A, 1024, kb * 64, nb * 32, scr, lane); continue; }
            r -= 16 * 32;
            if (r < 8 * 48) {
                const int nb = r % 48, kb = r / 48, n = nb * 32 + nl, hd = n / DQK, w = n - hd * DQK; int col = n;
                if (w >= NOPE) { const int jj = w - NOPE; col = hd * DQK + NOPE + (jj >> 1) + 32 * (jj & 1); }
                cv_item(in.mla_w_qb + (size_t)j * QRANK * 1536 + col, 1536, kb * 64, in.mla_q_norm + (size_t)j * QRANK, nullptr, WB + WM_QB, 512, kb * 64, nb * 32, scr, lane); continue; }
            r -= 8 * 48;
            if (r < 4 * 64) {
                const int nb = r % 64, kb = r / 64, n = nb * 32 + nl;
                cv_item(in.mla_w_kvb + (size_t)j * KVRANK * 2048 + n, 2048, kb * 64, in.mla_kv_norm + (size_t)j * KVRANK, nullptr, WB + WM_KVB, 256, kb * 64, nb * 32, scr, lane); continue; }
            r -= 4 * 64;
            { const int nb = r % 32, kb = r / 32, n = nb * 32 + nl;
              cv_item(in.mla_w_o + (size_t)j * 1024 * 1024 + n, 1024, kb * 64, nullptr, nullptr, WB + WM_O, 1024, kb * 64, nb * 32, scr, lane); }
        } else if (kind == 1) {
            const float* gmix = in.mix_norm + (size_t)layer * D;
            if (r < 16 * 104) {
                const int nb = r % 104, kb = r / 104, n = nb * 32 + nl;
                const float* W = (n < ML_NIN) ? in.ml_w_in + (size_t)j * D * ML_NIN + n : nullptr;
                cv_item(W, ML_NIN, kb * 64, gmix, nullptr, WB + WL_IN, 1024, kb * 64, nb * 32, scr, lane); continue; }
            r -= 16 * 104;
            { const int nb = r % 32, kb = r / 32, n = nb * 32 + nl;
              cv_item(in.ml_w_o + (size_t)j * 1024 * 1024 + n, 1024, kb * 64, nullptr, nullptr, WB + WL_O, 1024, kb * 64, nb * 32, scr, lane); }
        } else {
            const float* gmix = in.mix_norm + (size_t)layer * D;
            const float* mu = in.rw_mu + (size_t)j * 6 * D;
            if (r < 32 * 104) {
                const int nb = r % 104, kb = r / 104, n = nb * 32 + nl; const float* W; int ld; const float* m;
                if (n < 1024) { W = in.rw_w_r + (size_t)j * D * D + n; ld = D; m = mu + 0 * D; }
                else if (n < 2048) { W = in.rw_w_k + (size_t)j * D * D + (n - 1024); ld = D; m = mu + 2 * D; }
                else if (n < 3072) { W = in.rw_w_v + (size_t)j * D * D + (n - 2048); ld = D; m = mu + 3 * D; }
                else if (n < 3136) { W = in.rw_w1 + (size_t)j * D * 64 + (n - 3072); ld = 64; m = mu + 1 * D; }
                else if (n < 3200) { W = in.rw_a1 + (size_t)j * D * 64 + (n - 3136); ld = 64; m = mu + 4 * D; }
                else { W = in.rw_g1 + (size_t)j * D * 128 + (n - 3200); ld = 128; m = mu + 5 * D; }
                const int ks0 = (kb & 15) * 64;
                cv_item(W, ld, ks0, gmix, (kb >= 16) ? m : nullptr, WB + WR_BIG, 2048, kb * 64, nb * 32, scr, lane); continue; }
            r -= 32 * 104;
            if (r < 4 * 96) {
                const int nb = r % 96, kb = r / 96, n = nb * 32 + nl; const float* W = nullptr; int ld = 1024, ks0 = 0;
                if (n < 1024) { if (kb == 0) { W = in.rw_w2 + (size_t)j * 64 * D + n; ks0 = 0; } }
                else if (n < 2048) { if (kb == 1) { W = in.rw_a2 + (size_t)j * 64 * D + (n - 1024); ks0 = 0; } }
                else { if (kb >= 2) { W = in.rw_g2 + (size_t)j * 128 * D + (n - 2048); ks0 = (kb - 2) * 64; } }
                cv_item(W, ld, ks0, nullptr, nullptr, WB + WR_UP, 256, kb * 64, nb * 32, scr, lane); continue; }
            r -= 4 * 96;
            { const int nb = r % 32, kb = r / 32, n = nb * 32 + nl;
              cv_item(in.rw_w_o + (size_t)j * 1024 * 1024 + n, 1024, kb * 64, nullptr, nullptr, WB + WR_O, 1024, kb * 64, nb * 32, scr, lane); }
        }
    }
}

__device__ __forceinline__ void prologue(Frame& F, const Inputs& in) {
    for (int m = F.gw; m < T; m += F.NGW) {
        const GAS f32x4* xr = (const GAS f32x4*)(in.x + (size_t)m * D) + F.lane;
        GAS f32x4* xo = (GAS f32x4*)(F.X + (size_t)m * D) + F.lane;
        GAS v2u* xb = (GAS v2u*)(F.XB + (size_t)m * D) + F.lane;
        float s = 0.f;
#pragma unroll
        for (int jj = 0; jj < 4; ++jj) { const f32x4 v = xr[64 * jj]; xo[64 * jj] = v; s += (v.x * v.x + v.y * v.y) + (v.z * v.z + v.w * v.w);
            v2u w; w.x = cvtpk(v.x, v.y); w.y = cvtpk(v.z, v.w); xb[64 * jj] = w; }
        s = wave_sum(s);
        if (F.lane < 16) F.SS[(size_t)m * 16 + F.lane] = (F.lane == 0) ? s : 0.f;
    }
    float* COS = (float*)(F.ws + WS_COS); float* SIN = (float*)(F.ws + WS_SIN);
    for (int e = F.gw * 64 + F.lane; e < T * 32; e += F.NGW * 64) {
        const int t = e >> 5, i = e & 31;
        const float inv_freq = __builtin_amdgcn_exp2f(-(float)i * 0.41524101186092029f);
        const float ang = (float)in.positions[t] * inv_freq;
        float sn, cs; fsincos_big(ang, sn, cs);
        COS[e] = cs; SIN[e] = sn;
    }
}

__device__ __forceinline__ float rstd16(const float* SS, int row) {
    const GAS f32x4* p = (const GAS f32x4*)(SS + (size_t)row * 16);
    const f32x4 a = p[0], b = p[1], c = p[2], d = p[3];
    const float s = ((a.x + a.y) + (a.z + a.w)) + ((b.x + b.y) + (b.z + b.w)) + ((c.x + c.y) + (c.z + c.w)) + ((d.x + d.y) + (d.z + d.w));
    return frsq(s * (1.f / D) + RMS_EPS);
}

#define EPI_ROWS(ai, m) (u.pm * 256 + (ai) * 128 + wr * 64 + (m) * 16 + fr)
typedef const f32x4 (&AccT)[2][2][4][2];
using pg8::Unit;

struct EpiSwiGLU { static constexpr bool PERM = true, AFTER_DRAIN = false; const float* SS; bf16* ACT;
    __device__ __forceinline__ void operator()(AccT acc, const Unit& u, int wr, int wc, int fr, int fq) const {
        const int col = u.pn * 128 + wc * 32 + fq * 8;
#pragma unroll
        for (int ai = 0; ai < 2; ++ai)
#pragma unroll
            for (int m = 0; m < 4; ++m) { asm volatile("" ::: "memory"); const int row = EPI_ROWS(ai, m); const float r = rstd16(SS, row);
                float o[8];
#pragma unroll
                for (int n = 0; n < 2; ++n)
#pragma unroll
                    for (int e = 0; e < 4; ++e) { const float g = acc[ai][0][m][n][e] * r, up = acc[ai][1][m][n][e] * r; o[4 * n + e] = fsilu(g) * up; }
                *(GAS v4u*)(ACT + (size_t)row * FF + col) = pack8f(o); }
    }
};
struct EpiResidual { static constexpr bool PERM = true, AFTER_DRAIN = false; float* X; bf16* XB; float* SS; float scale;
    __device__ __forceinline__ void operator()(AccT acc, const Unit& u, int wr, int wc, int fr, int fq) const {
#pragma unroll
        for (int ai = 0; ai < 2; ++ai)
#pragma unroll
            for (int m = 0; m < 4; ++m) { asm volatile("" ::: "memory"); const int row = EPI_ROWS(ai, m); float ss = 0.f;
#pragma unroll
                for (int bj = 0; bj < 2; ++bj) { const int col = u.pn * 256 + bj * 128 + wc * 32 + fq * 8;
                    GAS f32x4* xp = (GAS f32x4*)(X + (size_t)row * D + col);
                    f32x4 x0 = xp[0], x1 = xp[1];
                    x0 = x0 + acc[ai][bj][m][0] * scale; x1 = x1 + acc[ai][bj][m][1] * scale;
                    xp[0] = x0; xp[1] = x1;
                    *(GAS v4u*)(XB + (size_t)row * D + col) = pack8v(x0, x1);
                    ss += (x0.x * x0.x + x0.y * x0.y) + (x0.z * x0.z + x0.w * x0.w) + (x1.x * x1.x + x1.y * x1.y) + (x1.z * x1.z + x1.w * x1.w); }
                ss += __shfl_xor(ss, 16); ss += __shfl_xor(ss, 32);
                if (fq == 0) SS[(size_t)row * 16 + u.pn * 4 + wc] = ss; }
    }
};
__device__ __forceinline__ void rope8(float* v, const float* COS, const float* SIN, int row, int p0) {
    const f32x4 c = *(const GAS f32x4*)(COS + (size_t)row * 32 + p0), s = *(const GAS f32x4*)(SIN + (size_t)row * 32 + p0);
#pragma unroll
    for (int p = 0; p < 4; ++p) { const float x1 = v[2 * p], x2 = v[2 * p + 1]; v[2 * p] = x1 * c[p] - x2 * s[p]; v[2 * p + 1] = x1 * s[p] + x2 * c[p]; }
}
struct EpiMlaA { static constexpr bool PERM = true, AFTER_DRAIN = false; const float* SS; bf16* LAT; float* SSQ; float* SSKV; bf16* KPE; const float* COS; const float* SIN;
    __device__ __forceinline__ void operator()(AccT acc, const Unit& u, int wr, int wc, int fr, int fq) const {
#pragma unroll
        for (int ai = 0; ai < 2; ++ai)
#pragma unroll
            for (int m = 0; m < 4; ++m) { asm volatile("" ::: "memory"); const int row = EPI_ROWS(ai, m); const float r = rstd16(SS, row); float ss = 0.f;
#pragma unroll
                for (int bj = 0; bj < 2; ++bj) { const int col = u.pn * 256 + bj * 128 + wc * 32 + fq * 8;
                    float v[8];
#pragma unroll
                    for (int n = 0; n < 2; ++n)
#pragma unroll
                        for (int e = 0; e < 4; ++e) { v[4 * n + e] = acc[ai][bj][m][n][e] * r; ss += v[4 * n + e] * v[4 * n + e]; }
                    *(GAS v4u*)(LAT + (size_t)row * 1024 + col) = pack8f(v);
                    if (u.pn == 3 && bj == 0 && wc < 2) { rope8(v, COS, SIN, row, wc * 16 + fq * 4); *(GAS v4u*)(KPE + (size_t)row * 64 + wc * 32 + fq * 8) = pack8f(v); } }
                ss += __shfl_xor(ss, 16); ss += __shfl_xor(ss, 32);
                if (fq == 0) { if (u.pn < 2) SSQ[(size_t)row * 8 + u.pn * 4 + wc] = ss; else if (u.pn == 2) SSKV[(size_t)row * 4 + wc] = ss; } }
    }
};
struct EpiMlaQ { static constexpr bool PERM = true, AFTER_DRAIN = false; const float* SSQ; bf16* Q; const float* COS; const float* SIN; float qscale;
    __device__ __forceinline__ void operator()(AccT acc, const Unit& u, int wr, int wc, int fr, int fq) const {
#pragma unroll
        for (int ai = 0; ai < 2; ++ai)
#pragma unroll
            for (int m = 0; m < 4; ++m) { asm volatile("" ::: "memory"); const int row = EPI_ROWS(ai, m);
                const GAS f32x4* p = (const GAS f32x4*)(SSQ + (size_t)row * 8); const f32x4 a = p[0], b = p[1];
                const float r = frsq((((a.x + a.y) + (a.z + a.w)) + ((b.x + b.y) + (b.z + b.w))) * (1.f / QRANK) + RMS_EPS) * qscale;
#pragma unroll
                for (int bj = 0; bj < 2; ++bj) { const int col = u.pn * 256 + bj * 128 + wc * 32 + fq * 8, hd = col / DQK, w = col - hd * DQK;
                    float v[8];
#pragma unroll
                    for (int n = 0; n < 2; ++n)
#pragma unroll
                        for (int e = 0; e < 4; ++e) v[4 * n + e] = acc[ai][bj][m][n][e] * r;
                    if (w >= NOPE) rope8(v, COS, SIN, row, (w - NOPE) >> 1);
                    *(GAS v4u*)(Q + (size_t)row * 1536 + col) = pack8f(v); } }
    }
};
struct EpiMlaKV { static constexpr bool PERM = true, AFTER_DRAIN = false; const float* SSKV; bf16* KV;
    __device__ __forceinline__ void operator()(AccT acc, const Unit& u, int wr, int wc, int fr, int fq) const {
#pragma unroll
        for (int ai = 0; ai < 2; ++ai)
#pragma unroll
            for (int m = 0; m < 4; ++m) { asm volatile("" ::: "memory"); const int row = EPI_ROWS(ai, m);
                const f32x4 a = *(const GAS f32x4*)(SSKV + (size_t)row * 4);
                const float r = frsq(((a.x + a.y) + (a.z + a.w)) * (1.f / KVRANK) + RMS_EPS);
#pragma unroll
                for (int bj = 0; bj < 2; ++bj) { const int col = u.pn * 256 + bj * 128 + wc * 32 + fq * 8;
                    *(GAS v4u*)(KV + (size_t)row * 2048 + col) = pack8v(acc[ai][bj][m][0] * r, acc[ai][bj][m][1] * r); } }
    }
};
struct EpiMlIn { static constexpr bool PERM = true, AFTER_DRAIN = false; const float* SS; bf16* P; float* GATES;
    __device__ __forceinline__ void operator()(AccT acc, const Unit& u, int wr, int wc, int fr, int fq) const {
#pragma unroll
        for (int ai = 0; ai < 2; ++ai)
#pragma unroll
            for (int m = 0; m < 4; ++m) { asm volatile("" ::: "memory"); const int row = EPI_ROWS(ai, m); const float r = rstd16(SS, row);
                if (u.pn < 12) {
#pragma unroll
                    for (int bj = 0; bj < 2; ++bj) { const int col = u.pn * 256 + bj * 128 + wc * 32 + fq * 8;
                        *(GAS v4u*)(P + (size_t)row * 3072 + col) = pack8v(acc[ai][bj][m][0] * r, acc[ai][bj][m][1] * r); }
                } else if (wc == 0 && fq < 2) {
                    GAS f32x4* g = (GAS f32x4*)(GATES + (size_t)row * 16 + fq * 8); g[0] = acc[ai][0][m][0] * r; g[1] = acc[ai][0][m][1] * r; } }
    }
};
struct EpiRwBig { static constexpr bool PERM = true, AFTER_DRAIN = false; bf16* RKV; bf16* LOR;
    __device__ __forceinline__ void operator()(AccT acc, const Unit& u, int wr, int wc, int fr, int fq) const {
#pragma unroll
        for (int ai = 0; ai < 2; ++ai)
#pragma unroll
            for (int m = 0; m < 4; ++m) { asm volatile("" ::: "memory"); const int row = EPI_ROWS(ai, m);
#pragma unroll
                for (int bj = 0; bj < 2; ++bj) { const int cl = bj * 128 + wc * 32 + fq * 8;
                    if (u.pn < 12) { *(GAS v4u*)(RKV + (size_t)row * 3072 + u.pn * 256 + cl) = pack8v(acc[ai][bj][m][0], acc[ai][bj][m][1]); }
                    else { float v[8];
#pragma unroll
                        for (int n = 0; n < 2; ++n)
#pragma unroll
                            for (int e = 0; e < 4; ++e) { const float a = acc[ai][bj][m][n][e]; v[4 * n + e] = (cl < 64) ? ftanh(a) : (cl < 128) ? a : fsigmoid(a); }
                        *(GAS v4u*)(LOR + (size_t)row * 256 + cl) = pack8f(v); } } }
    }
};
struct EpiRwUp { static constexpr bool PERM = true, AFTER_DRAIN = false; float* LW; bf16* AA; bf16* GG; const float* w0; const float* a0;
    __device__ __forceinline__ void operator()(AccT acc, const Unit& u, int wr, int wc, int fr, int fq) const {
        const int sec = u.pn >> 2;
#pragma unroll
        for (int ai = 0; ai < 2; ++ai)
#pragma unroll
            for (int m = 0; m < 4; ++m) { asm volatile("" ::: "memory"); const int row = EPI_ROWS(ai, m);
#pragma unroll
                for (int bj = 0; bj < 2; ++bj) { const int col = (u.pn & 3) * 256 + bj * 128 + wc * 32 + fq * 8;
                    if (sec == 0) {
#pragma unroll
                        for (int n = 0; n < 2; ++n) { const f32x4 b = *(const GAS f32x4*)(w0 + col + 4 * n); f32x4 o;
#pragma unroll
                            for (int e = 0; e < 4; ++e) { const float z = -(acc[ai][bj][m][n][e] + b[e]); const float sp = fmaxf(z, 0.f) + flog(1.f + fexp(-fabsf(z))); o[e] = -fexp(-sp - 0.5f); }
                            *(GAS f32x4*)(LW + (size_t)row * 1024 + col + 4 * n) = o; } }
                    else if (sec == 1) { const f32x4 b0 = *(const GAS f32x4*)(a0 + col), b1 = *(const GAS f32x4*)(a0 + col + 4); float v[8];
#pragma unroll
                        for (int e = 0; e < 4; ++e) { v[e] = fsigmoid(acc[ai][bj][m][0][e] + b0[e]); v[4 + e] = fsigmoid(acc[ai][bj][m][1][e] + b1[e]); }
                        *(GAS v4u*)(AA + (size_t)row * 1024 + col) = pack8f(v); }
                    else { *(GAS v4u*)(GG + (size_t)row * 1024 + col) = pack8v(acc[ai][bj][m][0], acc[ai][bj][m][1]); } } }
    }
};

namespace att {
constexpr int SHM_K = 64 * DQK * 2  , SHM_V = 64 * DVH * 2  ;
constexpr int OFF_V = 0, OFF_K = 2 * SHM_V, OFF_WS = OFF_K + 2 * SHM_K, ATT_LDS = OFF_WS + NWAVES * 64 * 4;
static_assert(ATT_LDS <= RING_BYTES, "attention LDS");
#define KSWZ(row, colB) ((row) * 384 + ((colB) ^ (((row) & 7) << 4)))
#define SBAR() __builtin_amdgcn_sched_barrier(0)
__device__ __forceinline__ int v_st(int k, int c) { const int kk = (k & ~0xC) | ((k & 4) << 1) | ((k & 8) >> 1); return ((kk >> 3) * 4 + (c >> 5)) * 512 + ((kk & 7) * 32 + (c & 31)) * 2; }
__device__ __forceinline__ int v_rd_base(int lane) { return ((lane & 3) << 3) | (((lane >> 2) & 3) << 6) | (((lane >> 4) & 1) << 5) | (((lane >> 5) & 1) << 8); }
constexpr int v_rd_off(int d0, int ks, int half) { return d0 * 512 + ks * 4096 + half * 2048; }
__device__ __forceinline__ int crow(int r, int hi) { return (r & 3) + 8 * (r >> 2) + 4 * hi; }
__device__ __forceinline__ void mask_tile(f32x16& p0, f32x16& p1, int dq) {
    const float NEG = -__builtin_inff();
#pragma unroll
    for (int r = 0; r < 16; ++r) { const int c = (r & 3) + 8 * (r >> 2);
        if (dq - c < 0) p0[r] = NEG;
        if (dq - c - 32 < 0) p1[r] = NEG; }
}
constexpr float THR2 = 11.5f;
__device__ __forceinline__ void partialSM(f32x16& p0, f32x16& p1, float& m_reg, float& alpha) {
    float pmax = p0[0];
#pragma unroll
    for (int r = 1; r < 16; ++r) pmax = fmaxf(pmax, p0[r]);
#pragma unroll
    for (int r = 0; r < 16; ++r) pmax = fmaxf(pmax, p1[r]);
    { auto rr = __builtin_amdgcn_permlane32_swap(__float_as_uint(pmax), __float_as_uint(pmax), false, false);
      pmax = fmaxf(__uint_as_float(rr[0]), __uint_as_float(rr[1])); }
    float mn;
    if (__builtin_expect(__all((pmax - m_reg) <= THR2), 1)) { mn = m_reg; alpha = 1.f; }
    else { mn = fmaxf(m_reg, pmax); alpha = __builtin_amdgcn_exp2f(m_reg - mn); m_reg = mn; }
#pragma unroll
    for (int r = 0; r < 16; ++r) { p0[r] = __builtin_amdgcn_exp2f(p0[r] - mn); p1[r] = __builtin_amdgcn_exp2f(p1[r] - mn); }
}
__device__ __forceinline__ void finishSM(f32x16& p0, f32x16& p1, float alpha, float& l_reg, bf16x8& pa0, bf16x8& pa1, bf16x8& pa2, bf16x8& pa3) {
    float ps = 0;
#pragma unroll
    for (int r = 0; r < 16; ++r) ps += p0[r];
#pragma unroll
    for (int r = 0; r < 16; ++r) ps += p1[r];
    { auto rr = __builtin_amdgcn_permlane32_swap(__float_as_uint(ps), __float_as_uint(ps), false, false);
      ps = __uint_as_float(rr[0]) + __uint_as_float(rr[1]); }
    l_reg = l_reg * alpha + ps;
#define PK4(P, B_, OUT) do { unsigned a0 = cvtpk(P[B_+0], P[B_+1]), a1 = cvtpk(P[B_+2], P[B_+3]);                          \
        unsigned b0 = cvtpk(P[B_+4], P[B_+5]), b1 = cvtpk(P[B_+6], P[B_+7]);                                             \
        auto r0 = __builtin_amdgcn_permlane32_swap(a0, b0, false, false); auto r1 = __builtin_amdgcn_permlane32_swap(a1, b1, false, false); \
        v4u w = {r0[0], r1[0], r0[1], r1[1]}; OUT = __builtin_bit_cast(bf16x8, w); } while (0)
    PK4(p0, 0, pa0); PK4(p0, 8, pa1); PK4(p1, 0, pa2); PK4(p1, 8, pa3);
#undef PK4
}
__device__ __forceinline__ void qkt(f32x16& p0, f32x16& p1, const LAS char* Kb, int r32, int hi, const bf16x8* qr) {
    p0 = f32x16{}; p1 = f32x16{};
    const LAS char* kb[4];
#pragma unroll
    for (int dd = 0; dd < 4; ++dd) kb[dd] = Kb + r32 * 384 + ((dd * 32 + hi * 16) ^ ((r32 & 7) << 4));
#pragma unroll
    for (int d0 = 0; d0 < 12; ++d0) { const LAS char* a = kb[d0 & 3] + (d0 >> 2) * 128;
        const bf16x8 b0 = *(const LAS bf16x8*)(a);
        const bf16x8 b1 = *(const LAS bf16x8*)(a + 32 * 384);
        p0 = __builtin_amdgcn_mfma_f32_32x32x16_bf16(b0, qr[d0], p0, 0, 0, 0);
        p1 = __builtin_amdgcn_mfma_f32_32x32x16_bf16(b1, qr[d0], p1, 0, 0, 0); }
}
__device__ __forceinline__ void pv_tile(f32x16* o, int vb0, bf16x8 pa0, bf16x8 pa1, bf16x8 pa2, bf16x8 pa3) {
#define TRRD(dst, off) asm volatile("ds_read_b64_tr_b16 %0, %1 offset:%2" : "=&v"(dst) : "v"(vb0), "i"(off) : "memory")
#define PV_D0(d0) do { s16x4 l0, l1, l2, l3, h0, h1, h2, h3; constexpr int b_ = v_rd_off(d0, 0, 0); \
        TRRD(l0, b_); TRRD(h0, b_ + 2048); TRRD(l1, b_ + 4096); TRRD(h1, b_ + 6144); TRRD(l2, b_ + 8192); TRRD(h2, b_ + 10240); TRRD(l3, b_ + 12288); TRRD(h3, b_ + 14336); \
        asm volatile("s_waitcnt lgkmcnt(0)" ::: "memory"); SBAR(); \
        o[d0] = __builtin_amdgcn_mfma_f32_32x32x16_bf16(pa0, (bf16x8){l0[0], l0[1], l0[2], l0[3], h0[0], h0[1], h0[2], h0[3]}, o[d0], 0, 0, 0);   \
        o[d0] = __builtin_amdgcn_mfma_f32_32x32x16_bf16(pa1, (bf16x8){l1[0], l1[1], l1[2], l1[3], h1[0], h1[1], h1[2], h1[3]}, o[d0], 0, 0, 0);   \
        o[d0] = __builtin_amdgcn_mfma_f32_32x32x16_bf16(pa2, (bf16x8){l2[0], l2[1], l2[2], l2[3], h2[0], h2[1], h2[2], h2[3]}, o[d0], 0, 0, 0);   \
        o[d0] = __builtin_amdgcn_mfma_f32_32x32x16_bf16(pa3, (bf16x8){l3[0], l3[1], l3[2], l3[3], h3[0], h3[1], h3[2], h3[3]}, o[d0], 0, 0, 0); } while (0)
    PV_D0(0); PV_D0(1); PV_D0(2); PV_D0(3);
#undef PV_D0
#undef TRRD
}
__device__ __forceinline__ void attn_unit(int wid, int b, int h, int qb, const bf16* Q, const bf16* KV, const bf16* KPE, bf16* O, LAS char* lds) {
    const int lane = fresh_lane(), tid = wid * 64 + lane, r32 = lane & 31, hi = lane >> 5;
    const size_t rowbase = (size_t)b * SEQ; const int q0 = qb * 256;
    LAS char* V_lds = lds + OFF_V; LAS char* K_lds = lds + OFF_K;
    LAS float* wsf = (LAS float*)(lds + OFF_WS) + wid * 64; LAS float* li_l = wsf; LAS float* al_l = wsf + 32;
    bf16x8 qr[12];
    { const bf16* Qw = Q + (rowbase + q0 + wid * 32 + r32) * 1536 + h * DQK + hi * 8;
#pragma unroll
      for (int d0 = 0; d0 < 12; ++d0) qr[d0] = *(const GAS bf16x8*)(Qw + d0 * 16); }
    const int NT = 4 * (qb + 1);
    const bf16* ksrc[3]; int kdst[3]; int kstr[3];
#pragma unroll
    for (int i = 0; i < 3; ++i) { const int id = tid + 512 * i, row = id / 24, ch = id - row * 24;
        if (ch < 16) { ksrc[i] = KV + (rowbase + row) * 2048 + h * 256 + ch * 8; kstr[i] = 2048; }
        else { ksrc[i] = KPE + (rowbase + row) * 64 + (ch - 16) * 8; kstr[i] = 64; }
        kdst[i] = KSWZ(row, ch * 16); }
    const int sr = tid >> 4, sc = (tid & 15) * 8;
    const bf16* vsrc = KV + (rowbase + sr) * 2048 + h * 256 + 128 + sc;
    const int vst0 = v_st(sr, sc), vst1 = v_st(32 + sr, sc);
    const int vb0 = (int)(uintptr_t)V_lds + v_rd_base(lane);
    bf16x8 sk0, sk1, sk2, sv0, sv1;
#define SLOAD(t) do { sk0 = *(const GAS bf16x8*)(ksrc[0] + (size_t)(t) * 64 * kstr[0]); sk1 = *(const GAS bf16x8*)(ksrc[1] + (size_t)(t) * 64 * kstr[1]); sk2 = *(const GAS bf16x8*)(ksrc[2] + (size_t)(t) * 64 * kstr[2]); \
                      sv0 = *(const GAS bf16x8*)(vsrc + (size_t)(t) * 64 * 2048); sv1 = *(const GAS bf16x8*)(vsrc + (size_t)((t) * 64 + 32) * 2048); } while (0)
#define SWRITE(bf) do { *(LAS bf16x8*)(K_lds + (bf) * SHM_K + kdst[0]) = sk0; *(LAS bf16x8*)(K_lds + (bf) * SHM_K + kdst[1]) = sk1; *(LAS bf16x8*)(K_lds + (bf) * SHM_K + kdst[2]) = sk2; \
                        *(LAS bf16x8*)(V_lds + (bf) * SHM_V + vst0) = sv0; *(LAS bf16x8*)(V_lds + (bf) * SHM_V + vst1) = sv1; } while (0)
    float m_reg = -1e30f, l_reg = 0.f; f32x16 o[4] = {};
    const int qlo = q0 + wid * 32, qm = qlo + r32 - 4 * hi;
    SLOAD(0); SWRITE(0);
    __syncthreads();
    for (int t = 0; t < NT; ++t) {
        const int bf = t & 1;
        if (t + 1 < NT) SLOAD(t + 1);
        f32x16 p0, p1; float alpha; bf16x8 pa0, pa1, pa2, pa3;
        SBAR();
        qkt(p0, p1, K_lds + bf * SHM_K, r32, hi, qr);
        const int kb = t * 64;
        if (kb + 63 > qlo) mask_tile(p0, p1, qm - kb);
        partialSM(p0, p1, m_reg, alpha);
        if (__any(alpha < 1.f)) { if (hi == 0) al_l[r32] = alpha; LDS_WAIT();
#pragma unroll
            for (int d_ = 0; d_ < 4; ++d_)
#pragma unroll
                for (int r = 0; r < 16; ++r) o[d_][r] *= al_l[crow(r, hi)]; }
        finishSM(p0, p1, alpha, l_reg, pa0, pa1, pa2, pa3);
        SBAR();
        pv_tile(o, vb0 + bf * SHM_V, pa0, pa1, pa2, pa3);
        if (t + 1 < NT) SWRITE(bf ^ 1);
        __syncthreads();
    }
    if (hi == 0) li_l[r32] = l_reg; LDS_WAIT();
    bf16* Ow = O + (rowbase + q0 + wid * 32) * 1024 + h * DVH;
#pragma unroll
    for (int r = 0; r < 16; ++r) { const int orow = crow(r, hi); const float rl = frcp(li_l[orow]);
#pragma unroll
        for (int d0 = 0; d0 < 4; ++d0) { const float v = o[d0][r] * rl; const float vn = __shfl_xor(v, 1);
            if ((r32 & 1) == 0) *(GAS unsigned*)(Ow + (size_t)orow * 1024 + d0 * 32 + r32) = cvtpk(v, vn); } }
    __syncthreads();
#undef SLOAD
#undef SWRITE
}
#undef KSWZ
}

__device__ __forceinline__ void ml_conv_phase(Frame& F, const Inputs& in, int j) {
    const bf16* P = (const bf16*)(F.ws + WS_ARENA + A_P); const float* GATES = (const float*)(F.ws + WS_ARENA + A_GATES);
    float* QKC = (float*)(F.ws + WS_ARENA + A_QKC); float* IGLF = (float*)(F.ws + WS_ARENA + A_IGLF);
    const float* cw = in.ml_conv_w + (size_t)j * 4 * 1024; const float* cb = in.ml_conv_b + (size_t)j * 1024; const float* bif = in.ml_b_if + (size_t)j * 16;
    const int gt = F.gw * 64 + F.lane, NT_ = F.NGW * 64;
    for (int e = gt; e < T * 128; e += NT_) {
        const int t = e >> 7, c = (e & 127) * 8, s = t & (SEQ - 1);
        float acc[8];
        { const f32x4 b0 = *(const GAS f32x4*)(cb + c), b1 = *(const GAS f32x4*)(cb + c + 4);
#pragma unroll
          for (int q = 0; q < 4; ++q) { acc[q] = b0[q]; acc[4 + q] = b1[q]; } }
#pragma unroll
        for (int k = 0; k < 4; ++k) { const int dt = 3 - k;
            if (s - dt >= 0) { float pv[8]; unpack8(*(const GAS v4u*)(P + (size_t)(t - dt) * 3072 + c), pv);
                const f32x4 w0 = *(const GAS f32x4*)(cw + k * 1024 + c), w1 = *(const GAS f32x4*)(cw + k * 1024 + c + 4);
#pragma unroll
                for (int q = 0; q < 4; ++q) { acc[q] += w0[q] * pv[q]; acc[4 + q] += w1[q] * pv[4 + q]; } } }
        const float sc = (c >= 512) ? 0.125f : 1.f;
        f32x4 o0, o1;
#pragma unroll
        for (int q = 0; q < 4; ++q) { o0[q] = fsilu(acc[q]) * sc; o1[q] = fsilu(acc[4 + q]) * sc; }
        GAS f32x4* op = (GAS f32x4*)(QKC + (size_t)t * 1024 + c); op[0] = o0; op[1] = o1;
    }
    for (int e = gt; e < T * 16; e += NT_) { const int hcol = e & 15; const float g = GATES[e] + bif[hcol];
        float r = g;
        if (hcol >= 8) r = fminf(g, 0.f) - flog(1.f + fexp(-fabsf(g)));
        IGLF[e] = r; }
}
__device__ __forceinline__ void ml_seq_phase(Frame& F) {
    if ((int)blockIdx.x >= BATCH * ML_H) return;
    const int bh = blockIdx.x, b = bh >> 3, h = bh & 7, tid = F.tid, v = tid >> 2, kq = tid & 3;
    const bf16* P = (const bf16*)(F.ws + WS_ARENA + A_P); const float* QKC = (const float*)(F.ws + WS_ARENA + A_QKC); const float* IGLF = (const float*)(F.ws + WS_ARENA + A_IGLF);
    float* HRAW = (float*)(F.ws + WS_ARENA + A_HRAW);
    LAS float* s_q = (LAS float*)F.lds; LAS float* s_k = s_q + 64 * 64; LAS float* s_v = s_k + 64 * 64; LAS float* s_h = s_v + 64 * 128; LAS float* s_ig = s_h + 64 * 128; LAS float* s_lf = s_ig + 64;
    float C[16], n[16]; float mst = 0.f;
#pragma unroll
    for (int d = 0; d < 16; ++d) { C[d] = 0.f; n[d] = 0.f; }
    for (int blk = 0; blk < SEQ / 64; ++blk) {
        const size_t t0 = (size_t)b * SEQ + (size_t)blk * 64;
        __syncthreads();
        for (int e = tid; e < 64 * 16; e += 512) { const int tt = e >> 4, c4 = (e & 15) * 4;
            *(LAS f32x4*)(s_q + tt * 64 + c4) = *(const GAS f32x4*)(QKC + (t0 + tt) * 1024 + h * 64 + c4);
            *(LAS f32x4*)(s_k + tt * 64 + c4) = *(const GAS f32x4*)(QKC + (t0 + tt) * 1024 + 512 + h * 64 + c4); }
        for (int e = tid; e < 64 * 16; e += 512) { const int tt = e >> 4, c8 = (e & 15) * 8; float pv[8];
            unpack8(*(const GAS v4u*)(P + (t0 + tt) * 3072 + 1024 + h * 128 + c8), pv);
#pragma unroll
            for (int q = 0; q < 8; ++q) s_v[tt * 128 + c8 + q] = pv[q]; }
        if (tid < 64) { s_ig[tid] = IGLF[(t0 + tid) * 16 + h]; s_lf[tid] = IGLF[(t0 + tid) * 16 + 8 + h]; }
        __syncthreads();
        for (int tt = 0; tt < 64; ++tt) {
            const float lf = s_lf[tt], ig = s_ig[tt];
            const float mn = fmaxf(lf + mst, ig), fw = fexp(lf + mst - mn), iw = fexp(ig - mn); mst = mn;
            const float vv = s_v[tt * 128 + v] * iw;
            float num = 0.f, den = 0.f;
#pragma unroll
            for (int d4 = 0; d4 < 4; ++d4) { const f32x4 kk = *(const LAS f32x4*)(s_k + tt * 64 + kq * 16 + d4 * 4), qq = *(const LAS f32x4*)(s_q + tt * 64 + kq * 16 + d4 * 4);
#pragma unroll
                for (int q = 0; q < 4; ++q) { const int d = d4 * 4 + q; C[d] = fw * C[d] + vv * kk[q]; n[d] = fw * n[d] + iw * kk[q]; num += C[d] * qq[q]; den += n[d] * qq[q]; } }
            num += __shfl_xor(num, 1); num += __shfl_xor(num, 2); den += __shfl_xor(den, 1); den += __shfl_xor(den, 2);
            const float hv = num * frcp(fmaxf(fabsf(den), fexp(-mn)));
            if (kq == 0) s_h[tt * 128 + v] = hv;
        }
        __syncthreads();
        for (int e = tid; e < 64 * 32; e += 512) { const int tt = e >> 5, c4 = (e & 31) * 4;
            *(GAS f32x4*)(HRAW + (t0 + tt) * 1024 + h * 128 + c4) = *(const LAS f32x4*)(s_h + tt * 128 + c4); }
    }
}
__device__ __forceinline__ void ml_out_phase(Frame& F, const Inputs& in, int j) {
    const bf16* P = (const bf16*)(F.ws + WS_ARENA + A_P); const float* HRAW = (const float*)(F.ws + WS_ARENA + A_HRAW); bf16* HM = (bf16*)(F.ws + WS_ARENA + A_HM);
    const float* gn = in.ml_out_norm + (size_t)j * 1024;
    for (int m = F.gw; m < T; m += F.NGW) { const int c = F.lane * 16;
        float hv[16]; float ss = 0.f;
#pragma unroll
        for (int q = 0; q < 4; ++q) { const f32x4 x = *(const GAS f32x4*)(HRAW + (size_t)m * 1024 + c + 4 * q);
#pragma unroll
            for (int e = 0; e < 4; ++e) { hv[4 * q + e] = x[e]; ss += x[e] * x[e]; } }
        ss += __shfl_xor(ss, 1); ss += __shfl_xor(ss, 2); ss += __shfl_xor(ss, 4);
        const float r = frsq(ss * (1.f / 128.f) + RMS_EPS);
        float ov[16]; unpack8(*(const GAS v4u*)(P + (size_t)m * 3072 + 2048 + c), ov); unpack8(*(const GAS v4u*)(P + (size_t)m * 3072 + 2048 + c + 8), ov + 8);
        float res[16];
#pragma unroll
        for (int e = 0; e < 16; ++e) res[e] = hv[e] * r * gn[c + e] * fsigmoid(ov[e]);
        GAS v4u* op = (GAS v4u*)(HM + (size_t)m * 1024 + c); op[0] = pack8f(res); op[1] = pack8f(res + 8);
    }
}

__device__ __forceinline__ void rw_shift_phase(Frame& F) {
    bf16* HX = (bf16*)(F.ws + WS_ARENA + A_HX);
    for (int m = F.gw; m < T; m += F.NGW) { const int c = F.lane * 16, s = m & (SEQ - 1);
        const float r = rstd16(F.SS, m), rp = (s > 0) ? rstd16(F.SS, m - 1) : 0.f;
        float hv[16], xv[16];
#pragma unroll
        for (int q = 0; q < 4; ++q) { const f32x4 x = *(const GAS f32x4*)(F.X + (size_t)m * D + c + 4 * q);
            f32x4 xp = {0.f, 0.f, 0.f, 0.f}; if (s > 0) xp = *(const GAS f32x4*)(F.X + (size_t)(m - 1) * D + c + 4 * q);
#pragma unroll
            for (int e = 0; e < 4; ++e) { hv[4 * q + e] = x[e] * r; xv[4 * q + e] = xp[e] * rp - x[e] * r; } }
        GAS v4u* o1 = (GAS v4u*)(HX + (size_t)m * 2048 + c); o1[0] = pack8f(hv); o1[1] = pack8f(hv + 8);
        GAS v4u* o2 = (GAS v4u*)(HX + (size_t)m * 2048 + 1024 + c); o2[0] = pack8f(xv); o2[1] = pack8f(xv + 8);
    }
}
__device__ __forceinline__ void rw_seq_phase(Frame& F, const Inputs& in, int j) {
    if ((int)blockIdx.x >= BATCH * RW_H) return;
    const int bh = blockIdx.x, b = bh >> 4, h = bh & 15, tid = F.tid, i = tid >> 3, jr = tid & 7;
    const bf16* RKV = (const bf16*)(F.ws + WS_ARENA + A_RKV); const bf16* AA = (const bf16*)(F.ws + WS_XB); float* LW = (float*)(F.ws + WS_ARENA + A_LW);
    LAS float* s_r = (LAS float*)F.lds; LAS float* s_w = s_r + 4096; LAS float* s_k = s_w + 4096; LAS float* s_v = s_k + 4096; LAS float* s_a = s_v + 4096; LAS float* s_b = s_a + 4096; LAS float* s_y = s_b + 4096;
    float kkc[8], kac[8];
#pragma unroll
    for (int q = 0; q < 8; ++q) { kkc[q] = in.rw_k_k[(size_t)j * 1024 + h * 64 + jr * 8 + q]; kac[q] = in.rw_k_a[(size_t)j * 1024 + h * 64 + jr * 8 + q]; }
    float S[8];
#pragma unroll
    for (int q = 0; q < 8; ++q) S[q] = 0.f;
    for (int blk = 0; blk < SEQ / 64; ++blk) {
        const size_t t0 = (size_t)b * SEQ + (size_t)blk * 64;
        __syncthreads();
        { const int tt = tid >> 3; const size_t t = t0 + tt; const int c = h * 64 + jr * 8;
          float rv[8], kv[8], vv[8], av[8];
          unpack8(*(const GAS v4u*)(RKV + t * 3072 + c), rv); unpack8(*(const GAS v4u*)(RKV + t * 3072 + 1024 + c), kv); unpack8(*(const GAS v4u*)(RKV + t * 3072 + 2048 + c), vv);
          unpack8(*(const GAS v4u*)(AA + t * 1024 + c), av);
          const f32x4 l0 = *(const GAS f32x4*)(LW + t * 1024 + c), l1 = *(const GAS f32x4*)(LW + t * 1024 + c + 4);
          float kk[8]; float ss = 0.f;
#pragma unroll
          for (int q = 0; q < 8; ++q) { kk[q] = kv[q] * kkc[q]; ss += kk[q] * kk[q]; }
          ss += __shfl_xor(ss, 1); ss += __shfl_xor(ss, 2); ss += __shfl_xor(ss, 4);
          const float inv = frcp(fmaxf(fsqrt(ss), 1e-12f));
#pragma unroll
          for (int q = 0; q < 8; ++q) { const float kn = kk[q] * inv; const int o = tt * 64 + jr * 8 + q;
              s_r[o] = rv[q]; s_w[o] = fexp(q < 4 ? l0[q] : l1[q - 4]); s_k[o] = kv[q] * (1.f + (av[q] - 1.f) * kac[q]); s_v[o] = vv[q]; s_a[o] = -kn; s_b[o] = kn * av[q]; } }
        __syncthreads();
        for (int tt = 0; tt < 64; ++tt) {
            const int o = tt * 64 + jr * 8;
            const f32x4 a0 = *(const LAS f32x4*)(s_a + o), a1 = *(const LAS f32x4*)(s_a + o + 4), w0 = *(const LAS f32x4*)(s_w + o), w1 = *(const LAS f32x4*)(s_w + o + 4);
            const f32x4 b0 = *(const LAS f32x4*)(s_b + o), b1 = *(const LAS f32x4*)(s_b + o + 4), k0 = *(const LAS f32x4*)(s_k + o), k1 = *(const LAS f32x4*)(s_k + o + 4);
            const f32x4 r0 = *(const LAS f32x4*)(s_r + o), r1 = *(const LAS f32x4*)(s_r + o + 4);
            const float vi = s_v[tt * 64 + i];
            float sa = 0.f;
#pragma unroll
            for (int q = 0; q < 4; ++q) { sa += S[q] * a0[q]; sa += S[4 + q] * a1[q]; }
            sa += __shfl_xor(sa, 1); sa += __shfl_xor(sa, 2); sa += __shfl_xor(sa, 4);
            float y = 0.f;
#pragma unroll
            for (int q = 0; q < 4; ++q) { S[q] = S[q] * w0[q] + sa * b0[q] + vi * k0[q]; S[4 + q] = S[4 + q] * w1[q] + sa * b1[q] + vi * k1[q]; y += S[q] * r0[q]; y += S[4 + q] * r1[q]; }
            y += __shfl_xor(y, 1); y += __shfl_xor(y, 2); y += __shfl_xor(y, 4);
            if (jr == 0) s_y[tt * 64 + i] = y;
        }
        __syncthreads();
        for (int e = tid; e < 64 * 16; e += 512) { const int tt = e >> 4, c4 = (e & 15) * 4;
            *(GAS f32x4*)(LW + (t0 + tt) * 1024 + h * 64 + c4) = *(const LAS f32x4*)(s_y + tt * 64 + c4); }
    }
}
__device__ __forceinline__ void rw_out_phase(Frame& F, const Inputs& in, int j) {
    const bf16* RKV = (const bf16*)(F.ws + WS_ARENA + A_RKV); const bf16* AA = (const bf16*)(F.ws + WS_XB); const float* Y = (const float*)(F.ws + WS_ARENA + A_LW);
    const bf16* GG = (const bf16*)(F.ws + WS_ARENA + A_GG); bf16* YG = (bf16*)(F.ws + WS_ARENA + A_YG);
    const float* ka = in.rw_k_a + (size_t)j * 1024; const float* rk = in.rw_r_k + (size_t)j * 1024; const float* lnw = in.rw_ln_w + (size_t)j * 1024; const float* lnb = in.rw_ln_b + (size_t)j * 1024;
    for (int m = F.gw; m < T; m += F.NGW) { const int c = F.lane * 16;
        float yv[16]; float s1 = 0.f;
#pragma unroll
        for (int q = 0; q < 4; ++q) { const f32x4 x = *(const GAS f32x4*)(Y + (size_t)m * 1024 + c + 4 * q);
#pragma unroll
            for (int e = 0; e < 4; ++e) { yv[4 * q + e] = x[e]; s1 += x[e]; } }
        s1 += __shfl_xor(s1, 1); s1 += __shfl_xor(s1, 2); const float mean = s1 * (1.f / 64.f);
        float s2 = 0.f;
#pragma unroll
        for (int e = 0; e < 16; ++e) { yv[e] -= mean; s2 += yv[e] * yv[e]; }
        s2 += __shfl_xor(s2, 1); s2 += __shfl_xor(s2, 2); const float rs = frsq(s2 * (1.f / 64.f) + 64e-5f);
        float rv[16], kv[16], vv[16], av[16], gv[16];
        unpack8(*(const GAS v4u*)(RKV + (size_t)m * 3072 + c), rv); unpack8(*(const GAS v4u*)(RKV + (size_t)m * 3072 + c + 8), rv + 8);
        unpack8(*(const GAS v4u*)(RKV + (size_t)m * 3072 + 1024 + c), kv); unpack8(*(const GAS v4u*)(RKV + (size_t)m * 3072 + 1024 + c + 8), kv + 8);
        unpack8(*(const GAS v4u*)(RKV + (size_t)m * 3072 + 2048 + c), vv); unpack8(*(const GAS v4u*)(RKV + (size_t)m * 3072 + 2048 + c + 8), vv + 8);
        unpack8(*(const GAS v4u*)(AA + (size_t)m * 1024 + c), av); unpack8(*(const GAS v4u*)(AA + (size_t)m * 1024 + c + 8), av + 8);
        unpack8(*(const GAS v4u*)(GG + (size_t)m * 1024 + c), gv); unpack8(*(const GAS v4u*)(GG + (size_t)m * 1024 + c + 8), gv + 8);
        float bs = 0.f;
#pragma unroll
        for (int e = 0; e < 16; ++e) { const float kp = kv[e] * (1.f + (av[e] - 1.f) * ka[c + e]); bs += rv[e] * kp * rk[c + e]; }
        bs += __shfl_xor(bs, 1); bs += __shfl_xor(bs, 2);
        float res[16];
#pragma unroll
        for (int e = 0; e < 16; ++e) res[e] = (yv[e] * rs * lnw[c + e] + lnb[c + e] + bs * vv[e]) * gv[e];
        GAS v4u* op = (GAS v4u*)(YG + (size_t)m * 1024 + c); op[0] = pack8f(res); op[1] = pack8f(res + 8);
    }
}
__device__ __forceinline__ void final_norm_phase(Frame& F, const Inputs& in) {
    for (int m = F.gw; m < T; m += F.NGW) { const float r = rstd16(F.SS, m);
        GAS f32x4* xp = (GAS f32x4*)(F.X + (size_t)m * D) + F.lane; const GAS f32x4* gp = (const GAS f32x4*)in.final_norm + F.lane;
#pragma unroll
        for (int q = 0; q < 4; ++q) { f32x4 x = xp[64 * q]; const f32x4 g = gp[64 * q]; x = x * r * g; xp[64 * q] = x; } }
}

namespace mlc {
constexpr int NUNIT = BATCH * ML_H * (SEQ / 64);
constexpr size_t A_QKB = 97 * MiB;
constexpr size_t A_XT = 130 * MiB;
constexpr size_t A_CT = 194 * MiB;
constexpr size_t A_NX = 226 * MiB, A_NC = 227 * MiB;
constexpr size_t A_SC = 228 * MiB;
constexpr size_t A_HM2 = A_XT;
constexpr size_t A_IG2 = 129 * MiB;
constexpr int SLOT = 34816;
using att::v_st; using att::v_rd_base; using att::v_rd_off; using att::crow;
#define TRRD(dst, base, off) asm volatile("ds_read_b64_tr_b16 %0, %1 offset:%2" : "=&v"(dst) : "v"(base), "i"(off) : "memory")
#define FRAG(l, h) ((bf16x8){l[0], l[1], l[2], l[3], h[0], h[1], h[2], h[3]})
__device__ __forceinline__ float swap_add(float x) { auto rr = __builtin_amdgcn_permlane32_swap(__float_as_uint(x), __float_as_uint(x), false, false); return __uint_as_float(rr[0]) + __uint_as_float(rr[1]); }
__device__ __forceinline__ float wave_incl_scan_add(float v, int lane) {
#pragma unroll
    for (int o = 1; o < 64; o <<= 1) { const float t = __shfl_up(v, o); if (lane >= o) v += t; }
    return v;
}
__device__ __forceinline__ float wave_incl_scan_max(float v, int lane) {
#pragma unroll
    for (int o = 1; o < 64; o <<= 1) { const float t = __shfl_up(v, o); if (lane >= o) v = fmaxf(v, t); }
    return v;
}
__device__ __forceinline__ float wave_max(float v) {
#pragma unroll
    for (int o = 1; o < 64; o <<= 1) v = fmaxf(v, __shfl_xor(v, o));
    return v;
}
__device__ __forceinline__ void conv_phase(Frame& F, const Inputs& in, int j) {
    const bf16* P = (const bf16*)(F.ws + WS_ARENA + A_P); const float* GATES = (const float*)(F.ws + WS_ARENA + A_GATES);
    bf16* QKB = (bf16*)(F.ws + WS_ARENA + A_QKB); float* IGLF = (float*)(F.ws + WS_ARENA + mlc::A_IG2);
    const float* cw = in.ml_conv_w + (size_t)j * 4 * 1024; const float* cb = in.ml_conv_b + (size_t)j * 1024; const float* bif = in.ml_b_if + (size_t)j * 16;
    const int gt = F.gw * 64 + F.lane, NT_ = F.NGW * 64;
    for (int e = gt; e < T * 128; e += NT_) {
        const int t = e >> 7, c = (e & 127) * 8, s = t & (SEQ - 1);
        float acc[8];
        { const f32x4 b0 = *(const GAS f32x4*)(cb + c), b1 = *(const GAS f32x4*)(cb + c + 4);
#pragma unroll
          for (int q = 0; q < 4; ++q) { acc[q] = b0[q]; acc[4 + q] = b1[q]; } }
#pragma unroll
        for (int k = 0; k < 4; ++k) { const int dt = 3 - k;
            if (s - dt >= 0) { float pv[8]; unpack8(*(const GAS v4u*)(P + (size_t)(t - dt) * 3072 + c), pv);
                const f32x4 w0 = *(const GAS f32x4*)(cw + k * 1024 + c), w1 = *(const GAS f32x4*)(cw + k * 1024 + c + 4);
#pragma unroll
                for (int q = 0; q < 4; ++q) { acc[q] += w0[q] * pv[q]; acc[4 + q] += w1[q] * pv[4 + q]; } } }
        const float sc = (c >= 512) ? 0.125f : 1.f;
        float o[8];
#pragma unroll
        for (int q = 0; q < 8; ++q) o[q] = fsilu(acc[q]) * sc;
        *(GAS v4u*)(QKB + (size_t)t * 1024 + c) = pack8f(o);
    }
    for (int e = gt; e < T * 16; e += NT_) { const int hcol = e & 15; const float g = GATES[e] + bif[hcol];
        float r = g;
        if (hcol >= 8) r = fminf(g, 0.f) - flog(1.f + fexp(-fabsf(g)));
        IGLF[e] = r; }
}
__device__ __forceinline__ void stage_tr128(LAS char* tile, const bf16* src, int ld, int lt, int nthr) {
    for (int idx = lt; idx < 1024; idx += nthr) { const int row = idx >> 4, ch = idx & 15;
        *(LAS v4u*)(tile + v_st(row, ch * 8)) = *(const GAS v4u*)(src + (size_t)row * ld + ch * 8); }
}
__device__ __forceinline__ void xa_phase(Frame& F) {
    const bf16* P = (const bf16*)(F.ws + WS_ARENA + A_P); const bf16* QKB = (const bf16*)(F.ws + WS_ARENA + A_QKB); const float* IGLF = (const float*)(F.ws + WS_ARENA + mlc::A_IG2);
    float* XT = (float*)(F.ws + WS_ARENA + A_XT); float* NX = (float*)(F.ws + WS_ARENA + A_NX); float* SC = (float*)(F.ws + WS_ARENA + A_SC);
    const int lane = F.lane, wave = F.wave, r32 = lane & 31, hi = lane >> 5, us = wave >> 1, half = wave & 1, lt = half * 64 + lane;
    LAS char* slot = (LAS char*)F.lds + us * SLOT; LAS char* Vt = slot; LAS char* KWt = slot + 16384; LAS float* wsl = (LAS float*)(slot + 32768);
    for (int u0 = (int)blockIdx.x * 4; u0 < NUNIT; u0 += F.G * 4) {
        const int u = u0 + us, bh = u >> 7, c = u & 127, b = bh >> 3, h = bh & 7; const size_t t0 = (size_t)b * SEQ + (size_t)c * 64;
        const float lf = IGLF[(t0 + lane) * 16 + 8 + h], ig = IGLF[(t0 + lane) * 16 + h];
        const float Fc = wave_incl_scan_add(lf, lane), bs = ig - Fc, M = wave_max(bs), a = __shfl(Fc, 63), w = fexp(bs - M);
        if (half == 0) { wsl[lane] = w; if (lane == 0) { SC[u] = a; SC[NUNIT + u] = M; } }
        __syncthreads();
        stage_tr128(Vt, P + t0 * 3072 + 1024 + h * 128, 3072, lt, 128);
        for (int idx = lt; idx < 512; idx += 128) { const int row = idx >> 3, ch = idx & 7; float kv[8];
            unpack8(*(const GAS v4u*)(QKB + (t0 + row) * 1024 + 512 + h * 64 + ch * 8), kv); const float ww = wsl[row];
#pragma unroll
            for (int q = 0; q < 8; ++q) kv[q] *= ww;
            *(LAS v4u*)(KWt + v_st(row, ch * 8)) = pack8f(kv); }
        __syncthreads();
        const int vb = (int)(uintptr_t)Vt + v_rd_base(lane), kb = (int)(uintptr_t)KWt + v_rd_base(lane) + half * 512;
        f32x16 acc[4] = {};
#define XA_VT(vt) do { s16x4 vl0, vh0, vl1, vh1, vl2, vh2, vl3, vh3, kl0, kh0, kl1, kh1, kl2, kh2, kl3, kh3; constexpr int o_ = v_rd_off(vt, 0, 0); \
            TRRD(vl0, vb, o_); TRRD(vh0, vb, o_ + 2048); TRRD(vl1, vb, o_ + 4096); TRRD(vh1, vb, o_ + 6144); TRRD(vl2, vb, o_ + 8192); TRRD(vh2, vb, o_ + 10240); TRRD(vl3, vb, o_ + 12288); TRRD(vh3, vb, o_ + 14336); \
            TRRD(kl0, kb, 0); TRRD(kh0, kb, 2048); TRRD(kl1, kb, 4096); TRRD(kh1, kb, 6144); TRRD(kl2, kb, 8192); TRRD(kh2, kb, 10240); TRRD(kl3, kb, 12288); TRRD(kh3, kb, 14336); \
            asm volatile("s_waitcnt lgkmcnt(0)" ::: "memory"); __builtin_amdgcn_sched_barrier(0); \
            acc[vt] = __builtin_amdgcn_mfma_f32_32x32x16_bf16(FRAG(vl0, vh0), FRAG(kl0, kh0), acc[vt], 0, 0, 0); \
            acc[vt] = __builtin_amdgcn_mfma_f32_32x32x16_bf16(FRAG(vl1, vh1), FRAG(kl1, kh1), acc[vt], 0, 0, 0); \
            acc[vt] = __builtin_amdgcn_mfma_f32_32x32x16_bf16(FRAG(vl2, vh2), FRAG(kl2, kh2), acc[vt], 0, 0, 0); \
            acc[vt] = __builtin_amdgcn_mfma_f32_32x32x16_bf16(FRAG(vl3, vh3), FRAG(kl3, kh3), acc[vt], 0, 0, 0); } while (0)
        XA_VT(0); XA_VT(1); XA_VT(2); XA_VT(3);
#undef XA_VT
        { const int d = half * 32 + r32; float nx = 0.f;
#pragma unroll 8
          for (int s = 0; s < 32; ++s) nx += bf1(*(const LAS bf16*)(KWt + v_st(32 * hi + s, d & ~7) + (d & 7) * 2));
          nx = swap_add(nx);
          if (hi == 0) NX[(size_t)u * 64 + d] = nx; }
        { GAS float* xo = (GAS float*)(XT + (size_t)u * 8192 + half * 32 + r32 + hi * 256);
#pragma unroll
          for (int vt = 0; vt < 4; ++vt)
#pragma unroll
              for (int r4 = 0; r4 < 4; ++r4) { asm volatile("" : "+v"(xo));
#pragma unroll
                  for (int r0 = 0; r0 < 4; ++r0) xo[r0 * 64] = acc[vt][r4 * 4 + r0];
                  xo += 512; } }
        __syncthreads();
    }
}
__device__ __forceinline__ void xb_phase(Frame& F) {
    const float* XT = (const float*)(F.ws + WS_ARENA + A_XT); const float* NX = (const float*)(F.ws + WS_ARENA + A_NX); float* SC = (float*)(F.ws + WS_ARENA + A_SC);
    bf16* CT = (bf16*)(F.ws + WS_ARENA + A_CT); float* NC = (float*)(F.ws + WS_ARENA + A_NC);
    for (int g = (int)blockIdx.x * 512 + F.tid; g < BATCH * ML_H * 8192; g += F.G * 512) {
        const int bh = g >> 13, e = g & 8191;
        float m = 0.f, C = 0.f, n = 0.f;
#pragma unroll 8
        for (int c = 0; c < 128; ++c) { const int u = bh * 128 + c;
            const float a = SC[u], M = SC[NUNIT + u];
            const float x = XT[(size_t)u * 8192 + e];
            CT[(size_t)u * 8192 + e] = (bf16)(cvtpk(C, 0.f) & 0xffffu);
            const float mn = a + fmaxf(m, M), fC = fexp(a + m - mn), fX = fexp(a + M - mn);
            if (e < 64) { NC[(size_t)u * 64 + e] = n; n = fC * n + fX * NX[(size_t)u * 64 + e]; }
            if (e == 0) SC[2 * NUNIT + u] = m;
            C = fC * C + fX * x; m = mn; }
    }
}
__device__ __forceinline__ void xc_phase(Frame& F, const Inputs& in, int j) {
    const bf16* P = (const bf16*)(F.ws + WS_ARENA + A_P); const bf16* QKB = (const bf16*)(F.ws + WS_ARENA + A_QKB); const float* IGLF = (const float*)(F.ws + WS_ARENA + mlc::A_IG2);
    const bf16* CT = (const bf16*)(F.ws + WS_ARENA + A_CT); const float* NC = (const float*)(F.ws + WS_ARENA + A_NC); const float* SC = (const float*)(F.ws + WS_ARENA + A_SC);
    bf16* HM = (bf16*)(F.ws + WS_ARENA + A_HM2); const float* gn = in.ml_out_norm + (size_t)j * 1024;
    const int lane = F.lane, wave = F.wave, r32 = lane & 31, hi = lane >> 5, us = wave >> 1, th = wave & 1, lt = th * 64 + lane;
    LAS char* slot = (LAS char*)F.lds + us * SLOT; LAS char* Kt = slot; LAS char* Vt = slot + 8192;
    LAS float* sb = (LAS float*)(slot + 24576); LAS float* se = sb + 64; LAS float* sF = se + 64; LAS float* sn = sF + 64;
    LAS float* ob = (LAS float*)(slot + th * 16896);
    for (int u0 = (int)blockIdx.x * 4; u0 < NUNIT; u0 += F.G * 4) {
        const int u = u0 + us, bh = u >> 7, c = u & 127, b = bh >> 3, h = bh & 7; const size_t t0 = (size_t)b * SEQ + (size_t)c * 64;
        const float mc = SC[2 * NUNIT + u];
        { const float lf = IGLF[(t0 + lane) * 16 + 8 + h], ig = IGLF[(t0 + lane) * 16 + h];
          const float Fc = wave_incl_scan_add(lf, lane), bs = ig - Fc, Mt = wave_incl_scan_max(bs, lane);
          if (th == 0) { sb[lane] = bs; se[lane] = fmaxf(mc, Mt); sF[lane] = Fc; sn[lane] = NC[(size_t)u * 64 + lane]; } }
        for (int idx = lt; idx < 512; idx += 128) { const int row = idx >> 3, ch = idx & 7;
            *(LAS v4u*)(Kt + row * 128 + ((ch * 16) ^ ((row & 7) << 4))) = *(const GAS v4u*)(QKB + (t0 + row) * 1024 + 512 + h * 64 + ch * 8); }
        stage_tr128(Vt, P + t0 * 3072 + 1024 + h * 128, 3072, lt, 128);
        const int tl = th * 32 + r32;
        bf16x8 qr[4];
#pragma unroll
        for (int d0 = 0; d0 < 4; ++d0) qr[d0] = *(const GAS bf16x8*)(QKB + (t0 + tl) * 1024 + h * 64 + d0 * 16 + hi * 8);
        __syncthreads();
        const float et = se[tl], Fct = sF[tl], iw = fexp(mc - et);
        f32x16 p0 = {}, p1 = {};
#pragma unroll
        for (int d0 = 0; d0 < 4; ++d0) { const int cb = (d0 * 32 + hi * 16) ^ ((r32 & 7) << 4);
            const bf16x8 k0 = *(const LAS bf16x8*)(Kt + r32 * 128 + cb);
            p0 = __builtin_amdgcn_mfma_f32_32x32x16_bf16(k0, qr[d0], p0, 0, 0, 0);
            if (th) { const bf16x8 k1 = *(const LAS bf16x8*)(Kt + (32 + r32) * 128 + cb); p1 = __builtin_amdgcn_mfma_f32_32x32x16_bf16(k1, qr[d0], p1, 0, 0, 0); } }
        float dsum = 0.f;
#pragma unroll
        for (int r = 0; r < 16; ++r) { const int s0 = crow(r, hi);
            const float w0 = (s0 <= tl) ? fexp(sb[s0] - et) : 0.f; p0[r] *= w0; dsum += p0[r];
            const float w1 = (th && s0 + 32 <= tl) ? fexp(sb[s0 + 32] - et) : 0.f; p1[r] *= w1; dsum += p1[r]; }
        dsum = swap_add(dsum);
        bf16x8 pa0, pa1, pa2, pa3;
#define PK4(Pv, B_, OUT) do { unsigned a0 = cvtpk(Pv[B_+0], Pv[B_+1]), a1 = cvtpk(Pv[B_+2], Pv[B_+3]); unsigned b0 = cvtpk(Pv[B_+4], Pv[B_+5]), b1 = cvtpk(Pv[B_+6], Pv[B_+7]); \
        auto r0 = __builtin_amdgcn_permlane32_swap(a0, b0, false, false); auto r1 = __builtin_amdgcn_permlane32_swap(a1, b1, false, false); \
        v4u w_ = {r0[0], r1[0], r0[1], r1[1]}; OUT = __builtin_bit_cast(bf16x8, w_); } while (0)
        PK4(p0, 0, pa0); PK4(p0, 8, pa1); PK4(p1, 0, pa2); PK4(p1, 8, pa3);
#undef PK4
        float qn = 0.f;
#pragma unroll
        for (int d0 = 0; d0 < 4; ++d0) { float qv[8]; unpack8(__builtin_bit_cast(v4u, qr[d0]), qv);
#pragma unroll
            for (int q = 0; q < 8; ++q) qn += qv[q] * sn[d0 * 16 + hi * 8 + q]; }
        qn = swap_add(qn);
        f32x16 acc[4] = {};
        const bf16* ctp = CT + (size_t)u * 8192 + (size_t)r32 * 64 + hi * 8;
#pragma unroll
        for (int vt = 0; vt < 4; ++vt)
#pragma unroll
            for (int d0 = 0; d0 < 4; ++d0) { const bf16x8 cf = *(const GAS bf16x8*)(ctp + vt * 32 * 64 + d0 * 16);
                acc[vt] = __builtin_amdgcn_mfma_f32_32x32x16_bf16(cf, qr[d0], acc[vt], 0, 0, 0); }
#pragma unroll
        for (int vt = 0; vt < 4; ++vt)
#pragma unroll
            for (int r = 0; r < 16; ++r) acc[vt][r] *= iw;
        const int vb = (int)(uintptr_t)Vt + v_rd_base(lane);
#define XC_VT(vt) do { s16x4 vl0, vh0, vl1, vh1, vl2, vh2, vl3, vh3; constexpr int o_ = v_rd_off(vt, 0, 0); \
            TRRD(vl0, vb, o_); TRRD(vh0, vb, o_ + 2048); TRRD(vl1, vb, o_ + 4096); TRRD(vh1, vb, o_ + 6144); \
            if (th) { TRRD(vl2, vb, o_ + 8192); TRRD(vh2, vb, o_ + 10240); TRRD(vl3, vb, o_ + 12288); TRRD(vh3, vb, o_ + 14336); } \
            asm volatile("s_waitcnt lgkmcnt(0)" ::: "memory"); __builtin_amdgcn_sched_barrier(0); \
            acc[vt] = __builtin_amdgcn_mfma_f32_32x32x16_bf16(FRAG(vl0, vh0), pa0, acc[vt], 0, 0, 0); \
            acc[vt] = __builtin_amdgcn_mfma_f32_32x32x16_bf16(FRAG(vl1, vh1), pa1, acc[vt], 0, 0, 0); \
            if (th) { acc[vt] = __builtin_amdgcn_mfma_f32_32x32x16_bf16(FRAG(vl2, vh2), pa2, acc[vt], 0, 0, 0); \
                      acc[vt] = __builtin_amdgcn_mfma_f32_32x32x16_bf16(FRAG(vl3, vh3), pa3, acc[vt], 0, 0, 0); } } while (0)
        XC_VT(0); XC_VT(1); XC_VT(2); XC_VT(3);
#undef XC_VT
        const float den = dsum + iw * qn;
        const float hs = frcp(fmaxf(fabsf(den), fexp(-Fct - et)));
        float ss = 0.f;
#pragma unroll
        for (int vt = 0; vt < 4; ++vt)
#pragma unroll
            for (int r = 0; r < 16; ++r) { acc[vt][r] *= hs; ss += acc[vt][r] * acc[vt][r]; }
        ss = swap_add(ss);
        const float rn = frsq(ss * (1.f / 128.f) + RMS_EPS);
        __syncthreads();
#pragma unroll
        for (int vt = 0; vt < 4; ++vt)
#pragma unroll
            for (int r = 0; r < 16; ++r) ob[(vt * 32 + crow(r, hi)) * 33 + r32] = acc[vt][r] * rn;
        LDS_WAIT();
        { const int v2 = lane * 2; const float g0 = gn[h * 128 + v2], g1 = gn[h * 128 + v2 + 1];
#pragma unroll 4
          for (int tt = 0; tt < 32; ++tt) { const size_t t = t0 + th * 32 + tt;
              const unsigned ow = *(const GAS unsigned*)(P + t * 3072 + 2048 + h * 128 + v2);
              const float x0 = ob[v2 * 33 + tt] * g0 * fsigmoid(bf_lo(ow)), x1 = ob[(v2 + 1) * 33 + tt] * g1 * fsigmoid(bf_hi(ow));
              *(GAS unsigned*)(HM + t * 1024 + h * 128 + v2) = cvtpk(x0, x1); } }
        __syncthreads();
    }
}
#undef TRRD
#undef FRAG
}

#ifndef MK_ONE_LAUNCH
#define MK_ONE_LAUNCH 1
#endif
template <class Epi> __device__ __forceinline__ void run_gemm(Frame& F, const bf16* A, int lda, const bf16* Bt, int ldb, int N, int K, const Epi& E) {
    pg8::Gemm g{A, Bt, T, N, K, lda, ldb, F.wave}; pg8::StaticOrder S; S.init(T, N, F.G, (int)blockIdx.x);
    pg8::gemm_phase<Epi, pg8::StaticOrder, true, true>(F.lds, g, S, E);
}
__host__ __device__ constexpr int mixer_phases(int kind) { return kind == 0 ? 4 : kind == 1 ? 6 : 6; }
constexpr int NPH = 4 * 3 + (mixer_phases(0) + 2) + (mixer_phases(1) + 2) + (mixer_phases(2) + 2) + (mixer_phases(0) + 2) + 1;

__global__ void __launch_bounds__(NWAVES * 64, 2) fwd(Args args) {
    extern __shared__ __attribute__((aligned(16))) unsigned char lds[];
    Frame F;
    F.lds = (LAS unsigned char*)lds;
    F.tid = threadIdx.x; F.lane = F.tid & 63; const int wave0 = __builtin_amdgcn_readfirstlane(F.tid >> 6); F.wave = wave0;
    F.G = gridDim.x; F.gw = (int)blockIdx.x * NWAVES + F.wave; F.NGW = F.G * NWAVES;
    F.ws = args.ws; F.ctl = (gu32*)(args.ws + WS_CTL);
    const Inputs& in = args.in;
    volatile LAS unsigned* MISC = (volatile LAS unsigned*)(F.lds + MISC_OFF);
    for (int u = F.tid; u < (LDS_BYTES - LDSCTL_OFF) / 4; u += NWAVES * 64) ((LAS unsigned*)(F.lds + LDSCTL_OFF))[u] = 0u;
    __syncthreads();
#if MK_ONE_LAUNCH
    XcdBarrier bar = xcd_barrier_post((unsigned*)(F.ctl + CW_BAR), MISC + 8);
#define GRID_BAR() xcd_barrier(bar)
#else
#define GRID_BAR() do { } while (0)
#endif
    const int lo = args.ph_lo, hi = args.ph_hi;
    int ph = 0;
#ifndef PHMASK
#define PHMASK 0xffffffffu
#endif
#define PH_BEGIN(id) if (ph >= lo && ph < hi) { if ((PHMASK >> (id)) & 1u) { { int w_ = wave0; asm volatile("" : "+s"(w_)); F.wave = w_; F.lane = fresh_lane(); F.tid = w_ * 64 + F.lane; F.gw = (int)blockIdx.x * NWAVES + w_; } unsigned char* ws = args.ws; asm volatile("" : "+s"(ws)); { float* xo_ = args.out; asm volatile("" : "+s"(xo_)); F.X = xo_; } F.ws = ws; F.ctl = (gu32*)(ws + WS_CTL); F.XB = (bf16*)(ws + WS_XB); F.SS = (float*)(ws + WS_SS); \
    bf16* const WB = (bf16*)(ws + WS_W); unsigned char* const AR = ws + WS_ARENA; float* const COS = (float*)(ws + WS_COS); float* const SIN = (float*)(ws + WS_SIN); float* const SSQ = (float*)(ws + WS_SSQ); float* const SSKV = (float*)(ws + WS_SSKV); (void)WB; (void)AR; (void)COS; (void)SIN; (void)SSQ; (void)SSKV;
#define PH_END } if (ph + 1 < hi) GRID_BAR(); } ++ph;

#ifdef DUMP
    if (lo == 1000) { unsigned char* ws = args.ws; unsigned char* const AR = ws + WS_ARENA; F.X = args.out; F.lane = fresh_lane();
#define HX ((bf16*)(AR + A_HX))
#define RKV ((bf16*)(AR + A_RKV))
#define LOR ((bf16*)(AR + A_LOR))
#define LW ((float*)(AR + A_LW))
#define AA ((bf16*)(ws + WS_XB))
#define GG ((bf16*)(AR + A_GG))
#define YG ((bf16*)(AR + A_YG))
        for (int e = F.gw * 64 + F.lane; e < T * 1024; e += F.NGW * 64) { const int t = e >> 10, c = e & 1023; float v = 0.f;
            if (DUMP == 1) v = bf1(HX[(size_t)t * 2048 + c]) + bf1(HX[(size_t)t * 2048 + 1024 + c]);
            if (DUMP == 2) v = bf1(RKV[(size_t)t * 3072 + c]) + bf1(RKV[(size_t)t * 3072 + 1024 + c]) + bf1(RKV[(size_t)t * 3072 + 2048 + c]) + bf1(LOR[(size_t)t * 256 + (c & 255)]);
            if (DUMP == 3) v = LW[(size_t)t * 1024 + c] + bf1(AA[(size_t)t * 1024 + c]) + bf1(GG[(size_t)t * 1024 + c]);
            if (DUMP == 4) v = bf1(YG[(size_t)t * 1024 + c]);
            if (DUMP == 5) v = ((size_t)e < (size_t)3328 * 2048) ? bf1(((const bf16*)(ws + WS_W))[WR_BIG + e]) : 0.f;
            F.X[e] = v; }
#undef HX
#undef RKV
#undef LOR
#undef LW
#undef AA
#undef GG
#undef YG
        return; }
#endif
#pragma unroll
    for (int s = 0; s < 2 * DEPTH; ++s) {
        const int layer = s >> 1, half = s & 1, kind = layer % 3, j = layer / 3;
        if (half == 0) {
            PH_BEGIN(0)
                if (layer == 0) prologue(F, in);
                conv_layer(F, in, layer);
            PH_END
        } else if (kind == 0) {
#define LAT ((bf16*)(AR + A_LAT))
#define Q ((bf16*)(AR + A_Q))
#define KV ((bf16*)(AR + A_KV))
#define O ((bf16*)(AR + A_O))
#define KPE ((bf16*)(AR + A_KPE))
            PH_BEGIN(1)
                EpiMlaA E{F.SS, LAT, SSQ, SSKV, KPE, COS, SIN};
                run_gemm(F, F.XB, D, WB + WM_A, 1024, 1024, 1024, E);
            PH_END
            PH_BEGIN(2)
                { EpiMlaQ E{SSQ, Q, COS, SIN, 0.07216878364870322f * 1.4426950408889634f};
                  run_gemm(F, LAT, 1024, WB + WM_QB, 512, 1536, 512, E); }
                { EpiMlaKV E{SSKV, KV};
                  run_gemm(F, LAT + 512, 1024, WB + WM_KVB, 256, 2048, 256, E); }
            PH_END
            PH_BEGIN(3)
                for (int it = (int)blockIdx.x; it < BATCH * MLA_H * 16; it += F.G) { const int bh = it >> 4, xq = it & 15;
                    att::attn_unit(F.wave, bh >> 3, bh & 7, xq, Q, KV, KPE, O, (LAS char*)F.lds);
                    att::attn_unit(F.wave, bh >> 3, bh & 7, 31 - xq, Q, KV, KPE, O, (LAS char*)F.lds); }
            PH_END
            PH_BEGIN(4)
                EpiResidual E{F.X, F.XB, F.SS, 1.0f};
                run_gemm(F, O, 1024, WB + WM_O, 1024, 1024, 1024, E);
            PH_END
        } else if (kind == 1) {
#define P ((bf16*)(AR + A_P))
#define GATES ((float*)(AR + A_GATES))
#define HM ((bf16*)(AR + A_HM))
            PH_BEGIN(5)
                EpiMlIn E{F.SS, P, GATES};
                run_gemm(F, F.XB, D, WB + WL_IN, 1024, 3328, 1024, E);
            PH_END
            PH_BEGIN(6)
                mlc::conv_phase(F, in, j);
            PH_END
            PH_BEGIN(7)
                mlc::xa_phase(F);
            PH_END
            PH_BEGIN(8)
                mlc::xb_phase(F);
            PH_END
            PH_BEGIN(19)
                mlc::xc_phase(F, in, j);
            PH_END
            PH_BEGIN(9)
                EpiResidual E{F.X, F.XB, F.SS, 1.0f};
                run_gemm(F, (bf16*)(AR + mlc::A_HM2), 1024, WB + WL_O, 1024, 1024, 1024, E);
            PH_END
        } else {
#define HX ((bf16*)(AR + A_HX))
#define RKV ((bf16*)(AR + A_RKV))
#define LOR ((bf16*)(AR + A_LOR))
#define LW ((float*)(AR + A_LW))
#define AA ((bf16*)(ws + WS_XB))
#define GG ((bf16*)(AR + A_GG))
#define YG ((bf16*)(AR + A_YG))
            PH_BEGIN(10)
                rw_shift_phase(F);
            PH_END
            PH_BEGIN(11)
                EpiRwBig E{RKV, LOR};
                run_gemm(F, HX, 2048, WB + WR_BIG, 2048, 3328, 2048, E);
            PH_END
            PH_BEGIN(12)
                EpiRwUp E{LW, AA, GG, in.rw_w0 + (size_t)j * 1024, in.rw_a0 + (size_t)j * 1024};
                run_gemm(F, LOR, 256, WB + WR_UP, 256, 3072, 256, E);
            PH_END
            PH_BEGIN(13)
                rw_seq_phase(F, in, j);
            PH_END
            PH_BEGIN(14)
                rw_out_phase(F, in, j);
            PH_END
            PH_BEGIN(15)
                EpiResidual E{F.X, F.XB, F.SS, 1.0f};
                run_gemm(F, YG, 1024, WB + WR_O, 1024, 1024, 1024, E);
            PH_END
        }
#define ACT ((bf16*)(AR + A_ACT))
        PH_BEGIN(16)
            EpiSwiGLU E{F.SS, ACT};
            run_gemm(F, F.XB, D, WB + (half ? WO_GU1 : WO_GU0), D, 2 * FF, D, E);
        PH_END
        PH_BEGIN(17)
            EpiResidual E{F.X, F.XB, F.SS, 0.5f};
            run_gemm(F, ACT, FF, WB + (half ? WO_D1 : WO_D0), FF, D, FF, E);
        PH_END
    }
    PH_BEGIN(18)
        final_norm_phase(F, in);
    PH_END
}

extern "C" void kernel_launch(void* const* d_in, const int* in_sizes, int n_in, void* d_out, int out_size, void* d_ws, size_t ws_size, hipStream_t stream) {
    static int grid = 0;
    if (grid == 0) {
        if (n_in != 38 || in_sizes[0] != T * D || out_size != T * D || ws_size < WS_END) { fprintf(stderr, "kernel_launch: unexpected shapes (n_in %d, in0 %d, out %d, ws %zu)\n", n_in, n_in > 0 ? in_sizes[0] : -1, out_size, ws_size); grid = -1; return; }
        int dev = 0, cus = 0, per_cu = 0;
        if (hipGetDevice(&dev) != hipSuccess || hipDeviceGetAttribute(&cus, hipDeviceAttributeMultiprocessorCount, dev) != hipSuccess) { grid = -1; return; }
        if (hipFuncSetAttribute((const void*)fwd, hipFuncAttributeMaxDynamicSharedMemorySize, LDS_BYTES) != hipSuccess) { fprintf(stderr, "kernel_launch: hipFuncSetAttribute failed\n"); grid = -1; return; }
        if (hipOccupancyMaxActiveBlocksPerMultiprocessor(&per_cu, (const void*)fwd, NWAVES * 64, LDS_BYTES) != hipSuccess || per_cu < 1)
            fprintf(stderr, "kernel_launch: occupancy query reports %d workgroups per CU\n", per_cu);
        (void)hipGetLastError();
        grid = cus;
    }
    if (grid < 0) return;
    if (hipMemsetAsync((char*)d_ws + WS_CTL, 0, CTL_ZERO_BYTES, stream) != hipSuccess) return;
    Args a{};
    const void** ip = (const void**)&a.in;
    for (int i = 0; i < 38; ++i) ip[i] = d_in[i];
    a.out = (float*)d_out; a.ws = (unsigned char*)d_ws;
#if MK_ONE_LAUNCH
    a.ph_lo = 0; a.ph_hi = NPH;
    hipLaunchKernelGGL(fwd, dim3(grid), dim3(NWAVES * 64), LDS_BYTES, stream, a);
#else
#ifdef DUMP
    for (int p = 0; p <= DUMP_LAST; ++p) { a.ph_lo = p; a.ph_hi = p + 1;
        hipLaunchKernelGGL(fwd, dim3(grid), dim3(NWAVES * 64), LDS_BYTES, stream, a); }
    a.ph_lo = 1000; a.ph_hi = 1001;
    hipLaunchKernelGGL(fwd, dim3(grid), dim3(NWAVES * 64), LDS_BYTES, stream, a);
#else
    for (int p = 0; p < NPH; ++p) { a.ph_lo = p; a.ph_hi = p + 1;
        hipLaunchKernelGGL(fwd, dim3(grid), dim3(NWAVES * 64), LDS_BYTES, stream, a); }
#endif
#endif
}
```

```cpp
#include <hip/hip_runtime.h>
#include <cstdio>
#include <cstdint>

__device__ __forceinline__ int fresh_lane() { int l; asm volatile("v_mbcnt_lo_u32_b32 %0, -1, 0\n\tv_mbcnt_hi_u32_b32 %0, -1, %0" : "=v"(l)); return l; }
namespace pg8 {
#define PG8_LAS __attribute__((address_space(3)))
typedef unsigned short bf16_t;
typedef short bf16x8 __attribute__((ext_vector_type(8)));
typedef float f32x4 __attribute__((ext_vector_type(4)));
typedef unsigned u32x4 __attribute__((ext_vector_type(4)));
typedef unsigned u32x2 __attribute__((ext_vector_type(2)));
constexpr int BM = 256, BK = 64, HALF = 128, HTB = HALF * BK * 2  , STAGE_BYTES = 8 * HTB, NXCD = 8, WGM = 8;

__host__ __device__ __forceinline__ int lds_byte(int r, int c) { const int st = (r >> 4) * 2 + (c >> 5), rr = r & 15, cc = c & 31, ob = rr * 64 + cc * 2; return st * 1024 + (ob ^ (((ob >> 9) & 1) << 5)); }
__host__ __device__ __forceinline__ void stage_rc(int b, int& R, int& C) { const int st = b / 1024, sb = b % 1024, swz = sb ^ (((sb >> 9) & 1) << 5); R = (st >> 1) * 16 + swz / 64; C = (st & 1) * 32 + (swz % 64) / 2; }
__host__ __device__ __forceinline__ int perm32(int rho) { const int n = rho >> 4, i = rho & 15; return 8 * (i >> 2) + 4 * n + (i & 3); }

struct Unit { int pm, pn; };
struct Gemm { const bf16_t* A; const bf16_t* Bt; int M, N, K, lda, ldb, wave; };

struct StaticOrder {
    int nM, nN, nwg, G, c;
    __host__ __device__ void init(int M, int N, int G_, int c_) { nM = M / BM; nN = N / BM; nwg = nM * nN; G = G_; c = c_; }
    __host__ __device__ bool next(int i, Unit& u) const {
        const long L = (long)i * G + c; if (L >= nwg) return false;
        int wgid = (int)L; { const int q = nwg / NXCD, r = nwg % NXCD, xcd = wgid % NXCD, off = wgid / NXCD; wgid = (xcd < r ? xcd * (q + 1) : r * (q + 1) + (xcd - r) * q) + off; }
        const int nig = WGM * nN, gid = wgid / nig, fm = gid * WGM, gsz = (nM - fm) < WGM ? (nM - fm) : WGM;
        u.pm = fm + ((wgid % nig) % gsz); u.pn = (wgid % nig) / gsz; return true;
    }
    __device__ __forceinline__ void a_ready(const Unit&) const {}
    __device__ __forceinline__ void done(const Unit&) const {}
};

template <class Epi, class Sched, bool ALIGN_EPI = false, bool SP2 = false>
__device__ __forceinline__ void gemm_phase(PG8_LAS unsigned char* lds, const Gemm g, const Sched& S, const Epi& E) {
    const int wid = g.wave; const int tid = wid * 64 + fresh_lane(), lane = tid & 63, wr = wid >> 2, wc = wid & 3, fr = lane & 15, fq = lane >> 4;
    const int K = g.K, nt = K / BK;
    unsigned voffA[2], voffB[2];
#pragma unroll
    for (int i = 0; i < 2; ++i) { int R, C; stage_rc(tid * 16 + i * 8192, R, C); const int Rb = Epi::PERM ? ((R & ~31) + perm32(R & 31)) : R;
        voffA[i] = (unsigned)(R * g.lda + C) * 2u; voffB[i] = (unsigned)(Rb * g.ldb + C) * 2u; }
    const size_t kstep = (size_t)(BK * 2);
    const size_t hstepA = (size_t)HALF * g.lda * 2, hstepB = (size_t)HALF * g.ldb * 2;
    const size_t tstepA = 2 * hstepA, tstepB = 2 * hstepB;
    const unsigned ldsw = (unsigned)wid * 1024u;
    const int aoff = lds_byte(wr * 64 + fr, fq * 8), boff = lds_byte(wc * 32 + fr, fq * 8);
#define PG8_SA(b, h) (((b) * 2 + (h)) * HTB)
#define PG8_SB(b, h) ((4 + (b) * 2 + (h)) * HTB)
#define PG8_STAGE(bufoff, gbase, voff) do { _Pragma("unroll") for (int _i = 0; _i < 2; ++_i) \
        __builtin_amdgcn_global_load_lds((const unsigned*)((const char*)(gbase) + (voff)[_i]), (PG8_LAS unsigned*)(lds + (bufoff) + ldsw + _i * 8192), 16, 0, 0); } while (0)
#define PG8_LDA(dst, b, h) do { _Pragma("unroll") for (int m = 0; m < 4; ++m) _Pragma("unroll") for (int k = 0; k < 2; ++k) dst[m][k] = *(const PG8_LAS bf16x8*)(lds + PG8_SA(b, h) + aoff + m * 2048 + k * 1024); } while (0)
#define PG8_LDB(dst, b, h) do { _Pragma("unroll") for (int n = 0; n < 2; ++n) _Pragma("unroll") for (int k = 0; k < 2; ++k) dst[n][k] = *(const PG8_LAS bf16x8*)(lds + PG8_SB(b, h) + boff + n * 2048 + k * 1024); } while (0)
#define PG8_MMA(ai, bj, At, Bt) do { __builtin_amdgcn_s_setprio(1); _Pragma("unroll") for (int m = 0; m < 4; ++m) _Pragma("unroll") for (int n = 0; n < 2; ++n) _Pragma("unroll") for (int k = 0; k < 2; ++k) \
        acc[ai][bj][m][n] = __builtin_amdgcn_mfma_f32_16x16x32_bf16(Bt[n][k], At[m][k], acc[ai][bj][m][n], 0, 0, 0); __builtin_amdgcn_s_setprio(0); } while (0)
#define PG8_WAIT_V(n) asm volatile("s_waitcnt vmcnt(" #n ")" ::: "memory")
#define PG8_WAIT_L(n) asm volatile("s_waitcnt lgkmcnt(" #n ")" ::: "memory")
#define PG8_BAR __builtin_amdgcn_s_barrier()
#define PG8_SCHED __builtin_amdgcn_sched_barrier(0)
    Unit cur, nxt; int ui = 0;
    if (!S.next(0, cur)) return;
    f32x4 acc[2][2][4][2];
#pragma unroll
    for (int a = 0; a < 2; ++a)
#pragma unroll
        for (int b = 0; b < 2; ++b)
#pragma unroll
            for (int m = 0; m < 4; ++m)
#pragma unroll
                for (int n = 0; n < 2; ++n) acc[a][b][m][n] = (f32x4){0.f, 0.f, 0.f, 0.f};
    bf16x8 At[4][2], B0[2][2], B1[2][2];
    const char* cA = (const char*)g.A + (size_t)cur.pm * tstepA; const char* cB = (const char*)g.Bt + (size_t)cur.pn * tstepB;
    S.a_ready(cur);
    if constexpr (SP2) {
        PG8_STAGE(PG8_SB(0, 0), cB, voffB); PG8_STAGE(PG8_SB(0, 1), cB + hstepB, voffB); PG8_STAGE(PG8_SA(0, 0), cA, voffA); PG8_STAGE(PG8_SA(0, 1), cA + hstepA, voffA);
        if (wr == 1) PG8_BAR;
        PG8_WAIT_V(2); PG8_BAR;
        PG8_STAGE(PG8_SB(1, 0), cB + kstep, voffB); PG8_STAGE(PG8_SA(1, 0), cA + kstep, voffA); PG8_STAGE(PG8_SB(1, 1), cB + hstepB + kstep, voffB);
        PG8_WAIT_V(6); PG8_BAR;
    } else {
        PG8_STAGE(PG8_SB(0, 0), cB, voffB); PG8_STAGE(PG8_SA(0, 0), cA, voffA); PG8_STAGE(PG8_SB(0, 1), cB + hstepB, voffB); PG8_STAGE(PG8_SA(0, 1), cA + hstepA, voffA);
        if (wr == 1) PG8_BAR;
        PG8_WAIT_V(4); PG8_BAR;
        PG8_STAGE(PG8_SB(1, 0), cB + kstep, voffB); PG8_STAGE(PG8_SA(1, 0), cA + kstep, voffA); PG8_STAGE(PG8_SB(1, 1), cB + hstepB + kstep, voffB);
        PG8_WAIT_V(6); PG8_BAR;
    }
    for (;;) {
        const bool has_next = S.next(ui + 1, nxt);
        const char* nA = has_next ? (const char*)g.A + (size_t)nxt.pm * tstepA : cA; const char* nB = has_next ? (const char*)g.Bt + (size_t)nxt.pn * tstepB : cB;
#pragma nounroll
        for (int t = 0; t < nt; t += 2) {
            const bool last = (t == nt - 2);
            const char* a1 = cA + (size_t)(t + 1) * kstep;
            const char* a2 = last ? nA : cA + (size_t)(t + 2) * kstep; const char* b2 = last ? nB : cB + (size_t)(t + 2) * kstep;
            const char* a3 = a2 + kstep; const char* b3 = b2 + kstep;
            if (last && has_next) S.a_ready(nxt);
            if constexpr (SP2) {
            PG8_LDB(B0, 0, 0); PG8_LDB(B1, 0, 1); PG8_SCHED; PG8_LDA(At, 0, 0); PG8_STAGE(PG8_SA(1, 1), a1 + hstepA, voffA);
            PG8_WAIT_V(8); PG8_WAIT_L(0); PG8_BAR; PG8_MMA(0, 0, At, B0); PG8_MMA(0, 1, At, B1); PG8_BAR; PG8_SCHED;
            PG8_LDA(At, 0, 1); PG8_STAGE(PG8_SB(0, 0), b2, voffB); PG8_STAGE(PG8_SB(0, 1), b2 + hstepB, voffB); PG8_STAGE(PG8_SA(0, 0), a2, voffA);
            PG8_WAIT_V(8); PG8_WAIT_L(0); PG8_BAR; PG8_MMA(1, 0, At, B0); PG8_MMA(1, 1, At, B1); PG8_BAR; PG8_SCHED;
            PG8_LDB(B0, 1, 0); PG8_LDB(B1, 1, 1); PG8_SCHED; PG8_LDA(At, 1, 0); PG8_STAGE(PG8_SA(0, 1), a2 + hstepA, voffA);
            PG8_WAIT_V(8); PG8_WAIT_L(0); PG8_BAR; PG8_MMA(0, 0, At, B0); PG8_MMA(0, 1, At, B1); PG8_BAR; PG8_SCHED;
            PG8_LDA(At, 1, 1); PG8_STAGE(PG8_SB(1, 0), b3, voffB); PG8_STAGE(PG8_SB(1, 1), b3 + hstepB, voffB); PG8_STAGE(PG8_SA(1, 0), a3, voffA);
            PG8_WAIT_V(8); PG8_WAIT_L(0); PG8_BAR; PG8_MMA(1, 0, At, B0); PG8_MMA(1, 1, At, B1); PG8_BAR; PG8_SCHED;
            } else {
            PG8_LDB(B0, 0, 0); PG8_SCHED; PG8_LDA(At, 0, 0); PG8_STAGE(PG8_SA(1, 1), a1 + hstepA, voffA);
            PG8_WAIT_L(8); PG8_BAR; PG8_WAIT_L(0); PG8_MMA(0, 0, At, B0); PG8_BAR; PG8_SCHED;
            PG8_LDB(B1, 0, 1); PG8_STAGE(PG8_SB(0, 0), b2, voffB);
            PG8_BAR; PG8_WAIT_L(0); PG8_MMA(0, 1, At, B1); PG8_BAR;
            PG8_LDA(At, 0, 1); PG8_STAGE(PG8_SA(0, 0), a2, voffA);
            PG8_BAR; PG8_WAIT_L(0); PG8_MMA(1, 0, At, B0); PG8_BAR; PG8_SCHED;
            PG8_STAGE(PG8_SB(0, 1), b2 + hstepB, voffB);
            PG8_WAIT_V(6); PG8_BAR; PG8_MMA(1, 1, At, B1); PG8_BAR;
            PG8_LDB(B0, 1, 0); PG8_SCHED; PG8_LDA(At, 1, 0); PG8_STAGE(PG8_SA(0, 1), a2 + hstepA, voffA);
            PG8_WAIT_L(8); PG8_BAR; PG8_WAIT_L(0); PG8_MMA(0, 0, At, B0); PG8_BAR; PG8_SCHED;
            PG8_LDB(B1, 1, 1); PG8_STAGE(PG8_SB(1, 0), b3, voffB);
            PG8_BAR; PG8_WAIT_L(0); PG8_MMA(0, 1, At, B1); PG8_BAR;
            PG8_LDA(At, 1, 1); PG8_STAGE(PG8_SA(1, 0), a3, voffA);
            PG8_BAR; PG8_WAIT_L(0); PG8_MMA(1, 0, At, B0); PG8_BAR; PG8_SCHED;
            PG8_STAGE(PG8_SB(1, 1), b3 + hstepB, voffB);
            PG8_WAIT_V(6); PG8_BAR; PG8_MMA(1, 1, At, B1); PG8_BAR;
            }
        }
        if constexpr (ALIGN_EPI) { if (wr == 0) PG8_BAR; }
        if constexpr (!Epi::AFTER_DRAIN) { E(acc, cur, wr, wc, fr, fq); S.done(cur); }
        if (!has_next) break;
#pragma unroll
        for (int a = 0; a < 2; ++a)
#pragma unroll
            for (int b = 0; b < 2; ++b)
#pragma unroll
                for (int m = 0; m < 4; ++m)
#pragma unroll
                    for (int n = 0; n < 2; ++n) acc[a][b][m][n] = (f32x4){0.f, 0.f, 0.f, 0.f};
        cur = nxt; cA = nA; cB = nB; ++ui;
        if constexpr (ALIGN_EPI) { if (wr == 1) PG8_BAR; }
    }
    PG8_WAIT_V(0);
    if constexpr (!ALIGN_EPI) { if (wr == 0) PG8_BAR; }
    PG8_BAR;
    if constexpr (Epi::AFTER_DRAIN) { E.fused(acc, cur, wr, wc, fr, fq, lds, wid, lane); S.done(cur); }
#undef PG8_SA
#undef PG8_SB
#undef PG8_STAGE
#undef PG8_LDA
#undef PG8_LDB
#undef PG8_MMA
#undef PG8_WAIT_V
#undef PG8_WAIT_L
#undef PG8_BAR
#undef PG8_SCHED
}
}

constexpr int NWAVES = 8;
constexpr int BATCH = 2, SEQ = 8192, D = 1024, T = BATCH * SEQ, FF = 2816, DEPTH = 4;
constexpr float RMS_EPS = 1e-6f;
constexpr int MLA_H = 8, QRANK = 512, KVRANK = 256, NOPE = 128, ROPE = 64, DVH = 128, DQK = NOPE + ROPE;
constexpr int LATN = QRANK + KVRANK + ROPE;
constexpr int ML_H = 8, ML_DK = 64, ML_DV = 128, ML_NIN = 3088;
constexpr int RW_H = 16, RW_N = 64;

constexpr size_t MiB = 1u << 20;
constexpr size_t WS_CTL = 0, CTL_ZERO_BYTES = 1 * MiB;
constexpr size_t WS_COS = 1 * MiB, WS_SIN = 3 * MiB;
constexpr size_t WS_SS = 5 * MiB;
constexpr size_t WS_SSQ = 6 * MiB;
constexpr size_t WS_SSKV = 6 * MiB + 512 * 1024;
constexpr size_t WS_W = 8 * MiB;
constexpr size_t WS_XB = 68 * MiB;
constexpr size_t WS_ARENA = 100 * MiB;
constexpr size_t WS_END = 352 * MiB;
constexpr size_t WO_GU0 = 0, WO_D0 = WO_GU0 + (size_t)2 * FF * D, WO_GU1 = WO_D0 + (size_t)D * FF, WO_D1 = WO_GU1 + (size_t)2 * FF * D, WO_MIX = WO_D1 + (size_t)D * FF;
constexpr size_t WM_A = WO_MIX, WM_QB = WM_A + (size_t)1024 * 1024, WM_KVB = WM_QB + (size_t)1536 * 512, WM_O = WM_KVB + (size_t)2048 * 256;
constexpr size_t WL_IN = WO_MIX, WL_O = WL_IN + (size_t)3328 * 1024;
constexpr size_t WR_BIG = WO_MIX, WR_UP = WR_BIG + (size_t)3328 * 2048, WR_O = WR_UP + (size_t)3072 * 256;
static_assert((WR_O + (size_t)1024 * 1024) * 2 <= 60 * MiB, "weight region");
constexpr size_t A_ACT = 0;
constexpr size_t A_LAT = 0, A_Q = 32 * MiB, A_KV = 80 * MiB, A_O = 144 * MiB, A_KPE = 176 * MiB;
constexpr size_t A_P = 0, A_GATES = 96 * MiB, A_QKC = 97 * MiB, A_IGLF = 161 * MiB, A_HRAW = 162 * MiB, A_HM = A_QKC;
constexpr size_t A_HX = 0, A_RKV = 64 * MiB, A_LOR = 160 * MiB, A_LW = 0, A_GG = 168 * MiB, A_YG = 200 * MiB;
static_assert(WS_ARENA + A_HRAW + (size_t)T * 1024 * 4 <= WS_END && WS_ARENA + A_YG + (size_t)T * 1024 * 2 <= WS_END && WS_ARENA + A_KPE + (size_t)T * 64 * 2 <= WS_END, "arena");

constexpr int CW_TMO = 0, CW_CODE = 1, CW_BAR = 4096;
constexpr size_t WS_PTRS = 512 * 1024;

constexpr int RING_BYTES = 131072;
constexpr int LDSCTL_OFF = 146432, MISC_OFF = LDSCTL_OFF + 320;
constexpr int LDS_BYTES = 147456;

#define GAS __attribute__((address_space(1)))
#define LAS __attribute__((address_space(3)))
typedef unsigned short bf16;
typedef unsigned v4u __attribute__((ext_vector_type(4)));
typedef unsigned v2u __attribute__((ext_vector_type(2)));
typedef float f32x4 __attribute__((ext_vector_type(4)));
typedef float f32x16 __attribute__((ext_vector_type(16)));
typedef short bf16x8 __attribute__((ext_vector_type(8)));
typedef short s16x4 __attribute__((ext_vector_type(4)));
typedef GAS unsigned gu32;
#define RLX_AGENT __ATOMIC_RELAXED, __HIP_MEMORY_SCOPE_AGENT
#define LDS_WAIT() asm volatile("s_waitcnt lgkmcnt(0)" ::: "memory")
#define VM_WAIT() asm volatile("s_waitcnt vmcnt(0)" ::: "memory")
typedef float f32x2_t __attribute__((ext_vector_type(2))); typedef __bf16 bf16x2_t __attribute__((ext_vector_type(2)));
__device__ __forceinline__ unsigned cvtpk(float lo, float hi) { f32x2_t v = {lo, hi}; bf16x2_t b = __builtin_convertvector(v, bf16x2_t); return __builtin_bit_cast(unsigned, b); }
__device__ __forceinline__ float bf_lo(unsigned w) { return __builtin_bit_cast(float, w << 16); }
__device__ __forceinline__ float bf_hi(unsigned w) { return __builtin_bit_cast(float, w & 0xffff0000u); }
__device__ __forceinline__ float bf1(bf16 h) { return __builtin_bit_cast(float, (unsigned)h << 16); }
__device__ __forceinline__ v4u pack8f(const float* v) { v4u w; w.x = cvtpk(v[0], v[1]); w.y = cvtpk(v[2], v[3]); w.z = cvtpk(v[4], v[5]); w.w = cvtpk(v[6], v[7]); return w; }
__device__ __forceinline__ v4u pack8v(f32x4 a, f32x4 b) { v4u w; w.x = cvtpk(a[0], a[1]); w.y = cvtpk(a[2], a[3]); w.z = cvtpk(b[0], b[1]); w.w = cvtpk(b[2], b[3]); return w; }
__device__ __forceinline__ void unpack8(v4u w, float* v) { v[0] = bf_lo(w.x); v[1] = bf_hi(w.x); v[2] = bf_lo(w.y); v[3] = bf_hi(w.y); v[4] = bf_lo(w.z); v[5] = bf_hi(w.z); v[6] = bf_lo(w.w); v[7] = bf_hi(w.w); }
__device__ __forceinline__ float fexp(float x) { return __builtin_amdgcn_exp2f(x * 1.4426950408889634f); }
__device__ __forceinline__ float frcp(float x) { return __builtin_amdgcn_rcpf(x); }
__device__ __forceinline__ float flog(float x) { return __builtin_amdgcn_logf(x) * 0.6931471805599453f; }
__device__ __forceinline__ float ftanh(float x) { const float t = fexp(-2.f * fabsf(x)); const float r = (1.f - t) * frcp(1.f + t); return x < 0.f ? -r : r; }
__device__ __forceinline__ float fsigmoid(float x) { return frcp(1.f + fexp(-x)); }
__device__ __forceinline__ float frsq(float x) { return __builtin_amdgcn_rsqf(x); }
__device__ __forceinline__ float fsqrt(float x) { return __builtin_amdgcn_sqrtf(x); }
__device__ __forceinline__ void fsincos_big(float a, float& s, float& c) {
    const float k = __builtin_rintf(a * 0.15915494309189535f);
    float r = __builtin_fmaf(-k, 6.28125f, a); r = __builtin_fmaf(-k, 1.9353071795864769e-3f, r);
    const float rev = r * 0.15915494309189535f;
    s = __builtin_amdgcn_sinf(rev); c = __builtin_amdgcn_cosf(rev);
}
__device__ __forceinline__ float fsilu(float x) { return x * frcp(1.f + fexp(-x)); }
__device__ __forceinline__ float wave_sum(float v) {
#pragma unroll
    for (int o = 1; o < 64; o <<= 1) v += __shfl_xor(v, o);
    return v;
}

#define XB_TMO      128
#define XB_XCNT(j)  (256  + 64 * (j))
#define XB_XSUB(j)  (1280 + 64 * (j))
#define XB_XGEN(j)  (2304 + 64 * (j))
#define XB_TOP      3328
#define XB_TOPGEN   3392
#define XCD_BAR_WORDS 3456
#define XB_SPIN_CAP (1u << 18)

__device__ __forceinline__ unsigned xb_ld(unsigned* p)              { return __hip_atomic_load(p, __ATOMIC_RELAXED, __HIP_MEMORY_SCOPE_AGENT); }
__device__ __forceinline__ unsigned xb_add(unsigned* p, unsigned v) { return __hip_atomic_fetch_add(p, v, __ATOMIC_RELAXED, __HIP_MEMORY_SCOPE_AGENT); }
__device__ __forceinline__ unsigned xb_xcc_id() { return (unsigned)__builtin_amdgcn_s_getreg((3 << 11) | 20) & 0xFu; }
#define XB_SPIN(cond, bar) do { unsigned _sp = 0; while (cond) { __builtin_amdgcn_s_sleep(1); \
    if ((++_sp & 255u) == 0u) { if (xb_ld(&(bar)[XB_TMO])) break; if (_sp > XB_SPIN_CAP) { atomicAdd(&(bar)[XB_TMO], 1u); break; } } } } while (0)

struct XcdBarrier {
    unsigned* bar; unsigned x;
    volatile LAS unsigned* st;
};

__device__ __forceinline__ XcdBarrier xcd_barrier_post(unsigned* bar, volatile LAS unsigned* st) {
    XcdBarrier b; b.bar = bar; b.x = xb_xcc_id(); b.st = st;
    if (threadIdx.x == 0) (void)xb_add(&bar[XB_XCNT(b.x)], 1u);
    return b;
}
__device__ __forceinline__ void xcd_barrier_complete(unsigned* bar, unsigned x, unsigned& nloc, unsigned& nx) {
    const unsigned G = gridDim.x * gridDim.y * gridDim.z;
    unsigned sum, cnt, mine, sp = 0u;
    for (;;) {
        sum = 0u; cnt = 0u; mine = 0u;
#pragma unroll
        for (unsigned j = 0; j < 16; ++j) { const unsigned c = xb_ld(&bar[XB_XCNT(j)]); sum += c; cnt += (c > 0u) ? 1u : 0u; mine = (j == x) ? c : mine; }
        if (sum == G) break;
        __builtin_amdgcn_s_sleep(1);
        if ((++sp & 255u) == 0u) { if (xb_ld(&bar[XB_TMO])) break; if (sp > XB_SPIN_CAP) { atomicAdd(&bar[XB_TMO], 1u); break; } }
    }
    nloc = mine > 0u ? mine : 1u; nx = cnt > 0u ? cnt : 1u;
}

__device__ __forceinline__ void xcd_barrier(const XcdBarrier& b) {
    asm volatile("s_waitcnt vmcnt(0)" ::: "memory");
    __syncthreads();
    if (threadIdx.x == 0) {
        unsigned* bar = b.bar;
        __builtin_amdgcn_s_waitcnt(0);
        unsigned nloc = b.st[0], nx = b.st[1];
        if (nloc == 0u) { xcd_barrier_complete(bar, b.x, nloc, nx); b.st[0] = nloc; b.st[1] = nx; }
        const unsigned old = xb_add(&bar[XB_XSUB(b.x)], 1u);
        const unsigned gen = old / nloc;
        if (old + 1u == (gen + 1u) * nloc) {
            __builtin_amdgcn_fence(__ATOMIC_RELEASE, "agent");
            asm volatile("s_waitcnt vmcnt(0)" ::: "memory");
            const unsigned og = xb_add(&bar[XB_TOP], 1u);
            const unsigned tg = og / nx;
            if (og + 1u == (tg + 1u) * nx) xb_add(&bar[XB_TOPGEN], 1u);
            else XB_SPIN(xb_ld(&bar[XB_TOPGEN]) == tg, bar);
            __builtin_amdgcn_fence(__ATOMIC_ACQUIRE, "agent");
            xb_add(&bar[XB_XGEN(b.x)], 1u);
            asm volatile("s_waitcnt vmcnt(0)" ::: "memory");
        } else {
            XB_SPIN(xb_ld(&bar[XB_XGEN(b.x)]) == gen, bar);
            __builtin_amdgcn_fence(__ATOMIC_ACQUIRE, "agent");
            asm volatile("s_waitcnt vmcnt(0)" ::: "memory");
        }
    }
    __syncthreads();
}

struct Inputs {
    const float* x; const int* positions; const float* ffn_norm; const float* ffn_w_gate; const float* ffn_w_up; const float* ffn_w_down; const float* mix_norm; const float* final_norm;
    const float* mla_w_a; const float* mla_q_norm; const float* mla_w_qb; const float* mla_kv_norm; const float* mla_w_kvb; const float* mla_w_o;
    const float* ml_w_in; const float* ml_b_if; const float* ml_conv_w; const float* ml_conv_b; const float* ml_out_norm; const float* ml_w_o;
    const float* rw_mu; const float* rw_w_r; const float* rw_w_k; const float* rw_w_v; const float* rw_w0; const float* rw_w1; const float* rw_w2; const float* rw_a0; const float* rw_a1; const float* rw_a2;
    const float* rw_g1; const float* rw_g2; const float* rw_k_k; const float* rw_k_a; const float* rw_r_k; const float* rw_ln_w; const float* rw_ln_b; const float* rw_w_o;
};
struct Args { Inputs in; float* out; unsigned char* ws; int ph_lo, ph_hi; };

struct Frame {
    LAS unsigned char* lds;
    gu32* ctl;
    int tid, lane, wave, G, gw, NGW;
    float* X;
    bf16* XB;
    float* SS;
    unsigned char* ws;
};

__device__ __forceinline__ void cv_item(const float* Wp, int ld, int ks0, const float* g1, const float* g2, bf16* dst, int ldd, int kd0, int n0, LAS float* scr, int lane) {
    const int nl = lane & 31, kh = lane >> 5;
#pragma unroll 8
    for (int i = 0; i < 32; ++i) { const int kk = 2 * i + kh, k = ks0 + kk; float v = 0.f;
        if (Wp) { v = Wp[(size_t)k * ld]; if (g1) v *= g1[k]; if (g2) v *= g2[k]; }
        scr[kk * 33 + nl] = v; }
    LDS_WAIT(); asm volatile("" ::: "memory");
    const int c = lane & 7;
#pragma unroll
    for (int j = 0; j < 4; ++j) { const int n = (lane >> 3) + 8 * j; const LAS float* s = scr + (8 * c) * 33 + n;
        v4u o; o.x = cvtpk(s[0 * 33], s[1 * 33]); o.y = cvtpk(s[2 * 33], s[3 * 33]); o.z = cvtpk(s[4 * 33], s[5 * 33]); o.w = cvtpk(s[6 * 33], s[7 * 33]);
        *(GAS v4u*)(dst + (size_t)(n0 + n) * ldd + kd0 + 8 * c) = o; }
    LDS_WAIT(); asm volatile("" ::: "memory");
}

__device__ __forceinline__ void conv_layer(Frame& F, const Inputs& in, int layer) {
    LAS float* scr = (LAS float*)(F.lds + F.wave * 16384);
    bf16* WB = (bf16*)(F.ws + WS_W);
    const int kind = layer % 3, j = layer / 3, lane = F.lane, nl = lane & 31;
    constexpr int I_GU = (D / 64) * (2 * FF / 32), I_DN = (FF / 64) * (D / 32);
    constexpr int I_FFN = 2 * (I_GU + I_DN);
    constexpr int I_MLA = (1024 / 64) * (1024 / 32) + (512 / 64) * (1536 / 32) + (256 / 64) * (2048 / 32) + (1024 / 64) * (1024 / 32);
    constexpr int I_ML = (1024 / 64) * (3328 / 32) + (1024 / 64) * (1024 / 32);
    constexpr int I_RW = (2048 / 64) * (3328 / 32) + (256 / 64) * (3072 / 32) + (1024 / 64) * (1024 / 32);
    const int n_items = I_FFN + (kind == 0 ? I_MLA : kind == 1 ? I_ML : I_RW);
    for (int it = F.gw; it < n_items; it += F.NGW) {
        int r = it;
        if (r < I_FFN) {
            const int half = r / (I_GU + I_DN); r -= half * (I_GU + I_DN);
            const size_t wsel = (size_t)(layer * 2 + half);
            if (r < I_GU) {
                const int nb = r % (2 * FF / 32), kb = r / (2 * FF / 32), n = nb * 32 + nl, tile = n >> 8, w = n & 255;
                const float* W = (w < 128 ? in.ffn_w_gate : in.ffn_w_up) + wsel * D * FF + (tile * 128 + (w & 127));
                cv_item(W, FF, kb * 64, in.ffn_norm + wsel * D, nullptr, WB + (half ? WO_GU1 : WO_GU0), D, kb * 64, nb * 32, scr, lane);
            } else { r -= I_GU;
                const int nb = r % (D / 32), kb = r / (D / 32), n = nb * 32 + nl;
                cv_item(in.ffn_w_down + wsel * FF * D + n, D, kb * 64, nullptr, nullptr, WB + (half ? WO_D1 : WO_D0), FF, kb * 64, nb * 32, scr, lane);
            }
            continue;
        }
        r -= I_FFN;
        if (kind == 0) {
            const float* gmix = in.mix_norm + (size_t)layer * D;
            if (r < 16 * 32) {
                const int nb = r % 32, kb = r / 32, n = nb * 32 + nl; int col = n;
                if (n >= 768 && n < 832) { const int jj = n - 768; col = 768 + (jj >> 1) + 32 * (jj & 1); }
                const float* W = (n < LATN) ? in.mla_w_a + (size_t)j * D * LATN + col : nullptr;
                cv_item(W, LATN, kb * 64, gmix, nullptr, WB + WM_A, 1024, kb * 64, nb * 32, scr, lane); continue; }
            r -= 16 * 32;
            if (r < 8 * 48) {
                const int nb = r % 48, kb = r / 48, n = nb * 32 + nl, hd = n / DQK, w = n - hd * DQK; int col = n;
                if (w >= NOPE) { const int jj = w - NOPE; col = hd * DQK + NOPE + (jj >> 1) + 32 * (jj & 1); }
                cv_item(in.mla_w_qb + (size_t)j * QRANK * 1536 + col, 1536, kb * 64, in.mla_q_norm + (size_t)j * QRANK, nullptr, WB + WM_QB, 512, kb * 64, nb * 32, scr, lane); continue; }
            r -= 8 * 48;
            if (r < 4 * 64) {
                const int nb = r % 64, kb = r / 64, n = nb * 32 + nl;
                cv_item(in.mla_w_kvb + (size_t)j * KVRANK * 2048 + n, 2048, kb * 64, in.mla_kv_norm + (size_t)j * KVRANK, nullptr, WB + WM_KVB, 256, kb * 64, nb * 32, scr, lane); continue; }
            r -= 4 * 64;
            { const int nb = r % 32, kb = r / 32, n = nb * 32 + nl;
              cv_item(in.mla_w_o + (size_t)j * 1024 * 1024 + n, 1024, kb * 64, nullptr, nullptr, WB + WM_O, 1024, kb * 64, nb * 32, scr, lane); }
        } else if (kind == 1) {
            const float* gmix = in.mix_norm + (size_t)layer * D;
            if (r < 16 * 104) {
                const int nb = r % 104, kb = r / 104, n = nb * 32 + nl;
                const float* W = (n < ML_NIN) ? in.ml_w_in + (size_t)j * D * ML_NIN + n : nullptr;
                cv_item(W, ML_NIN, kb * 64, gmix, nullptr, WB + WL_IN, 1024, kb * 64, nb * 32, scr, lane); continue; }
            r -= 16 * 104;
            { const int nb = r % 32, kb = r / 32, n = nb * 32 + nl;
              cv_item(in.ml_w_o + (size_t)j * 1024 * 1024 + n, 1024, kb * 64, nullptr, nullptr, WB + WL_O, 1024, kb * 64, nb * 32, scr, lane); }
        } else {
            const float* gmix = in.mix_norm + (size_t)layer * D;
            const float* mu = in.rw_mu + (size_t)j * 6 * D;
            if (r < 32 * 104) {
                const int nb = r % 104, kb = r / 104, n = nb * 32 + nl; const float* W; int ld; const float* m;
                if (n < 1024) { W = in.rw_w_r + (size_t)j * D * D + n; ld = D; m = mu + 0 * D; }
                else if (n < 2048) { W = in.rw_w_k + (size_t)j * D * D + (n - 1024); ld = D; m = mu + 2 * D; }
                else if (n < 3072) { W = in.rw_w_v + (size_t)j * D * D + (n - 2048); ld = D; m = mu + 3 * D; }
                else if (n < 3136) { W = in.rw_w1 + (size_t)j * D * 64 + (n - 3072); ld = 64; m = mu + 1 * D; }
                else if (n < 3200) { W = in.rw_a1 + (size_t)j * D * 64 + (n - 3136); ld = 64; m = mu + 4 * D; }
                else { W = in.rw_g1 + (size_t)j * D * 128 + (n - 3200); ld = 128; m = mu + 5 * D; }
                const int ks0 = (kb & 15) * 64;
                cv_item(W, ld, ks0, gmix, (kb >= 16) ? m : nullptr, WB + WR_BIG, 2048, kb * 64, nb * 32, scr, lane); continue; }
            r -= 32 * 104;
            if (r < 4 * 96) {
                const int nb = r % 96, kb = r / 96, n = nb * 32 + nl; const float* W = nullptr; int ld = 1024, ks0 = 0;
                if (n < 1024) { if (kb == 0) { W = in.rw_w2 + (size_t)j * 64 * D + n; ks0 = 0; } }
                else if (n < 2048) { if (kb == 1) { W = in.rw_a2 + (size_t)j * 64 * D + (n - 1024); ks0 = 0; } }
                else { if (kb >= 2) { W = in.rw_g2 + (size_t)j * 128 * D + (n - 2048); ks0 = (kb - 2) * 64; } }
                cv_item(W, ld, ks0, nullptr, nullptr, WB + WR_UP, 256, kb * 64, nb * 32, scr, lane); continue; }
            r -= 4 * 96;
            { const int nb = r % 32, kb = r / 32, n = nb * 32 + nl;
              cv_item(in.rw_w_o + (size_t)j * 1024 * 1024 + n, 1024, kb * 64, nullptr, nullptr, WB + WR_O, 1024, kb * 64, nb * 32, scr, lane); }
        }
    }
}

__device__ __forceinline__ void prologue(Frame& F, const Inputs& in) {
    for (int m = F.gw; m < T; m += F.NGW) {
        const GAS f32x4* xr = (const GAS f32x4*)(in.x + (size_t)m * D) + F.lane;
        GAS f32x4* xo = (GAS f32x4*)(F.X + (size_t)m * D) + F.lane;
        GAS v2u* xb = (GAS v2u*)(F.XB + (size_t)m * D) + F.lane;
        float s = 0.f;
#pragma unroll
        for (int jj = 0; jj < 4; ++jj) { const f32x4 v = xr[64 * jj]; xo[64 * jj] = v; s += (v.x * v.x + v.y * v.y) + (v.z * v.z + v.w * v.w);
            v2u w; w.x = cvtpk(v.x, v.y); w.y = cvtpk(v.z, v.w); xb[64 * jj] = w; }
        s = wave_sum(s);
        if (F.lane < 16) F.SS[(size_t)m * 16 + F.lane] = (F.lane == 0) ? s : 0.f;
    }
    float* COS = (float*)(F.ws + WS_COS); float* SIN = (float*)(F.ws + WS_SIN);
    for (int e = F.gw * 64 + F.lane; e < T * 32; e += F.NGW * 64) {
        const int t = e >> 5, i = e & 31;
        const float inv_freq = __builtin_amdgcn_exp2f(-(float)i * 0.41524101186092029f);
        const float ang = (float)in.positions[t] * inv_freq;
        float sn, cs; fsincos_big(ang, sn, cs);
        COS[e] = cs; SIN[e] = sn;
    }
}

__device__ __forceinline__ float rstd16(const float* SS, int row) {
    const GAS f32x4* p = (const GAS f32x4*)(SS + (size_t)row * 16);
    const f32x4 a = p[0], b = p[1], c = p[2], d = p[3];
    const float s = ((a.x + a.y) + (a.z + a.w)) + ((b.x + b.y) + (b.z + b.w)) + ((c.x + c.y) + (c.z + c.w)) + ((d.x + d.y) + (d.z + d.w));
    return frsq(s * (1.f / D) + RMS_EPS);
}

#define EPI_ROWS(ai, m) (u.pm * 256 + (ai) * 128 + wr * 64 + (m) * 16 + fr)
typedef const f32x4 (&AccT)[2][2][4][2];
using pg8::Unit;

struct EpiSwiGLU { static constexpr bool PERM = true, AFTER_DRAIN = false; const float* SS; bf16* ACT;
    __device__ __forceinline__ void operator()(AccT acc, const Unit& u, int wr, int wc, int fr, int fq) const {
        const int col = u.pn * 128 + wc * 32 + fq * 8;
#pragma unroll
        for (int ai = 0; ai < 2; ++ai)
#pragma unroll
            for (int m = 0; m < 4; ++m) { asm volatile("" ::: "memory"); const int row = EPI_ROWS(ai, m); const float r = rstd16(SS, row);
                float o[8];
#pragma unroll
                for (int n = 0; n < 2; ++n)
#pragma unroll
                    for (int e = 0; e < 4; ++e) { const float g = acc[ai][0][m][n][e] * r, up = acc[ai][1][m][n][e] * r; o[4 * n + e] = fsilu(g) * up; }
                *(GAS v4u*)(ACT + (size_t)row * FF + col) = pack8f(o); }
    }
};
struct EpiResidual { static constexpr bool PERM = true, AFTER_DRAIN = false; float* X; bf16* XB; float* SS; float scale;
    __device__ __forceinline__ void operator()(AccT acc, const Unit& u, int wr, int wc, int fr, int fq) const {
#pragma unroll
        for (int ai = 0; ai < 2; ++ai)
#pragma unroll
            for (int m = 0; m < 4; ++m) { asm volatile("" ::: "memory"); const int row = EPI_ROWS(ai, m); float ss = 0.f;
#pragma unroll
                for (int bj = 0; bj < 2; ++bj) { const int col = u.pn * 256 + bj * 128 + wc * 32 + fq * 8;
                    GAS f32x4* xp = (GAS f32x4*)(X + (size_t)row * D + col);
                    f32x4 x0 = xp[0], x1 = xp[1];
                    x0 = x0 + acc[ai][bj][m][0] * scale; x1 = x1 + acc[ai][bj][m][1] * scale;
                    xp[0] = x0; xp[1] = x1;
                    *(GAS v4u*)(XB + (size_t)row * D + col) = pack8v(x0, x1);
                    ss += (x0.x * x0.x + x0.y * x0.y) + (x0.z * x0.z + x0.w * x0.w) + (x1.x * x1.x + x1.y * x1.y) + (x1.z * x1.z + x1.w * x1.w); }
                ss += __shfl_xor(ss, 16); ss += __shfl_xor(ss, 32);
                if (fq == 0) SS[(size_t)row * 16 + u.pn * 4 + wc] = ss; }
    }
};
__device__ __forceinline__ void rope8(float* v, const float* COS, const float* SIN, int row, int p0) {
    const f32x4 c = *(const GAS f32x4*)(COS + (size_t)row * 32 + p0), s = *(const GAS f32x4*)(SIN + (size_t)row * 32 + p0);
#pragma unroll
    for (int p = 0; p < 4; ++p) { const float x1 = v[2 * p], x2 = v[2 * p + 1]; v[2 * p] = x1 * c[p] - x2 * s[p]; v[2 * p + 1] = x1 * s[p] + x2 * c[p]; }
}
struct EpiMlaA { static constexpr bool PERM = true, AFTER_DRAIN = false; const float* SS; bf16* LAT; float* SSQ; float* SSKV; bf16* KPE; const float* COS; const float* SIN;
    __device__ __forceinline__ void operator()(AccT acc, const Unit& u, int wr, int wc, int fr, int fq) const {
#pragma unroll
        for (int ai = 0; ai < 2; ++ai)
#pragma unroll
            for (int m = 0; m < 4; ++m) { asm volatile("" ::: "memory"); const int row = EPI_ROWS(ai, m); const float r = rstd16(SS, row); float ss = 0.f;
#pragma unroll
                for (int bj = 0; bj < 2; ++bj) { const int col = u.pn * 256 + bj * 128 + wc * 32 + fq * 8;
                    float v[8];
#pragma unroll
                    for (int n = 0; n < 2; ++n)
#pragma unroll
                        for (int e = 0; e < 4; ++e) { v[4 * n + e] = acc[ai][bj][m][n][e] * r; ss += v[4 * n + e] * v[4 * n + e]; }
                    *(GAS v4u*)(LAT + (size_t)row * 1024 + col) = pack8f(v);
                    if (u.pn == 3 && bj == 0 && wc < 2) { rope8(v, COS, SIN, row, wc * 16 + fq * 4); *(GAS v4u*)(KPE + (size_t)row * 64 + wc * 32 + fq * 8) = pack8f(v); } }
                ss += __shfl_xor(ss, 16); ss += __shfl_xor(ss, 32);
                if (fq == 0) { if (u.pn < 2) SSQ[(size_t)row * 8 + u.pn * 4 + wc] = ss; else if (u.pn == 2) SSKV[(size_t)row * 4 + wc] = ss; } }
    }
};
struct EpiMlaQ { static constexpr bool PERM = true, AFTER_DRAIN = false; const float* SSQ; bf16* Q; const float* COS; const float* SIN; float qscale;
    __device__ __forceinline__ void operator()(AccT acc, const Unit& u, int wr, int wc, int fr, int fq) const {
#pragma unroll
        for (int ai = 0; ai < 2; ++ai)
#pragma unroll
            for (int m = 0; m < 4; ++m) { asm volatile("" ::: "memory"); const int row = EPI_ROWS(ai, m);
                const GAS f32x4* p = (const GAS f32x4*)(SSQ + (size_t)row * 8); const f32x4 a = p[0], b = p[1];
                const float r = frsq((((a.x + a.y) + (a.z + a.w)) + ((b.x + b.y) + (b.z + b.w))) * (1.f / QRANK) + RMS_EPS) * qscale;
#pragma unroll
                for (int bj = 0; bj < 2; ++bj) { const int col = u.pn * 256 + bj * 128 + wc * 32 + fq * 8, hd = col / DQK, w = col - hd * DQK;
                    float v[8];
#pragma unroll
                    for (int n = 0; n < 2; ++n)
#pragma unroll
                        for (int e = 0; e < 4; ++e) v[4 * n + e] = acc[ai][bj][m][n][e] * r;
                    if (w >= NOPE) rope8(v, COS, SIN, row, (w - NOPE) >> 1);
                    *(GAS v4u*)(Q + (size_t)row * 1536 + col) = pack8f(v); } }
    }
};
struct EpiMlaKV { static constexpr bool PERM = true, AFTER_DRAIN = false; const float* SSKV; bf16* KV;
    __device__ __forceinline__ void operator()(AccT acc, const Unit& u, int wr, int wc, int fr, int fq) const {
#pragma unroll
        for (int ai = 0; ai < 2; ++ai)
#pragma unroll
            for (int m = 0; m < 4; ++m) { asm volatile("" ::: "memory"); const int row = EPI_ROWS(ai, m);
                const f32x4 a = *(const GAS f32x4*)(SSKV + (size_t)row * 4);
                const float r = frsq(((a.x + a.y) + (a.z + a.w)) * (1.f / KVRANK) + RMS_EPS);
#pragma unroll
                for (int bj = 0; bj < 2; ++bj) { const int col = u.pn * 256 + bj * 128 + wc * 32 + fq * 8;
                    *(GAS v4u*)(KV + (size_t)row * 2048 + col) = pack8v(acc[ai][bj][m][0] * r, acc[ai][bj][m][1] * r); } }
    }
};
struct EpiMlIn { static constexpr bool PERM = true, AFTER_DRAIN = false; const float* SS; bf16* P; float* GATES;
    __device__ __forceinline__ void operator()(AccT acc, const Unit& u, int wr, int wc, int fr, int fq) const {
#pragma unroll
        for (int ai = 0; ai < 2; ++ai)
#pragma unroll
            for (int m = 0; m < 4; ++m) { asm volatile("" ::: "memory"); const int row = EPI_ROWS(ai, m); const float r = rstd16(SS, row);
                if (u.pn < 12) {
#pragma unroll
                    for (int bj = 0; bj < 2; ++bj) { const int col = u.pn * 256 + bj * 128 + wc * 32 + fq * 8;
                        *(GAS v4u*)(P + (size_t)row * 3072 + col) = pack8v(acc[ai][bj][m][0] * r, acc[ai][bj][m][1] * r); }
                } else if (wc == 0 && fq < 2) {
                    GAS f32x4* g = (GAS f32x4*)(GATES + (size_t)row * 16 + fq * 8); g[0] = acc[ai][0][m][0] * r; g[1] = acc[ai][0][m][1] * r; } }
    }
};
struct EpiRwBig { static constexpr bool PERM = true, AFTER_DRAIN = false; bf16* RKV; bf16* LOR;
    __device__ __forceinline__ void operator()(AccT acc, const Unit& u, int wr, int wc, int fr, int fq) const {
#pragma unroll
        for (int ai = 0; ai < 2; ++ai)
#pragma unroll
            for (int m = 0; m < 4; ++m) { asm volatile("" ::: "memory"); const int row = EPI_ROWS(ai, m);
#pragma unroll
                for (int bj = 0; bj < 2; ++bj) { const int cl = bj * 128 + wc * 32 + fq * 8;
                    if (u.pn < 12) { *(GAS v4u*)(RKV + (size_t)row * 3072 + u.pn * 256 + cl) = pack8v(acc[ai][bj][m][0], acc[ai][bj][m][1]); }
                    else { float v[8];
#pragma unroll
                        for (int n = 0; n < 2; ++n)
#pragma unroll
                            for (int e = 0; e < 4; ++e) { const float a = acc[ai][bj][m][n][e]; v[4 * n + e] = (cl < 64) ? ftanh(a) : (cl < 128) ? a : fsigmoid(a); }
                        *(GAS v4u*)(LOR + (size_t)row * 256 + cl) = pack8f(v); } } }
    }
};
struct EpiRwUp { static constexpr bool PERM = true, AFTER_DRAIN = false; float* LW; bf16* AA; bf16* GG; const float* w0; const float* a0;
    __device__ __forceinline__ void operator()(AccT acc, const Unit& u, int wr, int wc, int fr, int fq) const {
        const int sec = u.pn >> 2;
#pragma unroll
        for (int ai = 0; ai < 2; ++ai)
#pragma unroll
            for (int m = 0; m < 4; ++m) { asm volatile("" ::: "memory"); const int row = EPI_ROWS(ai, m);
#pragma unroll
                for (int bj = 0; bj < 2; ++bj) { const int col = (u.pn & 3) * 256 + bj * 128 + wc * 32 + fq * 8;
                    if (sec == 0) {
#pragma unroll
                        for (int n = 0; n < 2; ++n) { const f32x4 b = *(const GAS f32x4*)(w0 + col + 4 * n); f32x4 o;
#pragma unroll
                            for (int e = 0; e < 4; ++e) { const float z = -(acc[ai][bj][m][n][e] + b[e]); const float sp = fmaxf(z, 0.f) + flog(1.f + fexp(-fabsf(z))); o[e] = -fexp(-sp - 0.5f); }
                            *(GAS f32x4*)(LW + (size_t)row * 1024 + col + 4 * n) = o; } }
                    else if (sec == 1) { const f32x4 b0 = *(const GAS f32x4*)(a0 + col), b1 = *(const GAS f32x4*)(a0 + col + 4); float v[8];
#pragma unroll
                        for (int e = 0; e < 4; ++e) { v[e] = fsigmoid(acc[ai][bj][m][0][e] + b0[e]); v[4 + e] = fsigmoid(acc[ai][bj][m][1][e] + b1[e]); }
                        *(GAS v4u*)(AA + (size_t)row * 1024 + col) = pack8f(v); }
                    else { *(GAS v4u*)(GG + (size_t)row * 1024 + col) = pack8v(acc[ai][bj][m][0], acc[ai][bj][m][1]); } } }
    }
};

namespace att {
constexpr int SHM_K = 64 * DQK * 2  , SHM_V = 64 * DVH * 2  ;
constexpr int OFF_V = 0, OFF_K = 2 * SHM_V, OFF_WS = OFF_K + 2 * SHM_K, ATT_LDS = OFF_WS + NWAVES * 64 * 4;
static_assert(ATT_LDS <= RING_BYTES, "attention LDS");
#define KSWZ(row, colB) ((row) * 384 + ((colB) ^ (((row) & 7) << 4)))
#define SBAR() __builtin_amdgcn_sched_barrier(0)
__device__ __forceinline__ int v_st(int k, int c) { const int kk = (k & ~0xC) | ((k & 4) << 1) | ((k & 8) >> 1); return ((kk >> 3) * 4 + (c >> 5)) * 512 + ((kk & 7) * 32 + (c & 31)) * 2; }
__device__ __forceinline__ int v_rd_base(int lane) { return ((lane & 3) << 3) | (((lane >> 2) & 3) << 6) | (((lane >> 4) & 1) << 5) | (((lane >> 5) & 1) << 8); }
constexpr int v_rd_off(int d0, int ks, int half) { return d0 * 512 + ks * 4096 + half * 2048; }
__device__ __forceinline__ int crow(int r, int hi) { return (r & 3) + 8 * (r >> 2) + 4 * hi; }
__device__ __forceinline__ void mask_tile(f32x16& p0, f32x16& p1, int dq) {
    const float NEG = -__builtin_inff();
#pragma unroll
    for (int r = 0; r < 16; ++r) { const int c = (r & 3) + 8 * (r >> 2);
        if (dq - c < 0) p0[r] = NEG;
        if (dq - c - 32 < 0) p1[r] = NEG; }
}
constexpr float THR2 = 11.5f;
__device__ __forceinline__ void partialSM(f32x16& p0, f32x16& p1, float& m_reg, float& alpha) {
    float pmax = p0[0];
#pragma unroll
    for (int r = 1; r < 16; ++r) pmax = fmaxf(pmax, p0[r]);
#pragma unroll
    for (int r = 0; r < 16; ++r) pmax = fmaxf(pmax, p1[r]);
    { auto rr = __builtin_amdgcn_permlane32_swap(__float_as_uint(pmax), __float_as_uint(pmax), false, false);
      pmax = fmaxf(__uint_as_float(rr[0]), __uint_as_float(rr[1])); }
    float mn;
    if (__builtin_expect(__all((pmax - m_reg) <= THR2), 1)) { mn = m_reg; alpha = 1.f; }
    else { mn = fmaxf(m_reg, pmax); alpha = __builtin_amdgcn_exp2f(m_reg - mn); m_reg = mn; }
#pragma unroll
    for (int r = 0; r < 16; ++r) { p0[r] = __builtin_amdgcn_exp2f(p0[r] - mn); p1[r] = __builtin_amdgcn_exp2f(p1[r] - mn); }
}
__device__ __forceinline__ void finishSM(f32x16& p0, f32x16& p1, float alpha, float& l_reg, bf16x8& pa0, bf16x8& pa1, bf16x8& pa2, bf16x8& pa3) {
    float ps = 0;
#pragma unroll
    for (int r = 0; r < 16; ++r) ps += p0[r];
#pragma unroll
    for (int r = 0; r < 16; ++r) ps += p1[r];
    { auto rr = __builtin_amdgcn_permlane32_swap(__float_as_uint(ps), __float_as_uint(ps), false, false);
      ps = __uint_as_float(rr[0]) + __uint_as_float(rr[1]); }
    l_reg = l_reg * alpha + ps;
#define PK4(P, B_, OUT) do { unsigned a0 = cvtpk(P[B_+0], P[B_+1]), a1 = cvtpk(P[B_+2], P[B_+3]);                          \
        unsigned b0 = cvtpk(P[B_+4], P[B_+5]), b1 = cvtpk(P[B_+6], P[B_+7]);                                             \
        auto r0 = __builtin_amdgcn_permlane32_swap(a0, b0, false, false); auto r1 = __builtin_amdgcn_permlane32_swap(a1, b1, false, false); \
        v4u w = {r0[0], r1[0], r0[1], r1[1]}; OUT = __builtin_bit_cast(bf16x8, w); } while (0)
    PK4(p0, 0, pa0); PK4(p0, 8, pa1); PK4(p1, 0, pa2); PK4(p1, 8, pa3);
#undef PK4
}
__device__ __forceinline__ void qkt(f32x16& p0, f32x16& p1, const LAS char* Kb, int r32, int hi, const bf16x8* qr) {
    p0 = f32x16{}; p1 = f32x16{};
    const LAS char* kb[4];
#pragma unroll
    for (int dd = 0; dd < 4; ++dd) kb[dd] = Kb + r32 * 384 + ((dd * 32 + hi * 16) ^ ((r32 & 7) << 4));
#pragma unroll
    for (int d0 = 0; d0 < 12; ++d0) { const LAS char* a = kb[d0 & 3] + (d0 >> 2) * 128;
        const bf16x8 b0 = *(const LAS bf16x8*)(a);
        const bf16x8 b1 = *(const LAS bf16x8*)(a + 32 * 384);
        p0 = __builtin_amdgcn_mfma_f32_32x32x16_bf16(b0, qr[d0], p0, 0, 0, 0);
        p1 = __builtin_amdgcn_mfma_f32_32x32x16_bf16(b1, qr[d0], p1, 0, 0, 0); }
}
__device__ __forceinline__ void pv_tile(f32x16* o, int vb0, bf16x8 pa0, bf16x8 pa1, bf16x8 pa2, bf16x8 pa3) {
#define TRRD(dst, off) asm volatile("ds_read_b64_tr_b16 %0, %1 offset:%2" : "=&v"(dst) : "v"(vb0), "i"(off) : "memory")
#define PV_D0(d0) do { s16x4 l0, l1, l2, l3, h0, h1, h2, h3; constexpr int b_ = v_rd_off(d0, 0, 0); \
        TRRD(l0, b_); TRRD(h0, b_ + 2048); TRRD(l1, b_ + 4096); TRRD(h1, b_ + 6144); TRRD(l2, b_ + 8192); TRRD(h2, b_ + 10240); TRRD(l3, b_ + 12288); TRRD(h3, b_ + 14336); \
        asm volatile("s_waitcnt lgkmcnt(0)" ::: "memory"); SBAR(); \
        o[d0] = __builtin_amdgcn_mfma_f32_32x32x16_bf16(pa0, (bf16x8){l0[0], l0[1], l0[2], l0[3], h0[0], h0[1], h0[2], h0[3]}, o[d0], 0, 0, 0);   \
        o[d0] = __builtin_amdgcn_mfma_f32_32x32x16_bf16(pa1, (bf16x8){l1[0], l1[1], l1[2], l1[3], h1[0], h1[1], h1[2], h1[3]}, o[d0], 0, 0, 0);   \
        o[d0] = __builtin_amdgcn_mfma_f32_32x32x16_bf16(pa2, (bf16x8){l2[0], l2[1], l2[2], l2[3], h2[0], h2[1], h2[2], h2[3]}, o[d0], 0, 0, 0);   \
        o[d0] = __builtin_amdgcn_mfma_f32_32x32x16_bf16(pa3, (bf16x8){l3[0], l3[1], l3[2], l3[3], h3[0], h3[1], h3[2], h3[3]}, o[d0], 0, 0, 0); } while (0)
    PV_D0(0); PV_D0(1); PV_D0(2); PV_D0(3);
#undef PV_D0
#undef TRRD
}
__device__ __forceinline__ void attn_unit(int wid, int b, int h, int qb, const bf16* Q, const bf16* KV, const bf16* KPE, bf16* O, LAS char* lds) {
    const int lane = fresh_lane(), tid = wid * 64 + lane, r32 = lane & 31, hi = lane >> 5;
    const size_t rowbase = (size_t)b * SEQ; const int q0 = qb * 256;
    LAS char* V_lds = lds + OFF_V; LAS char* K_lds = lds + OFF_K;
    LAS float* wsf = (LAS float*)(lds + OFF_WS) + wid * 64; LAS float* li_l = wsf; LAS float* al_l = wsf + 32;
    bf16x8 qr[12];
    { const bf16* Qw = Q + (rowbase + q0 + wid * 32 + r32) * 1536 + h * DQK + hi * 8;
#pragma unroll
      for (int d0 = 0; d0 < 12; ++d0) qr[d0] = *(const GAS bf16x8*)(Qw + d0 * 16); }
    const int NT = 4 * (qb + 1);
    const bf16* ksrc[3]; int kdst[3]; int kstr[3];
#pragma unroll
    for (int i = 0; i < 3; ++i) { const int id = tid + 512 * i, row = id / 24, ch = id - row * 24;
        if (ch < 16) { ksrc[i] = KV + (rowbase + row) * 2048 + h * 256 + ch * 8; kstr[i] = 2048; }
        else { ksrc[i] = KPE + (rowbase + row) * 64 + (ch - 16) * 8; kstr[i] = 64; }
        kdst[i] = KSWZ(row, ch * 16); }
    const int sr = tid >> 4, sc = (tid & 15) * 8;
    const bf16* vsrc = KV + (rowbase + sr) * 2048 + h * 256 + 128 + sc;
    const int vst0 = v_st(sr, sc), vst1 = v_st(32 + sr, sc);
    const int vb0 = (int)(uintptr_t)V_lds + v_rd_base(lane);
    bf16x8 sk0, sk1, sk2, sv0, sv1;
#define SLOAD(t) do { sk0 = *(const GAS bf16x8*)(ksrc[0] + (size_t)(t) * 64 * kstr[0]); sk1 = *(const GAS bf16x8*)(ksrc[1] + (size_t)(t) * 64 * kstr[1]); sk2 = *(const GAS bf16x8*)(ksrc[2] + (size_t)(t) * 64 * kstr[2]); \
                      sv0 = *(const GAS bf16x8*)(vsrc + (size_t)(t) * 64 * 2048); sv1 = *(const GAS bf16x8*)(vsrc + (size_t)((t) * 64 + 32) * 2048); } while (0)
#define SWRITE(bf) do { *(LAS bf16x8*)(K_lds + (bf) * SHM_K + kdst[0]) = sk0; *(LAS bf16x8*)(K_lds + (bf) * SHM_K + kdst[1]) = sk1; *(LAS bf16x8*)(K_lds + (bf) * SHM_K + kdst[2]) = sk2; \
                        *(LAS bf16x8*)(V_lds + (bf) * SHM_V + vst0) = sv0; *(LAS bf16x8*)(V_lds + (bf) * SHM_V + vst1) = sv1; } while (0)
    float m_reg = -1e30f, l_reg = 0.f; f32x16 o[4] = {};
    const int qlo = q0 + wid * 32, qm = qlo + r32 - 4 * hi;
    SLOAD(0); SWRITE(0);
    __syncthreads();
    for (int t = 0; t < NT; ++t) {
        const int bf = t & 1;
        if (t + 1 < NT) SLOAD(t + 1);
        f32x16 p0, p1; float alpha; bf16x8 pa0, pa1, pa2, pa3;
        SBAR();
        qkt(p0, p1, K_lds + bf * SHM_K, r32, hi, qr);
        const int kb = t * 64;
        if (kb + 63 > qlo) mask_tile(p0, p1, qm - kb);
        partialSM(p0, p1, m_reg, alpha);
        if (__any(alpha < 1.f)) { if (hi == 0) al_l[r32] = alpha; LDS_WAIT();
#pragma unroll
            for (int d_ = 0; d_ < 4; ++d_)
#pragma unroll
                for (int r = 0; r < 16; ++r) o[d_][r] *= al_l[crow(r, hi)]; }
        finishSM(p0, p1, alpha, l_reg, pa0, pa1, pa2, pa3);
        SBAR();
        pv_tile(o, vb0 + bf * SHM_V, pa0, pa1, pa2, pa3);
        if (t + 1 < NT) SWRITE(bf ^ 1);
        __syncthreads();
    }
    if (hi == 0) li_l[r32] = l_reg; LDS_WAIT();
    bf16* Ow = O + (rowbase + q0 + wid * 32) * 1024 + h * DVH;
#pragma unroll
    for (int r = 0; r < 16; ++r) { const int orow = crow(r, hi); const float rl = frcp(li_l[orow]);
#pragma unroll
        for (int d0 = 0; d0 < 4; ++d0) { const float v = o[d0][r] * rl; const float vn = __shfl_xor(v, 1);
            if ((r32 & 1) == 0) *(GAS unsigned*)(Ow + (size_t)orow * 1024 + d0 * 32 + r32) = cvtpk(v, vn); } }
    __syncthreads();
#undef SLOAD
#undef SWRITE
}
#undef KSWZ
}

__device__ __forceinline__ void ml_conv_phase(Frame& F, const Inputs& in, int j) {
    const bf16* P = (const bf16*)(F.ws + WS_ARENA + A_P); const float* GATES = (const float*)(F.ws + WS_ARENA + A_GATES);
    float* QKC = (float*)(F.ws + WS_ARENA + A_QKC); float* IGLF = (float*)(F.ws + WS_ARENA + A_IGLF);
    const float* cw = in.ml_conv_w + (size_t)j * 4 * 1024; const float* cb = in.ml_conv_b + (size_t)j * 1024; const float* bif = in.ml_b_if + (size_t)j * 16;
    const int gt = F.gw * 64 + F.lane, NT_ = F.NGW * 64;
    for (int e = gt; e < T * 128; e += NT_) {
        const int t = e >> 7, c = (e & 127) * 8, s = t & (SEQ - 1);
        float acc[8];
        { const f32x4 b0 = *(const GAS f32x4*)(cb + c), b1 = *(const GAS f32x4*)(cb + c + 4);
#pragma unroll
          for (int q = 0; q < 4; ++q) { acc[q] = b0[q]; acc[4 + q] = b1[q]; } }
#pragma unroll
        for (int k = 0; k < 4; ++k) { const int dt = 3 - k;
            if (s - dt >= 0) { float pv[8]; unpack8(*(const GAS v4u*)(P + (size_t)(t - dt) * 3072 + c), pv);
                const f32x4 w0 = *(const GAS f32x4*)(cw + k * 1024 + c), w1 = *(const GAS f32x4*)(cw + k * 1024 + c + 4);
#pragma unroll
                for (int q = 0; q < 4; ++q) { acc[q] += w0[q] * pv[q]; acc[4 + q] += w1[q] * pv[4 + q]; } } }
        const float sc = (c >= 512) ? 0.125f : 1.f;
        f32x4 o0, o1;
#pragma unroll
        for (int q = 0; q < 4; ++q) { o0[q] = fsilu(acc[q]) * sc; o1[q] = fsilu(acc[4 + q]) * sc; }
        GAS f32x4* op = (GAS f32x4*)(QKC + (size_t)t * 1024 + c); op[0] = o0; op[1] = o1;
    }
    for (int e = gt; e < T * 16; e += NT_) { const int hcol = e & 15; const float g = GATES[e] + bif[hcol];
        float r = g;
        if (hcol >= 8) r = fminf(g, 0.f) - flog(1.f + fexp(-fabsf(g)));
        IGLF[e] = r; }
}
__device__ __forceinline__ void ml_seq_phase(Frame& F) {
    if ((int)blockIdx.x >= BATCH * ML_H) return;
    const int bh = blockIdx.x, b = bh >> 3, h = bh & 7, tid = F.tid, v = tid >> 2, kq = tid & 3;
    const bf16* P = (const bf16*)(F.ws + WS_ARENA + A_P); const float* QKC = (const float*)(F.ws + WS_ARENA + A_QKC); const float* IGLF = (const float*)(F.ws + WS_ARENA + A_IGLF);
    float* HRAW = (float*)(F.ws + WS_ARENA + A_HRAW);
    LAS float* s_q = (LAS float*)F.lds; LAS float* s_k = s_q + 64 * 64; LAS float* s_v = s_k + 64 * 64; LAS float* s_h = s_v + 64 * 128; LAS float* s_ig = s_h + 64 * 128; LAS float* s_lf = s_ig + 64;
    float C[16], n[16]; float mst = 0.f;
#pragma unroll
    for (int d = 0; d < 16; ++d) { C[d] = 0.f; n[d] = 0.f; }
    for (int blk = 0; blk < SEQ / 64; ++blk) {
        const size_t t0 = (size_t)b * SEQ + (size_t)blk * 64;
        __syncthreads();
        for (int e = tid; e < 64 * 16; e += 512) { const int tt = e >> 4, c4 = (e & 15) * 4;
            *(LAS f32x4*)(s_q + tt * 64 + c4) = *(const GAS f32x4*)(QKC + (t0 + tt) * 1024 + h * 64 + c4);
            *(LAS f32x4*)(s_k + tt * 64 + c4) = *(const GAS f32x4*)(QKC + (t0 + tt) * 1024 + 512 + h * 64 + c4); }
        for (int e = tid; e < 64 * 16; e += 512) { const int tt = e >> 4, c8 = (e & 15) * 8; float pv[8];
            unpack8(*(const GAS v4u*)(P + (t0 + tt) * 3072 + 1024 + h * 128 + c8), pv);
#pragma unroll
            for (int q = 0; q < 8; ++q) s_v[tt * 128 + c8 + q] = pv[q]; }
        if (tid < 64) { s_ig[tid] = IGLF[(t0 + tid) * 16 + h]; s_lf[tid] = IGLF[(t0 + tid) * 16 + 8 + h]; }
        __syncthreads();
        for (int tt = 0; tt < 64; ++tt) {
            const float lf = s_lf[tt], ig = s_ig[tt];
            const float mn = fmaxf(lf + mst, ig), fw = fexp(lf + mst - mn), iw = fexp(ig - mn); mst = mn;
            const float vv = s_v[tt * 128 + v] * iw;
            float num = 0.f, den = 0.f;
#pragma unroll
            for (int d4 = 0; d4 < 4; ++d4) { const f32x4 kk = *(const LAS f32x4*)(s_k + tt * 64 + kq * 16 + d4 * 4), qq = *(const LAS f32x4*)(s_q + tt * 64 + kq * 16 + d4 * 4);
#pragma unroll
                for (int q = 0; q < 4; ++q) { const int d = d4 * 4 + q; C[d] = fw * C[d] + vv * kk[q]; n[d] = fw * n[d] + iw * kk[q]; num += C[d] * qq[q]; den += n[d] * qq[q]; } }
            num += __shfl_xor(num, 1); num += __shfl_xor(num, 2); den += __shfl_xor(den, 1); den += __shfl_xor(den, 2);
            const float hv = num * frcp(fmaxf(fabsf(den), fexp(-mn)));
            if (kq == 0) s_h[tt * 128 + v] = hv;
        }
        __syncthreads();
        for (int e = tid; e < 64 * 32; e += 512) { const int tt = e >> 5, c4 = (e & 31) * 4;
            *(GAS f32x4*)(HRAW + (t0 + tt) * 1024 + h * 128 + c4) = *(const LAS f32x4*)(s_h + tt * 128 + c4); }
    }
}
__device__ __forceinline__ void ml_out_phase(Frame& F, const Inputs& in, int j) {
    const bf16* P = (const bf16*)(F.ws + WS_ARENA + A_P); const float* HRAW = (const float*)(F.ws + WS_ARENA + A_HRAW); bf16* HM = (bf16*)(F.ws + WS_ARENA + A_HM);
    const float* gn = in.ml_out_norm + (size_t)j * 1024;
    for (int m = F.gw; m < T; m += F.NGW) { const int c = F.lane * 16;
        float hv[16]; float ss = 0.f;
#pragma unroll
        for (int q = 0; q < 4; ++q) { const f32x4 x = *(const GAS f32x4*)(HRAW + (size_t)m * 1024 + c + 4 * q);
#pragma unroll
            for (int e = 0; e < 4; ++e) { hv[4 * q + e] = x[e]; ss += x[e] * x[e]; } }
        ss += __shfl_xor(ss, 1); ss += __shfl_xor(ss, 2); ss += __shfl_xor(ss, 4);
        const float r = frsq(ss * (1.f / 128.f) + RMS_EPS);
        float ov[16]; unpack8(*(const GAS v4u*)(P + (size_t)m * 3072 + 2048 + c), ov); unpack8(*(const GAS v4u*)(P + (size_t)m * 3072 + 2048 + c + 8), ov + 8);
        float res[16];
#pragma unroll
        for (int e = 0; e < 16; ++e) res[e] = hv[e] * r * gn[c + e] * fsigmoid(ov[e]);
        GAS v4u* op = (GAS v4u*)(HM + (size_t)m * 1024 + c); op[0] = pack8f(res); op[1] = pack8f(res + 8);
    }
}

__device__ __forceinline__ void rw_shift_phase(Frame& F) {
    bf16* HX = (bf16*)(F.ws + WS_ARENA + A_HX);
    for (int m = F.gw; m < T; m += F.NGW) { const int c = F.lane * 16, s = m & (SEQ - 1);
        const float r = rstd16(F.SS, m), rp = (s > 0) ? rstd16(F.SS, m - 1) : 0.f;
        float hv[16], xv[16];
#pragma unroll
        for (int q = 0; q < 4; ++q) { const f32x4 x = *(const GAS f32x4*)(F.X + (size_t)m * D + c + 4 * q);
            f32x4 xp = {0.f, 0.f, 0.f, 0.f}; if (s > 0) xp = *(const GAS f32x4*)(F.X + (size_t)(m - 1) * D + c + 4 * q);
#pragma unroll
            for (int e = 0; e < 4; ++e) { hv[4 * q + e] = x[e] * r; xv[4 * q + e] = xp[e] * rp - x[e] * r; } }
        GAS v4u* o1 = (GAS v4u*)(HX + (size_t)m * 2048 + c); o1[0] = pack8f(hv); o1[1] = pack8f(hv + 8);
        GAS v4u* o2 = (GAS v4u*)(HX + (size_t)m * 2048 + 1024 + c); o2[0] = pack8f(xv); o2[1] = pack8f(xv + 8);
    }
}
__device__ __forceinline__ void rw_seq_phase(Frame& F, const Inputs& in, int j) {
    if ((int)blockIdx.x >= BATCH * RW_H) return;
    const int bh = blockIdx.x, b = bh >> 4, h = bh & 15, tid = F.tid, i = tid >> 3, jr = tid & 7;
    const bf16* RKV = (const bf16*)(F.ws + WS_ARENA + A_RKV); const bf16* AA = (const bf16*)(F.ws + WS_XB); float* LW = (float*)(F.ws + WS_ARENA + A_LW);
    LAS float* s_r = (LAS float*)F.lds; LAS float* s_w = s_r + 4096; LAS float* s_k = s_w + 4096; LAS float* s_v = s_k + 4096; LAS float* s_a = s_v + 4096; LAS float* s_b = s_a + 4096; LAS float* s_y = s_b + 4096;
    float kkc[8], kac[8];
#pragma unroll
    for (int q = 0; q < 8; ++q) { kkc[q] = in.rw_k_k[(size_t)j * 1024 + h * 64 + jr * 8 + q]; kac[q] = in.rw_k_a[(size_t)j * 1024 + h * 64 + jr * 8 + q]; }
    float S[8];
#pragma unroll
    for (int q = 0; q < 8; ++q) S[q] = 0.f;
    for (int blk = 0; blk < SEQ / 64; ++blk) {
        const size_t t0 = (size_t)b * SEQ + (size_t)blk * 64;
        __syncthreads();
        { const int tt = tid >> 3; const size_t t = t0 + tt; const int c = h * 64 + jr * 8;
          float rv[8], kv[8], vv[8], av[8];
          unpack8(*(const GAS v4u*)(RKV + t * 3072 + c), rv); unpack8(*(const GAS v4u*)(RKV + t * 3072 + 1024 + c), kv); unpack8(*(const GAS v4u*)(RKV + t * 3072 + 2048 + c), vv);
          unpack8(*(const GAS v4u*)(AA + t * 1024 + c), av);
          const f32x4 l0 = *(const GAS f32x4*)(LW + t * 1024 + c), l1 = *(const GAS f32x4*)(LW + t * 1024 + c + 4);
          float kk[8]; float ss = 0.f;
#pragma unroll
          for (int q = 0; q < 8; ++q) { kk[q] = kv[q] * kkc[q]; ss += kk[q] * kk[q]; }
          ss += __shfl_xor(ss, 1); ss += __shfl_xor(ss, 2); ss += __shfl_xor(ss, 4);
          const float inv = frcp(fmaxf(fsqrt(ss), 1e-12f));
#pragma unroll
          for (int q = 0; q < 8; ++q) { const float kn = kk[q] * inv; const int o = tt * 64 + jr * 8 + q;
              s_r[o] = rv[q]; s_w[o] = fexp(q < 4 ? l0[q] : l1[q - 4]); s_k[o] = kv[q] * (1.f + (av[q] - 1.f) * kac[q]); s_v[o] = vv[q]; s_a[o] = -kn; s_b[o] = kn * av[q]; } }
        __syncthreads();
        for (int tt = 0; tt < 64; ++tt) {
            const int o = tt * 64 + jr * 8;
            const f32x4 a0 = *(const LAS f32x4*)(s_a + o), a1 = *(const LAS f32x4*)(s_a + o + 4), w0 = *(const LAS f32x4*)(s_w + o), w1 = *(const LAS f32x4*)(s_w + o + 4);
            const f32x4 b0 = *(const LAS f32x4*)(s_b + o), b1 = *(const LAS f32x4*)(s_b + o + 4), k0 = *(const LAS f32x4*)(s_k + o), k1 = *(const LAS f32x4*)(s_k + o + 4);
            const f32x4 r0 = *(const LAS f32x4*)(s_r + o), r1 = *(const LAS f32x4*)(s_r + o + 4);
            const float vi = s_v[tt * 64 + i];
            float sa = 0.f;
#pragma unroll
            for (int q = 0; q < 4; ++q) { sa += S[q] * a0[q]; sa += S[4 + q] * a1[q]; }
            sa += __shfl_xor(sa, 1); sa += __shfl_xor(sa, 2); sa += __shfl_xor(sa, 4);
            float y = 0.f;
#pragma unroll
            for (int q = 0; q < 4; ++q) { S[q] = S[q] * w0[q] + sa * b0[q] + vi * k0[q]; S[4 + q] = S[4 + q] * w1[q] + sa * b1[q] + vi * k1[q]; y += S[q] * r0[q]; y += S[4 + q] * r1[q]; }
            y += __shfl_xor(y, 1); y += __shfl_xor(y, 2); y += __shfl_xor(y, 4);
            if (jr == 0) s_y[tt * 64 + i] = y;
        }
        __syncthreads();
        for (int e = tid; e < 64 * 16; e += 512) { const int tt = e >> 4, c4 = (e & 15) * 4;
            *(GAS f32x4*)(LW + (t0 + tt) * 1024 + h * 64 + c4) = *(const LAS f32x4*)(s_y + tt * 64 + c4); }
    }
}
__device__ __forceinline__ void rw_out_phase(Frame& F, const Inputs& in, int j) {
    const bf16* RKV = (const bf16*)(F.ws + WS_ARENA + A_RKV); const bf16* AA = (const bf16*)(F.ws + WS_XB); const float* Y = (const float*)(F.ws + WS_ARENA + A_LW);
    const bf16* GG = (const bf16*)(F.ws + WS_ARENA + A_GG); bf16* YG = (bf16*)(F.ws + WS_ARENA + A_YG);
    const float* ka = in.rw_k_a + (size_t)j * 1024; const float* rk = in.rw_r_k + (size_t)j * 1024; const float* lnw = in.rw_ln_w + (size_t)j * 1024; const float* lnb = in.rw_ln_b + (size_t)j * 1024;
    for (int m = F.gw; m < T; m += F.NGW) { const int c = F.lane * 16;
        float yv[16]; float s1 = 0.f;
#pragma unroll
        for (int q = 0; q < 4; ++q) { const f32x4 x = *(const GAS f32x4*)(Y + (size_t)m * 1024 + c + 4 * q);
#pragma unroll
            for (int e = 0; e < 4; ++e) { yv[4 * q + e] = x[e]; s1 += x[e]; } }
        s1 += __shfl_xor(s1, 1); s1 += __shfl_xor(s1, 2); const float mean = s1 * (1.f / 64.f);
        float s2 = 0.f;
#pragma unroll
        for (int e = 0; e < 16; ++e) { yv[e] -= mean; s2 += yv[e] * yv[e]; }
        s2 += __shfl_xor(s2, 1); s2 += __shfl_xor(s2, 2); const float rs = frsq(s2 * (1.f / 64.f) + 64e-5f);
        float rv[16], kv[16], vv[16], av[16], gv[16];
        unpack8(*(const GAS v4u*)(RKV + (size_t)m * 3072 + c), rv); unpack8(*(const GAS v4u*)(RKV + (size_t)m * 3072 + c + 8), rv + 8);
        unpack8(*(const GAS v4u*)(RKV + (size_t)m * 3072 + 1024 + c), kv); unpack8(*(const GAS v4u*)(RKV + (size_t)m * 3072 + 1024 + c + 8), kv + 8);
        unpack8(*(const GAS v4u*)(RKV + (size_t)m * 3072 + 2048 + c), vv); unpack8(*(const GAS v4u*)(RKV + (size_t)m * 3072 + 2048 + c + 8), vv + 8);
        unpack8(*(const GAS v4u*)(AA + (size_t)m * 1024 + c), av); unpack8(*(const GAS v4u*)(AA + (size_t)m * 1024 + c + 8), av + 8);
        unpack8(*(const GAS v4u*)(GG + (size_t)m * 1024 + c), gv); unpack8(*(const GAS v4u*)(GG + (size_t)m * 1024 + c + 8), gv + 8);
        float bs = 0.f;
#pragma unroll
        for (int e = 0; e < 16; ++e) { const float kp = kv[e] * (1.f + (av[e] - 1.f) * ka[c + e]); bs += rv[e] * kp * rk[c + e]; }
        bs += __shfl_xor(bs, 1); bs += __shfl_xor(bs, 2);
        float res[16];
#pragma unroll
        for (int e = 0; e < 16; ++e) res[e] = (yv[e] * rs * lnw[c + e] + lnb[c + e] + bs * vv[e]) * gv[e];
        GAS v4u* op = (GAS v4u*)(YG + (size_t)m * 1024 + c); op[0] = pack8f(res); op[1] = pack8f(res + 8);
    }
}
__device__ __forceinline__ void final_norm_phase(Frame& F, const Inputs& in) {
    for (int m = F.gw; m < T; m += F.NGW) { const float r = rstd16(F.SS, m);
        GAS f32x4* xp = (GAS f32x4*)(F.X + (size_t)m * D) + F.lane; const GAS f32x4* gp = (const GAS f32x4*)in.final_norm + F.lane;
#pragma unroll
        for (int q = 0; q < 4; ++q) { f32x4 x = xp[64 * q]; const f32x4 g = gp[64 * q]; x = x * r * g; xp[64 * q] = x; } }
}

namespace mlc {
constexpr int NUNIT = BATCH * ML_H * (SEQ / 64);
constexpr size_t A_QKB = 97 * MiB;
constexpr size_t A_XT = 130 * MiB;
constexpr size_t A_CT = 194 * MiB;
constexpr size_t A_NX = 226 * MiB, A_NC = 227 * MiB;
constexpr size_t A_SC = 228 * MiB;
constexpr size_t A_HM2 = A_XT;
constexpr size_t A_IG2 = 129 * MiB;
constexpr int SLOT = 34816;
using att::v_st; using att::v_rd_base; using att::v_rd_off; using att::crow;
#define TRRD(dst, base, off) asm volatile("ds_read_b64_tr_b16 %0, %1 offset:%2" : "=&v"(dst) : "v"(base), "i"(off) : "memory")
#define FRAG(l, h) ((bf16x8){l[0], l[1], l[2], l[3], h[0], h[1], h[2], h[3]})
__device__ __forceinline__ float swap_add(float x) { auto rr = __builtin_amdgcn_permlane32_swap(__float_as_uint(x), __float_as_uint(x), false, false); return __uint_as_float(rr[0]) + __uint_as_float(rr[1]); }
__device__ __forceinline__ float wave_incl_scan_add(float v, int lane) {
#pragma unroll
    for (int o = 1; o < 64; o <<= 1) { const float t = __shfl_up(v, o); if (lane >= o) v += t; }
    return v;
}
__device__ __forceinline__ float wave_incl_scan_max(float v, int lane) {
#pragma unroll
    for (int o = 1; o < 64; o <<= 1) { const float t = __shfl_up(v, o); if (lane >= o) v = fmaxf(v, t); }
    return v;
}
__device__ __forceinline__ float wave_max(float v) {
#pragma unroll
    for (int o = 1; o < 64; o <<= 1) v = fmaxf(v, __shfl_xor(v, o));
    return v;
}
__device__ __forceinline__ void conv_phase(Frame& F, const Inputs& in, int j) {
    const bf16* P = (const bf16*)(F.ws + WS_ARENA + A_P); const float* GATES = (const float*)(F.ws + WS_ARENA + A_GATES);
    bf16* QKB = (bf16*)(F.ws + WS_ARENA + A_QKB); float* IGLF = (float*)(F.ws + WS_ARENA + mlc::A_IG2);
    const float* cw = in.ml_conv_w + (size_t)j * 4 * 1024; const float* cb = in.ml_conv_b + (size_t)j * 1024; const float* bif = in.ml_b_if + (size_t)j * 16;
    const int gt = F.gw * 64 + F.lane, NT_ = F.NGW * 64;
    for (int e = gt; e < T * 128; e += NT_) {
        const int t = e >> 7, c = (e & 127) * 8, s = t & (SEQ - 1);
        float acc[8];
        { const f32x4 b0 = *(const GAS f32x4*)(cb + c), b1 = *(const GAS f32x4*)(cb + c + 4);
#pragma unroll
          for (int q = 0; q < 4; ++q) { acc[q] = b0[q]; acc[4 + q] = b1[q]; } }
#pragma unroll
        for (int k = 0; k < 4; ++k) { const int dt = 3 - k;
            if (s - dt >= 0) { float pv[8]; unpack8(*(const GAS v4u*)(P + (size_t)(t - dt) * 3072 + c), pv);
                const f32x4 w0 = *(const GAS f32x4*)(cw + k * 1024 + c), w1 = *(const GAS f32x4*)(cw + k * 1024 + c + 4);
#pragma unroll
                for (int q = 0; q < 4; ++q) { acc[q] += w0[q] * pv[q]; acc[4 + q] += w1[q] * pv[4 + q]; } } }
        const float sc = (c >= 512) ? 0.125f : 1.f;
        float o[8];
#pragma unroll
        for (int q = 0; q < 8; ++q) o[q] = fsilu(acc[q]) * sc;
        *(GAS v4u*)(QKB + (size_t)t * 1024 + c) = pack8f(o);
    }
    for (int e = gt; e < T * 16; e += NT_) { const int hcol = e & 15; const float g = GATES[e] + bif[hcol];
        float r = g;
        if (hcol >= 8) r = fminf(g, 0.f) - flog(1.f + fexp(-fabsf(g)));
        IGLF[e] = r; }
}
__device__ __forceinline__ void stage_tr128(LAS char* tile, const bf16* src, int ld, int lt, int nthr) {
    for (int idx = lt; idx < 1024; idx += nthr) { const int row = idx >> 4, ch = idx & 15;
        *(LAS v4u*)(tile + v_st(row, ch * 8)) = *(const GAS v4u*)(src + (size_t)row * ld + ch * 8); }
}
__device__ __forceinline__ void xa_phase(Frame& F) {
    const bf16* P = (const bf16*)(F.ws + WS_ARENA + A_P); const bf16* QKB = (const bf16*)(F.ws + WS_ARENA + A_QKB); const float* IGLF = (const float*)(F.ws + WS_ARENA + mlc::A_IG2);
    float* XT = (float*)(F.ws + WS_ARENA + A_XT); float* NX = (float*)(F.ws + WS_ARENA + A_NX); float* SC = (float*)(F.ws + WS_ARENA + A_SC);
    const int lane = F.lane, wave = F.wave, r32 = lane & 31, hi = lane >> 5, us = wave >> 1, half = wave & 1, lt = half * 64 + lane;
    LAS char* slot = (LAS char*)F.lds + us * SLOT; LAS char* Vt = slot; LAS char* KWt = slot + 16384; LAS float* wsl = (LAS float*)(slot + 32768);
    for (int u0 = (int)blockIdx.x * 4; u0 < NUNIT; u0 += F.G * 4) {
        const int u = u0 + us, bh = u >> 7, c = u & 127, b = bh >> 3, h = bh & 7; const size_t t0 = (size_t)b * SEQ + (size_t)c * 64;
        const float lf = IGLF[(t0 + lane) * 16 + 8 + h], ig = IGLF[(t0 + lane) * 16 + h];
        const float Fc = wave_incl_scan_add(lf, lane), bs = ig - Fc, M = wave_max(bs), a = __shfl(Fc, 63), w = fexp(bs - M);
        if (half == 0) { wsl[lane] = w; if (lane == 0) { SC[u] = a; SC[NUNIT + u] = M; } }
        __syncthreads();
        stage_tr128(Vt, P + t0 * 3072 + 1024 + h * 128, 3072, lt, 128);
        for (int idx = lt; idx < 512; idx += 128) { const int row = idx >> 3, ch = idx & 7; float kv[8];
            unpack8(*(const GAS v4u*)(QKB + (t0 + row) * 1024 + 512 + h * 64 + ch * 8), kv); const float ww = wsl[row];
#pragma unroll
            for (int q = 0; q < 8; ++q) kv[q] *= ww;
            *(LAS v4u*)(KWt + v_st(row, ch * 8)) = pack8f(kv); }
        __syncthreads();
        const int vb = (int)(uintptr_t)Vt + v_rd_base(lane), kb = (int)(uintptr_t)KWt + v_rd_base(lane) + half * 512;
        f32x16 acc[4] = {};
#define XA_VT(vt) do { s16x4 vl0, vh0, vl1, vh1, vl2, vh2, vl3, vh3, kl0, kh0, kl1, kh1, kl2, kh2, kl3, kh3; constexpr int o_ = v_rd_off(vt, 0, 0); \
            TRRD(vl0, vb, o_); TRRD(vh0, vb, o_ + 2048); TRRD(vl1, vb, o_ + 4096); TRRD(vh1, vb, o_ + 6144); TRRD(vl2, vb, o_ + 8192); TRRD(vh2, vb, o_ + 10240); TRRD(vl3, vb, o_ + 12288); TRRD(vh3, vb, o_ + 14336); \
            TRRD(kl0, kb, 0); TRRD(kh0, kb, 2048); TRRD(kl1, kb, 4096); TRRD(kh1, kb, 6144); TRRD(kl2, kb, 8192); TRRD(kh2, kb, 10240); TRRD(kl3, kb, 12288); TRRD(kh3, kb, 14336); \
            asm volatile("s_waitcnt lgkmcnt(0)" ::: "memory"); __builtin_amdgcn_sched_barrier(0); \
            acc[vt] = __builtin_amdgcn_mfma_f32_32x32x16_bf16(FRAG(vl0, vh0), FRAG(kl0, kh0), acc[vt], 0, 0, 0); \
            acc[vt] = __builtin_amdgcn_mfma_f32_32x32x16_bf16(FRAG(vl1, vh1), FRAG(kl1, kh1), acc[vt], 0, 0, 0); \
            acc[vt] = __builtin_amdgcn_mfma_f32_32x32x16_bf16(FRAG(vl2, vh2), FRAG(kl2, kh2), acc[vt], 0, 0, 0); \
            acc[vt] = __builtin_amdgcn_mfma_f32_32x32x16_bf16(FRAG(vl3, vh3), FRAG(kl3, kh3), acc[vt], 0, 0, 0); } while (0)
        XA_VT(0); XA_VT(1); XA_VT(2); XA_VT(3);
#undef XA_VT
        { const int d = half * 32 + r32; float nx = 0.f;
#pragma unroll 8
          for (int s = 0; s < 32; ++s) nx += bf1(*(const LAS bf16*)(KWt + v_st(32 * hi + s, d & ~7) + (d & 7) * 2));
          nx = swap_add(nx);
          if (hi == 0) NX[(size_t)u * 64 + d] = nx; }
        { GAS float* xo = (GAS float*)(XT + (size_t)u * 8192 + half * 32 + r32 + hi * 256);
#pragma unroll
          for (int vt = 0; vt < 4; ++vt)
#pragma unroll
              for (int r4 = 0; r4 < 4; ++r4) { asm volatile("" : "+v"(xo));
#pragma unroll
                  for (int r0 = 0; r0 < 4; ++r0) xo[r0 * 64] = acc[vt][r4 * 4 + r0];
                  xo += 512; } }
        __syncthreads();
    }
}
__device__ __forceinline__ void xb_phase(Frame& F) {
    const float* XT = (const float*)(F.ws + WS_ARENA + A_XT); const float* NX = (const float*)(F.ws + WS_ARENA + A_NX); float* SC = (float*)(F.ws + WS_ARENA + A_SC);
    bf16* CT = (bf16*)(F.ws + WS_ARENA + A_CT); float* NC = (float*)(F.ws + WS_ARENA + A_NC);
    for (int g = (int)blockIdx.x * 512 + F.tid; g < BATCH * ML_H * 8192; g += F.G * 512) {
        const int bh = g >> 13, e = g & 8191;
        float m = 0.f, C = 0.f, n = 0.f;
#pragma unroll 8
        for (int c = 0; c < 128; ++c) { const int u = bh * 128 + c;
            const float a = SC[u], M = SC[NUNIT + u];
            const float x = XT[(size_t)u * 8192 + e];
            CT[(size_t)u * 8192 + e] = (bf16)(cvtpk(C, 0.f) & 0xffffu);
            const float mn = a + fmaxf(m, M), fC = fexp(a + m - mn), fX = fexp(a + M - mn);
            if (e < 64) { NC[(size_t)u * 64 + e] = n; n = fC * n + fX * NX[(size_t)u * 64 + e]; }
            if (e == 0) SC[2 * NUNIT + u] = m;
            C = fC * C + fX * x; m = mn; }
    }
}
__device__ __forceinline__ void xc_phase(Frame& F, const Inputs& in, int j) {
    const bf16* P = (const bf16*)(F.ws + WS_ARENA + A_P); const bf16* QKB = (const bf16*)(F.ws + WS_ARENA + A_QKB); const float* IGLF = (const float*)(F.ws + WS_ARENA + mlc::A_IG2);
    const bf16* CT = (const bf16*)(F.ws + WS_ARENA + A_CT); const float* NC = (const float*)(F.ws + WS_ARENA + A_NC); const float* SC = (const float*)(F.ws + WS_ARENA + A_SC);
    bf16* HM = (bf16*)(F.ws + WS_ARENA + A_HM2); const float* gn = in.ml_out_norm + (size_t)j * 1024;
    const int lane = F.lane, wave = F.wave, r32 = lane & 31, hi = lane >> 5, us = wave >> 1, th = wave & 1, lt = th * 64 + lane;
    LAS char* slot = (LAS char*)F.lds + us * SLOT; LAS char* Kt = slot; LAS char* Vt = slot + 8192;
    LAS float* sb = (LAS float*)(slot + 24576); LAS float* se = sb + 64; LAS float* sF = se + 64; LAS float* sn = sF + 64;
    LAS float* ob = (LAS float*)(slot + th * 16896);
    for (int u0 = (int)blockIdx.x * 4; u0 < NUNIT; u0 += F.G * 4) {
        const int u = u0 + us, bh = u >> 7, c = u & 127, b = bh >> 3, h = bh & 7; const size_t t0 = (size_t)b * SEQ + (size_t)c * 64;
        const float mc = SC[2 * NUNIT + u];
        { const float lf = IGLF[(t0 + lane) * 16 + 8 + h], ig = IGLF[(t0 + lane) * 16 + h];
          const float Fc = wave_incl_scan_add(lf, lane), bs = ig - Fc, Mt = wave_incl_scan_max(bs, lane);
          if (th == 0) { sb[lane] = bs; se[lane] = fmaxf(mc, Mt); sF[lane] = Fc; sn[lane] = NC[(size_t)u * 64 + lane]; } }
        for (int idx = lt; idx < 512; idx += 128) { const int row = idx >> 3, ch = idx & 7;
            *(LAS v4u*)(Kt + row * 128 + ((ch * 16) ^ ((row & 7) << 4))) = *(const GAS v4u*)(QKB + (t0 + row) * 1024 + 512 + h * 64 + ch * 8); }
        stage_tr128(Vt, P + t0 * 3072 + 1024 + h * 128, 3072, lt, 128);
        const int tl = th * 32 + r32;
        bf16x8 qr[4];
#pragma unroll
        for (int d0 = 0; d0 < 4; ++d0) qr[d0] = *(const GAS bf16x8*)(QKB + (t0 + tl) * 1024 + h * 64 + d0 * 16 + hi * 8);
        __syncthreads();
        const float et = se[tl], Fct = sF[tl], iw = fexp(mc - et);
        f32x16 p0 = {}, p1 = {};
#pragma unroll
        for (int d0 = 0; d0 < 4; ++d0) { const int cb = (d0 * 32 + hi * 16) ^ ((r32 & 7) << 4);
            const bf16x8 k0 = *(const LAS bf16x8*)(Kt + r32 * 128 + cb);
            p0 = __builtin_amdgcn_mfma_f32_32x32x16_bf16(k0, qr[d0], p0, 0, 0, 0);
            if (th) { const bf16x8 k1 = *(const LAS bf16x8*)(Kt + (32 + r32) * 128 + cb); p1 = __builtin_amdgcn_mfma_f32_32x32x16_bf16(k1, qr[d0], p1, 0, 0, 0); } }
        float dsum = 0.f;
#pragma unroll
        for (int r = 0; r < 16; ++r) { const int s0 = crow(r, hi);
            const float w0 = (s0 <= tl) ? fexp(sb[s0] - et) : 0.f; p0[r] *= w0; dsum += p0[r];
            const float w1 = (th && s0 + 32 <= tl) ? fexp(sb[s0 + 32] - et) : 0.f; p1[r] *= w1; dsum += p1[r]; }
        dsum = swap_add(dsum);
        bf16x8 pa0, pa1, pa2, pa3;
#define PK4(Pv, B_, OUT) do { unsigned a0 = cvtpk(Pv[B_+0], Pv[B_+1]), a1 = cvtpk(Pv[B_+2], Pv[B_+3]); unsigned b0 = cvtpk(Pv[B_+4], Pv[B_+5]), b1 = cvtpk(Pv[B_+6], Pv[B_+7]); \
        auto r0 = __builtin_amdgcn_permlane32_swap(a0, b0, false, false); auto r1 = __builtin_amdgcn_permlane32_swap(a1, b1, false, false); \
        v4u w_ = {r0[0], r1[0], r0[1], r1[1]}; OUT = __builtin_bit_cast(bf16x8, w_); } while (0)
        PK4(p0, 0, pa0); PK4(p0, 8, pa1); PK4(p1, 0, pa2); PK4(p1, 8, pa3);
#undef PK4
        float qn = 0.f;
#pragma unroll
        for (int d0 = 0; d0 < 4; ++d0) { float qv[8]; unpack8(__builtin_bit_cast(v4u, qr[d0]), qv);
#pragma unroll
            for (int q = 0; q < 8; ++q) qn += qv[q] * sn[d0 * 16 + hi * 8 + q]; }
        qn = swap_add(qn);
        f32x16 acc[4] = {};
        const bf16* ctp = CT + (size_t)u * 8192 + (size_t)r32 * 64 + hi * 8;
#pragma unroll
        for (int vt = 0; vt < 4; ++vt)
#pragma unroll
            for (int d0 = 0; d0 < 4; ++d0) { const bf16x8 cf = *(const GAS bf16x8*)(ctp + vt * 32 * 64 + d0 * 16);
                acc[vt] = __builtin_amdgcn_mfma_f32_32x32x16_bf16(cf, qr[d0], acc[vt], 0, 0, 0); }
#pragma unroll
        for (int vt = 0; vt < 4; ++vt)
#pragma unroll
            for (int r = 0; r < 16; ++r) acc[vt][r] *= iw;
        const int vb = (int)(uintptr_t)Vt + v_rd_base(lane);
#define XC_VT(vt) do { s16x4 vl0, vh0, vl1, vh1, vl2, vh2, vl3, vh3; constexpr int o_ = v_rd_off(vt, 0, 0); \
            TRRD(vl0, vb, o_); TRRD(vh0, vb, o_ + 2048); TRRD(vl1, vb, o_ + 4096); TRRD(vh1, vb, o_ + 6144); \
            if (th) { TRRD(vl2, vb, o_ + 8192); TRRD(vh2, vb, o_ + 10240); TRRD(vl3, vb, o_ + 12288); TRRD(vh3, vb, o_ + 14336); } \
            asm volatile("s_waitcnt lgkmcnt(0)" ::: "memory"); __builtin_amdgcn_sched_barrier(0); \
            acc[vt] = __builtin_amdgcn_mfma_f32_32x32x16_bf16(FRAG(vl0, vh0), pa0, acc[vt], 0, 0, 0); \
            acc[vt] = __builtin_amdgcn_mfma_f32_32x32x16_bf16(FRAG(vl1, vh1), pa1, acc[vt], 0, 0, 0); \
            if (th) { acc[vt] = __builtin_amdgcn_mfma_f32_32x32x16_bf16(FRAG(vl2, vh2), pa2, acc[vt], 0, 0, 0); \
                      acc[vt] = __builtin_amdgcn_mfma_f32_32x32x16_bf16(FRAG(vl3, vh3), pa3, acc[vt], 0, 0, 0); } } while (0)
        XC_VT(0); XC_VT(1); XC_VT(2); XC_VT(3);
#undef XC_VT
        const float den = dsum + iw * qn;
        const float hs = frcp(fmaxf(fabsf(den), fexp(-Fct - et)));
        float ss = 0.f;
#pragma unroll
        for (int vt = 0; vt < 4; ++vt)
#pragma unroll
            for (int r = 0; r < 16; ++r) { acc[vt][r] *= hs; ss += acc[vt][r] * acc[vt][r]; }
        ss = swap_add(ss);
        const float rn = frsq(ss * (1.f / 128.f) + RMS_EPS);
        __syncthreads();
#pragma unroll
        for (int vt = 0; vt < 4; ++vt)
#pragma unroll
            for (int r = 0; r < 16; ++r) ob[(vt * 32 + crow(r, hi)) * 33 + r32] = acc[vt][r] * rn;
        LDS_WAIT();
        { const int v2 = lane * 2; const float g0 = gn[h * 128 + v2], g1 = gn[h * 128 + v2 + 1];
#pragma unroll 4
          for (int tt = 0; tt < 32; ++tt) { const size_t t = t0 + th * 32 + tt;
              const unsigned ow = *(const GAS unsigned*)(P + t * 3072 + 2048 + h * 128 + v2);
              const float x0 = ob[v2 * 33 + tt] * g0 * fsigmoid(bf_lo(ow)), x1 = ob[(v2 + 1) * 33 + tt] * g1 * fsigmoid(bf_hi(ow));
              *(GAS unsigned*)(HM + t * 1024 + h * 128 + v2) = cvtpk(x0, x1); } }
        __syncthreads();
    }
}
#undef TRRD
#undef FRAG
}

namespace rwc {
constexpr int NU = BATCH * RW_H * (SEQ / 64);
constexpr size_t A_GL = 160 * MiB, A_BON = 161 * MiB;
constexpr int RMB = 9216, TRB = 8192;
constexpr int L_LWF = 0, L_AT_RM = 16384, L_BT_RM = L_AT_RM + RMB, L_KT_RM = L_BT_RM + RMB, L_RT_RM = L_KT_RM + RMB, L_KH_RM = L_RT_RM + RMB, L_T_RM = L_KH_RM + RMB, L_ARB_RM = L_T_RM + RMB,
              L_AT_TR = L_ARB_RM + RMB, L_BH_TR = L_AT_TR + TRB, L_V_TR = L_BH_TR + TRB, L_AAK_TR = L_V_TR + TRB, L_W2_TR = L_AAK_TR + TRB, L_H_TR = L_W2_TR + TRB, L_SEG = L_H_TR + TRB,
              L_P1_RM = L_BT_RM, L_P2_RM = L_KT_RM;
static_assert(L_SEG + 2048 <= LDSCTL_OFF, "RWKV LDS map");
using att::crow; using att::v_rd_base;
__device__ __forceinline__ int rm_off(int row, int col) { return row * 144 + col * 2; }
__device__ __forceinline__ int tr_off(int row, int col) { const int kk = (row & ~0xC) | ((row & 4) << 1) | ((row & 8) >> 1); return ((kk >> 3) * 2 + (col >> 5)) * 512 + ((kk & 7) * 32 + (col & 31)) * 2; }
__device__ __forceinline__ bf16x8 frag_rm(const LAS char* tile, int row, int kb, int hi) { return *(const LAS bf16x8*)(tile + rm_off(row, kb * 16 + hi * 8)); }
__device__ __forceinline__ void frag_tr4(bf16x8 (&f)[4], const LAS char* tile, int cb, int lane) {
    const int base = (int)(uintptr_t)tile + v_rd_base(lane) + cb * 512; s16x4 l[4], h[4];
#pragma unroll
    for (int kb = 0; kb < 4; ++kb) { asm volatile("ds_read_b64_tr_b16 %0, %1" : "=&v"(l[kb]) : "v"(base + kb * 2048) : "memory"); asm volatile("ds_read_b64_tr_b16 %0, %1" : "=&v"(h[kb]) : "v"(base + kb * 2048 + 1024) : "memory"); }
    asm volatile("s_waitcnt lgkmcnt(0)" ::: "memory"); __builtin_amdgcn_sched_barrier(0);
#pragma unroll
    for (int kb = 0; kb < 4; ++kb) f[kb] = (bf16x8){l[kb][0], l[kb][1], l[kb][2], l[kb][3], h[kb][0], h[kb][1], h[kb][2], h[kb][3]};
}
__device__ __forceinline__ void frag_rm4(bf16x8 (&f)[4], const LAS char* tile, int row, int hi) {
#pragma unroll
    for (int kb = 0; kb < 4; ++kb) f[kb] = frag_rm(tile, row, kb, hi);
}
__device__ __forceinline__ f32x16 mm4(const bf16x8 (&a)[4], const bf16x8 (&b)[4]) { f32x16 acc = {};
#pragma unroll
    for (int kb = 0; kb < 4; ++kb) acc = __builtin_amdgcn_mfma_f32_32x32x16_bf16(a[kb], b[kb], acc, 0, 0, 0);
    return acc; }
__device__ __forceinline__ bf16 tobf(float x) { return (bf16)(cvtpk(x, 0.f) & 0xffffu); }
#define STORE_RM(tile, acc, mt, nt) do { _Pragma("unroll") for (int r_ = 0; r_ < 16; ++r_) *(LAS bf16*)((tile) + rm_off(32 * (mt) + crow(r_, hi), 32 * (nt) + r32)) = tobf((acc)[r_]); } while (0)
#define STORE_TR(tile, acc, mt, nt) do { _Pragma("unroll") for (int r_ = 0; r_ < 16; ++r_) *(LAS bf16*)((tile) + tr_off(32 * (mt) + crow(r_, hi), 32 * (nt) + r32)) = tobf((acc)[r_]); } while (0)

__device__ __forceinline__ void ra_phase(Frame& F, const Inputs& in, int jl) {
    bf16* RKV = (bf16*)(F.ws + WS_ARENA + A_RKV); const bf16* AA = (const bf16*)(F.ws + WS_XB); float* LW = (float*)(F.ws + WS_ARENA + A_LW);
    float* GL = (float*)(F.ws + WS_ARENA + A_GL); float* BON = (float*)(F.ws + WS_ARENA + A_BON);
    const float* k_k = in.rw_k_k + (size_t)jl * 1024; const float* k_a = in.rw_k_a + (size_t)jl * 1024; const float* r_k = in.rw_r_k + (size_t)jl * 1024;
    LAS char* L = (LAS char*)F.lds; LAS float* LWF = (LAS float*)(L + L_LWF); LAS float* SEG = (LAS float*)(L + L_SEG);
    const int w = F.wave;
#define FRESH() const int lane = fresh_lane(), r32 = lane & 31, hi = lane >> 5; (void)r32; (void)hi
    for (int u = (int)blockIdx.x; u < NU; u += F.G) {
        const int tid = w * 64 + fresh_lane();
        const int bh = u >> 7, c = u & 127, b = bh >> 4, h = bh & 15; const size_t t0 = (size_t)b * SEQ + (size_t)c * 64;
        const int t = tid >> 3, j0 = (tid & 7) * 8; const size_t row = t0 + t; const int col = h * 64 + j0;
        float rv[8], kp[8], vv[8], am[8], bb[8], lw[8];
        { float kv[8], av[8];
          unpack8(*(const GAS v4u*)(RKV + row * 3072 + col), rv); unpack8(*(const GAS v4u*)(RKV + row * 3072 + 1024 + col), kv); unpack8(*(const GAS v4u*)(RKV + row * 3072 + 2048 + col), vv);
          unpack8(*(const GAS v4u*)(AA + row * 1024 + col), av);
          const f32x4 l0 = *(const GAS f32x4*)(LW + row * 1024 + col), l1 = *(const GAS f32x4*)(LW + row * 1024 + col + 4);
          float ss = 0.f, bs = 0.f; float kk[8];
#pragma unroll
          for (int q = 0; q < 8; ++q) { lw[q] = q < 4 ? l0[q] : l1[q - 4]; kk[q] = kv[q] * k_k[col + q]; ss += kk[q] * kk[q]; kp[q] = kv[q] * (1.f + (av[q] - 1.f) * k_a[col + q]); bs += rv[q] * kp[q] * r_k[col + q]; }
          ss += __shfl_xor(ss, 1); ss += __shfl_xor(ss, 2); ss += __shfl_xor(ss, 4); bs += __shfl_xor(bs, 1); bs += __shfl_xor(bs, 2); bs += __shfl_xor(bs, 4);
          const float inv = frcp(fmaxf(fsqrt(ss), 1e-12f));
#pragma unroll
          for (int q = 0; q < 8; ++q) { const float kn = kk[q] * inv; am[q] = -kn; bb[q] = kn * av[q]; }
          if ((tid & 7) == 0) BON[row * 16 + h] = bs; }
        { LAS f32x4* lp = (LAS f32x4*)(LWF + t * 64 + j0); lp[0] = (f32x4){lw[0], lw[1], lw[2], lw[3]}; lp[1] = (f32x4){lw[4], lw[5], lw[6], lw[7]}; }
        __syncthreads();
        { const int jc = tid & 63, sg = tid >> 6; float run = 0.f;
#pragma unroll
          for (int q = 0; q < 8; ++q) { run += LWF[(sg * 8 + q) * 64 + jc]; LWF[(sg * 8 + q) * 64 + jc] = run; }
          SEG[sg * 64 + jc] = run; }
        __syncthreads();
        { const int jc = tid & 63, sg = tid >> 6; float pre = 0.f;
#pragma unroll
          for (int q = 0; q < 8; ++q) if (q < sg) pre += SEG[q * 64 + jc];
#pragma unroll
          for (int q = 0; q < 8; ++q) LWF[(sg * 8 + q) * 64 + jc] += pre; }
        __syncthreads();
        { float at[8], bt[8], kt[8], rt[8], bh_[8], kh[8];
#pragma unroll
          for (int q = 0; q < 8; ++q) { const float cum = LWF[t * 64 + j0 + q], cl = LWF[63 * 64 + j0 + q];
              const float ein = fexp(-cum), eL = fexp(cl - cum);
              at[q] = am[q] * fexp(cum - lw[q]); bt[q] = bb[q] * ein; kt[q] = kp[q] * ein; rt[q] = rv[q] * fexp(cum); bh_[q] = bb[q] * eL; kh[q] = kp[q] * eL;
              if (t == 63) GL[(size_t)u * 64 + j0 + q] = fexp(cl); }
          const int ro = rm_off(t, j0), to = tr_off(t, j0);
          *(LAS v4u*)(L + L_AT_RM + ro) = pack8f(at); *(LAS v4u*)(L + L_AT_TR + to) = pack8f(at); *(LAS v4u*)(L + L_BT_RM + ro) = pack8f(bt); *(LAS v4u*)(L + L_KT_RM + ro) = pack8f(kt);
          *(LAS v4u*)(L + L_RT_RM + ro) = pack8f(rt); *(LAS v4u*)(L + L_BH_TR + to) = pack8f(bh_); *(LAS v4u*)(L + L_KH_RM + ro) = pack8f(kh); *(LAS v4u*)(L + L_V_TR + to) = pack8f(vv); }
        __syncthreads();
        f32x16 rk[2];
        { FRESH(); const int p = w >> 1, mt = w & 1; const LAS char* At = L + ((p < 2) ? L_AT_RM : L_RT_RM); const LAS char* Bt = L + ((p & 1) ? L_KT_RM : L_BT_RM);
          bf16x8 fa[4]; frag_rm4(fa, At, 32 * mt + r32, hi);
#pragma unroll
          for (int nt = 0; nt < 2; ++nt) { f32x16 acc = {};
              if (nt <= mt) { bf16x8 fb[4]; frag_rm4(fb, Bt, 32 * nt + r32, hi); acc = mm4(fa, fb); }
#pragma unroll
              for (int r = 0; r < 16; ++r) { const int tt = 32 * mt + crow(r, hi), s = 32 * nt + r32; const bool keep = (p < 2) ? (s < tt) : (s <= tt); if (!keep) acc[r] = 0.f; }
              if (p == 0) {
#pragma unroll
                  for (int r = 0; r < 16; ++r) LWF[(32 * mt + crow(r, hi)) * 64 + 32 * nt + r32] = acc[r]; }
              else if (p == 1) STORE_TR(L + L_AAK_TR, acc, mt, nt);
              else if (p == 2) STORE_RM(L + L_ARB_RM, acc, mt, nt);
              rk[nt] = acc; } }
        __syncthreads();
        if (w == 0) { FRESH(); float Tc[64];
#pragma unroll
            for (int tt = 0; tt < 64; ++tt) { asm volatile("" ::: "memory"); float acc = (tt == lane) ? 1.f : 0.f;
#pragma unroll
                for (int s4 = 0; s4 < (tt + 3) / 4; ++s4) { const f32x4 a4 = *(const LAS f32x4*)(LWF + tt * 64 + s4 * 4);
#pragma unroll
                    for (int e = 0; e < 4; ++e) if (s4 * 4 + e < tt) acc += a4[e] * Tc[s4 * 4 + e]; }
                Tc[tt] = acc;
                *(LAS bf16*)(L + L_T_RM + rm_off(tt, lane)) = tobf(acc); } }
        __syncthreads();
        { FRESH(); const int q = w & 3, mt = q >> 1, nt = q & 1; bf16x8 fa[4], fb[4]; frag_rm4(fa, L + L_T_RM, 32 * mt + r32, hi);
          frag_tr4(fb, L + ((w < 4) ? L_AT_TR : L_AAK_TR), nt, lane);
          const f32x16 acc = mm4(fa, fb);
          if (w < 4) STORE_TR(L + L_W2_TR, acc, mt, nt); else STORE_TR(L + L_H_TR, acc, mt, nt); }
        __syncthreads();
        { FRESH(); const int g = w >> 1, mt = w & 1; bf16x8 fa[4];
          if (g == 0 || g == 3) frag_rm4(fa, L + L_ARB_RM, 32 * mt + r32, hi); else frag_tr4(fa, L + L_BH_TR, mt, lane);
#pragma unroll
          for (int nt = 0; nt < 2; ++nt) { bf16x8 fb[4]; frag_tr4(fb, L + ((g < 2) ? L_W2_TR : L_H_TR), nt, lane);
              f32x16 acc = mm4(fa, fb);
              if (g == 0) {
#pragma unroll
                  for (int r = 0; r < 16; ++r) { const int tt = 32 * mt + crow(r, hi), jj = 32 * nt + r32;
                      RKV[(t0 + tt) * 3072 + h * 64 + jj] = tobf(acc[r] + bf1(*(const LAS bf16*)(L + L_RT_RM + rm_off(tt, jj)))); } }
              else if (g == 1) {
#pragma unroll
                  for (int r = 0; r < 16; ++r) { const int jp = 32 * mt + crow(r, hi), jj = 32 * nt + r32; RKV[(t0 + jp) * 3072 + 1024 + h * 64 + jj] = tobf(acc[r]); } }
              else if (g == 2) {
#pragma unroll
                  for (int r = 0; r < 16; ++r) { const int jp = 32 * mt + crow(r, hi), s = 32 * nt + r32; acc[r] += bf1(*(const LAS bf16*)(L + L_KH_RM + rm_off(s, jp))); }
                  STORE_RM(L + L_P2_RM, acc, mt, nt); }
              else {
#pragma unroll
                  for (int r = 0; r < 16; ++r) acc[r] += rk[nt][r];
                  STORE_RM(L + L_P1_RM, acc, mt, nt); } } }
        __syncthreads();
        { FRESH(); const int q = w & 3, m_ = q >> 1, n_ = q & 1; bf16x8 fa[4], fb[4];
          if (w < 4) { frag_tr4(fa, L + L_V_TR, m_, lane); frag_rm4(fb, L + L_P1_RM, 32 * n_ + r32, hi); }
          else { frag_rm4(fa, L + L_P2_RM, 32 * m_ + r32, hi); frag_tr4(fb, L + L_V_TR, n_, lane); }
          const f32x16 acc = mm4(fa, fb);
          const int o = (q * 64 + lane) * 32, orow = o >> 7, owi = o & 127;
          GAS v4u* dst = (GAS v4u*)((GAS char*)LW + ((t0 + orow) * 1024 + h * 64) * 4 + ((w < 4) ? 0 : 128) + owi);
          float tmp[16];
#pragma unroll
          for (int r = 0; r < 16; ++r) tmp[r] = acc[r];
          dst[0] = pack8f(tmp); dst[1] = pack8f(tmp + 8); }
        __syncthreads();
    }
}
__device__ __forceinline__ void rb_phase(Frame& F) {
    if (F.wave != 0 || (int)blockIdx.x >= BATCH * RW_H * 2) return;
    const bf16* RKV = (const bf16*)(F.ws + WS_ARENA + A_RKV); const float* LW = (const float*)(F.ws + WS_ARENA + A_LW); const float* GL = (const float*)(F.ws + WS_ARENA + A_GL);
    bf16* ZC = (bf16*)(F.ws + WS_XB);
    const int lane = F.lane, r32 = lane & 31, hi = lane >> 5, task = blockIdx.x, bh = task >> 1, it = task & 1, b = bh >> 4, h = bh & 15;
    f32x16 Z[2] = {};
    for (int c = 0; c < SEQ / 64; ++c) { const int u = bh * 128 + c; const size_t t0 = (size_t)b * SEQ + (size_t)c * 64;
        bf16x8 mf[2][4]; f32x16 nn[2]; f32x16 gam[2];
#pragma unroll
        for (int mt = 0; mt < 2; ++mt) { const bf16* mrow = RKV + (t0 + 32 * mt + r32) * 3072 + 1024 + h * 64 + 4 * hi;
#pragma unroll
            for (int kb = 0; kb < 4; ++kb) { const v2u lo = *(const GAS v2u*)(mrow + kb * 16), hi2 = *(const GAS v2u*)(mrow + kb * 16 + 8); mf[mt][kb] = __builtin_bit_cast(bf16x8, (v4u){lo.x, lo.y, hi2.x, hi2.y}); }
            const int o = ((mt * 2 + it) * 64 + lane) * 32, orow = o >> 7, owi = o & 127;
            const GAS v4u* np = (const GAS v4u*)((const GAS char*)LW + ((t0 + orow) * 1024 + h * 64) * 4 + 128 + owi);
            float tmp[16]; unpack8(np[0], tmp); unpack8(np[1], tmp + 8);
#pragma unroll
            for (int r = 0; r < 16; ++r) nn[mt][r] = tmp[r];
#pragma unroll
            for (int q = 0; q < 4; ++q) { const f32x4 g4 = *(const GAS f32x4*)(GL + (size_t)u * 64 + 32 * mt + 8 * q + 4 * hi);
#pragma unroll
                for (int e = 0; e < 4; ++e) gam[mt][4 * q + e] = g4[e]; } }
        bf16x8 zh[4], zl[4];
#pragma unroll
        for (int kb = 0; kb < 4; ++kb) { float a8[8], l8[8];
#pragma unroll
            for (int e = 0; e < 8; ++e) a8[e] = Z[kb >> 1][(kb & 1) * 8 + e];
            const v4u hw = pack8f(a8); float h8[8]; unpack8(hw, h8);
#pragma unroll
            for (int e = 0; e < 8; ++e) l8[e] = a8[e] - h8[e];
            zh[kb] = __builtin_bit_cast(bf16x8, hw); zl[kb] = __builtin_bit_cast(bf16x8, pack8f(l8));
            *(GAS v4u*)(ZC + (size_t)u * 4096 + ((kb * 2 + it) * 64 + lane) * 8) = hw; }
#pragma unroll
        for (int mt = 0; mt < 2; ++mt) { f32x16 acc;
#pragma unroll
            for (int r = 0; r < 16; ++r) acc[r] = nn[mt][r] + gam[mt][r] * Z[mt][r];
#pragma unroll
            for (int kb = 0; kb < 4; ++kb) { acc = __builtin_amdgcn_mfma_f32_32x32x16_bf16(mf[mt][kb], zh[kb], acc, 0, 0, 0); acc = __builtin_amdgcn_mfma_f32_32x32x16_bf16(mf[mt][kb], zl[kb], acc, 0, 0, 0); }
            nn[mt] = acc; }
        Z[0] = nn[0]; Z[1] = nn[1];
    }
}
__device__ __forceinline__ void rc_phase(Frame& F, const Inputs& in, int jl) {
    const bf16* RKV = (const bf16*)(F.ws + WS_ARENA + A_RKV); const float* LW = (const float*)(F.ws + WS_ARENA + A_LW); const float* BON = (const float*)(F.ws + WS_ARENA + A_BON);
    const bf16* ZC = (const bf16*)(F.ws + WS_XB); const bf16* GG = (const bf16*)(F.ws + WS_ARENA + A_GG); bf16* YG = (bf16*)(F.ws + WS_ARENA + A_YG);
    const float* lnw = in.rw_ln_w + (size_t)jl * 1024; const float* lnb = in.rw_ln_b + (size_t)jl * 1024;
    const int lane = F.lane, r32 = lane & 31, hi = lane >> 5;
    for (int task = F.gw; task < NU * 2; task += F.NGW) { const int u = task >> 1, tt = task & 1, bh = u >> 7, c = u & 127, b = bh >> 4, h = bh & 15; const size_t t0 = (size_t)b * SEQ + (size_t)c * 64, trow = t0 + 32 * tt + r32;
        bf16x8 yw[4];
        { const bf16* yrow = RKV + trow * 3072 + h * 64 + 4 * hi;
#pragma unroll
          for (int kb = 0; kb < 4; ++kb) { const v2u lo = *(const GAS v2u*)(yrow + kb * 16), hi2 = *(const GAS v2u*)(yrow + kb * 16 + 8); yw[kb] = __builtin_bit_cast(bf16x8, (v4u){lo.x, lo.y, hi2.x, hi2.y}); } }
        f32x16 y[2];
#pragma unroll
        for (int it = 0; it < 2; ++it) { const int o = ((it * 2 + tt) * 64 + lane) * 32, orow = o >> 7, owi = o & 127;
            const GAS v4u* yp = (const GAS v4u*)((const GAS char*)LW + ((t0 + orow) * 1024 + h * 64) * 4 + owi);
            float tmp[16]; unpack8(yp[0], tmp); unpack8(yp[1], tmp + 8);
#pragma unroll
            for (int r = 0; r < 16; ++r) y[it][r] = tmp[r];
#pragma unroll
            for (int kb = 0; kb < 4; ++kb) { const bf16x8 zf = *(const GAS bf16x8*)(ZC + (size_t)u * 4096 + ((kb * 2 + it) * 64 + lane) * 8);
                y[it] = __builtin_amdgcn_mfma_f32_32x32x16_bf16(zf, yw[kb], y[it], 0, 0, 0); } }
        float s1 = 0.f;
#pragma unroll
        for (int it = 0; it < 2; ++it)
#pragma unroll
            for (int r = 0; r < 16; ++r) s1 += y[it][r];
        const float mean = mlc::swap_add(s1) * (1.f / 64.f); float s2 = 0.f;
#pragma unroll
        for (int it = 0; it < 2; ++it)
#pragma unroll
            for (int r = 0; r < 16; ++r) { y[it][r] -= mean; s2 += y[it][r] * y[it][r]; }
        const float rs = frsq(mlc::swap_add(s2) * (1.f / 64.f) + 64e-5f), bon = BON[trow * 16 + h];
#pragma unroll
        for (int it = 0; it < 2; ++it)
#pragma unroll
            for (int q = 0; q < 4; ++q) { const int i0 = 32 * it + 8 * q + 4 * hi, col = h * 64 + i0;
                const f32x4 w4 = *(const GAS f32x4*)(lnw + col), b4 = *(const GAS f32x4*)(lnb + col);
                const v2u vw = *(const GAS v2u*)(RKV + trow * 3072 + 2048 + col), gw2 = *(const GAS v2u*)(GG + trow * 1024 + col);
                const float v4[4] = {bf_lo(vw.x), bf_hi(vw.x), bf_lo(vw.y), bf_hi(vw.y)}, g4[4] = {bf_lo(gw2.x), bf_hi(gw2.x), bf_lo(gw2.y), bf_hi(gw2.y)};
                float o4[4];
#pragma unroll
                for (int e = 0; e < 4; ++e) o4[e] = (y[it][4 * q + e] * rs * w4[e] + b4[e] + bon * v4[e]) * g4[e];
                v2u ow; ow.x = cvtpk(o4[0], o4[1]); ow.y = cvtpk(o4[2], o4[3]);
                *(GAS v2u*)(YG + trow * 1024 + col) = ow; }
    }
}
#undef STORE_RM
#undef STORE_TR
#undef FRESH
}

#ifndef MK_ONE_LAUNCH
#define MK_ONE_LAUNCH 1
#endif
template <class Epi> __device__ __forceinline__ void run_gemm(Frame& F, const bf16* A, int lda, const bf16* Bt, int ldb, int N, int K, const Epi& E) {
    pg8::Gemm g{A, Bt, T, N, K, lda, ldb, F.wave}; pg8::StaticOrder S; S.init(T, N, F.G, (int)blockIdx.x);
    pg8::gemm_phase<Epi, pg8::StaticOrder, true, true>(F.lds, g, S, E);
}
__host__ __device__ constexpr int mixer_phases(int kind) { return kind == 0 ? 4 : kind == 1 ? 6 : 7; }
constexpr int NPH = 4 * 3 + (mixer_phases(0) + 2) + (mixer_phases(1) + 2) + (mixer_phases(2) + 2) + (mixer_phases(0) + 2) + 1;

__global__ void __launch_bounds__(NWAVES * 64, 2) fwd(Args args) {
    extern __shared__ __attribute__((aligned(16))) unsigned char lds[];
    Frame F;
    F.lds = (LAS unsigned char*)lds;
    F.tid = threadIdx.x; F.lane = F.tid & 63; const int wave0 = __builtin_amdgcn_readfirstlane(F.tid >> 6); F.wave = wave0;
    F.G = gridDim.x; F.gw = (int)blockIdx.x * NWAVES + F.wave; F.NGW = F.G * NWAVES;
    F.ws = args.ws; F.ctl = (gu32*)(args.ws + WS_CTL);
    const Inputs& in = args.in;
    volatile LAS unsigned* MISC = (volatile LAS unsigned*)(F.lds + MISC_OFF);
    for (int u = F.tid; u < (LDS_BYTES - LDSCTL_OFF) / 4; u += NWAVES * 64) ((LAS unsigned*)(F.lds + LDSCTL_OFF))[u] = 0u;
    __syncthreads();
#if MK_ONE_LAUNCH
    XcdBarrier bar = xcd_barrier_post((unsigned*)(F.ctl + CW_BAR), MISC + 8);
#define GRID_BAR() xcd_barrier(bar)
#else
#define GRID_BAR() do { } while (0)
#endif
    const int lo = args.ph_lo, hi = args.ph_hi;
    int ph = 0;
#ifndef PHMASK
#define PHMASK 0xffffffffu
#endif
#define PH_BEGIN(id) if (ph >= lo && ph < hi) { if ((PHMASK >> (id)) & 1u) { { int w_ = wave0; asm volatile("" : "+s"(w_)); F.wave = w_; F.lane = fresh_lane(); F.tid = w_ * 64 + F.lane; F.gw = (int)blockIdx.x * NWAVES + w_; } unsigned char* ws = args.ws; asm volatile("" : "+s"(ws)); { float* xo_ = args.out; asm volatile("" : "+s"(xo_)); F.X = xo_; } F.ws = ws; F.ctl = (gu32*)(ws + WS_CTL); F.XB = (bf16*)(ws + WS_XB); F.SS = (float*)(ws + WS_SS); \
    bf16* const WB = (bf16*)(ws + WS_W); unsigned char* const AR = ws + WS_ARENA; float* const COS = (float*)(ws + WS_COS); float* const SIN = (float*)(ws + WS_SIN); float* const SSQ = (float*)(ws + WS_SSQ); float* const SSKV = (float*)(ws + WS_SSKV); (void)WB; (void)AR; (void)COS; (void)SIN; (void)SSQ; (void)SSKV;
#define PH_END } if (ph + 1 < hi) GRID_BAR(); } ++ph;

#ifdef DUMP
    if (lo == 1000) { unsigned char* ws = args.ws; unsigned char* const AR = ws + WS_ARENA; F.X = args.out; F.lane = fresh_lane();
#define HX ((bf16*)(AR + A_HX))
#define RKV ((bf16*)(AR + A_RKV))
#define LOR ((bf16*)(AR + A_LOR))
#define LW ((float*)(AR + A_LW))
#define AA ((bf16*)(ws + WS_XB))
#define GG ((bf16*)(AR + A_GG))
#define YG ((bf16*)(AR + A_YG))
        for (int e = F.gw * 64 + F.lane; e < T * 1024; e += F.NGW * 64) { const int t = e >> 10, c = e & 1023; float v = 0.f;
            if (DUMP == 1) v = bf1(HX[(size_t)t * 2048 + c]) + bf1(HX[(size_t)t * 2048 + 1024 + c]);
            if (DUMP == 2) v = bf1(RKV[(size_t)t * 3072 + c]) + bf1(RKV[(size_t)t * 3072 + 1024 + c]) + bf1(RKV[(size_t)t * 3072 + 2048 + c]) + bf1(LOR[(size_t)t * 256 + (c & 255)]);
            if (DUMP == 3) v = LW[(size_t)t * 1024 + c] + bf1(AA[(size_t)t * 1024 + c]) + bf1(GG[(size_t)t * 1024 + c]);
            if (DUMP == 4) v = bf1(YG[(size_t)t * 1024 + c]);
            if (DUMP == 5) v = ((size_t)e < (size_t)3328 * 2048) ? bf1(((const bf16*)(ws + WS_W))[WR_BIG + e]) : 0.f;
            F.X[e] = v; }
#undef HX
#undef RKV
#undef LOR
#undef LW
#undef AA
#undef GG
#undef YG
        return; }
#endif
#pragma unroll
    for (int s = 0; s < 2 * DEPTH; ++s) {
        const int layer = s >> 1, half = s & 1, kind = layer % 3, j = layer / 3;
        if (half == 0) {
            PH_BEGIN(0)
                if (layer == 0) prologue(F, in);
                conv_layer(F, in, layer);
            PH_END
        } else if (kind == 0) {
#define LAT ((bf16*)(AR + A_LAT))
#define Q ((bf16*)(AR + A_Q))
#define KV ((bf16*)(AR + A_KV))
#define O ((bf16*)(AR + A_O))
#define KPE ((bf16*)(AR + A_KPE))
            PH_BEGIN(1)
                EpiMlaA E{F.SS, LAT, SSQ, SSKV, KPE, COS, SIN};
                run_gemm(F, F.XB, D, WB + WM_A, 1024, 1024, 1024, E);
            PH_END
            PH_BEGIN(2)
                { EpiMlaQ E{SSQ, Q, COS, SIN, 0.07216878364870322f * 1.4426950408889634f};
                  run_gemm(F, LAT, 1024, WB + WM_QB, 512, 1536, 512, E); }
                { EpiMlaKV E{SSKV, KV};
                  run_gemm(F, LAT + 512, 1024, WB + WM_KVB, 256, 2048, 256, E); }
            PH_END
            PH_BEGIN(3)
                for (int it = (int)blockIdx.x; it < BATCH * MLA_H * 16; it += F.G) { const int bh = it >> 4, xq = it & 15;
                    att::attn_unit(F.wave, bh >> 3, bh & 7, xq, Q, KV, KPE, O, (LAS char*)F.lds);
                    att::attn_unit(F.wave, bh >> 3, bh & 7, 31 - xq, Q, KV, KPE, O, (LAS char*)F.lds); }
            PH_END
            PH_BEGIN(4)
                EpiResidual E{F.X, F.XB, F.SS, 1.0f};
                run_gemm(F, O, 1024, WB + WM_O, 1024, 1024, 1024, E);
            PH_END
        } else if (kind == 1) {
#define P ((bf16*)(AR + A_P))
#define GATES ((float*)(AR + A_GATES))
#define HM ((bf16*)(AR + A_HM))
            PH_BEGIN(5)
                EpiMlIn E{F.SS, P, GATES};
                run_gemm(F, F.XB, D, WB + WL_IN, 1024, 3328, 1024, E);
            PH_END
            PH_BEGIN(6)
                mlc::conv_phase(F, in, j);
            PH_END
            PH_BEGIN(7)
                mlc::xa_phase(F);
            PH_END
            PH_BEGIN(8)
                mlc::xb_phase(F);
            PH_END
            PH_BEGIN(19)
                mlc::xc_phase(F, in, j);
            PH_END
            PH_BEGIN(9)
                EpiResidual E{F.X, F.XB, F.SS, 1.0f};
                run_gemm(F, (bf16*)(AR + mlc::A_HM2), 1024, WB + WL_O, 1024, 1024, 1024, E);
            PH_END
        } else {
#define HX ((bf16*)(AR + A_HX))
#define RKV ((bf16*)(AR + A_RKV))
#define LOR ((bf16*)(AR + A_LOR))
#define LW ((float*)(AR + A_LW))
#define AA ((bf16*)(ws + WS_XB))
#define GG ((bf16*)(AR + A_GG))
#define YG ((bf16*)(AR + A_YG))
            PH_BEGIN(10)
                rw_shift_phase(F);
            PH_END
            PH_BEGIN(11)
                EpiRwBig E{RKV, LOR};
                run_gemm(F, HX, 2048, WB + WR_BIG, 2048, 3328, 2048, E);
            PH_END
            PH_BEGIN(12)
                EpiRwUp E{LW, AA, GG, in.rw_w0 + (size_t)j * 1024, in.rw_a0 + (size_t)j * 1024};
                run_gemm(F, LOR, 256, WB + WR_UP, 256, 3072, 256, E);
            PH_END
            PH_BEGIN(13)
                rwc::ra_phase(F, in, j);
            PH_END
            PH_BEGIN(14)
                rwc::rb_phase(F);
            PH_END
            PH_BEGIN(20)
                rwc::rc_phase(F, in, j);
            PH_END
            PH_BEGIN(15)
                EpiResidual E{F.X, F.XB, F.SS, 1.0f};
                run_gemm(F, YG, 1024, WB + WR_O, 1024, 1024, 1024, E);
            PH_END
        }
#define ACT ((bf16*)(AR + A_ACT))
        PH_BEGIN(16)
            EpiSwiGLU E{F.SS, ACT};
            run_gemm(F, F.XB, D, WB + (half ? WO_GU1 : WO_GU0), D, 2 * FF, D, E);
        PH_END
        PH_BEGIN(17)
            EpiResidual E{F.X, F.XB, F.SS, 0.5f};
            run_gemm(F, ACT, FF, WB + (half ? WO_D1 : WO_D0), FF, D, FF, E);
        PH_END
    }
    PH_BEGIN(18)
        final_norm_phase(F, in);
    PH_END
}

extern "C" void kernel_launch(void* const* d_in, const int* in_sizes, int n_in, void* d_out, int out_size, void* d_ws, size_t ws_size, hipStream_t stream) {
    static int grid = 0;
    if (grid == 0) {
        if (n_in != 38 || in_sizes[0] != T * D || out_size != T * D || ws_size < WS_END) { fprintf(stderr, "kernel_launch: unexpected shapes (n_in %d, in0 %d, out %d, ws %zu)\n", n_in, n_in > 0 ? in_sizes[0] : -1, out_size, ws_size); grid = -1; return; }
        int dev = 0, cus = 0, per_cu = 0;
        if (hipGetDevice(&dev) != hipSuccess || hipDeviceGetAttribute(&cus, hipDeviceAttributeMultiprocessorCount, dev) != hipSuccess) { grid = -1; return; }
        if (hipFuncSetAttribute((const void*)fwd, hipFuncAttributeMaxDynamicSharedMemorySize, LDS_BYTES) != hipSuccess) { fprintf(stderr, "kernel_launch: hipFuncSetAttribute failed\n"); grid = -1; return; }
        if (hipOccupancyMaxActiveBlocksPerMultiprocessor(&per_cu, (const void*)fwd, NWAVES * 64, LDS_BYTES) != hipSuccess || per_cu < 1)
            fprintf(stderr, "kernel_launch: occupancy query reports %d workgroups per CU\n", per_cu);
        (void)hipGetLastError();
        grid = cus;
    }
    if (grid < 0) return;
    if (hipMemsetAsync((char*)d_ws + WS_CTL, 0, CTL_ZERO_BYTES, stream) != hipSuccess) return;
    Args a{};
    const void** ip = (const void**)&a.in;
    for (int i = 0; i < 38; ++i) ip[i] = d_in[i];
    a.out = (float*)d_out; a.ws = (unsigned char*)d_ws;
#if MK_ONE_LAUNCH
    a.ph_lo = 0; a.ph_hi = NPH;
    hipLaunchKernelGGL(fwd, dim3(grid), dim3(NWAVES * 64), LDS_BYTES, stream, a);
#else
#ifdef DUMP
    for (int p = 0; p <= DUMP_LAST; ++p) { a.ph_lo = p; a.ph_hi = p + 1;
        hipLaunchKernelGGL(fwd, dim3(grid), dim3(NWAVES * 64), LDS_BYTES, stream, a); }
    a.ph_lo = 1000; a.ph_hi = 1001;
    hipLaunchKernelGGL(fwd, dim3(grid), dim3(NWAVES * 64), LDS_BYTES, stream, a);
#else
    for (int p = 0; p < NPH; ++p) { a.ph_lo = p; a.ph_hi = p + 1;
        hipLaunchKernelGGL(fwd, dim3(grid), dim3(NWAVES * 64), LDS_BYTES, stream, a); }
#endif
#endif
}
```

```cpp
#include <hip/hip_runtime.h>
#include <cstdio>
#include <cstdint>

__device__ __forceinline__ int fresh_lane() { int l; asm volatile("v_mbcnt_lo_u32_b32 %0, -1, 0\n\tv_mbcnt_hi_u32_b32 %0, -1, %0" : "=v"(l)); return l; }
namespace pg8 {
#define PG8_LAS __attribute__((address_space(3)))
typedef unsigned short bf16_t;
typedef short bf16x8 __attribute__((ext_vector_type(8)));
typedef float f32x4 __attribute__((ext_vector_type(4)));
typedef unsigned u32x4 __attribute__((ext_vector_type(4)));
typedef unsigned u32x2 __attribute__((ext_vector_type(2)));
constexpr int BM = 256, BK = 64, HALF = 128, HTB = HALF * BK * 2  , STAGE_BYTES = 8 * HTB, NXCD = 8, WGM = 8;

__host__ __device__ __forceinline__ int lds_byte(int r, int c) { const int st = (r >> 4) * 2 + (c >> 5), rr = r & 15, cc = c & 31, ob = rr * 64 + cc * 2; return st * 1024 + (ob ^ (((ob >> 9) & 1) << 5)); }
__host__ __device__ __forceinline__ void stage_rc(int b, int& R, int& C) { const int st = b / 1024, sb = b % 1024, swz = sb ^ (((sb >> 9) & 1) << 5); R = (st >> 1) * 16 + swz / 64; C = (st & 1) * 32 + (swz % 64) / 2; }
__host__ __device__ __forceinline__ int perm32(int rho) { const int n = rho >> 4, i = rho & 15; return 8 * (i >> 2) + 4 * n + (i & 3); }

struct Unit { int pm, pn; };
struct Gemm { const bf16_t* A; const bf16_t* Bt; int M, N, K, lda, ldb, wave; };

struct StaticOrder {
    int nM, nN, nwg, G, c;
    __host__ __device__ void init(int M, int N, int G_, int c_) { nM = M / BM; nN = N / BM; nwg = nM * nN; G = G_; c = c_; }
    __host__ __device__ bool next(int i, Unit& u) const {
        const long L = (long)i * G + c; if (L >= nwg) return false;
        int wgid = (int)L; { const int q = nwg / NXCD, r = nwg % NXCD, xcd = wgid % NXCD, off = wgid / NXCD; wgid = (xcd < r ? xcd * (q + 1) : r * (q + 1) + (xcd - r) * q) + off; }
        const int nig = WGM * nN, gid = wgid / nig, fm = gid * WGM, gsz = (nM - fm) < WGM ? (nM - fm) : WGM;
        u.pm = fm + ((wgid % nig) % gsz); u.pn = (wgid % nig) / gsz; return true;
    }
    __device__ __forceinline__ void a_ready(const Unit&) const {}
    __device__ __forceinline__ void done(const Unit&) const {}
};

template <class Epi, class Sched, bool ALIGN_EPI = false, bool SP2 = false>
__device__ __forceinline__ void gemm_phase(PG8_LAS unsigned char* lds, const Gemm g, const Sched& S, const Epi& E) {
    const int wid = g.wave; const int tid = wid * 64 + fresh_lane(), lane = tid & 63, wr = wid >> 2, wc = wid & 3, fr = lane & 15, fq = lane >> 4;
    const int K = g.K, nt = K / BK;
    unsigned voffA[2], voffB[2];
#pragma unroll
    for (int i = 0; i < 2; ++i) { int R, C; stage_rc(tid * 16 + i * 8192, R, C); const int Rb = Epi::PERM ? ((R & ~31) + perm32(R & 31)) : R;
        voffA[i] = (unsigned)(R * g.lda + C) * 2u; voffB[i] = (unsigned)(Rb * g.ldb + C) * 2u; }
    const size_t kstep = (size_t)(BK * 2);
    const size_t hstepA = (size_t)HALF * g.lda * 2, hstepB = (size_t)HALF * g.ldb * 2;
    const size_t tstepA = 2 * hstepA, tstepB = 2 * hstepB;
    const unsigned ldsw = (unsigned)wid * 1024u;
    const int aoff = lds_byte(wr * 64 + fr, fq * 8), boff = lds_byte(wc * 32 + fr, fq * 8);
#define PG8_SA(b, h) (((b) * 2 + (h)) * HTB)
#define PG8_SB(b, h) ((4 + (b) * 2 + (h)) * HTB)
#define PG8_STAGE(bufoff, gbase, voff) do { _Pragma("unroll") for (int _i = 0; _i < 2; ++_i) \
        __builtin_amdgcn_global_load_lds((const unsigned*)((const char*)(gbase) + (voff)[_i]), (PG8_LAS unsigned*)(lds + (bufoff) + ldsw + _i * 8192), 16, 0, 0); } while (0)
#define PG8_LDA(dst, b, h) do { _Pragma("unroll") for (int m = 0; m < 4; ++m) _Pragma("unroll") for (int k = 0; k < 2; ++k) dst[m][k] = *(const PG8_LAS bf16x8*)(lds + PG8_SA(b, h) + aoff + m * 2048 + k * 1024); } while (0)
#define PG8_LDB(dst, b, h) do { _Pragma("unroll") for (int n = 0; n < 2; ++n) _Pragma("unroll") for (int k = 0; k < 2; ++k) dst[n][k] = *(const PG8_LAS bf16x8*)(lds + PG8_SB(b, h) + boff + n * 2048 + k * 1024); } while (0)
#define PG8_MMA(ai, bj, At, Bt) do { __builtin_amdgcn_s_setprio(1); _Pragma("unroll") for (int m = 0; m < 4; ++m) _Pragma("unroll") for (int n = 0; n < 2; ++n) _Pragma("unroll") for (int k = 0; k < 2; ++k) \
        acc[ai][bj][m][n] = __builtin_amdgcn_mfma_f32_16x16x32_bf16(Bt[n][k], At[m][k], acc[ai][bj][m][n], 0, 0, 0); __builtin_amdgcn_s_setprio(0); } while (0)
#define PG8_WAIT_V(n) asm volatile("s_waitcnt vmcnt(" #n ")" ::: "memory")
#define PG8_WAIT_L(n) asm volatile("s_waitcnt lgkmcnt(" #n ")" ::: "memory")
#define PG8_BAR __builtin_amdgcn_s_barrier()
#define PG8_SCHED __builtin_amdgcn_sched_barrier(0)
    Unit cur, nxt; int ui = 0;
    if (!S.next(0, cur)) return;
    f32x4 acc[2][2][4][2];
#pragma unroll
    for (int a = 0; a < 2; ++a)
#pragma unroll
        for (int b = 0; b < 2; ++b)
#pragma unroll
            for (int m = 0; m < 4; ++m)
#pragma unroll
                for (int n = 0; n < 2; ++n) acc[a][b][m][n] = (f32x4){0.f, 0.f, 0.f, 0.f};
    bf16x8 At[4][2], B0[2][2], B1[2][2];
    const char* cA = (const char*)g.A + (size_t)cur.pm * tstepA; const char* cB = (const char*)g.Bt + (size_t)cur.pn * tstepB;
    S.a_ready(cur);
    if constexpr (SP2) {
        PG8_STAGE(PG8_SB(0, 0), cB, voffB); PG8_STAGE(PG8_SB(0, 1), cB + hstepB, voffB); PG8_STAGE(PG8_SA(0, 0), cA, voffA); PG8_STAGE(PG8_SA(0, 1), cA + hstepA, voffA);
        if (wr == 1) PG8_BAR;
        PG8_WAIT_V(2); PG8_BAR;
        PG8_STAGE(PG8_SB(1, 0), cB + kstep, voffB); PG8_STAGE(PG8_SA(1, 0), cA + kstep, voffA); PG8_STAGE(PG8_SB(1, 1), cB + hstepB + kstep, voffB);
        PG8_WAIT_V(6); PG8_BAR;
    } else {
        PG8_STAGE(PG8_SB(0, 0), cB, voffB); PG8_STAGE(PG8_SA(0, 0), cA, voffA); PG8_STAGE(PG8_SB(0, 1), cB + hstepB, voffB); PG8_STAGE(PG8_SA(0, 1), cA + hstepA, voffA);
        if (wr == 1) PG8_BAR;
        PG8_WAIT_V(4); PG8_BAR;
        PG8_STAGE(PG8_SB(1, 0), cB + kstep, voffB); PG8_STAGE(PG8_SA(1, 0), cA + kstep, voffA); PG8_STAGE(PG8_SB(1, 1), cB + hstepB + kstep, voffB);
        PG8_WAIT_V(6); PG8_BAR;
    }
    for (;;) {
        const bool has_next = S.next(ui + 1, nxt);
        const char* nA = has_next ? (const char*)g.A + (size_t)nxt.pm * tstepA : cA; const char* nB = has_next ? (const char*)g.Bt + (size_t)nxt.pn * tstepB : cB;
#pragma nounroll
        for (int t = 0; t < nt; t += 2) {
            const bool last = (t == nt - 2);
            const char* a1 = cA + (size_t)(t + 1) * kstep;
            const char* a2 = last ? nA : cA + (size_t)(t + 2) * kstep; const char* b2 = last ? nB : cB + (size_t)(t + 2) * kstep;
            const char* a3 = a2 + kstep; const char* b3 = b2 + kstep;
            if (last && has_next) S.a_ready(nxt);
            if constexpr (SP2) {
            PG8_LDB(B0, 0, 0); PG8_LDB(B1, 0, 1); PG8_SCHED; PG8_LDA(At, 0, 0); PG8_STAGE(PG8_SA(1, 1), a1 + hstepA, voffA);
            PG8_WAIT_V(8); PG8_WAIT_L(0); PG8_BAR; PG8_MMA(0, 0, At, B0); PG8_MMA(0, 1, At, B1); PG8_BAR; PG8_SCHED;
            PG8_LDA(At, 0, 1); PG8_STAGE(PG8_SB(0, 0), b2, voffB); PG8_STAGE(PG8_SB(0, 1), b2 + hstepB, voffB); PG8_STAGE(PG8_SA(0, 0), a2, voffA);
            PG8_WAIT_V(8); PG8_WAIT_L(0); PG8_BAR; PG8_MMA(1, 0, At, B0); PG8_MMA(1, 1, At, B1); PG8_BAR; PG8_SCHED;
            PG8_LDB(B0, 1, 0); PG8_LDB(B1, 1, 1); PG8_SCHED; PG8_LDA(At, 1, 0); PG8_STAGE(PG8_SA(0, 1), a2 + hstepA, voffA);
            PG8_WAIT_V(8); PG8_WAIT_L(0); PG8_BAR; PG8_MMA(0, 0, At, B0); PG8_MMA(0, 1, At, B1); PG8_BAR; PG8_SCHED;
            PG8_LDA(At, 1, 1); PG8_STAGE(PG8_SB(1, 0), b3, voffB); PG8_STAGE(PG8_SB(1, 1), b3 + hstepB, voffB); PG8_STAGE(PG8_SA(1, 0), a3, voffA);
            PG8_WAIT_V(8); PG8_WAIT_L(0); PG8_BAR; PG8_MMA(1, 0, At, B0); PG8_MMA(1, 1, At, B1); PG8_BAR; PG8_SCHED;
            } else {
            PG8_LDB(B0, 0, 0); PG8_SCHED; PG8_LDA(At, 0, 0); PG8_STAGE(PG8_SA(1, 1), a1 + hstepA, voffA);
            PG8_WAIT_L(8); PG8_BAR; PG8_WAIT_L(0); PG8_MMA(0, 0, At, B0); PG8_BAR; PG8_SCHED;
            PG8_LDB(B1, 0, 1); PG8_STAGE(PG8_SB(0, 0), b2, voffB);
            PG8_BAR; PG8_WAIT_L(0); PG8_MMA(0, 1, At, B1); PG8_BAR;
            PG8_LDA(At, 0, 1); PG8_STAGE(PG8_SA(0, 0), a2, voffA);
            PG8_BAR; PG8_WAIT_L(0); PG8_MMA(1, 0, At, B0); PG8_BAR; PG8_SCHED;
            PG8_STAGE(PG8_SB(0, 1), b2 + hstepB, voffB);
            PG8_WAIT_V(6); PG8_BAR; PG8_MMA(1, 1, At, B1); PG8_BAR;
            PG8_LDB(B0, 1, 0); PG8_SCHED; PG8_LDA(At, 1, 0); PG8_STAGE(PG8_SA(0, 1), a2 + hstepA, voffA);
            PG8_WAIT_L(8); PG8_BAR; PG8_WAIT_L(0); PG8_MMA(0, 0, At, B0); PG8_BAR; PG8_SCHED;
            PG8_LDB(B1, 1, 1); PG8_STAGE(PG8_SB(1, 0), b3, voffB);
            PG8_BAR; PG8_WAIT_L(0); PG8_MMA(0, 1, At, B1); PG8_BAR;
            PG8_LDA(At, 1, 1); PG8_STAGE(PG8_SA(1, 0), a3, voffA);
            PG8_BAR; PG8_WAIT_L(0); PG8_MMA(1, 0, At, B0); PG8_BAR; PG8_SCHED;
            PG8_STAGE(PG8_SB(1, 1), b3 + hstepB, voffB);
            PG8_WAIT_V(6); PG8_BAR; PG8_MMA(1, 1, At, B1); PG8_BAR;
            }
        }
        if constexpr (ALIGN_EPI) { if (wr == 0) PG8_BAR; }
        if constexpr (!Epi::AFTER_DRAIN) { E(acc, cur, wr, wc, fr, fq); S.done(cur); }
        if (!has_next) break;
#pragma unroll
        for (int a = 0; a < 2; ++a)
#pragma unroll
            for (int b = 0; b < 2; ++b)
#pragma unroll
                for (int m = 0; m < 4; ++m)
#pragma unroll
                    for (int n = 0; n < 2; ++n) acc[a][b][m][n] = (f32x4){0.f, 0.f, 0.f, 0.f};
        cur = nxt; cA = nA; cB = nB; ++ui;
        if constexpr (ALIGN_EPI) { if (wr == 1) PG8_BAR; }
    }
    PG8_WAIT_V(0);
    if constexpr (!ALIGN_EPI) { if (wr == 0) PG8_BAR; }
    PG8_BAR;
    if constexpr (Epi::AFTER_DRAIN) { E.fused(acc, cur, wr, wc, fr, fq, lds, wid, lane); S.done(cur); }
#undef PG8_SA
#undef PG8_SB
#undef PG8_STAGE
#undef PG8_LDA
#undef PG8_LDB
#undef PG8_MMA
#undef PG8_WAIT_V
#undef PG8_WAIT_L
#undef PG8_BAR
#undef PG8_SCHED
}
}

constexpr int NWAVES = 8;
constexpr int BATCH = 2, SEQ = 8192, D = 1024, T = BATCH * SEQ, FF = 2816, DEPTH = 4;
constexpr float RMS_EPS = 1e-6f;
constexpr int MLA_H = 8, QRANK = 512, KVRANK = 256, NOPE = 128, ROPE = 64, DVH = 128, DQK = NOPE + ROPE;
constexpr int LATN = QRANK + KVRANK + ROPE;
constexpr int ML_H = 8, ML_DK = 64, ML_DV = 128, ML_NIN = 3088;
constexpr int RW_H = 16, RW_N = 64;

constexpr size_t MiB = 1u << 20;
constexpr size_t WS_CTL = 0, CTL_ZERO_BYTES = 1 * MiB;
constexpr size_t WS_COS = 1 * MiB, WS_SIN = 3 * MiB;
constexpr size_t WS_SS = 5 * MiB;
constexpr size_t WS_SSQ = 6 * MiB;
constexpr size_t WS_SSKV = 6 * MiB + 512 * 1024;
constexpr size_t WS_W = 8 * MiB;
constexpr size_t WS_XB = 68 * MiB;
constexpr size_t WS_ARENA = 100 * MiB;
constexpr size_t WS_END = 352 * MiB;
constexpr size_t WO_GU0 = 0, WO_D0 = WO_GU0 + (size_t)2 * FF * D, WO_GU1 = WO_D0 + (size_t)D * FF, WO_D1 = WO_GU1 + (size_t)2 * FF * D, WO_MIX = WO_D1 + (size_t)D * FF;
constexpr size_t WM_A = WO_MIX, WM_QB = WM_A + (size_t)1024 * 1024, WM_KVB = WM_QB + (size_t)1536 * 512, WM_O = WM_KVB + (size_t)2048 * 256;
constexpr size_t WL_IN = WO_MIX, WL_O = WL_IN + (size_t)3328 * 1024;
constexpr size_t WR_BIG = WO_MIX, WR_UP = WR_BIG + (size_t)3328 * 2048, WR_O = WR_UP + (size_t)3072 * 256;
static_assert((WR_O + (size_t)1024 * 1024) * 2 <= 60 * MiB, "weight region");
constexpr size_t A_ACT = 0;
constexpr size_t A_LAT = 0, A_Q = 32 * MiB, A_KV = 80 * MiB, A_O = 144 * MiB, A_KPE = 176 * MiB;
constexpr size_t A_P = 0, A_GATES = 96 * MiB, A_QKC = 97 * MiB, A_IGLF = 161 * MiB, A_HRAW = 162 * MiB, A_HM = A_QKC;
constexpr size_t A_HX = 0, A_RKV = 64 * MiB, A_LOR = 160 * MiB, A_LW = 0, A_GG = 168 * MiB, A_YG = 200 * MiB;
static_assert(WS_ARENA + A_HRAW + (size_t)T * 1024 * 4 <= WS_END && WS_ARENA + A_YG + (size_t)T * 1024 * 2 <= WS_END && WS_ARENA + A_KPE + (size_t)T * 64 * 2 <= WS_END, "arena");

constexpr int CW_TMO = 0, CW_CODE = 1, CW_BAR = 4096;
constexpr size_t WS_PTRS = 512 * 1024;

constexpr int RING_BYTES = 131072;
constexpr int LDSCTL_OFF = 146432, MISC_OFF = LDSCTL_OFF + 320;
constexpr int LDS_BYTES = 147456;

#define GAS __attribute__((address_space(1)))
#define LAS __attribute__((address_space(3)))
typedef unsigned short bf16;
typedef unsigned v4u __attribute__((ext_vector_type(4)));
typedef unsigned v2u __attribute__((ext_vector_type(2)));
typedef float f32x4 __attribute__((ext_vector_type(4)));
typedef float f32x16 __attribute__((ext_vector_type(16)));
typedef short bf16x8 __attribute__((ext_vector_type(8)));
typedef short s16x4 __attribute__((ext_vector_type(4)));
typedef GAS unsigned gu32;
#define RLX_AGENT __ATOMIC_RELAXED, __HIP_MEMORY_SCOPE_AGENT
#define LDS_WAIT() asm volatile("s_waitcnt lgkmcnt(0)" ::: "memory")
#define VM_WAIT() asm volatile("s_waitcnt vmcnt(0)" ::: "memory")
typedef float f32x2_t __attribute__((ext_vector_type(2))); typedef __bf16 bf16x2_t __attribute__((ext_vector_type(2)));
__device__ __forceinline__ unsigned cvtpk(float lo, float hi) { f32x2_t v = {lo, hi}; bf16x2_t b = __builtin_convertvector(v, bf16x2_t); return __builtin_bit_cast(unsigned, b); }
__device__ __forceinline__ float bf_lo(unsigned w) { return __builtin_bit_cast(float, w << 16); }
__device__ __forceinline__ float bf_hi(unsigned w) { return __builtin_bit_cast(float, w & 0xffff0000u); }
__device__ __forceinline__ float bf1(bf16 h) { return __builtin_bit_cast(float, (unsigned)h << 16); }
__device__ __forceinline__ v4u pack8f(const float* v) { v4u w; w.x = cvtpk(v[0], v[1]); w.y = cvtpk(v[2], v[3]); w.z = cvtpk(v[4], v[5]); w.w = cvtpk(v[6], v[7]); return w; }
__device__ __forceinline__ v4u pack8v(f32x4 a, f32x4 b) { v4u w; w.x = cvtpk(a[0], a[1]); w.y = cvtpk(a[2], a[3]); w.z = cvtpk(b[0], b[1]); w.w = cvtpk(b[2], b[3]); return w; }
__device__ __forceinline__ void unpack8(v4u w, float* v) { v[0] = bf_lo(w.x); v[1] = bf_hi(w.x); v[2] = bf_lo(w.y); v[3] = bf_hi(w.y); v[4] = bf_lo(w.z); v[5] = bf_hi(w.z); v[6] = bf_lo(w.w); v[7] = bf_hi(w.w); }
__device__ __forceinline__ float fexp(float x) { return __builtin_amdgcn_exp2f(x * 1.4426950408889634f); }
__device__ __forceinline__ float frcp(float x) { return __builtin_amdgcn_rcpf(x); }
__device__ __forceinline__ float flog(float x) { return __builtin_amdgcn_logf(x) * 0.6931471805599453f; }
__device__ __forceinline__ float ftanh(float x) { const float t = fexp(-2.f * fabsf(x)); const float r = (1.f - t) * frcp(1.f + t); return x < 0.f ? -r : r; }
__device__ __forceinline__ float fsigmoid(float x) { return frcp(1.f + fexp(-x)); }
__device__ __forceinline__ float frsq(float x) { return __builtin_amdgcn_rsqf(x); }
__device__ __forceinline__ float fsqrt(float x) { return __builtin_amdgcn_sqrtf(x); }
__device__ __forceinline__ void fsincos_big(float a, float& s, float& c) {
    const float k = __builtin_rintf(a * 0.15915494309189535f);
    float r = __builtin_fmaf(-k, 6.28125f, a); r = __builtin_fmaf(-k, 1.9353071795864769e-3f, r);
    const float rev = r * 0.15915494309189535f;
    s = __builtin_amdgcn_sinf(rev); c = __builtin_amdgcn_cosf(rev);
}
__device__ __forceinline__ float fsilu(float x) { return x * frcp(1.f + fexp(-x)); }
__device__ __forceinline__ float wave_sum(float v) {
#pragma unroll
    for (int o = 1; o < 64; o <<= 1) v += __shfl_xor(v, o);
    return v;
}

#define XB_TMO      128
#define XB_XCNT(j)  (256  + 64 * (j))
#define XB_XSUB(j)  (1280 + 64 * (j))
#define XB_XGEN(j)  (2304 + 64 * (j))
#define XB_TOP      3328
#define XB_TOPGEN   3392
#define XCD_BAR_WORDS 3456
#define XB_SPIN_CAP (1u << 18)

__device__ __forceinline__ unsigned xb_ld(unsigned* p)              { return __hip_atomic_load(p, __ATOMIC_RELAXED, __HIP_MEMORY_SCOPE_AGENT); }
__device__ __forceinline__ unsigned xb_add(unsigned* p, unsigned v) { return __hip_atomic_fetch_add(p, v, __ATOMIC_RELAXED, __HIP_MEMORY_SCOPE_AGENT); }
__device__ __forceinline__ unsigned xb_xcc_id() { return (unsigned)__builtin_amdgcn_s_getreg((3 << 11) | 20) & 0xFu; }
#define XB_SPIN(cond, bar) do { unsigned _sp = 0; while (cond) { __builtin_amdgcn_s_sleep(1); \
    if ((++_sp & 255u) == 0u) { if (xb_ld(&(bar)[XB_TMO])) break; if (_sp > XB_SPIN_CAP) { atomicAdd(&(bar)[XB_TMO], 1u); break; } } } } while (0)

struct XcdBarrier {
    unsigned* bar; unsigned x;
    volatile LAS unsigned* st;
};

__device__ __forceinline__ XcdBarrier xcd_barrier_post(unsigned* bar, volatile LAS unsigned* st) {
    XcdBarrier b; b.bar = bar; b.x = xb_xcc_id(); b.st = st;
    if (threadIdx.x == 0) (void)xb_add(&bar[XB_XCNT(b.x)], 1u);
    return b;
}
__device__ __forceinline__ void xcd_barrier_complete(unsigned* bar, unsigned x, unsigned& nloc, unsigned& nx) {
    const unsigned G = gridDim.x * gridDim.y * gridDim.z;
    unsigned sum, cnt, mine, sp = 0u;
    for (;;) {
        sum = 0u; cnt = 0u; mine = 0u;
#pragma unroll
        for (unsigned j = 0; j < 16; ++j) { const unsigned c = xb_ld(&bar[XB_XCNT(j)]); sum += c; cnt += (c > 0u) ? 1u : 0u; mine = (j == x) ? c : mine; }
        if (sum == G) break;
        __builtin_amdgcn_s_sleep(1);
        if ((++sp & 255u) == 0u) { if (xb_ld(&bar[XB_TMO])) break; if (sp > XB_SPIN_CAP) { atomicAdd(&bar[XB_TMO], 1u); break; } }
    }
    nloc = mine > 0u ? mine : 1u; nx = cnt > 0u ? cnt : 1u;
}

__device__ __forceinline__ void xcd_barrier(const XcdBarrier& b) {
    asm volatile("s_waitcnt vmcnt(0)" ::: "memory");
    __syncthreads();
    if (threadIdx.x == 0) {
        unsigned* bar = b.bar;
        __builtin_amdgcn_s_waitcnt(0);
        unsigned nloc = b.st[0], nx = b.st[1];
        if (nloc == 0u) { xcd_barrier_complete(bar, b.x, nloc, nx); b.st[0] = nloc; b.st[1] = nx; }
        const unsigned old = xb_add(&bar[XB_XSUB(b.x)], 1u);
        const unsigned gen = old / nloc;
        if (old + 1u == (gen + 1u) * nloc) {
            __builtin_amdgcn_fence(__ATOMIC_RELEASE, "agent");
            asm volatile("s_waitcnt vmcnt(0)" ::: "memory");
            const unsigned og = xb_add(&bar[XB_TOP], 1u);
            const unsigned tg = og / nx;
            if (og + 1u == (tg + 1u) * nx) xb_add(&bar[XB_TOPGEN], 1u);
            else XB_SPIN(xb_ld(&bar[XB_TOPGEN]) == tg, bar);
            __builtin_amdgcn_fence(__ATOMIC_ACQUIRE, "agent");
            xb_add(&bar[XB_XGEN(b.x)], 1u);
            asm volatile("s_waitcnt vmcnt(0)" ::: "memory");
        } else {
            XB_SPIN(xb_ld(&bar[XB_XGEN(b.x)]) == gen, bar);
            __builtin_amdgcn_fence(__ATOMIC_ACQUIRE, "agent");
            asm volatile("s_waitcnt vmcnt(0)" ::: "memory");
        }
    }
    __syncthreads();
}

struct Inputs {
    const float* x; const int* positions; const float* ffn_norm; const float* ffn_w_gate; const float* ffn_w_up; const float* ffn_w_down; const float* mix_norm; const float* final_norm;
    const float* mla_w_a; const float* mla_q_norm; const float* mla_w_qb; const float* mla_kv_norm; const float* mla_w_kvb; const float* mla_w_o;
    const float* ml_w_in; const float* ml_b_if; const float* ml_conv_w; const float* ml_conv_b; const float* ml_out_norm; const float* ml_w_o;
    const float* rw_mu; const float* rw_w_r; const float* rw_w_k; const float* rw_w_v; const float* rw_w0; const float* rw_w1; const float* rw_w2; const float* rw_a0; const float* rw_a1; const float* rw_a2;
    const float* rw_g1; const float* rw_g2; const float* rw_k_k; const float* rw_k_a; const float* rw_r_k; const float* rw_ln_w; const float* rw_ln_b; const float* rw_w_o;
};
struct Args { Inputs in; float* out; unsigned char* ws; int ph_lo, ph_hi; };

struct Frame {
    LAS unsigned char* lds;
    gu32* ctl;
    int tid, lane, wave, G, gw, NGW;
    float* X;
    bf16* XB;
    float* SS;
    unsigned char* ws;
};

__device__ __forceinline__ void cv_item(const float* Wp, int ld, int ks0, const float* g1, const float* g2, bf16* dst, int ldd, int kd0, int n0, LAS float* scr, int lane) {
    const int nl = lane & 31, kh = lane >> 5;
#pragma unroll 8
    for (int i = 0; i < 32; ++i) { const int kk = 2 * i + kh, k = ks0 + kk; float v = 0.f;
        if (Wp) { v = Wp[(size_t)k * ld]; if (g1) v *= g1[k]; if (g2) v *= g2[k]; }
        scr[kk * 33 + nl] = v; }
    LDS_WAIT(); asm volatile("" ::: "memory");
    const int c = lane & 7;
#pragma unroll
    for (int j = 0; j < 4; ++j) { const int n = (lane >> 3) + 8 * j; const LAS float* s = scr + (8 * c) * 33 + n;
        v4u o; o.x = cvtpk(s[0 * 33], s[1 * 33]); o.y = cvtpk(s[2 * 33], s[3 * 33]); o.z = cvtpk(s[4 * 33], s[5 * 33]); o.w = cvtpk(s[6 * 33], s[7 * 33]);
        *(GAS v4u*)(dst + (size_t)(n0 + n) * ldd + kd0 + 8 * c) = o; }
    LDS_WAIT(); asm volatile("" ::: "memory");
}

__device__ __forceinline__ void cv_item_vec(const float* W0  , int ld, int ks0, const float* g1, const float* g2, bf16* dst, int ldd, int kd0, int n0, LAS float* scr, int lane) {
    const int kr = lane >> 3, nc = (lane & 7) * 4;
    f32x4 v[8]; float g[8];
#pragma unroll
    for (int i = 0; i < 8; ++i) { const int k = ks0 + 8 * i + kr;
        v[i] = W0 ? *(const GAS f32x4*)(W0 + (size_t)k * ld + nc) : (f32x4){0.f, 0.f, 0.f, 0.f};
        g[i] = g1 ? g1[k] : 1.f; if (g2) g[i] *= g2[k]; }
#pragma unroll
    for (int i = 0; i < 8; ++i) { LAS float* s = scr + (8 * i + kr) * 33 + nc; const f32x4 x = v[i] * g[i]; s[0] = x[0]; s[1] = x[1]; s[2] = x[2]; s[3] = x[3]; }
    LDS_WAIT(); asm volatile("" ::: "memory");
    const int c = lane & 7;
#pragma unroll
    for (int j = 0; j < 4; ++j) { const int n = (lane >> 3) + 8 * j; const LAS float* s = scr + (8 * c) * 33 + n;
        v4u o; o.x = cvtpk(s[0 * 33], s[1 * 33]); o.y = cvtpk(s[2 * 33], s[3 * 33]); o.z = cvtpk(s[4 * 33], s[5 * 33]); o.w = cvtpk(s[6 * 33], s[7 * 33]);
        *(GAS v4u*)(dst + (size_t)(n0 + n) * ldd + kd0 + 8 * c) = o; }
    LDS_WAIT(); asm volatile("" ::: "memory");
}
__device__ __forceinline__ void conv_layer(Frame& F, const Inputs& in, int layer) {
    LAS float* scr = (LAS float*)(F.lds + F.wave * 16384);
    bf16* WB = (bf16*)(F.ws + WS_W);
    const int kind = layer % 3, j = layer / 3, lane = F.lane, nl = lane & 31;
    constexpr int I_GU = (D / 64) * (2 * FF / 32), I_DN = (FF / 64) * (D / 32);
    constexpr int I_FFN = 2 * (I_GU + I_DN);
    constexpr int I_MLA = (1024 / 64) * (1024 / 32) + (512 / 64) * (1536 / 32) + (256 / 64) * (2048 / 32) + (1024 / 64) * (1024 / 32);
    constexpr int I_ML = (1024 / 64) * (3328 / 32) + (1024 / 64) * (1024 / 32);
    constexpr int I_RW = (2048 / 64) * (3328 / 32) + (256 / 64) * (3072 / 32) + (1024 / 64) * (1024 / 32);
    const int n_items = I_FFN + (kind == 0 ? I_MLA : kind == 1 ? I_ML : I_RW);
    for (int it = F.gw; it < n_items; it += F.NGW) {
        int r = it;
        if (r < I_FFN) {
            const int half = r / (I_GU + I_DN); r -= half * (I_GU + I_DN);
            const size_t wsel = (size_t)(layer * 2 + half);
            if (r < I_GU) {
                const int nb = r % (2 * FF / 32), kb = r / (2 * FF / 32), n = nb * 32 + nl, tile = n >> 8, w = n & 255;
                const float* W = (w < 128 ? in.ffn_w_gate : in.ffn_w_up) + wsel * D * FF + (tile * 128 + (w & 127)) - nl;
                cv_item_vec(W, FF, kb * 64, in.ffn_norm + wsel * D, nullptr, WB + (half ? WO_GU1 : WO_GU0), D, kb * 64, nb * 32, scr, lane);
            } else { r -= I_GU;
                const int nb = r % (D / 32), kb = r / (D / 32), n = nb * 32 + nl;
                cv_item_vec(in.ffn_w_down + wsel * FF * D + n - nl, D, kb * 64, nullptr, nullptr, WB + (half ? WO_D1 : WO_D0), FF, kb * 64, nb * 32, scr, lane);
            }
            continue;
        }
        r -= I_FFN;
        if (kind == 0) {
            const float* gmix = in.mix_norm + (size_t)layer * D;
            if (r < 16 * 32) {
                const int nb = r % 32, kb = r / 32, n = nb * 32 + nl; int col = n;
                if (n >= 768 && n < 832) { const int jj = n - 768; col = 768 + (jj >> 1) + 32 * (jj & 1); }
                const float* W = (n < LATN) ? in.mla_w_a + (size_t)j * D * LATN + col : nullptr;
                if (nb < 24 || nb >= 26) cv_item_vec(nb < 24 ? W - nl : nullptr, LATN, kb * 64, gmix, nullptr, WB + WM_A, 1024, kb * 64, nb * 32, scr, lane);
                else cv_item(W, LATN, kb * 64, gmix, nullptr, WB + WM_A, 1024, kb * 64, nb * 32, scr, lane);
                continue; }
            r -= 16 * 32;
            if (r < 8 * 48) {
                const int nb = r % 48, kb = r / 48, n = nb * 32 + nl, hd = n / DQK, w = n - hd * DQK; int col = n;
                if (w >= NOPE) { const int jj = w - NOPE; col = hd * DQK + NOPE + (jj >> 1) + 32 * (jj & 1); }
                if ((nb % 6) < 4) cv_item_vec(in.mla_w_qb + (size_t)j * QRANK * 1536 + col - nl, 1536, kb * 64, in.mla_q_norm + (size_t)j * QRANK, nullptr, WB + WM_QB, 512, kb * 64, nb * 32, scr, lane);
                else cv_item(in.mla_w_qb + (size_t)j * QRANK * 1536 + col, 1536, kb * 64, in.mla_q_norm + (size_t)j * QRANK, nullptr, WB + WM_QB, 512, kb * 64, nb * 32, scr, lane);
                continue; }
            r -= 8 * 48;
            if (r < 4 * 64) {
                const int nb = r % 64, kb = r / 64, n = nb * 32 + nl;
                cv_item_vec(in.mla_w_kvb + (size_t)j * KVRANK * 2048 + n - nl, 2048, kb * 64, in.mla_kv_norm + (size_t)j * KVRANK, nullptr, WB + WM_KVB, 256, kb * 64, nb * 32, scr, lane); continue; }
            r -= 4 * 64;
            { const int nb = r % 32, kb = r / 32, n = nb * 32 + nl;
              cv_item_vec(in.mla_w_o + (size_t)j * 1024 * 1024 + n - nl, 1024, kb * 64, nullptr, nullptr, WB + WM_O, 1024, kb * 64, nb * 32, scr, lane); }
        } else if (kind == 1) {
            const float* gmix = in.mix_norm + (size_t)layer * D;
            if (r < 16 * 104) {
                const int nb = r % 104, kb = r / 104, n = nb * 32 + nl;
                const float* W = (n < ML_NIN) ? in.ml_w_in + (size_t)j * D * ML_NIN + n : nullptr;
                if (nb != 96) cv_item_vec(nb < 96 ? in.ml_w_in + (size_t)j * D * ML_NIN + nb * 32 : nullptr, ML_NIN, kb * 64, gmix, nullptr, WB + WL_IN, 1024, kb * 64, nb * 32, scr, lane);
                else cv_item(W, ML_NIN, kb * 64, gmix, nullptr, WB + WL_IN, 1024, kb * 64, nb * 32, scr, lane);
                continue; }
            r -= 16 * 104;
            { const int nb = r % 32, kb = r / 32, n = nb * 32 + nl;
              cv_item_vec(in.ml_w_o + (size_t)j * 1024 * 1024 + n - nl, 1024, kb * 64, nullptr, nullptr, WB + WL_O, 1024, kb * 64, nb * 32, scr, lane); }
        } else {
            const float* gmix = in.mix_norm + (size_t)layer * D;
            const float* mu = in.rw_mu + (size_t)j * 6 * D;
            if (r < 32 * 104) {
                const int nb = r % 104, kb = r / 104, n = nb * 32 + nl; const float* W; int ld; const float* m;
                if (n < 1024) { W = in.rw_w_r + (size_t)j * D * D + n; ld = D; m = mu + 0 * D; }
                else if (n < 2048) { W = in.rw_w_k + (size_t)j * D * D + (n - 1024); ld = D; m = mu + 2 * D; }
                else if (n < 3072) { W = in.rw_w_v + (size_t)j * D * D + (n - 2048); ld = D; m = mu + 3 * D; }
                else if (n < 3136) { W = in.rw_w1 + (size_t)j * D * 64 + (n - 3072); ld = 64; m = mu + 1 * D; }
                else if (n < 3200) { W = in.rw_a1 + (size_t)j * D * 64 + (n - 3136); ld = 64; m = mu + 4 * D; }
                else { W = in.rw_g1 + (size_t)j * D * 128 + (n - 3200); ld = 128; m = mu + 5 * D; }
                const int ks0 = (kb & 15) * 64;
                cv_item_vec(W - nl, ld, ks0, gmix, (kb >= 16) ? m : nullptr, WB + WR_BIG, 2048, kb * 64, nb * 32, scr, lane); continue; }
            r -= 32 * 104;
            if (r < 4 * 96) {
                const int nb = r % 96, kb = r / 96, n = nb * 32 + nl; const float* W = nullptr; int ld = 1024, ks0 = 0;
                if (n < 1024) { if (kb == 0) { W = in.rw_w2 + (size_t)j * 64 * D + n; ks0 = 0; } }
                else if (n < 2048) { if (kb == 1) { W = in.rw_a2 + (size_t)j * 64 * D + (n - 1024); ks0 = 0; } }
                else { if (kb >= 2) { W = in.rw_g2 + (size_t)j * 128 * D + (n - 2048); ks0 = (kb - 2) * 64; } }
                cv_item_vec(W ? W - nl : nullptr, ld, ks0, nullptr, nullptr, WB + WR_UP, 256, kb * 64, nb * 32, scr, lane); continue; }
            r -= 4 * 96;
            { const int nb = r % 32, kb = r / 32, n = nb * 32 + nl;
              cv_item_vec(in.rw_w_o + (size_t)j * 1024 * 1024 + n - nl, 1024, kb * 64, nullptr, nullptr, WB + WR_O, 1024, kb * 64, nb * 32, scr, lane); }
        }
    }
}

__device__ __forceinline__ void prologue(Frame& F, const Inputs& in) {
    for (int m = F.gw; m < T; m += F.NGW) {
        const GAS f32x4* xr = (const GAS f32x4*)(in.x + (size_t)m * D) + F.lane;
        GAS f32x4* xo = (GAS f32x4*)(F.X + (size_t)m * D) + F.lane;
        GAS v2u* xb = (GAS v2u*)(F.XB + (size_t)m * D) + F.lane;
        float s = 0.f;
#pragma unroll
        for (int jj = 0; jj < 4; ++jj) { const f32x4 v = xr[64 * jj]; xo[64 * jj] = v; s += (v.x * v.x + v.y * v.y) + (v.z * v.z + v.w * v.w);
            v2u w; w.x = cvtpk(v.x, v.y); w.y = cvtpk(v.z, v.w); xb[64 * jj] = w; }
        s = wave_sum(s);
        if (F.lane < 16) F.SS[(size_t)m * 16 + F.lane] = (F.lane == 0) ? s : 0.f;
    }
    float* COS = (float*)(F.ws + WS_COS); float* SIN = (float*)(F.ws + WS_SIN);
    for (int e = F.gw * 64 + F.lane; e < T * 32; e += F.NGW * 64) {
        const int t = e >> 5, i = e & 31;
        const float inv_freq = __builtin_amdgcn_exp2f(-(float)i * 0.41524101186092029f);
        const float ang = (float)in.positions[t] * inv_freq;
        float sn, cs; fsincos_big(ang, sn, cs);
        COS[e] = cs; SIN[e] = sn;
    }
}

__device__ __forceinline__ float rstd16(const float* SS, int row) {
    const GAS f32x4* p = (const GAS f32x4*)(SS + (size_t)row * 16);
    const f32x4 a = p[0], b = p[1], c = p[2], d = p[3];
    const float s = ((a.x + a.y) + (a.z + a.w)) + ((b.x + b.y) + (b.z + b.w)) + ((c.x + c.y) + (c.z + c.w)) + ((d.x + d.y) + (d.z + d.w));
    return frsq(s * (1.f / D) + RMS_EPS);
}

#define EPI_ROWS(ai, m) (u.pm * 256 + (ai) * 128 + wr * 64 + (m) * 16 + fr)
typedef const f32x4 (&AccT)[2][2][4][2];
using pg8::Unit;

struct EpiSwiGLU { static constexpr bool PERM = true, AFTER_DRAIN = false; const float* SS; bf16* ACT;
    __device__ __forceinline__ void operator()(AccT acc, const Unit& u, int wr, int wc, int fr, int fq) const {
        const int col = u.pn * 128 + wc * 32 + fq * 8;
#pragma unroll
        for (int ai = 0; ai < 2; ++ai)
#pragma unroll
            for (int m = 0; m < 4; ++m) { asm volatile("" ::: "memory"); const int row = EPI_ROWS(ai, m); const float r = rstd16(SS, row);
                float o[8];
#pragma unroll
                for (int n = 0; n < 2; ++n)
#pragma unroll
                    for (int e = 0; e < 4; ++e) { const float g = acc[ai][0][m][n][e] * r, up = acc[ai][1][m][n][e] * r; o[4 * n + e] = fsilu(g) * up; }
                *(GAS v4u*)(ACT + (size_t)row * FF + col) = pack8f(o); }
    }
};
struct EpiResidual { static constexpr bool PERM = true, AFTER_DRAIN = false; float* X; bf16* XB; float* SS; float scale;
    __device__ __forceinline__ void operator()(AccT acc, const Unit& u, int wr, int wc, int fr, int fq) const {
#pragma unroll
        for (int ai = 0; ai < 2; ++ai)
#pragma unroll
            for (int m = 0; m < 4; ++m) { asm volatile("" ::: "memory"); const int row = EPI_ROWS(ai, m); float ss = 0.f;
#pragma unroll
                for (int bj = 0; bj < 2; ++bj) { const int col = u.pn * 256 + bj * 128 + wc * 32 + fq * 8;
                    GAS f32x4* xp = (GAS f32x4*)(X + (size_t)row * D + col);
                    f32x4 x0 = xp[0], x1 = xp[1];
                    x0 = x0 + acc[ai][bj][m][0] * scale; x1 = x1 + acc[ai][bj][m][1] * scale;
                    xp[0] = x0; xp[1] = x1;
                    *(GAS v4u*)(XB + (size_t)row * D + col) = pack8v(x0, x1);
                    ss += (x0.x * x0.x + x0.y * x0.y) + (x0.z * x0.z + x0.w * x0.w) + (x1.x * x1.x + x1.y * x1.y) + (x1.z * x1.z + x1.w * x1.w); }
                ss += __shfl_xor(ss, 16); ss += __shfl_xor(ss, 32);
                if (fq == 0) SS[(size_t)row * 16 + u.pn * 4 + wc] = ss; }
    }
};
__device__ __forceinline__ void rope8(float* v, const float* COS, const float* SIN, int row, int p0) {
    const f32x4 c = *(const GAS f32x4*)(COS + (size_t)row * 32 + p0), s = *(const GAS f32x4*)(SIN + (size_t)row * 32 + p0);
#pragma unroll
    for (int p = 0; p < 4; ++p) { const float x1 = v[2 * p], x2 = v[2 * p + 1]; v[2 * p] = x1 * c[p] - x2 * s[p]; v[2 * p + 1] = x1 * s[p] + x2 * c[p]; }
}
struct EpiMlaA { static constexpr bool PERM = true, AFTER_DRAIN = false; const float* SS; bf16* LAT; float* SSQ; float* SSKV; bf16* KPE; const float* COS; const float* SIN;
    __device__ __forceinline__ void operator()(AccT acc, const Unit& u, int wr, int wc, int fr, int fq) const {
#pragma unroll
        for (int ai = 0; ai < 2; ++ai)
#pragma unroll
            for (int m = 0; m < 4; ++m) { asm volatile("" ::: "memory"); const int row = EPI_ROWS(ai, m); const float r = rstd16(SS, row); float ss = 0.f;
#pragma unroll
                for (int bj = 0; bj < 2; ++bj) { const int col = u.pn * 256 + bj * 128 + wc * 32 + fq * 8;
                    float v[8];
#pragma unroll
                    for (int n = 0; n < 2; ++n)
#pragma unroll
                        for (int e = 0; e < 4; ++e) { v[4 * n + e] = acc[ai][bj][m][n][e] * r; ss += v[4 * n + e] * v[4 * n + e]; }
                    *(GAS v4u*)(LAT + (size_t)row * 1024 + col) = pack8f(v);
                    if (u.pn == 3 && bj == 0 && wc < 2) { rope8(v, COS, SIN, row, wc * 16 + fq * 4); *(GAS v4u*)(KPE + (size_t)row * 64 + wc * 32 + fq * 8) = pack8f(v); } }
                ss += __shfl_xor(ss, 16); ss += __shfl_xor(ss, 32);
                if (fq == 0) { if (u.pn < 2) SSQ[(size_t)row * 8 + u.pn * 4 + wc] = ss; else if (u.pn == 2) SSKV[(size_t)row * 4 + wc] = ss; } }
    }
};
struct EpiMlaQ { static constexpr bool PERM = true, AFTER_DRAIN = false; const float* SSQ; bf16* Q; const float* COS; const float* SIN; float qscale;
    __device__ __forceinline__ void operator()(AccT acc, const Unit& u, int wr, int wc, int fr, int fq) const {
#pragma unroll
        for (int ai = 0; ai < 2; ++ai)
#pragma unroll
            for (int m = 0; m < 4; ++m) { asm volatile("" ::: "memory"); const int row = EPI_ROWS(ai, m);
                const GAS f32x4* p = (const GAS f32x4*)(SSQ + (size_t)row * 8); const f32x4 a = p[0], b = p[1];
                const float r = frsq((((a.x + a.y) + (a.z + a.w)) + ((b.x + b.y) + (b.z + b.w))) * (1.f / QRANK) + RMS_EPS) * qscale;
#pragma unroll
                for (int bj = 0; bj < 2; ++bj) { const int col = u.pn * 256 + bj * 128 + wc * 32 + fq * 8, hd = col / DQK, w = col - hd * DQK;
                    float v[8];
#pragma unroll
                    for (int n = 0; n < 2; ++n)
#pragma unroll
                        for (int e = 0; e < 4; ++e) v[4 * n + e] = acc[ai][bj][m][n][e] * r;
                    if (w >= NOPE) rope8(v, COS, SIN, row, (w - NOPE) >> 1);
                    *(GAS v4u*)(Q + (size_t)row * 1536 + col) = pack8f(v); } }
    }
};
struct EpiMlaKV { static constexpr bool PERM = true, AFTER_DRAIN = false; const float* SSKV; bf16* KV;
    __device__ __forceinline__ void operator()(AccT acc, const Unit& u, int wr, int wc, int fr, int fq) const {
#pragma unroll
        for (int ai = 0; ai < 2; ++ai)
#pragma unroll
            for (int m = 0; m < 4; ++m) { asm volatile("" ::: "memory"); const int row = EPI_ROWS(ai, m);
                const f32x4 a = *(const GAS f32x4*)(SSKV + (size_t)row * 4);
                const float r = frsq(((a.x + a.y) + (a.z + a.w)) * (1.f / KVRANK) + RMS_EPS);
#pragma unroll
                for (int bj = 0; bj < 2; ++bj) { const int col = u.pn * 256 + bj * 128 + wc * 32 + fq * 8;
                    *(GAS v4u*)(KV + (size_t)row * 2048 + col) = pack8v(acc[ai][bj][m][0] * r, acc[ai][bj][m][1] * r); } }
    }
};
struct EpiMlIn { static constexpr bool PERM = true, AFTER_DRAIN = false; const float* SS; bf16* P; float* GATES;
    __device__ __forceinline__ void operator()(AccT acc, const Unit& u, int wr, int wc, int fr, int fq) const {
#pragma unroll
        for (int ai = 0; ai < 2; ++ai)
#pragma unroll
            for (int m = 0; m < 4; ++m) { asm volatile("" ::: "memory"); const int row = EPI_ROWS(ai, m); const float r = rstd16(SS, row);
                if (u.pn < 12) {
#pragma unroll
                    for (int bj = 0; bj < 2; ++bj) { const int col = u.pn * 256 + bj * 128 + wc * 32 + fq * 8;
                        *(GAS v4u*)(P + (size_t)row * 3072 + col) = pack8v(acc[ai][bj][m][0] * r, acc[ai][bj][m][1] * r); }
                } else if (wc == 0 && fq < 2) {
                    GAS f32x4* g = (GAS f32x4*)(GATES + (size_t)row * 16 + fq * 8); g[0] = acc[ai][0][m][0] * r; g[1] = acc[ai][0][m][1] * r; } }
    }
};
struct EpiRwBig { static constexpr bool PERM = true, AFTER_DRAIN = false; bf16* RKV; bf16* LOR;
    __device__ __forceinline__ void operator()(AccT acc, const Unit& u, int wr, int wc, int fr, int fq) const {
#pragma unroll
        for (int ai = 0; ai < 2; ++ai)
#pragma unroll
            for (int m = 0; m < 4; ++m) { asm volatile("" ::: "memory"); const int row = EPI_ROWS(ai, m);
#pragma unroll
                for (int bj = 0; bj < 2; ++bj) { const int cl = bj * 128 + wc * 32 + fq * 8;
                    if (u.pn < 12) { *(GAS v4u*)(RKV + (size_t)row * 3072 + u.pn * 256 + cl) = pack8v(acc[ai][bj][m][0], acc[ai][bj][m][1]); }
                    else { float v[8];
#pragma unroll
                        for (int n = 0; n < 2; ++n)
#pragma unroll
                            for (int e = 0; e < 4; ++e) { const float a = acc[ai][bj][m][n][e]; v[4 * n + e] = (cl < 64) ? ftanh(a) : (cl < 128) ? a : fsigmoid(a); }
                        *(GAS v4u*)(LOR + (size_t)row * 256 + cl) = pack8f(v); } } }
    }
};
struct EpiRwUp { static constexpr bool PERM = true, AFTER_DRAIN = false; float* LW; bf16* AA; bf16* GG; const float* w0; const float* a0;
    __device__ __forceinline__ void operator()(AccT acc, const Unit& u, int wr, int wc, int fr, int fq) const {
        const int sec = u.pn >> 2;
#pragma unroll
        for (int ai = 0; ai < 2; ++ai)
#pragma unroll
            for (int m = 0; m < 4; ++m) { asm volatile("" ::: "memory"); const int row = EPI_ROWS(ai, m);
#pragma unroll
                for (int bj = 0; bj < 2; ++bj) { const int col = (u.pn & 3) * 256 + bj * 128 + wc * 32 + fq * 8;
                    if (sec == 0) {
#pragma unroll
                        for (int n = 0; n < 2; ++n) { const f32x4 b = *(const GAS f32x4*)(w0 + col + 4 * n); f32x4 o;
#pragma unroll
                            for (int e = 0; e < 4; ++e) { const float z = -(acc[ai][bj][m][n][e] + b[e]); const float sp = fmaxf(z, 0.f) + flog(1.f + fexp(-fabsf(z))); o[e] = -fexp(-sp - 0.5f); }
                            *(GAS f32x4*)(LW + (size_t)row * 1024 + col + 4 * n) = o; } }
                    else if (sec == 1) { const f32x4 b0 = *(const GAS f32x4*)(a0 + col), b1 = *(const GAS f32x4*)(a0 + col + 4); float v[8];
#pragma unroll
                        for (int e = 0; e < 4; ++e) { v[e] = fsigmoid(acc[ai][bj][m][0][e] + b0[e]); v[4 + e] = fsigmoid(acc[ai][bj][m][1][e] + b1[e]); }
                        *(GAS v4u*)(AA + (size_t)row * 1024 + col) = pack8f(v); }
                    else { *(GAS v4u*)(GG + (size_t)row * 1024 + col) = pack8v(acc[ai][bj][m][0], acc[ai][bj][m][1]); } } }
    }
};

namespace att {
constexpr int SHM_K = 64 * DQK * 2  , SHM_V = 64 * DVH * 2  ;
constexpr int OFF_V = 0, OFF_K = 2 * SHM_V, OFF_WS = OFF_K + 2 * SHM_K, ATT_LDS = OFF_WS + NWAVES * 64 * 4;
static_assert(ATT_LDS <= RING_BYTES, "attention LDS");
#define KSWZ(row, colB) ((row) * 384 + ((colB) ^ (((row) & 7) << 4)))
#define SBAR() __builtin_amdgcn_sched_barrier(0)
__device__ __forceinline__ int v_st(int k, int c) { const int kk = (k & ~0xC) | ((k & 4) << 1) | ((k & 8) >> 1); return ((kk >> 3) * 4 + (c >> 5)) * 512 + ((kk & 7) * 32 + (c & 31)) * 2; }
__device__ __forceinline__ int v_rd_base(int lane) { return ((lane & 3) << 3) | (((lane >> 2) & 3) << 6) | (((lane >> 4) & 1) << 5) | (((lane >> 5) & 1) << 8); }
constexpr int v_rd_off(int d0, int ks, int half) { return d0 * 512 + ks * 4096 + half * 2048; }
__device__ __forceinline__ int crow(int r, int hi) { return (r & 3) + 8 * (r >> 2) + 4 * hi; }
__device__ __forceinline__ void mask_tile(f32x16& p0, f32x16& p1, int dq) {
    const float NEG = -__builtin_inff();
#pragma unroll
    for (int r = 0; r < 16; ++r) { const int c = (r & 3) + 8 * (r >> 2);
        if (dq - c < 0) p0[r] = NEG;
        if (dq - c - 32 < 0) p1[r] = NEG; }
}
constexpr float THR2 = 11.5f;
__device__ __forceinline__ void partialSM(f32x16& p0, f32x16& p1, float& m_reg, float& alpha) {
    float pmax = p0[0];
#pragma unroll
    for (int r = 1; r < 16; ++r) pmax = fmaxf(pmax, p0[r]);
#pragma unroll
    for (int r = 0; r < 16; ++r) pmax = fmaxf(pmax, p1[r]);
    { auto rr = __builtin_amdgcn_permlane32_swap(__float_as_uint(pmax), __float_as_uint(pmax), false, false);
      pmax = fmaxf(__uint_as_float(rr[0]), __uint_as_float(rr[1])); }
    float mn;
    if (__builtin_expect(__all((pmax - m_reg) <= THR2), 1)) { mn = m_reg; alpha = 1.f; }
    else { mn = fmaxf(m_reg, pmax); alpha = __builtin_amdgcn_exp2f(m_reg - mn); m_reg = mn; }
#pragma unroll
    for (int r = 0; r < 16; ++r) { p0[r] = __builtin_amdgcn_exp2f(p0[r] - mn); p1[r] = __builtin_amdgcn_exp2f(p1[r] - mn); }
}
__device__ __forceinline__ void finishSM(f32x16& p0, f32x16& p1, float alpha, float& l_reg, bf16x8& pa0, bf16x8& pa1, bf16x8& pa2, bf16x8& pa3) {
    float ps = 0;
#pragma unroll
    for (int r = 0; r < 16; ++r) ps += p0[r];
#pragma unroll
    for (int r = 0; r < 16; ++r) ps += p1[r];
    { auto rr = __builtin_amdgcn_permlane32_swap(__float_as_uint(ps), __float_as_uint(ps), false, false);
      ps = __uint_as_float(rr[0]) + __uint_as_float(rr[1]); }
    l_reg = l_reg * alpha + ps;
#define PK4(P, B_, OUT) do { unsigned a0 = cvtpk(P[B_+0], P[B_+1]), a1 = cvtpk(P[B_+2], P[B_+3]);                          \
        unsigned b0 = cvtpk(P[B_+4], P[B_+5]), b1 = cvtpk(P[B_+6], P[B_+7]);                                             \
        auto r0 = __builtin_amdgcn_permlane32_swap(a0, b0, false, false); auto r1 = __builtin_amdgcn_permlane32_swap(a1, b1, false, false); \
        v4u w = {r0[0], r1[0], r0[1], r1[1]}; OUT = __builtin_bit_cast(bf16x8, w); } while (0)
    PK4(p0, 0, pa0); PK4(p0, 8, pa1); PK4(p1, 0, pa2); PK4(p1, 8, pa3);
#undef PK4
}
__device__ __forceinline__ void qkt(f32x16& p0, f32x16& p1, const LAS char* Kb, int r32, int hi, const bf16x8* qr) {
    p0 = f32x16{}; p1 = f32x16{};
    const LAS char* kb[4];
#pragma unroll
    for (int dd = 0; dd < 4; ++dd) kb[dd] = Kb + r32 * 384 + ((dd * 32 + hi * 16) ^ ((r32 & 7) << 4));
#pragma unroll
    for (int d0 = 0; d0 < 12; ++d0) { const LAS char* a = kb[d0 & 3] + (d0 >> 2) * 128;
        const bf16x8 b0 = *(const LAS bf16x8*)(a);
        const bf16x8 b1 = *(const LAS bf16x8*)(a + 32 * 384);
        p0 = __builtin_amdgcn_mfma_f32_32x32x16_bf16(b0, qr[d0], p0, 0, 0, 0);
        p1 = __builtin_amdgcn_mfma_f32_32x32x16_bf16(b1, qr[d0], p1, 0, 0, 0); }
}
__device__ __forceinline__ void pv_tile(f32x16* o, int vb0, bf16x8 pa0, bf16x8 pa1, bf16x8 pa2, bf16x8 pa3) {
#define TRRD(dst, off) asm volatile("ds_read_b64_tr_b16 %0, %1 offset:%2" : "=&v"(dst) : "v"(vb0), "i"(off) : "memory")
#define PV_D0(d0) do { s16x4 l0, l1, l2, l3, h0, h1, h2, h3; constexpr int b_ = v_rd_off(d0, 0, 0); \
        TRRD(l0, b_); TRRD(h0, b_ + 2048); TRRD(l1, b_ + 4096); TRRD(h1, b_ + 6144); TRRD(l2, b_ + 8192); TRRD(h2, b_ + 10240); TRRD(l3, b_ + 12288); TRRD(h3, b_ + 14336); \
        asm volatile("s_waitcnt lgkmcnt(0)" ::: "memory"); SBAR(); \
        o[d0] = __builtin_amdgcn_mfma_f32_32x32x16_bf16(pa0, (bf16x8){l0[0], l0[1], l0[2], l0[3], h0[0], h0[1], h0[2], h0[3]}, o[d0], 0, 0, 0);   \
        o[d0] = __builtin_amdgcn_mfma_f32_32x32x16_bf16(pa1, (bf16x8){l1[0], l1[1], l1[2], l1[3], h1[0], h1[1], h1[2], h1[3]}, o[d0], 0, 0, 0);   \
        o[d0] = __builtin_amdgcn_mfma_f32_32x32x16_bf16(pa2, (bf16x8){l2[0], l2[1], l2[2], l2[3], h2[0], h2[1], h2[2], h2[3]}, o[d0], 0, 0, 0);   \
        o[d0] = __builtin_amdgcn_mfma_f32_32x32x16_bf16(pa3, (bf16x8){l3[0], l3[1], l3[2], l3[3], h3[0], h3[1], h3[2], h3[3]}, o[d0], 0, 0, 0); } while (0)
    PV_D0(0); PV_D0(1); PV_D0(2); PV_D0(3);
#undef PV_D0
#undef TRRD
}
__device__ __forceinline__ void attn_unit(int wid, int b, int h, int qb, const bf16* Q, const bf16* KV, const bf16* KPE, bf16* O, LAS char* lds) {
    const int lane = fresh_lane(), tid = wid * 64 + lane, r32 = lane & 31, hi = lane >> 5;
    const size_t rowbase = (size_t)b * SEQ; const int q0 = qb * 256;
    LAS char* V_lds = lds + OFF_V; LAS char* K_lds = lds + OFF_K;
    LAS float* wsf = (LAS float*)(lds + OFF_WS) + wid * 64; LAS float* li_l = wsf; LAS float* al_l = wsf + 32;
    bf16x8 qr[12];
    { const bf16* Qw = Q + (rowbase + q0 + wid * 32 + r32) * 1536 + h * DQK + hi * 8;
#pragma unroll
      for (int d0 = 0; d0 < 12; ++d0) qr[d0] = *(const GAS bf16x8*)(Qw + d0 * 16); }
    const int NT = 4 * (qb + 1);
    const bf16* ksrc[3]; int kdst[3]; int kstr[3];
#pragma unroll
    for (int i = 0; i < 3; ++i) { const int id = tid + 512 * i, row = id / 24, ch = id - row * 24;
        if (ch < 16) { ksrc[i] = KV + (rowbase + row) * 2048 + h * 256 + ch * 8; kstr[i] = 2048; }
        else { ksrc[i] = KPE + (rowbase + row) * 64 + (ch - 16) * 8; kstr[i] = 64; }
        kdst[i] = KSWZ(row, ch * 16); }
    const int sr = tid >> 4, sc = (tid & 15) * 8;
    const bf16* vsrc = KV + (rowbase + sr) * 2048 + h * 256 + 128 + sc;
    const int vst0 = v_st(sr, sc), vst1 = v_st(32 + sr, sc);
    const int vb0 = (int)(uintptr_t)V_lds + v_rd_base(lane);
    bf16x8 sk0, sk1, sk2, sv0, sv1;
#define SLOAD(t) do { sk0 = *(const GAS bf16x8*)(ksrc[0] + (size_t)(t) * 64 * kstr[0]); sk1 = *(const GAS bf16x8*)(ksrc[1] + (size_t)(t) * 64 * kstr[1]); sk2 = *(const GAS bf16x8*)(ksrc[2] + (size_t)(t) * 64 * kstr[2]); \
                      sv0 = *(const GAS bf16x8*)(vsrc + (size_t)(t) * 64 * 2048); sv1 = *(const GAS bf16x8*)(vsrc + (size_t)((t) * 64 + 32) * 2048); } while (0)
#define SWRITE(bf) do { *(LAS bf16x8*)(K_lds + (bf) * SHM_K + kdst[0]) = sk0; *(LAS bf16x8*)(K_lds + (bf) * SHM_K + kdst[1]) = sk1; *(LAS bf16x8*)(K_lds + (bf) * SHM_K + kdst[2]) = sk2; \
                        *(LAS bf16x8*)(V_lds + (bf) * SHM_V + vst0) = sv0; *(LAS bf16x8*)(V_lds + (bf) * SHM_V + vst1) = sv1; } while (0)
    float m_reg = -1e30f, l_reg = 0.f; f32x16 o[4] = {};
    const int qlo = q0 + wid * 32, qm = qlo + r32 - 4 * hi;
    SLOAD(0); SWRITE(0);
    __syncthreads();
    for (int t = 0; t < NT; ++t) {
        const int bf = t & 1;
        if (t + 1 < NT) SLOAD(t + 1);
        f32x16 p0, p1; float alpha; bf16x8 pa0, pa1, pa2, pa3;
        SBAR();
        qkt(p0, p1, K_lds + bf * SHM_K, r32, hi, qr);
        const int kb = t * 64;
        if (kb + 63 > qlo) mask_tile(p0, p1, qm - kb);
        partialSM(p0, p1, m_reg, alpha);
        if (__any(alpha < 1.f)) { if (hi == 0) al_l[r32] = alpha; LDS_WAIT();
#pragma unroll
            for (int d_ = 0; d_ < 4; ++d_)
#pragma unroll
                for (int r = 0; r < 16; ++r) o[d_][r] *= al_l[crow(r, hi)]; }
        finishSM(p0, p1, alpha, l_reg, pa0, pa1, pa2, pa3);
        SBAR();
        pv_tile(o, vb0 + bf * SHM_V, pa0, pa1, pa2, pa3);
        if (t + 1 < NT) SWRITE(bf ^ 1);
        __syncthreads();
    }
    if (hi == 0) li_l[r32] = l_reg; LDS_WAIT();
    bf16* Ow = O + (rowbase + q0 + wid * 32) * 1024 + h * DVH;
#pragma unroll
    for (int r = 0; r < 16; ++r) { const int orow = crow(r, hi); const float rl = frcp(li_l[orow]);
#pragma unroll
        for (int d0 = 0; d0 < 4; ++d0) { const float v = o[d0][r] * rl; const float vn = __shfl_xor(v, 1);
            if ((r32 & 1) == 0) *(GAS unsigned*)(Ow + (size_t)orow * 1024 + d0 * 32 + r32) = cvtpk(v, vn); } }
    __syncthreads();
#undef SLOAD
#undef SWRITE
}
#undef KSWZ
}

__device__ __forceinline__ void ml_conv_phase(Frame& F, const Inputs& in, int j) {
    const bf16* P = (const bf16*)(F.ws + WS_ARENA + A_P); const float* GATES = (const float*)(F.ws + WS_ARENA + A_GATES);
    float* QKC = (float*)(F.ws + WS_ARENA + A_QKC); float* IGLF = (float*)(F.ws + WS_ARENA + A_IGLF);
    const float* cw = in.ml_conv_w + (size_t)j * 4 * 1024; const float* cb = in.ml_conv_b + (size_t)j * 1024; const float* bif = in.ml_b_if + (size_t)j * 16;
    const int gt = F.gw * 64 + F.lane, NT_ = F.NGW * 64;
    for (int e = gt; e < T * 128; e += NT_) {
        const int t = e >> 7, c = (e & 127) * 8, s = t & (SEQ - 1);
        float acc[8];
        { const f32x4 b0 = *(const GAS f32x4*)(cb + c), b1 = *(const GAS f32x4*)(cb + c + 4);
#pragma unroll
          for (int q = 0; q < 4; ++q) { acc[q] = b0[q]; acc[4 + q] = b1[q]; } }
#pragma unroll
        for (int k = 0; k < 4; ++k) { const int dt = 3 - k;
            if (s - dt >= 0) { float pv[8]; unpack8(*(const GAS v4u*)(P + (size_t)(t - dt) * 3072 + c), pv);
                const f32x4 w0 = *(const GAS f32x4*)(cw + k * 1024 + c), w1 = *(const GAS f32x4*)(cw + k * 1024 + c + 4);
#pragma unroll
                for (int q = 0; q < 4; ++q) { acc[q] += w0[q] * pv[q]; acc[4 + q] += w1[q] * pv[4 + q]; } } }
        const float sc = (c >= 512) ? 0.125f : 1.f;
        f32x4 o0, o1;
#pragma unroll
        for (int q = 0; q < 4; ++q) { o0[q] = fsilu(acc[q]) * sc; o1[q] = fsilu(acc[4 + q]) * sc; }
        GAS f32x4* op = (GAS f32x4*)(QKC + (size_t)t * 1024 + c); op[0] = o0; op[1] = o1;
    }
    for (int e = gt; e < T * 16; e += NT_) { const int hcol = e & 15; const float g = GATES[e] + bif[hcol];
        float r = g;
        if (hcol >= 8) r = fminf(g, 0.f) - flog(1.f + fexp(-fabsf(g)));
        IGLF[e] = r; }
}
__device__ __forceinline__ void ml_seq_phase(Frame& F) {
    if ((int)blockIdx.x >= BATCH * ML_H) return;
    const int bh = blockIdx.x, b = bh >> 3, h = bh & 7, tid = F.tid, v = tid >> 2, kq = tid & 3;
    const bf16* P = (const bf16*)(F.ws + WS_ARENA + A_P); const float* QKC = (const float*)(F.ws + WS_ARENA + A_QKC); const float* IGLF = (const float*)(F.ws + WS_ARENA + A_IGLF);
    float* HRAW = (float*)(F.ws + WS_ARENA + A_HRAW);
    LAS float* s_q = (LAS float*)F.lds; LAS float* s_k = s_q + 64 * 64; LAS float* s_v = s_k + 64 * 64; LAS float* s_h = s_v + 64 * 128; LAS float* s_ig = s_h + 64 * 128; LAS float* s_lf = s_ig + 64;
    float C[16], n[16]; float mst = 0.f;
#pragma unroll
    for (int d = 0; d < 16; ++d) { C[d] = 0.f; n[d] = 0.f; }
    for (int blk = 0; blk < SEQ / 64; ++blk) {
        const size_t t0 = (size_t)b * SEQ + (size_t)blk * 64;
        __syncthreads();
        for (int e = tid; e < 64 * 16; e += 512) { const int tt = e >> 4, c4 = (e & 15) * 4;
            *(LAS f32x4*)(s_q + tt * 64 + c4) = *(const GAS f32x4*)(QKC + (t0 + tt) * 1024 + h * 64 + c4);
            *(LAS f32x4*)(s_k + tt * 64 + c4) = *(const GAS f32x4*)(QKC + (t0 + tt) * 1024 + 512 + h * 64 + c4); }
        for (int e = tid; e < 64 * 16; e += 512) { const int tt = e >> 4, c8 = (e & 15) * 8; float pv[8];
            unpack8(*(const GAS v4u*)(P + (t0 + tt) * 3072 + 1024 + h * 128 + c8), pv);
#pragma unroll
            for (int q = 0; q < 8; ++q) s_v[tt * 128 + c8 + q] = pv[q]; }
        if (tid < 64) { s_ig[tid] = IGLF[(t0 + tid) * 16 + h]; s_lf[tid] = IGLF[(t0 + tid) * 16 + 8 + h]; }
        __syncthreads();
        for (int tt = 0; tt < 64; ++tt) {
            const float lf = s_lf[tt], ig = s_ig[tt];
            const float mn = fmaxf(lf + mst, ig), fw = fexp(lf + mst - mn), iw = fexp(ig - mn); mst = mn;
            const float vv = s_v[tt * 128 + v] * iw;
            float num = 0.f, den = 0.f;
#pragma unroll
            for (int d4 = 0; d4 < 4; ++d4) { const f32x4 kk = *(const LAS f32x4*)(s_k + tt * 64 + kq * 16 + d4 * 4), qq = *(const LAS f32x4*)(s_q + tt * 64 + kq * 16 + d4 * 4);
#pragma unroll
                for (int q = 0; q < 4; ++q) { const int d = d4 * 4 + q; C[d] = fw * C[d] + vv * kk[q]; n[d] = fw * n[d] + iw * kk[q]; num += C[d] * qq[q]; den += n[d] * qq[q]; } }
            num += __shfl_xor(num, 1); num += __shfl_xor(num, 2); den += __shfl_xor(den, 1); den += __shfl_xor(den, 2);
            const float hv = num * frcp(fmaxf(fabsf(den), fexp(-mn)));
            if (kq == 0) s_h[tt * 128 + v] = hv;
        }
        __syncthreads();
        for (int e = tid; e < 64 * 32; e += 512) { const int tt = e >> 5, c4 = (e & 31) * 4;
            *(GAS f32x4*)(HRAW + (t0 + tt) * 1024 + h * 128 + c4) = *(const LAS f32x4*)(s_h + tt * 128 + c4); }
    }
}
__device__ __forceinline__ void ml_out_phase(Frame& F, const Inputs& in, int j) {
    const bf16* P = (const bf16*)(F.ws + WS_ARENA + A_P); const float* HRAW = (const float*)(F.ws + WS_ARENA + A_HRAW); bf16* HM = (bf16*)(F.ws + WS_ARENA + A_HM);
    const float* gn = in.ml_out_norm + (size_t)j * 1024;
    for (int m = F.gw; m < T; m += F.NGW) { const int c = F.lane * 16;
        float hv[16]; float ss = 0.f;
#pragma unroll
        for (int q = 0; q < 4; ++q) { const f32x4 x = *(const GAS f32x4*)(HRAW + (size_t)m * 1024 + c + 4 * q);
#pragma unroll
            for (int e = 0; e < 4; ++e) { hv[4 * q + e] = x[e]; ss += x[e] * x[e]; } }
        ss += __shfl_xor(ss, 1); ss += __shfl_xor(ss, 2); ss += __shfl_xor(ss, 4);
        const float r = frsq(ss * (1.f / 128.f) + RMS_EPS);
        float ov[16]; unpack8(*(const GAS v4u*)(P + (size_t)m * 3072 + 2048 + c), ov); unpack8(*(const GAS v4u*)(P + (size_t)m * 3072 + 2048 + c + 8), ov + 8);
        float res[16];
#pragma unroll
        for (int e = 0; e < 16; ++e) res[e] = hv[e] * r * gn[c + e] * fsigmoid(ov[e]);
        GAS v4u* op = (GAS v4u*)(HM + (size_t)m * 1024 + c); op[0] = pack8f(res); op[1] = pack8f(res + 8);
    }
}

__device__ __forceinline__ void rw_shift_phase(Frame& F) {
    bf16* HX = (bf16*)(F.ws + WS_ARENA + A_HX);
    for (int m = F.gw; m < T; m += F.NGW) { const int c = F.lane * 16, s = m & (SEQ - 1);
        const float r = rstd16(F.SS, m), rp = (s > 0) ? rstd16(F.SS, m - 1) : 0.f;
        float hv[16], xv[16];
#pragma unroll
        for (int q = 0; q < 4; ++q) { const f32x4 x = *(const GAS f32x4*)(F.X + (size_t)m * D + c + 4 * q);
            f32x4 xp = {0.f, 0.f, 0.f, 0.f}; if (s > 0) xp = *(const GAS f32x4*)(F.X + (size_t)(m - 1) * D + c + 4 * q);
#pragma unroll
            for (int e = 0; e < 4; ++e) { hv[4 * q + e] = x[e] * r; xv[4 * q + e] = xp[e] * rp - x[e] * r; } }
        GAS v4u* o1 = (GAS v4u*)(HX + (size_t)m * 2048 + c); o1[0] = pack8f(hv); o1[1] = pack8f(hv + 8);
        GAS v4u* o2 = (GAS v4u*)(HX + (size_t)m * 2048 + 1024 + c); o2[0] = pack8f(xv); o2[1] = pack8f(xv + 8);
    }
}
__device__ __forceinline__ void rw_seq_phase(Frame& F, const Inputs& in, int j) {
    if ((int)blockIdx.x >= BATCH * RW_H) return;
    const int bh = blockIdx.x, b = bh >> 4, h = bh & 15, tid = F.tid, i = tid >> 3, jr = tid & 7;
    const bf16* RKV = (const bf16*)(F.ws + WS_ARENA + A_RKV); const bf16* AA = (const bf16*)(F.ws + WS_XB); float* LW = (float*)(F.ws + WS_ARENA + A_LW);
    LAS float* s_r = (LAS float*)F.lds; LAS float* s_w = s_r + 4096; LAS float* s_k = s_w + 4096; LAS float* s_v = s_k + 4096; LAS float* s_a = s_v + 4096; LAS float* s_b = s_a + 4096; LAS float* s_y = s_b + 4096;
    float kkc[8], kac[8];
#pragma unroll
    for (int q = 0; q < 8; ++q) { kkc[q] = in.rw_k_k[(size_t)j * 1024 + h * 64 + jr * 8 + q]; kac[q] = in.rw_k_a[(size_t)j * 1024 + h * 64 + jr * 8 + q]; }
    float S[8];
#pragma unroll
    for (int q = 0; q < 8; ++q) S[q] = 0.f;
    for (int blk = 0; blk < SEQ / 64; ++blk) {
        const size_t t0 = (size_t)b * SEQ + (size_t)blk * 64;
        __syncthreads();
        { const int tt = tid >> 3; const size_t t = t0 + tt; const int c = h * 64 + jr * 8;
          float rv[8], kv[8], vv[8], av[8];
          unpack8(*(const GAS v4u*)(RKV + t * 3072 + c), rv); unpack8(*(const GAS v4u*)(RKV + t * 3072 + 1024 + c), kv); unpack8(*(const GAS v4u*)(RKV + t * 3072 + 2048 + c), vv);
          unpack8(*(const GAS v4u*)(AA + t * 1024 + c), av);
          const f32x4 l0 = *(const GAS f32x4*)(LW + t * 1024 + c), l1 = *(const GAS f32x4*)(LW + t * 1024 + c + 4);
          float kk[8]; float ss = 0.f;
#pragma unroll
          for (int q = 0; q < 8; ++q) { kk[q] = kv[q] * kkc[q]; ss += kk[q] * kk[q]; }
          ss += __shfl_xor(ss, 1); ss += __shfl_xor(ss, 2); ss += __shfl_xor(ss, 4);
          const float inv = frcp(fmaxf(fsqrt(ss), 1e-12f));
#pragma unroll
          for (int q = 0; q < 8; ++q) { const float kn = kk[q] * inv; const int o = tt * 64 + jr * 8 + q;
              s_r[o] = rv[q]; s_w[o] = fexp(q < 4 ? l0[q] : l1[q - 4]); s_k[o] = kv[q] * (1.f + (av[q] - 1.f) * kac[q]); s_v[o] = vv[q]; s_a[o] = -kn; s_b[o] = kn * av[q]; } }
        __syncthreads();
        for (int tt = 0; tt < 64; ++tt) {
            const int o = tt * 64 + jr * 8;
            const f32x4 a0 = *(const LAS f32x4*)(s_a + o), a1 = *(const LAS f32x4*)(s_a + o + 4), w0 = *(const LAS f32x4*)(s_w + o), w1 = *(const LAS f32x4*)(s_w + o + 4);
            const f32x4 b0 = *(const LAS f32x4*)(s_b + o), b1 = *(const LAS f32x4*)(s_b + o + 4), k0 = *(const LAS f32x4*)(s_k + o), k1 = *(const LAS f32x4*)(s_k + o + 4);
            const f32x4 r0 = *(const LAS f32x4*)(s_r + o), r1 = *(const LAS f32x4*)(s_r + o + 4);
            const float vi = s_v[tt * 64 + i];
            float sa = 0.f;
#pragma unroll
            for (int q = 0; q < 4; ++q) { sa += S[q] * a0[q]; sa += S[4 + q] * a1[q]; }
            sa += __shfl_xor(sa, 1); sa += __shfl_xor(sa, 2); sa += __shfl_xor(sa, 4);
            float y = 0.f;
#pragma unroll
            for (int q = 0; q < 4; ++q) { S[q] = S[q] * w0[q] + sa * b0[q] + vi * k0[q]; S[4 + q] = S[4 + q] * w1[q] + sa * b1[q] + vi * k1[q]; y += S[q] * r0[q]; y += S[4 + q] * r1[q]; }
            y += __shfl_xor(y, 1); y += __shfl_xor(y, 2); y += __shfl_xor(y, 4);
            if (jr == 0) s_y[tt * 64 + i] = y;
        }
        __syncthreads();
        for (int e = tid; e < 64 * 16; e += 512) { const int tt = e >> 4, c4 = (e & 15) * 4;
            *(GAS f32x4*)(LW + (t0 + tt) * 1024 + h * 64 + c4) = *(const LAS f32x4*)(s_y + tt * 64 + c4); }
    }
}
__device__ __forceinline__ void rw_out_phase(Frame& F, const Inputs& in, int j) {
    const bf16* RKV = (const bf16*)(F.ws + WS_ARENA + A_RKV); const bf16* AA = (const bf16*)(F.ws + WS_XB); const float* Y = (const float*)(F.ws + WS_ARENA + A_LW);
    const bf16* GG = (const bf16*)(F.ws + WS_ARENA + A_GG); bf16* YG = (bf16*)(F.ws + WS_ARENA + A_YG);
    const float* ka = in.rw_k_a + (size_t)j * 1024; const float* rk = in.rw_r_k + (size_t)j * 1024; const float* lnw = in.rw_ln_w + (size_t)j * 1024; const float* lnb = in.rw_ln_b + (size_t)j * 1024;
    for (int m = F.gw; m < T; m += F.NGW) { const int c = F.lane * 16;
        float yv[16]; float s1 = 0.f;
#pragma unroll
        for (int q = 0; q < 4; ++q) { const f32x4 x = *(const GAS f32x4*)(Y + (size_t)m * 1024 + c + 4 * q);
#pragma unroll
            for (int e = 0; e < 4; ++e) { yv[4 * q + e] = x[e]; s1 += x[e]; } }
        s1 += __shfl_xor(s1, 1); s1 += __shfl_xor(s1, 2); const float mean = s1 * (1.f / 64.f);
        float s2 = 0.f;
#pragma unroll
        for (int e = 0; e < 16; ++e) { yv[e] -= mean; s2 += yv[e] * yv[e]; }
        s2 += __shfl_xor(s2, 1); s2 += __shfl_xor(s2, 2); const float rs = frsq(s2 * (1.f / 64.f) + 64e-5f);
        float rv[16], kv[16], vv[16], av[16], gv[16];
        unpack8(*(const GAS v4u*)(RKV + (size_t)m * 3072 + c), rv); unpack8(*(const GAS v4u*)(RKV + (size_t)m * 3072 + c + 8), rv + 8);
        unpack8(*(const GAS v4u*)(RKV + (size_t)m * 3072 + 1024 + c), kv); unpack8(*(const GAS v4u*)(RKV + (size_t)m * 3072 + 1024 + c + 8), kv + 8);
        unpack8(*(const GAS v4u*)(RKV + (size_t)m * 3072 + 2048 + c), vv); unpack8(*(const GAS v4u*)(RKV + (size_t)m * 3072 + 2048 + c + 8), vv + 8);
        unpack8(*(const GAS v4u*)(AA + (size_t)m * 1024 + c), av); unpack8(*(const GAS v4u*)(AA + (size_t)m * 1024 + c + 8), av + 8);
        unpack8(*(const GAS v4u*)(GG + (size_t)m * 1024 + c), gv); unpack8(*(const GAS v4u*)(GG + (size_t)m * 1024 + c + 8), gv + 8);
        float bs = 0.f;
#pragma unroll
        for (int e = 0; e < 16; ++e) { const float kp = kv[e] * (1.f + (av[e] - 1.f) * ka[c + e]); bs += rv[e] * kp * rk[c + e]; }
        bs += __shfl_xor(bs, 1); bs += __shfl_xor(bs, 2);
        float res[16];
#pragma unroll
        for (int e = 0; e < 16; ++e) res[e] = (yv[e] * rs * lnw[c + e] + lnb[c + e] + bs * vv[e]) * gv[e];
        GAS v4u* op = (GAS v4u*)(YG + (size_t)m * 1024 + c); op[0] = pack8f(res); op[1] = pack8f(res + 8);
    }
}
__device__ __forceinline__ void final_norm_phase(Frame& F, const Inputs& in) {
    for (int m = F.gw; m < T; m += F.NGW) { const float r = rstd16(F.SS, m);
        GAS f32x4* xp = (GAS f32x4*)(F.X + (size_t)m * D) + F.lane; const GAS f32x4* gp = (const GAS f32x4*)in.final_norm + F.lane;
#pragma unroll
        for (int q = 0; q < 4; ++q) { f32x4 x = xp[64 * q]; const f32x4 g = gp[64 * q]; x = x * r * g; xp[64 * q] = x; } }
}

namespace mlc {
constexpr int NUNIT = BATCH * ML_H * (SEQ / 64);
constexpr size_t A_QKB = 97 * MiB;
constexpr size_t A_XT = 130 * MiB;
constexpr size_t A_CT = 194 * MiB;
constexpr size_t A_NX = 226 * MiB, A_NC = 227 * MiB;
constexpr size_t A_SC = 228 * MiB;
constexpr size_t A_HM2 = A_XT;
constexpr size_t A_IG2 = 129 * MiB;
constexpr int SLOT = 34816;
using att::v_st; using att::v_rd_base; using att::v_rd_off; using att::crow;
#define TRRD(dst, base, off) asm volatile("ds_read_b64_tr_b16 %0, %1 offset:%2" : "=&v"(dst) : "v"(base), "i"(off) : "memory")
#define FRAG(l, h) ((bf16x8){l[0], l[1], l[2], l[3], h[0], h[1], h[2], h[3]})
__device__ __forceinline__ float swap_add(float x) { auto rr = __builtin_amdgcn_permlane32_swap(__float_as_uint(x), __float_as_uint(x), false, false); return __uint_as_float(rr[0]) + __uint_as_float(rr[1]); }
__device__ __forceinline__ float wave_incl_scan_add(float v, int lane) {
#pragma unroll
    for (int o = 1; o < 64; o <<= 1) { const float t = __shfl_up(v, o); if (lane >= o) v += t; }
    return v;
}
__device__ __forceinline__ float wave_incl_scan_max(float v, int lane) {
#pragma unroll
    for (int o = 1; o < 64; o <<= 1) { const float t = __shfl_up(v, o); if (lane >= o) v = fmaxf(v, t); }
    return v;
}
__device__ __forceinline__ float wave_max(float v) {
#pragma unroll
    for (int o = 1; o < 64; o <<= 1) v = fmaxf(v, __shfl_xor(v, o));
    return v;
}
__device__ __forceinline__ void conv_phase(Frame& F, const Inputs& in, int j) {
    const bf16* P = (const bf16*)(F.ws + WS_ARENA + A_P); const float* GATES = (const float*)(F.ws + WS_ARENA + A_GATES);
    bf16* QKB = (bf16*)(F.ws + WS_ARENA + A_QKB); float* IGLF = (float*)(F.ws + WS_ARENA + mlc::A_IG2);
    const float* cw = in.ml_conv_w + (size_t)j * 4 * 1024; const float* cb = in.ml_conv_b + (size_t)j * 1024; const float* bif = in.ml_b_if + (size_t)j * 16;
    const int gt = F.gw * 64 + F.lane, NT_ = F.NGW * 64;
    for (int e = gt; e < T * 128; e += NT_) {
        const int t = e >> 7, c = (e & 127) * 8, s = t & (SEQ - 1);
        float acc[8];
        { const f32x4 b0 = *(const GAS f32x4*)(cb + c), b1 = *(const GAS f32x4*)(cb + c + 4);
#pragma unroll
          for (int q = 0; q < 4; ++q) { acc[q] = b0[q]; acc[4 + q] = b1[q]; } }
#pragma unroll
        for (int k = 0; k < 4; ++k) { const int dt = 3 - k;
            if (s - dt >= 0) { float pv[8]; unpack8(*(const GAS v4u*)(P + (size_t)(t - dt) * 3072 + c), pv);
                const f32x4 w0 = *(const GAS f32x4*)(cw + k * 1024 + c), w1 = *(const GAS f32x4*)(cw + k * 1024 + c + 4);
#pragma unroll
                for (int q = 0; q < 4; ++q) { acc[q] += w0[q] * pv[q]; acc[4 + q] += w1[q] * pv[4 + q]; } } }
        const float sc = (c >= 512) ? 0.125f : 1.f;
        float o[8];
#pragma unroll
        for (int q = 0; q < 8; ++q) o[q] = fsilu(acc[q]) * sc;
        *(GAS v4u*)(QKB + (size_t)t * 1024 + c) = pack8f(o);
    }
    for (int e = gt; e < T * 16; e += NT_) { const int hcol = e & 15; const float g = GATES[e] + bif[hcol];
        float r = g;
        if (hcol >= 8) r = fminf(g, 0.f) - flog(1.f + fexp(-fabsf(g)));
        IGLF[e] = r; }
}
__device__ __forceinline__ void stage_tr128(LAS char* tile, const bf16* src, int ld, int lt, int nthr) {
    for (int idx = lt; idx < 1024; idx += nthr) { const int row = idx >> 4, ch = idx & 15;
        *(LAS v4u*)(tile + v_st(row, ch * 8)) = *(const GAS v4u*)(src + (size_t)row * ld + ch * 8); }
}
__device__ __forceinline__ void xa_phase(Frame& F) {
    const bf16* P = (const bf16*)(F.ws + WS_ARENA + A_P); const bf16* QKB = (const bf16*)(F.ws + WS_ARENA + A_QKB); const float* IGLF = (const float*)(F.ws + WS_ARENA + mlc::A_IG2);
    float* XT = (float*)(F.ws + WS_ARENA + A_XT); float* NX = (float*)(F.ws + WS_ARENA + A_NX); float* SC = (float*)(F.ws + WS_ARENA + A_SC);
    const int lane = F.lane, wave = F.wave, r32 = lane & 31, hi = lane >> 5, us = wave >> 1, half = wave & 1, lt = half * 64 + lane;
    LAS char* slot = (LAS char*)F.lds + us * SLOT; LAS char* Vt = slot; LAS char* KWt = slot + 16384; LAS float* wsl = (LAS float*)(slot + 32768);
    for (int u0 = (int)blockIdx.x * 4; u0 < NUNIT; u0 += F.G * 4) {
        const int u = u0 + us, bh = u >> 7, c = u & 127, b = bh >> 3, h = bh & 7; const size_t t0 = (size_t)b * SEQ + (size_t)c * 64;
        const float lf = IGLF[(t0 + lane) * 16 + 8 + h], ig = IGLF[(t0 + lane) * 16 + h];
        const float Fc = wave_incl_scan_add(lf, lane), bs = ig - Fc, M = wave_max(bs), a = __shfl(Fc, 63), w = fexp(bs - M);
        if (half == 0) { wsl[lane] = w; if (lane == 0) { SC[u] = a; SC[NUNIT + u] = M; } }
        __syncthreads();
        stage_tr128(Vt, P + t0 * 3072 + 1024 + h * 128, 3072, lt, 128);
        for (int idx = lt; idx < 512; idx += 128) { const int row = idx >> 3, ch = idx & 7; float kv[8];
            unpack8(*(const GAS v4u*)(QKB + (t0 + row) * 1024 + 512 + h * 64 + ch * 8), kv); const float ww = wsl[row];
#pragma unroll
            for (int q = 0; q < 8; ++q) kv[q] *= ww;
            *(LAS v4u*)(KWt + v_st(row, ch * 8)) = pack8f(kv); }
        __syncthreads();
        const int vb = (int)(uintptr_t)Vt + v_rd_base(lane), kb = (int)(uintptr_t)KWt + v_rd_base(lane) + half * 512;
        f32x16 acc[4] = {};
#define XA_VT(vt) do { s16x4 vl0, vh0, vl1, vh1, vl2, vh2, vl3, vh3, kl0, kh0, kl1, kh1, kl2, kh2, kl3, kh3; constexpr int o_ = v_rd_off(vt, 0, 0); \
            TRRD(vl0, vb, o_); TRRD(vh0, vb, o_ + 2048); TRRD(vl1, vb, o_ + 4096); TRRD(vh1, vb, o_ + 6144); TRRD(vl2, vb, o_ + 8192); TRRD(vh2, vb, o_ + 10240); TRRD(vl3, vb, o_ + 12288); TRRD(vh3, vb, o_ + 14336); \
            TRRD(kl0, kb, 0); TRRD(kh0, kb, 2048); TRRD(kl1, kb, 4096); TRRD(kh1, kb, 6144); TRRD(kl2, kb, 8192); TRRD(kh2, kb, 10240); TRRD(kl3, kb, 12288); TRRD(kh3, kb, 14336); \
            asm volatile("s_waitcnt lgkmcnt(0)" ::: "memory"); __builtin_amdgcn_sched_barrier(0); \
            acc[vt] = __builtin_amdgcn_mfma_f32_32x32x16_bf16(FRAG(vl0, vh0), FRAG(kl0, kh0), acc[vt], 0, 0, 0); \
            acc[vt] = __builtin_amdgcn_mfma_f32_32x32x16_bf16(FRAG(vl1, vh1), FRAG(kl1, kh1), acc[vt], 0, 0, 0); \
            acc[vt] = __builtin_amdgcn_mfma_f32_32x32x16_bf16(FRAG(vl2, vh2), FRAG(kl2, kh2), acc[vt], 0, 0, 0); \
            acc[vt] = __builtin_amdgcn_mfma_f32_32x32x16_bf16(FRAG(vl3, vh3), FRAG(kl3, kh3), acc[vt], 0, 0, 0); } while (0)
        XA_VT(0); XA_VT(1); XA_VT(2); XA_VT(3);
#undef XA_VT
        { const int d = half * 32 + r32; float nx = 0.f;
#pragma unroll 8
          for (int s = 0; s < 32; ++s) nx += bf1(*(const LAS bf16*)(KWt + v_st(32 * hi + s, d & ~7) + (d & 7) * 2));
          nx = swap_add(nx);
          if (hi == 0) NX[(size_t)u * 64 + d] = nx; }
        { GAS float* xo = (GAS float*)(XT + (size_t)u * 8192 + half * 32 + r32 + hi * 256);
#pragma unroll
          for (int vt = 0; vt < 4; ++vt)
#pragma unroll
              for (int r4 = 0; r4 < 4; ++r4) { asm volatile("" : "+v"(xo));
#pragma unroll
                  for (int r0 = 0; r0 < 4; ++r0) xo[r0 * 64] = acc[vt][r4 * 4 + r0];
                  xo += 512; } }
        __syncthreads();
    }
}
__device__ __forceinline__ void xb_phase(Frame& F) {
    const float* XT = (const float*)(F.ws + WS_ARENA + A_XT); const float* NX = (const float*)(F.ws + WS_ARENA + A_NX); float* SC = (float*)(F.ws + WS_ARENA + A_SC);
    bf16* CT = (bf16*)(F.ws + WS_ARENA + A_CT); float* NC = (float*)(F.ws + WS_ARENA + A_NC);
    for (int g = (int)blockIdx.x * 512 + F.tid; g < BATCH * ML_H * 8192; g += F.G * 512) {
        const int bh = g >> 13, e = g & 8191;
        float m = 0.f, C = 0.f, n = 0.f;
#pragma unroll 8
        for (int c = 0; c < 128; ++c) { const int u = bh * 128 + c;
            const float a = SC[u], M = SC[NUNIT + u];
            const float x = XT[(size_t)u * 8192 + e];
            CT[(size_t)u * 8192 + e] = (bf16)(cvtpk(C, 0.f) & 0xffffu);
            const float mn = a + fmaxf(m, M), fC = fexp(a + m - mn), fX = fexp(a + M - mn);
            if (e < 64) { NC[(size_t)u * 64 + e] = n; n = fC * n + fX * NX[(size_t)u * 64 + e]; }
            if (e == 0) SC[2 * NUNIT + u] = m;
            C = fC * C + fX * x; m = mn; }
    }
}
__device__ __forceinline__ void xc_phase(Frame& F, const Inputs& in, int j) {
    const bf16* P = (const bf16*)(F.ws + WS_ARENA + A_P); const bf16* QKB = (const bf16*)(F.ws + WS_ARENA + A_QKB); const float* IGLF = (const float*)(F.ws + WS_ARENA + mlc::A_IG2);
    const bf16* CT = (const bf16*)(F.ws + WS_ARENA + A_CT); const float* NC = (const float*)(F.ws + WS_ARENA + A_NC); const float* SC = (const float*)(F.ws + WS_ARENA + A_SC);
    bf16* HM = (bf16*)(F.ws + WS_ARENA + A_HM2); const float* gn = in.ml_out_norm + (size_t)j * 1024;
    const int lane = F.lane, wave = F.wave, r32 = lane & 31, hi = lane >> 5, us = wave >> 1, th = wave & 1, lt = th * 64 + lane;
    LAS char* slot = (LAS char*)F.lds + us * SLOT; LAS char* Kt = slot; LAS char* Vt = slot + 8192;
    LAS float* sb = (LAS float*)(slot + 24576); LAS float* se = sb + 64; LAS float* sF = se + 64; LAS float* sn = sF + 64;
    LAS float* ob = (LAS float*)(slot + th * 16896);
    for (int u0 = (int)blockIdx.x * 4; u0 < NUNIT; u0 += F.G * 4) {
        const int u = u0 + us, bh = u >> 7, c = u & 127, b = bh >> 3, h = bh & 7; const size_t t0 = (size_t)b * SEQ + (size_t)c * 64;
        const float mc = SC[2 * NUNIT + u];
        { const float lf = IGLF[(t0 + lane) * 16 + 8 + h], ig = IGLF[(t0 + lane) * 16 + h];
          const float Fc = wave_incl_scan_add(lf, lane), bs = ig - Fc, Mt = wave_incl_scan_max(bs, lane);
          if (th == 0) { sb[lane] = bs; se[lane] = fmaxf(mc, Mt); sF[lane] = Fc; sn[lane] = NC[(size_t)u * 64 + lane]; } }
        for (int idx = lt; idx < 512; idx += 128) { const int row = idx >> 3, ch = idx & 7;
            *(LAS v4u*)(Kt + row * 128 + ((ch * 16) ^ ((row & 7) << 4))) = *(const GAS v4u*)(QKB + (t0 + row) * 1024 + 512 + h * 64 + ch * 8); }
        stage_tr128(Vt, P + t0 * 3072 + 1024 + h * 128, 3072, lt, 128);
        const int tl = th * 32 + r32;
        bf16x8 qr[4];
#pragma unroll
        for (int d0 = 0; d0 < 4; ++d0) qr[d0] = *(const GAS bf16x8*)(QKB + (t0 + tl) * 1024 + h * 64 + d0 * 16 + hi * 8);
        __syncthreads();
        const float et = se[tl], Fct = sF[tl], iw = fexp(mc - et);
        f32x16 p0 = {}, p1 = {};
#pragma unroll
        for (int d0 = 0; d0 < 4; ++d0) { const int cb = (d0 * 32 + hi * 16) ^ ((r32 & 7) << 4);
            const bf16x8 k0 = *(const LAS bf16x8*)(Kt + r32 * 128 + cb);
            p0 = __builtin_amdgcn_mfma_f32_32x32x16_bf16(k0, qr[d0], p0, 0, 0, 0);
            if (th) { const bf16x8 k1 = *(const LAS bf16x8*)(Kt + (32 + r32) * 128 + cb); p1 = __builtin_amdgcn_mfma_f32_32x32x16_bf16(k1, qr[d0], p1, 0, 0, 0); } }
        float dsum = 0.f;
#pragma unroll
        for (int r = 0; r < 16; ++r) { const int s0 = crow(r, hi);
            const float w0 = (s0 <= tl) ? fexp(sb[s0] - et) : 0.f; p0[r] *= w0; dsum += p0[r];
            const float w1 = (th && s0 + 32 <= tl) ? fexp(sb[s0 + 32] - et) : 0.f; p1[r] *= w1; dsum += p1[r]; }
        dsum = swap_add(dsum);
        bf16x8 pa0, pa1, pa2, pa3;
#define PK4(Pv, B_, OUT) do { unsigned a0 = cvtpk(Pv[B_+0], Pv[B_+1]), a1 = cvtpk(Pv[B_+2], Pv[B_+3]); unsigned b0 = cvtpk(Pv[B_+4], Pv[B_+5]), b1 = cvtpk(Pv[B_+6], Pv[B_+7]); \
        auto r0 = __builtin_amdgcn_permlane32_swap(a0, b0, false, false); auto r1 = __builtin_amdgcn_permlane32_swap(a1, b1, false, false); \
        v4u w_ = {r0[0], r1[0], r0[1], r1[1]}; OUT = __builtin_bit_cast(bf16x8, w_); } while (0)
        PK4(p0, 0, pa0); PK4(p0, 8, pa1); PK4(p1, 0, pa2); PK4(p1, 8, pa3);
#undef PK4
        float qn = 0.f;
#pragma unroll
        for (int d0 = 0; d0 < 4; ++d0) { float qv[8]; unpack8(__builtin_bit_cast(v4u, qr[d0]), qv);
#pragma unroll
            for (int q = 0; q < 8; ++q) qn += qv[q] * sn[d0 * 16 + hi * 8 + q]; }
        qn = swap_add(qn);
        f32x16 acc[4] = {};
        const bf16* ctp = CT + (size_t)u * 8192 + (size_t)r32 * 64 + hi * 8;
#pragma unroll
        for (int vt = 0; vt < 4; ++vt)
#pragma unroll
            for (int d0 = 0; d0 < 4; ++d0) { const bf16x8 cf = *(const GAS bf16x8*)(ctp + vt * 32 * 64 + d0 * 16);
                acc[vt] = __builtin_amdgcn_mfma_f32_32x32x16_bf16(cf, qr[d0], acc[vt], 0, 0, 0); }
#pragma unroll
        for (int vt = 0; vt < 4; ++vt)
#pragma unroll
            for (int r = 0; r < 16; ++r) acc[vt][r] *= iw;
        const int vb = (int)(uintptr_t)Vt + v_rd_base(lane);
#define XC_VT(vt) do { s16x4 vl0, vh0, vl1, vh1, vl2, vh2, vl3, vh3; constexpr int o_ = v_rd_off(vt, 0, 0); \
            TRRD(vl0, vb, o_); TRRD(vh0, vb, o_ + 2048); TRRD(vl1, vb, o_ + 4096); TRRD(vh1, vb, o_ + 6144); \
            if (th) { TRRD(vl2, vb, o_ + 8192); TRRD(vh2, vb, o_ + 10240); TRRD(vl3, vb, o_ + 12288); TRRD(vh3, vb, o_ + 14336); } \
            asm volatile("s_waitcnt lgkmcnt(0)" ::: "memory"); __builtin_amdgcn_sched_barrier(0); \
            acc[vt] = __builtin_amdgcn_mfma_f32_32x32x16_bf16(FRAG(vl0, vh0), pa0, acc[vt], 0, 0, 0); \
            acc[vt] = __builtin_amdgcn_mfma_f32_32x32x16_bf16(FRAG(vl1, vh1), pa1, acc[vt], 0, 0, 0); \
            if (th) { acc[vt] = __builtin_amdgcn_mfma_f32_32x32x16_bf16(FRAG(vl2, vh2), pa2, acc[vt], 0, 0, 0); \
                      acc[vt] = __builtin_amdgcn_mfma_f32_32x32x16_bf16(FRAG(vl3, vh3), pa3, acc[vt], 0, 0, 0); } } while (0)
        XC_VT(0); XC_VT(1); XC_VT(2); XC_VT(3);
#undef XC_VT
        const float den = dsum + iw * qn;
        const float hs = frcp(fmaxf(fabsf(den), fexp(-Fct - et)));
        float ss = 0.f;
#pragma unroll
        for (int vt = 0; vt < 4; ++vt)
#pragma unroll
            for (int r = 0; r < 16; ++r) { acc[vt][r] *= hs; ss += acc[vt][r] * acc[vt][r]; }
        ss = swap_add(ss);
        const float rn = frsq(ss * (1.f / 128.f) + RMS_EPS);
        __syncthreads();
#pragma unroll
        for (int vt = 0; vt < 4; ++vt)
#pragma unroll
            for (int r = 0; r < 16; ++r) ob[(vt * 32 + crow(r, hi)) * 33 + r32] = acc[vt][r] * rn;
        LDS_WAIT();
        { const int v2 = lane * 2; const float g0 = gn[h * 128 + v2], g1 = gn[h * 128 + v2 + 1];
#pragma unroll 4
          for (int tt = 0; tt < 32; ++tt) { const size_t t = t0 + th * 32 + tt;
              const unsigned ow = *(const GAS unsigned*)(P + t * 3072 + 2048 + h * 128 + v2);
              const float x0 = ob[v2 * 33 + tt] * g0 * fsigmoid(bf_lo(ow)), x1 = ob[(v2 + 1) * 33 + tt] * g1 * fsigmoid(bf_hi(ow));
              *(GAS unsigned*)(HM + t * 1024 + h * 128 + v2) = cvtpk(x0, x1); } }
        __syncthreads();
    }
}
#undef TRRD
#undef FRAG
}

namespace rwc {
constexpr int NU = BATCH * RW_H * (SEQ / 64);
constexpr size_t A_GL = 160 * MiB, A_BON = 161 * MiB;
constexpr int RMB = 9216, TRB = 8192;
constexpr int L_LWF = 0, L_AT_RM = 16384, L_BT_RM = L_AT_RM + RMB, L_KT_RM = L_BT_RM + RMB, L_RT_RM = L_KT_RM + RMB, L_KH_RM = L_RT_RM + RMB, L_T_RM = L_KH_RM + RMB, L_ARB_RM = L_T_RM + RMB,
              L_AT_TR = L_ARB_RM + RMB, L_BH_TR = L_AT_TR + TRB, L_V_TR = L_BH_TR + TRB, L_AAK_TR = L_V_TR + TRB, L_W2_TR = L_AAK_TR + TRB, L_H_TR = L_W2_TR + TRB, L_SEG = L_H_TR + TRB,
              L_P1_RM = L_BT_RM, L_P2_RM = L_KT_RM;
static_assert(L_SEG + 2048 <= LDSCTL_OFF, "RWKV LDS map");
using att::crow; using att::v_rd_base;
__device__ __forceinline__ int rm_off(int row, int col) { return row * 144 + col * 2; }
__device__ __forceinline__ int tr_off(int row, int col) { const int kk = (row & ~0xC) | ((row & 4) << 1) | ((row & 8) >> 1); return ((kk >> 3) * 2 + (col >> 5)) * 512 + ((kk & 7) * 32 + (col & 31)) * 2; }
__device__ __forceinline__ bf16x8 frag_rm(const LAS char* tile, int row, int kb, int hi) { return *(const LAS bf16x8*)(tile + rm_off(row, kb * 16 + hi * 8)); }
__device__ __forceinline__ void frag_tr4(bf16x8 (&f)[4], const LAS char* tile, int cb, int lane) {
    const int base = (int)(uintptr_t)tile + v_rd_base(lane) + cb * 512; s16x4 l[4], h[4];
#pragma unroll
    for (int kb = 0; kb < 4; ++kb) { asm volatile("ds_read_b64_tr_b16 %0, %1" : "=&v"(l[kb]) : "v"(base + kb * 2048) : "memory"); asm volatile("ds_read_b64_tr_b16 %0, %1" : "=&v"(h[kb]) : "v"(base + kb * 2048 + 1024) : "memory"); }
    asm volatile("s_waitcnt lgkmcnt(0)" ::: "memory"); __builtin_amdgcn_sched_barrier(0);
#pragma unroll
    for (int kb = 0; kb < 4; ++kb) f[kb] = (bf16x8){l[kb][0], l[kb][1], l[kb][2], l[kb][3], h[kb][0], h[kb][1], h[kb][2], h[kb][3]};
}
__device__ __forceinline__ void frag_rm4(bf16x8 (&f)[4], const LAS char* tile, int row, int hi) {
#pragma unroll
    for (int kb = 0; kb < 4; ++kb) f[kb] = frag_rm(tile, row, kb, hi);
}
__device__ __forceinline__ f32x16 mm4(const bf16x8 (&a)[4], const bf16x8 (&b)[4]) { f32x16 acc = {};
#pragma unroll
    for (int kb = 0; kb < 4; ++kb) acc = __builtin_amdgcn_mfma_f32_32x32x16_bf16(a[kb], b[kb], acc, 0, 0, 0);
    return acc; }
__device__ __forceinline__ bf16 tobf(float x) { return (bf16)(cvtpk(x, 0.f) & 0xffffu); }
#define STORE_RM(tile, acc, mt, nt) do { _Pragma("unroll") for (int r_ = 0; r_ < 16; ++r_) *(LAS bf16*)((tile) + rm_off(32 * (mt) + crow(r_, hi), 32 * (nt) + r32)) = tobf((acc)[r_]); } while (0)
#define STORE_TR(tile, acc, mt, nt) do { _Pragma("unroll") for (int r_ = 0; r_ < 16; ++r_) *(LAS bf16*)((tile) + tr_off(32 * (mt) + crow(r_, hi), 32 * (nt) + r32)) = tobf((acc)[r_]); } while (0)

__device__ __forceinline__ void ra_phase(Frame& F, const Inputs& in, int jl) {
    bf16* RKV = (bf16*)(F.ws + WS_ARENA + A_RKV); const bf16* AA = (const bf16*)(F.ws + WS_XB); float* LW = (float*)(F.ws + WS_ARENA + A_LW);
    float* GL = (float*)(F.ws + WS_ARENA + A_GL); float* BON = (float*)(F.ws + WS_ARENA + A_BON);
    const float* k_k = in.rw_k_k + (size_t)jl * 1024; const float* k_a = in.rw_k_a + (size_t)jl * 1024; const float* r_k = in.rw_r_k + (size_t)jl * 1024;
    LAS char* L = (LAS char*)F.lds; LAS float* LWF = (LAS float*)(L + L_LWF); LAS float* SEG = (LAS float*)(L + L_SEG);
    const int w = F.wave;
#define FRESH() const int lane = fresh_lane(), r32 = lane & 31, hi = lane >> 5; (void)r32; (void)hi
    for (int u = (int)blockIdx.x; u < NU; u += F.G) {
        const int tid = w * 64 + fresh_lane();
        const int bh = u >> 7, c = u & 127, b = bh >> 4, h = bh & 15; const size_t t0 = (size_t)b * SEQ + (size_t)c * 64;
        const int t = tid >> 3, j0 = (tid & 7) * 8; const size_t row = t0 + t; const int col = h * 64 + j0;
        float rv[8], kp[8], vv[8], am[8], bb[8], lw[8];
        { float kv[8], av[8];
          unpack8(*(const GAS v4u*)(RKV + row * 3072 + col), rv); unpack8(*(const GAS v4u*)(RKV + row * 3072 + 1024 + col), kv); unpack8(*(const GAS v4u*)(RKV + row * 3072 + 2048 + col), vv);
          unpack8(*(const GAS v4u*)(AA + row * 1024 + col), av);
          const f32x4 l0 = *(const GAS f32x4*)(LW + row * 1024 + col), l1 = *(const GAS f32x4*)(LW + row * 1024 + col + 4);
          float ss = 0.f, bs = 0.f; float kk[8];
#pragma unroll
          for (int q = 0; q < 8; ++q) { lw[q] = q < 4 ? l0[q] : l1[q - 4]; kk[q] = kv[q] * k_k[col + q]; ss += kk[q] * kk[q]; kp[q] = kv[q] * (1.f + (av[q] - 1.f) * k_a[col + q]); bs += rv[q] * kp[q] * r_k[col + q]; }
          ss += __shfl_xor(ss, 1); ss += __shfl_xor(ss, 2); ss += __shfl_xor(ss, 4); bs += __shfl_xor(bs, 1); bs += __shfl_xor(bs, 2); bs += __shfl_xor(bs, 4);
          const float inv = frcp(fmaxf(fsqrt(ss), 1e-12f));
#pragma unroll
          for (int q = 0; q < 8; ++q) { const float kn = kk[q] * inv; am[q] = -kn; bb[q] = kn * av[q]; }
          if ((tid & 7) == 0) BON[row * 16 + h] = bs; }
        { LAS f32x4* lp = (LAS f32x4*)(LWF + t * 64 + j0); lp[0] = (f32x4){lw[0], lw[1], lw[2], lw[3]}; lp[1] = (f32x4){lw[4], lw[5], lw[6], lw[7]}; }
        __syncthreads();
        { const int jc = tid & 63, sg = tid >> 6; float run = 0.f;
#pragma unroll
          for (int q = 0; q < 8; ++q) { run += LWF[(sg * 8 + q) * 64 + jc]; LWF[(sg * 8 + q) * 64 + jc] = run; }
          SEG[sg * 64 + jc] = run; }
        __syncthreads();
        { const int jc = tid & 63, sg = tid >> 6; float pre = 0.f;
#pragma unroll
          for (int q = 0; q < 8; ++q) if (q < sg) pre += SEG[q * 64 + jc];
#pragma unroll
          for (int q = 0; q < 8; ++q) LWF[(sg * 8 + q) * 64 + jc] += pre; }
        __syncthreads();
        { float at[8], bt[8], kt[8], rt[8], bh_[8], kh[8];
#pragma unroll
          for (int q = 0; q < 8; ++q) { const float cum = LWF[t * 64 + j0 + q], cl = LWF[63 * 64 + j0 + q];
              const float ein = fexp(-cum), eL = fexp(cl - cum);
              at[q] = am[q] * fexp(cum - lw[q]); bt[q] = bb[q] * ein; kt[q] = kp[q] * ein; rt[q] = rv[q] * fexp(cum); bh_[q] = bb[q] * eL; kh[q] = kp[q] * eL;
              if (t == 63) GL[(size_t)u * 64 + j0 + q] = fexp(cl); }
          const int ro = rm_off(t, j0), to = tr_off(t, j0);
          *(LAS v4u*)(L + L_AT_RM + ro) = pack8f(at); *(LAS v4u*)(L + L_AT_TR + to) = pack8f(at); *(LAS v4u*)(L + L_BT_RM + ro) = pack8f(bt); *(LAS v4u*)(L + L_KT_RM + ro) = pack8f(kt);
          *(LAS v4u*)(L + L_RT_RM + ro) = pack8f(rt); *(LAS v4u*)(L + L_BH_TR + to) = pack8f(bh_); *(LAS v4u*)(L + L_KH_RM + ro) = pack8f(kh); *(LAS v4u*)(L + L_V_TR + to) = pack8f(vv); }
        __syncthreads();
        f32x16 rk[2];
        { FRESH(); const int p = w >> 1, mt = w & 1; const LAS char* At = L + ((p < 2) ? L_AT_RM : L_RT_RM); const LAS char* Bt = L + ((p & 1) ? L_KT_RM : L_BT_RM);
          bf16x8 fa[4]; frag_rm4(fa, At, 32 * mt + r32, hi);
#pragma unroll
          for (int nt = 0; nt < 2; ++nt) { f32x16 acc = {};
              if (nt <= mt) { bf16x8 fb[4]; frag_rm4(fb, Bt, 32 * nt + r32, hi); acc = mm4(fa, fb); }
#pragma unroll
              for (int r = 0; r < 16; ++r) { const int tt = 32 * mt + crow(r, hi), s = 32 * nt + r32; const bool keep = (p < 2) ? (s < tt) : (s <= tt); if (!keep) acc[r] = 0.f; }
              if (p == 0) {
#pragma unroll
                  for (int r = 0; r < 16; ++r) LWF[(32 * mt + crow(r, hi)) * 64 + 32 * nt + r32] = acc[r]; }
              else if (p == 1) STORE_TR(L + L_AAK_TR, acc, mt, nt);
              else if (p == 2) STORE_RM(L + L_ARB_RM, acc, mt, nt);
              rk[nt] = acc; } }
        __syncthreads();
        if (w == 0) { FRESH(); float Tc[64];
#pragma unroll
            for (int tt = 0; tt < 64; ++tt) { asm volatile("" ::: "memory"); float acc = (tt == lane) ? 1.f : 0.f;
#pragma unroll
                for (int s4 = 0; s4 < (tt + 3) / 4; ++s4) { const f32x4 a4 = *(const LAS f32x4*)(LWF + tt * 64 + s4 * 4);
#pragma unroll
                    for (int e = 0; e < 4; ++e) if (s4 * 4 + e < tt) acc += a4[e] * Tc[s4 * 4 + e]; }
                Tc[tt] = acc;
                *(LAS bf16*)(L + L_T_RM + rm_off(tt, lane)) = tobf(acc); } }
        __syncthreads();
        { FRESH(); const int q = w & 3, mt = q >> 1, nt = q & 1; bf16x8 fa[4], fb[4]; frag_rm4(fa, L + L_T_RM, 32 * mt + r32, hi);
          frag_tr4(fb, L + ((w < 4) ? L_AT_TR : L_AAK_TR), nt, lane);
          const f32x16 acc = mm4(fa, fb);
          if (w < 4) STORE_TR(L + L_W2_TR, acc, mt, nt); else STORE_TR(L + L_H_TR, acc, mt, nt); }
        __syncthreads();
        { FRESH(); const int g = w >> 1, mt = w & 1; bf16x8 fa[4];
          if (g == 0 || g == 3) frag_rm4(fa, L + L_ARB_RM, 32 * mt + r32, hi); else frag_tr4(fa, L + L_BH_TR, mt, lane);
#pragma unroll
          for (int nt = 0; nt < 2; ++nt) { bf16x8 fb[4]; frag_tr4(fb, L + ((g < 2) ? L_W2_TR : L_H_TR), nt, lane);
              f32x16 acc = mm4(fa, fb);
              if (g == 0) {
#pragma unroll
                  for (int r = 0; r < 16; ++r) { const int tt = 32 * mt + crow(r, hi), jj = 32 * nt + r32;
                      RKV[(t0 + tt) * 3072 + h * 64 + jj] = tobf(acc[r] + bf1(*(const LAS bf16*)(L + L_RT_RM + rm_off(tt, jj)))); } }
              else if (g == 1) {
#pragma unroll
                  for (int r = 0; r < 16; ++r) { const int jp = 32 * mt + crow(r, hi), jj = 32 * nt + r32; RKV[(t0 + jp) * 3072 + 1024 + h * 64 + jj] = tobf(acc[r]); } }
              else if (g == 2) {
#pragma unroll
                  for (int r = 0; r < 16; ++r) { const int jp = 32 * mt + crow(r, hi), s = 32 * nt + r32; acc[r] += bf1(*(const LAS bf16*)(L + L_KH_RM + rm_off(s, jp))); }
                  STORE_RM(L + L_P2_RM, acc, mt, nt); }
              else {
#pragma unroll
                  for (int r = 0; r < 16; ++r) acc[r] += rk[nt][r];
                  STORE_RM(L + L_P1_RM, acc, mt, nt); } } }
        __syncthreads();
        { FRESH(); const int q = w & 3, m_ = q >> 1, n_ = q & 1; bf16x8 fa[4], fb[4];
          if (w < 4) { frag_tr4(fa, L + L_V_TR, m_, lane); frag_rm4(fb, L + L_P1_RM, 32 * n_ + r32, hi); }
          else { frag_rm4(fa, L + L_P2_RM, 32 * m_ + r32, hi); frag_tr4(fb, L + L_V_TR, n_, lane); }
          const f32x16 acc = mm4(fa, fb);
          const int o = (q * 64 + lane) * 32, orow = o >> 7, owi = o & 127;
          GAS v4u* dst = (GAS v4u*)((GAS char*)LW + ((t0 + orow) * 1024 + h * 64) * 4 + ((w < 4) ? 0 : 128) + owi);
          float tmp[16];
#pragma unroll
          for (int r = 0; r < 16; ++r) tmp[r] = acc[r];
          dst[0] = pack8f(tmp); dst[1] = pack8f(tmp + 8); }
        __syncthreads();
    }
}
__device__ __forceinline__ void rb_phase(Frame& F) {
    if ((int)blockIdx.x >= BATCH * RW_H * 2) return;
    const bf16* RKV = (const bf16*)(F.ws + WS_ARENA + A_RKV); const float* LW = (const float*)(F.ws + WS_ARENA + A_LW); const float* GL = (const float*)(F.ws + WS_ARENA + A_GL);
    bf16* ZC = (bf16*)(F.ws + WS_XB);
    const int lane = F.lane, r32 = lane & 31, hi = lane >> 5, task = blockIdx.x, bh = task >> 1, it = task & 1, b = bh >> 4, h = bh & 15;
    LAS float* sg = (LAS float*)F.lds;
    for (int e = F.tid; e < 128 * 16; e += 512) *(LAS f32x4*)(sg + e * 4) = *(const GAS f32x4*)(GL + (size_t)bh * 8192 + e * 4);
    __syncthreads();
    if (F.wave != 0) return;
    f32x16 Z[2] = {};
    bf16x8 mfA[2][4], mfB[2][4]; v4u nnA[2][2], nnB[2][2];
#define RB_LOAD(c_, mf_, nn_) do { const size_t t0_ = (size_t)b * SEQ + (size_t)(c_) * 64; \
        _Pragma("unroll") for (int mt = 0; mt < 2; ++mt) { const bf16* mrow = RKV + (t0_ + 32 * mt + r32) * 3072 + 1024 + h * 64 + 4 * hi; \
            _Pragma("unroll") for (int kb = 0; kb < 4; ++kb) { const v2u lo = *(const GAS v2u*)(mrow + kb * 16), hi2 = *(const GAS v2u*)(mrow + kb * 16 + 8); mf_[mt][kb] = __builtin_bit_cast(bf16x8, (v4u){lo.x, lo.y, hi2.x, hi2.y}); } \
            const int o = ((mt * 2 + it) * 64 + lane) * 32, orow = o >> 7, owi = o & 127; \
            const GAS v4u* np = (const GAS v4u*)((const GAS char*)LW + ((t0_ + orow) * 1024 + h * 64) * 4 + 128 + owi); nn_[mt][0] = np[0]; nn_[mt][1] = np[1]; } } while (0)
#define RB_STEP(c_, mf_, nn_) do { const int u = bh * 128 + (c_); \
        bf16x8 zh[4], zl[4]; \
        _Pragma("unroll") for (int kb = 0; kb < 4; ++kb) { float a8[8], l8[8]; \
            _Pragma("unroll") for (int e = 0; e < 8; ++e) a8[e] = Z[kb >> 1][(kb & 1) * 8 + e]; \
            const v4u hw = pack8f(a8); float h8[8]; unpack8(hw, h8); \
            _Pragma("unroll") for (int e = 0; e < 8; ++e) l8[e] = a8[e] - h8[e]; \
            zh[kb] = __builtin_bit_cast(bf16x8, hw); zl[kb] = __builtin_bit_cast(bf16x8, pack8f(l8)); \
            *(GAS v4u*)(ZC + (size_t)u * 4096 + ((kb * 2 + it) * 64 + lane) * 8) = hw; } \
        _Pragma("unroll") for (int mt = 0; mt < 2; ++mt) { f32x16 acc; float tmp[16]; unpack8(nn_[mt][0], tmp); unpack8(nn_[mt][1], tmp + 8); \
            _Pragma("unroll") for (int q = 0; q < 4; ++q) { const f32x4 g4 = *(const LAS f32x4*)(sg + (c_) * 64 + 32 * mt + 8 * q + 4 * hi); \
                _Pragma("unroll") for (int e = 0; e < 4; ++e) acc[4 * q + e] = tmp[4 * q + e] + g4[e] * Z[mt][4 * q + e]; } \
            _Pragma("unroll") for (int kb = 0; kb < 4; ++kb) { acc = __builtin_amdgcn_mfma_f32_32x32x16_bf16(mf_[mt][kb], zh[kb], acc, 0, 0, 0); acc = __builtin_amdgcn_mfma_f32_32x32x16_bf16(mf_[mt][kb], zl[kb], acc, 0, 0, 0); } \
            if (mt == 0) zn0 = acc; else Z[1] = acc; } \
        Z[0] = zn0; } while (0)
    f32x16 zn0;
    RB_LOAD(0, mfA, nnA);
    for (int c = 0; c < SEQ / 64; c += 2) {
        RB_LOAD(c + 1, mfB, nnB);
        RB_STEP(c, mfA, nnA);
        if (c + 2 < SEQ / 64) RB_LOAD(c + 2, mfA, nnA);
        RB_STEP(c + 1, mfB, nnB);
    }
#undef RB_LOAD
#undef RB_STEP
}
__device__ __forceinline__ void rc_phase(Frame& F, const Inputs& in, int jl) {
    const bf16* RKV = (const bf16*)(F.ws + WS_ARENA + A_RKV); const float* LW = (const float*)(F.ws + WS_ARENA + A_LW); const float* BON = (const float*)(F.ws + WS_ARENA + A_BON);
    const bf16* ZC = (const bf16*)(F.ws + WS_XB); const bf16* GG = (const bf16*)(F.ws + WS_ARENA + A_GG); bf16* YG = (bf16*)(F.ws + WS_ARENA + A_YG);
    const float* lnw = in.rw_ln_w + (size_t)jl * 1024; const float* lnb = in.rw_ln_b + (size_t)jl * 1024;
    const int lane = F.lane, r32 = lane & 31, hi = lane >> 5;
    for (int task = F.gw; task < NU * 2; task += F.NGW) { const int u = task >> 1, tt = task & 1, bh = u >> 7, c = u & 127, b = bh >> 4, h = bh & 15; const size_t t0 = (size_t)b * SEQ + (size_t)c * 64, trow = t0 + 32 * tt + r32;
        bf16x8 yw[4];
        { const bf16* yrow = RKV + trow * 3072 + h * 64 + 4 * hi;
#pragma unroll
          for (int kb = 0; kb < 4; ++kb) { const v2u lo = *(const GAS v2u*)(yrow + kb * 16), hi2 = *(const GAS v2u*)(yrow + kb * 16 + 8); yw[kb] = __builtin_bit_cast(bf16x8, (v4u){lo.x, lo.y, hi2.x, hi2.y}); } }
        f32x16 y[2];
#pragma unroll
        for (int it = 0; it < 2; ++it) { const int o = ((it * 2 + tt) * 64 + lane) * 32, orow = o >> 7, owi = o & 127;
            const GAS v4u* yp = (const GAS v4u*)((const GAS char*)LW + ((t0 + orow) * 1024 + h * 64) * 4 + owi);
            float tmp[16]; unpack8(yp[0], tmp); unpack8(yp[1], tmp + 8);
#pragma unroll
            for (int r = 0; r < 16; ++r) y[it][r] = tmp[r];
#pragma unroll
            for (int kb = 0; kb < 4; ++kb) { const bf16x8 zf = *(const GAS bf16x8*)(ZC + (size_t)u * 4096 + ((kb * 2 + it) * 64 + lane) * 8);
                y[it] = __builtin_amdgcn_mfma_f32_32x32x16_bf16(zf, yw[kb], y[it], 0, 0, 0); } }
        float s1 = 0.f;
#pragma unroll
        for (int it = 0; it < 2; ++it)
#pragma unroll
            for (int r = 0; r < 16; ++r) s1 += y[it][r];
        const float mean = mlc::swap_add(s1) * (1.f / 64.f); float s2 = 0.f;
#pragma unroll
        for (int it = 0; it < 2; ++it)
#pragma unroll
            for (int r = 0; r < 16; ++r) { y[it][r] -= mean; s2 += y[it][r] * y[it][r]; }
        const float rs = frsq(mlc::swap_add(s2) * (1.f / 64.f) + 64e-5f), bon = BON[trow * 16 + h];
#pragma unroll
        for (int it = 0; it < 2; ++it)
#pragma unroll
            for (int q = 0; q < 4; ++q) { const int i0 = 32 * it + 8 * q + 4 * hi, col = h * 64 + i0;
                const f32x4 w4 = *(const GAS f32x4*)(lnw + col), b4 = *(const GAS f32x4*)(lnb + col);
                const v2u vw = *(const GAS v2u*)(RKV + trow * 3072 + 2048 + col), gw2 = *(const GAS v2u*)(GG + trow * 1024 + col);
                const float v4[4] = {bf_lo(vw.x), bf_hi(vw.x), bf_lo(vw.y), bf_hi(vw.y)}, g4[4] = {bf_lo(gw2.x), bf_hi(gw2.x), bf_lo(gw2.y), bf_hi(gw2.y)};
                float o4[4];
#pragma unroll
                for (int e = 0; e < 4; ++e) o4[e] = (y[it][4 * q + e] * rs * w4[e] + b4[e] + bon * v4[e]) * g4[e];
                v2u ow; ow.x = cvtpk(o4[0], o4[1]); ow.y = cvtpk(o4[2], o4[3]);
                *(GAS v2u*)(YG + trow * 1024 + col) = ow; }
    }
}
#undef STORE_RM
#undef STORE_TR
#undef FRESH
}

#ifndef MK_ONE_LAUNCH
#define MK_ONE_LAUNCH 1
#endif
template <class Epi> __device__ __forceinline__ void run_gemm(Frame& F, const bf16* A, int lda, const bf16* Bt, int ldb, int N, int K, const Epi& E) {
    pg8::Gemm g{A, Bt, T, N, K, lda, ldb, F.wave}; pg8::StaticOrder S; S.init(T, N, F.G, (int)blockIdx.x);
    pg8::gemm_phase<Epi, pg8::StaticOrder, true, true>(F.lds, g, S, E);
}
__host__ __device__ constexpr int mixer_phases(int kind) { return kind == 0 ? 4 : kind == 1 ? 6 : 7; }
constexpr int NPH = 4 * 3 + (mixer_phases(0) + 2) + (mixer_phases(1) + 2) + (mixer_phases(2) + 2) + (mixer_phases(0) + 2) + 1;

__global__ void __launch_bounds__(NWAVES * 64, 2) fwd(Args args) {
    extern __shared__ __attribute__((aligned(16))) unsigned char lds[];
    Frame F;
    F.lds = (LAS unsigned char*)lds;
    F.tid = threadIdx.x; F.lane = F.tid & 63; const int wave0 = __builtin_amdgcn_readfirstlane(F.tid >> 6); F.wave = wave0;
    F.G = gridDim.x; F.gw = (int)blockIdx.x * NWAVES + F.wave; F.NGW = F.G * NWAVES;
    F.ws = args.ws; F.ctl = (gu32*)(args.ws + WS_CTL);
    const Inputs& in = args.in;
    volatile LAS unsigned* MISC = (volatile LAS unsigned*)(F.lds + MISC_OFF);
    for (int u = F.tid; u < (LDS_BYTES - LDSCTL_OFF) / 4; u += NWAVES * 64) ((LAS unsigned*)(F.lds + LDSCTL_OFF))[u] = 0u;
    __syncthreads();
#if MK_ONE_LAUNCH
    XcdBarrier bar = xcd_barrier_post((unsigned*)(F.ctl + CW_BAR), MISC + 8);
#define GRID_BAR() xcd_barrier(bar)
#else
#define GRID_BAR() do { } while (0)
#endif
    const int lo = args.ph_lo, hi = args.ph_hi;
    int ph = 0;
#ifndef PHMASK
#define PHMASK 0xffffffffu
#endif
#ifndef PHREP
#define PHREP 0u
#endif
#define PH_BEGIN(id) if (ph >= lo && ph < hi) { if ((PHMASK >> (id)) & 1u) for (int rep_ = 0; rep_ < ((((PHREP) >> (id)) & 1u) ? 2 : 1); ++rep_) { if (rep_) GRID_BAR(); { int w_ = wave0; asm volatile("" : "+s"(w_)); F.wave = w_; F.lane = fresh_lane(); F.tid = w_ * 64 + F.lane; F.gw = (int)blockIdx.x * NWAVES + w_; } unsigned char* ws = args.ws; asm volatile("" : "+s"(ws)); { float* xo_ = args.out; asm volatile("" : "+s"(xo_)); F.X = xo_; } F.ws = ws; F.ctl = (gu32*)(ws + WS_CTL); F.XB = (bf16*)(ws + WS_XB); F.SS = (float*)(ws + WS_SS); \
    bf16* const WB = (bf16*)(ws + WS_W); unsigned char* const AR = ws + WS_ARENA; float* const COS = (float*)(ws + WS_COS); float* const SIN = (float*)(ws + WS_SIN); float* const SSQ = (float*)(ws + WS_SSQ); float* const SSKV = (float*)(ws + WS_SSKV); (void)WB; (void)AR; (void)COS; (void)SIN; (void)SSQ; (void)SSKV;
#define PH_END } if (ph + 1 < hi) GRID_BAR(); } ++ph;

#ifdef DUMP
    if (lo == 1000) { unsigned char* ws = args.ws; unsigned char* const AR = ws + WS_ARENA; F.X = args.out; F.lane = fresh_lane();
#define HX ((bf16*)(AR + A_HX))
#define RKV ((bf16*)(AR + A_RKV))
#define LOR ((bf16*)(AR + A_LOR))
#define LW ((float*)(AR + A_LW))
#define AA ((bf16*)(ws + WS_XB))
#define GG ((bf16*)(AR + A_GG))
#define YG ((bf16*)(AR + A_YG))
        for (int e = F.gw * 64 + F.lane; e < T * 1024; e += F.NGW * 64) { const int t = e >> 10, c = e & 1023; float v = 0.f;
            if (DUMP == 1) v = bf1(HX[(size_t)t * 2048 + c]) + bf1(HX[(size_t)t * 2048 + 1024 + c]);
            if (DUMP == 2) v = bf1(RKV[(size_t)t * 3072 + c]) + bf1(RKV[(size_t)t * 3072 + 1024 + c]) + bf1(RKV[(size_t)t * 3072 + 2048 + c]) + bf1(LOR[(size_t)t * 256 + (c & 255)]);
            if (DUMP == 3) v = LW[(size_t)t * 1024 + c] + bf1(AA[(size_t)t * 1024 + c]) + bf1(GG[(size_t)t * 1024 + c]);
            if (DUMP == 4) v = bf1(YG[(size_t)t * 1024 + c]);
            if (DUMP == 5) v = ((size_t)e < (size_t)3328 * 2048) ? bf1(((const bf16*)(ws + WS_W))[WR_BIG + e]) : 0.f;
            F.X[e] = v; }
#undef HX
#undef RKV
#undef LOR
#undef LW
#undef AA
#undef GG
#undef YG
        return; }
#endif
#pragma unroll
    for (int s = 0; s < 2 * DEPTH; ++s) {
        const int layer = s >> 1, half = s & 1, kind = layer % 3, j = layer / 3;
        if (half == 0) {
            PH_BEGIN(0)
                if (layer == 0) prologue(F, in);
                conv_layer(F, in, layer);
            PH_END
        } else if (kind == 0) {
#define LAT ((bf16*)(AR + A_LAT))
#define Q ((bf16*)(AR + A_Q))
#define KV ((bf16*)(AR + A_KV))
#define O ((bf16*)(AR + A_O))
#define KPE ((bf16*)(AR + A_KPE))
            PH_BEGIN(1)
                EpiMlaA E{F.SS, LAT, SSQ, SSKV, KPE, COS, SIN};
                run_gemm(F, F.XB, D, WB + WM_A, 1024, 1024, 1024, E);
            PH_END
            PH_BEGIN(2)
                { EpiMlaQ E{SSQ, Q, COS, SIN, 0.07216878364870322f * 1.4426950408889634f};
                  run_gemm(F, LAT, 1024, WB + WM_QB, 512, 1536, 512, E); }
                { EpiMlaKV E{SSKV, KV};
                  run_gemm(F, LAT + 512, 1024, WB + WM_KVB, 256, 2048, 256, E); }
            PH_END
            PH_BEGIN(3)
                for (int it = (int)blockIdx.x; it < BATCH * MLA_H * 16; it += F.G) { const int bh = it >> 4, xq = it & 15;
                    att::attn_unit(F.wave, bh >> 3, bh & 7, xq, Q, KV, KPE, O, (LAS char*)F.lds);
                    att::attn_unit(F.wave, bh >> 3, bh & 7, 31 - xq, Q, KV, KPE, O, (LAS char*)F.lds); }
            PH_END
            PH_BEGIN(4)
                EpiResidual E{F.X, F.XB, F.SS, 1.0f};
                run_gemm(F, O, 1024, WB + WM_O, 1024, 1024, 1024, E);
            PH_END
        } else if (kind == 1) {
#define P ((bf16*)(AR + A_P))
#define GATES ((float*)(AR + A_GATES))
#define HM ((bf16*)(AR + A_HM))
            PH_BEGIN(5)
                EpiMlIn E{F.SS, P, GATES};
                run_gemm(F, F.XB, D, WB + WL_IN, 1024, 3328, 1024, E);
            PH_END
            PH_BEGIN(6)
                mlc::conv_phase(F, in, j);
            PH_END
            PH_BEGIN(7)
                mlc::xa_phase(F);
            PH_END
            PH_BEGIN(8)
                mlc::xb_phase(F);
            PH_END
            PH_BEGIN(19)
                mlc::xc_phase(F, in, j);
            PH_END
            PH_BEGIN(9)
                EpiResidual E{F.X, F.XB, F.SS, 1.0f};
                run_gemm(F, (bf16*)(AR + mlc::A_HM2), 1024, WB + WL_O, 1024, 1024, 1024, E);
            PH_END
        } else {
#define HX ((bf16*)(AR + A_HX))
#define RKV ((bf16*)(AR + A_RKV))
#define LOR ((bf16*)(AR + A_LOR))
#define LW ((float*)(AR + A_LW))
#define AA ((bf16*)(ws + WS_XB))
#define GG ((bf16*)(AR + A_GG))
#define YG ((bf16*)(AR + A_YG))
            PH_BEGIN(10)
                rw_shift_phase(F);
            PH_END
            PH_BEGIN(11)
                EpiRwBig E{RKV, LOR};
                run_gemm(F, HX, 2048, WB + WR_BIG, 2048, 3328, 2048, E);
            PH_END
            PH_BEGIN(12)
                EpiRwUp E{LW, AA, GG, in.rw_w0 + (size_t)j * 1024, in.rw_a0 + (size_t)j * 1024};
                run_gemm(F, LOR, 256, WB + WR_UP, 256, 3072, 256, E);
            PH_END
            PH_BEGIN(13)
                rwc::ra_phase(F, in, j);
            PH_END
            PH_BEGIN(14)
                rwc::rb_phase(F);
            PH_END
            PH_BEGIN(20)
                rwc::rc_phase(F, in, j);
            PH_END
            PH_BEGIN(15)
                EpiResidual E{F.X, F.XB, F.SS, 1.0f};
                run_gemm(F, YG, 1024, WB + WR_O, 1024, 1024, 1024, E);
            PH_END
        }
#define ACT ((bf16*)(AR + A_ACT))
        PH_BEGIN(16)
            EpiSwiGLU E{F.SS, ACT};
            run_gemm(F, F.XB, D, WB + (half ? WO_GU1 : WO_GU0), D, 2 * FF, D, E);
        PH_END
        PH_BEGIN(17)
            EpiResidual E{F.X, F.XB, F.SS, 0.5f};
            run_gemm(F, ACT, FF, WB + (half ? WO_D1 : WO_D0), FF, D, FF, E);
        PH_END
    }
    PH_BEGIN(18)
        final_norm_phase(F, in);
    PH_END
}

extern "C" void kernel_launch(void* const* d_in, const int* in_sizes, int n_in, void* d_out, int out_size, void* d_ws, size_t ws_size, hipStream_t stream) {
    static int grid = 0;
    if (grid == 0) {
        if (n_in != 38 || in_sizes[0] != T * D || out_size != T * D || ws_size < WS_END) { fprintf(stderr, "kernel_launch: unexpected shapes (n_in %d, in0 %d, out %d, ws %zu)\n", n_in, n_in > 0 ? in_sizes[0] : -1, out_size, ws_size); grid = -1; return; }
        int dev = 0, cus = 0, per_cu = 0;
        if (hipGetDevice(&dev) != hipSuccess || hipDeviceGetAttribute(&cus, hipDeviceAttributeMultiprocessorCount, dev) != hipSuccess) { grid = -1; return; }
        if (hipFuncSetAttribute((const void*)fwd, hipFuncAttributeMaxDynamicSharedMemorySize, LDS_BYTES) != hipSuccess) { fprintf(stderr, "kernel_launch: hipFuncSetAttribute failed\n"); grid = -1; return; }
        if (hipOccupancyMaxActiveBlocksPerMultiprocessor(&per_cu, (const void*)fwd, NWAVES * 64, LDS_BYTES) != hipSuccess || per_cu < 1)
            fprintf(stderr, "kernel_launch: occupancy query reports %d workgroups per CU\n", per_cu);
        (void)hipGetLastError();
        grid = cus;
    }
    if (grid < 0) return;
    if (hipMemsetAsync((char*)d_ws + WS_CTL, 0, CTL_ZERO_BYTES, stream) != hipSuccess) return;
    Args a{};
    const void** ip = (const void**)&a.in;
    for (int i = 0; i < 38; ++i) ip[i] = d_in[i];
    a.out = (float*)d_out; a.ws = (unsigned char*)d_ws;
#if MK_ONE_LAUNCH
    a.ph_lo = 0; a.ph_hi = NPH;
    hipLaunchKernelGGL(fwd, dim3(grid), dim3(NWAVES * 64), LDS_BYTES, stream, a);
#else
#ifdef DUMP
    for (int p = 0; p <= DUMP_LAST; ++p) { a.ph_lo = p; a.ph_hi = p + 1;
        hipLaunchKernelGGL(fwd, dim3(grid), dim3(NWAVES * 64), LDS_BYTES, stream, a); }
    a.ph_lo = 1000; a.ph_hi = 1001;
    hipLaunchKernelGGL(fwd, dim3(grid), dim3(NWAVES * 64), LDS_BYTES, stream, a);
#else
    for (int p = 0; p < NPH; ++p) { a.ph_lo = p; a.ph_hi = p + 1;
        hipLaunchKernelGGL(fwd, dim3(grid), dim3(NWAVES * 64), LDS_BYTES, stream, a); }
#endif
#endif
}
```

```cpp
#include <hip/hip_runtime.h>
#include <cstdio>
#include <cstdint>

__device__ __forceinline__ int fresh_lane() { int l; asm volatile("v_mbcnt_lo_u32_b32 %0, -1, 0\n\tv_mbcnt_hi_u32_b32 %0, -1, %0" : "=v"(l)); return l; }
namespace pg8 {
#define PG8_LAS __attribute__((address_space(3)))
typedef unsigned short bf16_t;
typedef short bf16x8 __attribute__((ext_vector_type(8)));
typedef float f32x4 __attribute__((ext_vector_type(4)));
typedef unsigned u32x4 __attribute__((ext_vector_type(4)));
typedef unsigned u32x2 __attribute__((ext_vector_type(2)));
constexpr int BM = 256, BK = 64, HALF = 128, HTB = HALF * BK * 2  , STAGE_BYTES = 8 * HTB, NXCD = 8, WGM = 8;

__host__ __device__ __forceinline__ int lds_byte(int r, int c) { const int st = (r >> 4) * 2 + (c >> 5), rr = r & 15, cc = c & 31, ob = rr * 64 + cc * 2; return st * 1024 + (ob ^ (((ob >> 9) & 1) << 5)); }
__host__ __device__ __forceinline__ void stage_rc(int b, int& R, int& C) { const int st = b / 1024, sb = b % 1024, swz = sb ^ (((sb >> 9) & 1) << 5); R = (st >> 1) * 16 + swz / 64; C = (st & 1) * 32 + (swz % 64) / 2; }
__host__ __device__ __forceinline__ int perm32(int rho) { const int n = rho >> 4, i = rho & 15; return 8 * (i >> 2) + 4 * n + (i & 3); }

struct Unit { int pm, pn; };
struct Gemm { const bf16_t* A; const bf16_t* Bt; int M, N, K, lda, ldb, wave; };

struct StaticOrder {
    int nM, nN, nwg, G, c;
    __host__ __device__ void init(int M, int N, int G_, int c_) { nM = M / BM; nN = N / BM; nwg = nM * nN; G = G_; c = c_; }
    __host__ __device__ bool next(int i, Unit& u) const {
        const long L = (long)i * G + c; if (L >= nwg) return false;
        int wgid = (int)L; { const int q = nwg / NXCD, r = nwg % NXCD, xcd = wgid % NXCD, off = wgid / NXCD; wgid = (xcd < r ? xcd * (q + 1) : r * (q + 1) + (xcd - r) * q) + off; }
        const int nig = WGM * nN, gid = wgid / nig, fm = gid * WGM, gsz = (nM - fm) < WGM ? (nM - fm) : WGM;
        u.pm = fm + ((wgid % nig) % gsz); u.pn = (wgid % nig) / gsz; return true;
    }
    __device__ __forceinline__ void a_ready(const Unit&) const {}
    __device__ __forceinline__ void done(const Unit&) const {}
};

template <class Epi, class Sched, bool ALIGN_EPI = false, bool SP2 = false>
__device__ __forceinline__ void gemm_phase(PG8_LAS unsigned char* lds, const Gemm g, const Sched& S, const Epi& E) {
    const int wid = g.wave; const int tid = wid * 64 + fresh_lane(), lane = tid & 63, wr = wid >> 2, wc = wid & 3, fr = lane & 15, fq = lane >> 4;
    const int K = g.K, nt = K / BK;
    unsigned voffA[2], voffB[2];
#pragma unroll
    for (int i = 0; i < 2; ++i) { int R, C; stage_rc(tid * 16 + i * 8192, R, C); const int Rb = Epi::PERM ? ((R & ~31) + perm32(R & 31)) : R;
        voffA[i] = (unsigned)(R * g.lda + C) * 2u; voffB[i] = (unsigned)(Rb * g.ldb + C) * 2u; }
    const size_t kstep = (size_t)(BK * 2);
    const size_t hstepA = (size_t)HALF * g.lda * 2, hstepB = (size_t)HALF * g.ldb * 2;
    const size_t tstepA = 2 * hstepA, tstepB = 2 * hstepB;
    const unsigned ldsw = (unsigned)wid * 1024u;
    const int aoff = lds_byte(wr * 64 + fr, fq * 8), boff = lds_byte(wc * 32 + fr, fq * 8);
#define PG8_SA(b, h) (((b) * 2 + (h)) * HTB)
#define PG8_SB(b, h) ((4 + (b) * 2 + (h)) * HTB)
#define PG8_STAGE(bufoff, gbase, voff) do { _Pragma("unroll") for (int _i = 0; _i < 2; ++_i) \
        __builtin_amdgcn_global_load_lds((const unsigned*)((const char*)(gbase) + (voff)[_i]), (PG8_LAS unsigned*)(lds + (bufoff) + ldsw + _i * 8192), 16, 0, 0); } while (0)
#define PG8_LDA(dst, b, h) do { _Pragma("unroll") for (int m = 0; m < 4; ++m) _Pragma("unroll") for (int k = 0; k < 2; ++k) dst[m][k] = *(const PG8_LAS bf16x8*)(lds + PG8_SA(b, h) + aoff + m * 2048 + k * 1024); } while (0)
#define PG8_LDB(dst, b, h) do { _Pragma("unroll") for (int n = 0; n < 2; ++n) _Pragma("unroll") for (int k = 0; k < 2; ++k) dst[n][k] = *(const PG8_LAS bf16x8*)(lds + PG8_SB(b, h) + boff + n * 2048 + k * 1024); } while (0)
#define PG8_MMA(ai, bj, At, Bt) do { __builtin_amdgcn_s_setprio(1); _Pragma("unroll") for (int m = 0; m < 4; ++m) _Pragma("unroll") for (int n = 0; n < 2; ++n) _Pragma("unroll") for (int k = 0; k < 2; ++k) \
        acc[ai][bj][m][n] = __builtin_amdgcn_mfma_f32_16x16x32_bf16(Bt[n][k], At[m][k], acc[ai][bj][m][n], 0, 0, 0); __builtin_amdgcn_s_setprio(0); } while (0)
#define PG8_WAIT_V(n) asm volatile("s_waitcnt vmcnt(" #n ")" ::: "memory")
#define PG8_WAIT_L(n) asm volatile("s_waitcnt lgkmcnt(" #n ")" ::: "memory")
#define PG8_BAR __builtin_amdgcn_s_barrier()
#define PG8_SCHED __builtin_amdgcn_sched_barrier(0)
    Unit cur, nxt; int ui = 0;
    if (!S.next(0, cur)) return;
    f32x4 acc[2][2][4][2];
#pragma unroll
    for (int a = 0; a < 2; ++a)
#pragma unroll
        for (int b = 0; b < 2; ++b)
#pragma unroll
            for (int m = 0; m < 4; ++m)
#pragma unroll
                for (int n = 0; n < 2; ++n) acc[a][b][m][n] = (f32x4){0.f, 0.f, 0.f, 0.f};
    bf16x8 At[4][2], B0[2][2], B1[2][2];
    const char* cA = (const char*)g.A + (size_t)cur.pm * tstepA; const char* cB = (const char*)g.Bt + (size_t)cur.pn * tstepB;
    S.a_ready(cur);
    if constexpr (SP2) {
        PG8_STAGE(PG8_SB(0, 0), cB, voffB); PG8_STAGE(PG8_SB(0, 1), cB + hstepB, voffB); PG8_STAGE(PG8_SA(0, 0), cA, voffA); PG8_STAGE(PG8_SA(0, 1), cA + hstepA, voffA);
        if (wr == 1) PG8_BAR;
        PG8_WAIT_V(2); PG8_BAR;
        PG8_STAGE(PG8_SB(1, 0), cB + kstep, voffB); PG8_STAGE(PG8_SA(1, 0), cA + kstep, voffA); PG8_STAGE(PG8_SB(1, 1), cB + hstepB + kstep, voffB);
        PG8_WAIT_V(6); PG8_BAR;
    } else {
        PG8_STAGE(PG8_SB(0, 0), cB, voffB); PG8_STAGE(PG8_SA(0, 0), cA, voffA); PG8_STAGE(PG8_SB(0, 1), cB + hstepB, voffB); PG8_STAGE(PG8_SA(0, 1), cA + hstepA, voffA);
        if (wr == 1) PG8_BAR;
        PG8_WAIT_V(4); PG8_BAR;
        PG8_STAGE(PG8_SB(1, 0), cB + kstep, voffB); PG8_STAGE(PG8_SA(1, 0), cA + kstep, voffA); PG8_STAGE(PG8_SB(1, 1), cB + hstepB + kstep, voffB);
        PG8_WAIT_V(6); PG8_BAR;
    }
    for (;;) {
        const bool has_next = S.next(ui + 1, nxt);
        const char* nA = has_next ? (const char*)g.A + (size_t)nxt.pm * tstepA : cA; const char* nB = has_next ? (const char*)g.Bt + (size_t)nxt.pn * tstepB : cB;
#pragma nounroll
        for (int t = 0; t < nt; t += 2) {
            const bool last = (t == nt - 2);
            const char* a1 = cA + (size_t)(t + 1) * kstep;
            const char* a2 = last ? nA : cA + (size_t)(t + 2) * kstep; const char* b2 = last ? nB : cB + (size_t)(t + 2) * kstep;
            const char* a3 = a2 + kstep; const char* b3 = b2 + kstep;
            if (last && has_next) S.a_ready(nxt);
            if constexpr (SP2) {
            PG8_LDB(B0, 0, 0); PG8_LDB(B1, 0, 1); PG8_SCHED; PG8_LDA(At, 0, 0); PG8_STAGE(PG8_SA(1, 1), a1 + hstepA, voffA);
            PG8_WAIT_V(8); PG8_WAIT_L(0); PG8_BAR; PG8_MMA(0, 0, At, B0); PG8_MMA(0, 1, At, B1); PG8_BAR; PG8_SCHED;
            PG8_LDA(At, 0, 1); PG8_STAGE(PG8_SB(0, 0), b2, voffB); PG8_STAGE(PG8_SB(0, 1), b2 + hstepB, voffB); PG8_STAGE(PG8_SA(0, 0), a2, voffA);
            PG8_WAIT_V(8); PG8_WAIT_L(0); PG8_BAR; PG8_MMA(1, 0, At, B0); PG8_MMA(1, 1, At, B1); PG8_BAR; PG8_SCHED;
            PG8_LDB(B0, 1, 0); PG8_LDB(B1, 1, 1); PG8_SCHED; PG8_LDA(At, 1, 0); PG8_STAGE(PG8_SA(0, 1), a2 + hstepA, voffA);
            PG8_WAIT_V(8); PG8_WAIT_L(0); PG8_BAR; PG8_MMA(0, 0, At, B0); PG8_MMA(0, 1, At, B1); PG8_BAR; PG8_SCHED;
            PG8_LDA(At, 1, 1); PG8_STAGE(PG8_SB(1, 0), b3, voffB); PG8_STAGE(PG8_SB(1, 1), b3 + hstepB, voffB); PG8_STAGE(PG8_SA(1, 0), a3, voffA);
            PG8_WAIT_V(8); PG8_WAIT_L(0); PG8_BAR; PG8_MMA(1, 0, At, B0); PG8_MMA(1, 1, At, B1); PG8_BAR; PG8_SCHED;
            } else {
            PG8_LDB(B0, 0, 0); PG8_SCHED; PG8_LDA(At, 0, 0); PG8_STAGE(PG8_SA(1, 1), a1 + hstepA, voffA);
            PG8_WAIT_L(8); PG8_BAR; PG8_WAIT_L(0); PG8_MMA(0, 0, At, B0); PG8_BAR; PG8_SCHED;
            PG8_LDB(B1, 0, 1); PG8_STAGE(PG8_SB(0, 0), b2, voffB);
            PG8_BAR; PG8_WAIT_L(0); PG8_MMA(0, 1, At, B1); PG8_BAR;
            PG8_LDA(At, 0, 1); PG8_STAGE(PG8_SA(0, 0), a2, voffA);
            PG8_BAR; PG8_WAIT_L(0); PG8_MMA(1, 0, At, B0); PG8_BAR; PG8_SCHED;
            PG8_STAGE(PG8_SB(0, 1), b2 + hstepB, voffB);
            PG8_WAIT_V(6); PG8_BAR; PG8_MMA(1, 1, At, B1); PG8_BAR;
            PG8_LDB(B0, 1, 0); PG8_SCHED; PG8_LDA(At, 1, 0); PG8_STAGE(PG8_SA(0, 1), a2 + hstepA, voffA);
            PG8_WAIT_L(8); PG8_BAR; PG8_WAIT_L(0); PG8_MMA(0, 0, At, B0); PG8_BAR; PG8_SCHED;
            PG8_LDB(B1, 1, 1); PG8_STAGE(PG8_SB(1, 0), b3, voffB);
            PG8_BAR; PG8_WAIT_L(0); PG8_MMA(0, 1, At, B1); PG8_BAR;
            PG8_LDA(At, 1, 1); PG8_STAGE(PG8_SA(1, 0), a3, voffA);
            PG8_BAR; PG8_WAIT_L(0); PG8_MMA(1, 0, At, B0); PG8_BAR; PG8_SCHED;
            PG8_STAGE(PG8_SB(1, 1), b3 + hstepB, voffB);
            PG8_WAIT_V(6); PG8_BAR; PG8_MMA(1, 1, At, B1); PG8_BAR;
            }
        }
        if constexpr (ALIGN_EPI) { if (wr == 0) PG8_BAR; }
        if constexpr (!Epi::AFTER_DRAIN) { E(acc, cur, wr, wc, fr, fq); S.done(cur); }
        if (!has_next) break;
#pragma unroll
        for (int a = 0; a < 2; ++a)
#pragma unroll
            for (int b = 0; b < 2; ++b)
#pragma unroll
                for (int m = 0; m < 4; ++m)
#pragma unroll
                    for (int n = 0; n < 2; ++n) acc[a][b][m][n] = (f32x4){0.f, 0.f, 0.f, 0.f};
        cur = nxt; cA = nA; cB = nB; ++ui;
        if constexpr (ALIGN_EPI) { if (wr == 1) PG8_BAR; }
    }
    PG8_WAIT_V(0);
    if constexpr (!ALIGN_EPI) { if (wr == 0) PG8_BAR; }
    PG8_BAR;
    if constexpr (Epi::AFTER_DRAIN) { E.fused(acc, cur, wr, wc, fr, fq, lds, wid, lane); S.done(cur); }
#undef PG8_SA
#undef PG8_SB
#undef PG8_STAGE
#undef PG8_LDA
#undef PG8_LDB
#undef PG8_MMA
#undef PG8_WAIT_V
#undef PG8_WAIT_L
#undef PG8_BAR
#undef PG8_SCHED
}
}

constexpr int NWAVES = 8;
constexpr int BATCH = 2, SEQ = 8192, D = 1024, T = BATCH * SEQ, FF = 2816, DEPTH = 4;
constexpr float RMS_EPS = 1e-6f;
constexpr int MLA_H = 8, QRANK = 512, KVRANK = 256, NOPE = 128, ROPE = 64, DVH = 128, DQK = NOPE + ROPE;
constexpr int LATN = QRANK + KVRANK + ROPE;
constexpr int ML_H = 8, ML_DK = 64, ML_DV = 128, ML_NIN = 3088;
constexpr int RW_H = 16, RW_N = 64;

constexpr size_t MiB = 1u << 20;
constexpr size_t WS_CTL = 0, CTL_ZERO_BYTES = 1 * MiB;
constexpr size_t WS_COS = 1 * MiB, WS_SIN = 3 * MiB;
constexpr size_t WS_SS = 5 * MiB;
constexpr size_t WS_SSQ = 6 * MiB;
constexpr size_t WS_SSKV = 6 * MiB + 512 * 1024;
constexpr size_t WS_W = 8 * MiB;
constexpr size_t WS_XB = 68 * MiB;
constexpr size_t WS_ARENA = 100 * MiB;
constexpr size_t WS_END = 352 * MiB;
constexpr size_t WO_GU0 = 0, WO_D0 = WO_GU0 + (size_t)2 * FF * D, WO_GU1 = WO_D0 + (size_t)D * FF, WO_D1 = WO_GU1 + (size_t)2 * FF * D, WO_MIX = WO_D1 + (size_t)D * FF;
constexpr size_t WM_A = WO_MIX, WM_QB = WM_A + (size_t)1024 * 1024, WM_KVB = WM_QB + (size_t)1536 * 512, WM_O = WM_KVB + (size_t)2048 * 256;
constexpr size_t WL_IN = WO_MIX, WL_O = WL_IN + (size_t)3328 * 1024;
constexpr size_t WR_BIG = WO_MIX, WR_UP = WR_BIG + (size_t)3328 * 2048, WR_O = WR_UP + (size_t)3072 * 256;
static_assert((WR_O + (size_t)1024 * 1024) * 2 <= 60 * MiB, "weight region");
constexpr size_t A_ACT = 0;
constexpr size_t A_LAT = 0, A_Q = 32 * MiB, A_KV = 80 * MiB, A_O = 144 * MiB, A_KPE = 176 * MiB;
constexpr size_t A_P = 0, A_GATES = 96 * MiB, A_QKC = 97 * MiB, A_IGLF = 161 * MiB, A_HRAW = 162 * MiB, A_HM = A_QKC;
constexpr size_t A_HX = 0, A_RKV = 64 * MiB, A_LOR = 160 * MiB, A_LW = 0, A_GG = 168 * MiB, A_YG = A_GG  , A_AAZ = 200 * MiB  ;
static_assert(WS_ARENA + A_HRAW + (size_t)T * 1024 * 4 <= WS_END && WS_ARENA + A_YG + (size_t)T * 1024 * 2 <= WS_END && WS_ARENA + A_KPE + (size_t)T * 64 * 2 <= WS_END, "arena");

constexpr int CW_TMO = 0, CW_CODE = 1, CW_BAR = 4096, CW_Q = 8192;
constexpr size_t WS_PTRS = 512 * 1024;

constexpr int RING_BYTES = 131072;
constexpr int LDSCTL_OFF = 146432, MISC_OFF = LDSCTL_OFF + 320;
constexpr int LDS_BYTES = 147456;

#define GAS __attribute__((address_space(1)))
#define LAS __attribute__((address_space(3)))
typedef unsigned short bf16;
typedef unsigned v4u __attribute__((ext_vector_type(4)));
typedef unsigned v2u __attribute__((ext_vector_type(2)));
typedef float f32x4 __attribute__((ext_vector_type(4)));
typedef float f32x16 __attribute__((ext_vector_type(16)));
typedef short bf16x8 __attribute__((ext_vector_type(8)));
typedef short s16x4 __attribute__((ext_vector_type(4)));
typedef GAS unsigned gu32;
#define RLX_AGENT __ATOMIC_RELAXED, __HIP_MEMORY_SCOPE_AGENT
#define LDS_WAIT() asm volatile("s_waitcnt lgkmcnt(0)" ::: "memory")
#define VM_WAIT() asm volatile("s_waitcnt vmcnt(0)" ::: "memory")
typedef float f32x2_t __attribute__((ext_vector_type(2))); typedef __bf16 bf16x2_t __attribute__((ext_vector_type(2)));
__device__ __forceinline__ unsigned cvtpk(float lo, float hi) { f32x2_t v = {lo, hi}; bf16x2_t b = __builtin_convertvector(v, bf16x2_t); return __builtin_bit_cast(unsigned, b); }
__device__ __forceinline__ float bf_lo(unsigned w) { return __builtin_bit_cast(float, w << 16); }
__device__ __forceinline__ float bf_hi(unsigned w) { return __builtin_bit_cast(float, w & 0xffff0000u); }
__device__ __forceinline__ float bf1(bf16 h) { return __builtin_bit_cast(float, (unsigned)h << 16); }
__device__ __forceinline__ v4u pack8f(const float* v) { v4u w; w.x = cvtpk(v[0], v[1]); w.y = cvtpk(v[2], v[3]); w.z = cvtpk(v[4], v[5]); w.w = cvtpk(v[6], v[7]); return w; }
__device__ __forceinline__ v4u pack8v(f32x4 a, f32x4 b) { v4u w; w.x = cvtpk(a[0], a[1]); w.y = cvtpk(a[2], a[3]); w.z = cvtpk(b[0], b[1]); w.w = cvtpk(b[2], b[3]); return w; }
__device__ __forceinline__ void unpack8(v4u w, float* v) { v[0] = bf_lo(w.x); v[1] = bf_hi(w.x); v[2] = bf_lo(w.y); v[3] = bf_hi(w.y); v[4] = bf_lo(w.z); v[5] = bf_hi(w.z); v[6] = bf_lo(w.w); v[7] = bf_hi(w.w); }
__device__ __forceinline__ float fexp(float x) { return __builtin_amdgcn_exp2f(x * 1.4426950408889634f); }
__device__ __forceinline__ float frcp(float x) { return __builtin_amdgcn_rcpf(x); }
__device__ __forceinline__ float flog(float x) { return __builtin_amdgcn_logf(x) * 0.6931471805599453f; }
__device__ __forceinline__ float ftanh(float x) { const float t = fexp(-2.f * fabsf(x)); const float r = (1.f - t) * frcp(1.f + t); return x < 0.f ? -r : r; }
__device__ __forceinline__ float fsigmoid(float x) { return frcp(1.f + fexp(-x)); }
__device__ __forceinline__ float frsq(float x) { return __builtin_amdgcn_rsqf(x); }
__device__ __forceinline__ float fsqrt(float x) { return __builtin_amdgcn_sqrtf(x); }
__device__ __forceinline__ void fsincos_big(float a, float& s, float& c) {
    const float k = __builtin_rintf(a * 0.15915494309189535f);
    float r = __builtin_fmaf(-k, 6.28125f, a); r = __builtin_fmaf(-k, 1.9353071795864769e-3f, r);
    const float rev = r * 0.15915494309189535f;
    s = __builtin_amdgcn_sinf(rev); c = __builtin_amdgcn_cosf(rev);
}
__device__ __forceinline__ float fsilu(float x) { return x * frcp(1.f + fexp(-x)); }
__device__ __forceinline__ float wave_sum(float v) {
#pragma unroll
    for (int o = 1; o < 64; o <<= 1) v += __shfl_xor(v, o);
    return v;
}

#define XB_TMO      128
#define XB_XCNT(j)  (256  + 64 * (j))
#define XB_XSUB(j)  (1280 + 64 * (j))
#define XB_XGEN(j)  (2304 + 64 * (j))
#define XB_TOP      3328
#define XB_TOPGEN   3392
#define XCD_BAR_WORDS 3456
#define XB_SPIN_CAP (1u << 18)

__device__ __forceinline__ unsigned xb_ld(unsigned* p)              { return __hip_atomic_load(p, __ATOMIC_RELAXED, __HIP_MEMORY_SCOPE_AGENT); }
__device__ __forceinline__ unsigned xb_add(unsigned* p, unsigned v) { return __hip_atomic_fetch_add(p, v, __ATOMIC_RELAXED, __HIP_MEMORY_SCOPE_AGENT); }
__device__ __forceinline__ unsigned xb_xcc_id() { return (unsigned)__builtin_amdgcn_s_getreg((3 << 11) | 20) & 0xFu; }
#define XB_SPIN(cond, bar) do { unsigned _sp = 0; while (cond) { __builtin_amdgcn_s_sleep(1); \
    if ((++_sp & 255u) == 0u) { if (xb_ld(&(bar)[XB_TMO])) break; if (_sp > XB_SPIN_CAP) { atomicAdd(&(bar)[XB_TMO], 1u); break; } } } } while (0)

struct XcdBarrier {
    unsigned* bar; unsigned x;
    volatile LAS unsigned* st;
};

__device__ __forceinline__ XcdBarrier xcd_barrier_post(unsigned* bar, volatile LAS unsigned* st) {
    XcdBarrier b; b.bar = bar; b.x = xb_xcc_id(); b.st = st;
    if (threadIdx.x == 0) (void)xb_add(&bar[XB_XCNT(b.x)], 1u);
    return b;
}
__device__ __forceinline__ void xcd_barrier_complete(unsigned* bar, unsigned x, unsigned& nloc, unsigned& nx) {
    const unsigned G = gridDim.x * gridDim.y * gridDim.z;
    unsigned sum, cnt, mine, sp = 0u;
    for (;;) {
        sum = 0u; cnt = 0u; mine = 0u;
#pragma unroll
        for (unsigned j = 0; j < 16; ++j) { const unsigned c = xb_ld(&bar[XB_XCNT(j)]); sum += c; cnt += (c > 0u) ? 1u : 0u; mine = (j == x) ? c : mine; }
        if (sum == G) break;
        __builtin_amdgcn_s_sleep(1);
        if ((++sp & 255u) == 0u) { if (xb_ld(&bar[XB_TMO])) break; if (sp > XB_SPIN_CAP) { atomicAdd(&bar[XB_TMO], 1u); break; } }
    }
    nloc = mine > 0u ? mine : 1u; nx = cnt > 0u ? cnt : 1u;
}

__device__ __forceinline__ void xcd_barrier(const XcdBarrier& b) {
    asm volatile("s_waitcnt vmcnt(0)" ::: "memory");
    __syncthreads();
    if (threadIdx.x == 0) {
        unsigned* bar = b.bar;
        __builtin_amdgcn_s_waitcnt(0);
        unsigned nloc = b.st[0], nx = b.st[1];
        if (nloc == 0u) { xcd_barrier_complete(bar, b.x, nloc, nx); b.st[0] = nloc; b.st[1] = nx; }
        const unsigned old = xb_add(&bar[XB_XSUB(b.x)], 1u);
        const unsigned gen = old / nloc;
        if (old + 1u == (gen + 1u) * nloc) {
            __builtin_amdgcn_fence(__ATOMIC_RELEASE, "agent");
            asm volatile("s_waitcnt vmcnt(0)" ::: "memory");
            const unsigned og = xb_add(&bar[XB_TOP], 1u);
            const unsigned tg = og / nx;
            if (og + 1u == (tg + 1u) * nx) xb_add(&bar[XB_TOPGEN], 1u);
            else XB_SPIN(xb_ld(&bar[XB_TOPGEN]) == tg, bar);
            __builtin_amdgcn_fence(__ATOMIC_ACQUIRE, "agent");
            xb_add(&bar[XB_XGEN(b.x)], 1u);
            asm volatile("s_waitcnt vmcnt(0)" ::: "memory");
        } else {
            XB_SPIN(xb_ld(&bar[XB_XGEN(b.x)]) == gen, bar);
            __builtin_amdgcn_fence(__ATOMIC_ACQUIRE, "agent");
            asm volatile("s_waitcnt vmcnt(0)" ::: "memory");
        }
    }
    __syncthreads();
}

struct Inputs {
    const float* x; const int* positions; const float* ffn_norm; const float* ffn_w_gate; const float* ffn_w_up; const float* ffn_w_down; const float* mix_norm; const float* final_norm;
    const float* mla_w_a; const float* mla_q_norm; const float* mla_w_qb; const float* mla_kv_norm; const float* mla_w_kvb; const float* mla_w_o;
    const float* ml_w_in; const float* ml_b_if; const float* ml_conv_w; const float* ml_conv_b; const float* ml_out_norm; const float* ml_w_o;
    const float* rw_mu; const float* rw_w_r; const float* rw_w_k; const float* rw_w_v; const float* rw_w0; const float* rw_w1; const float* rw_w2; const float* rw_a0; const float* rw_a1; const float* rw_a2;
    const float* rw_g1; const float* rw_g2; const float* rw_k_k; const float* rw_k_a; const float* rw_r_k; const float* rw_ln_w; const float* rw_ln_b; const float* rw_w_o;
};
struct Args { Inputs in; float* out; unsigned char* ws; int ph_lo, ph_hi; };

struct Frame {
    LAS unsigned char* lds;
    gu32* ctl;
    int tid, lane, wave, G, gw, NGW;
    float* X;
    bf16* XB;
    float* SS;
    unsigned char* ws;
};

struct CvDesc { const float* Wp; const float* g1; const float* g2; bf16* dst; int ld, ks0, ldd, kd0, n0; bool vec; };
__device__ __forceinline__ void cv_load(const CvDesc& d, f32x4 (&v)[8], float (&g)[8], int lane) {
    const int kr = lane >> 3, nc = (lane & 7) * 4; const float* W0 = d.Wp ? d.Wp - (lane & 31) : nullptr;
#pragma unroll
    for (int i = 0; i < 8; ++i) { const int k = d.ks0 + 8 * i + kr;
        v[i] = W0 ? *(const GAS f32x4*)(W0 + (size_t)k * d.ld + nc) : (f32x4){0.f, 0.f, 0.f, 0.f};
        g[i] = d.g1 ? d.g1[k] : 1.f; if (d.g2) g[i] *= d.g2[k]; }
}
__device__ __forceinline__ void cv_finish(const CvDesc& d, const f32x4 (&v)[8], const float (&g)[8], LAS float* scr, int lane) {
    const int kr = lane >> 3, nc = (lane & 7) * 4;
    if (d.vec) {
#pragma unroll
        for (int i = 0; i < 8; ++i) { LAS float* s = scr + (8 * i + kr) * 33 + nc; const f32x4 x = v[i] * g[i]; s[0] = x[0]; s[1] = x[1]; s[2] = x[2]; s[3] = x[3]; }
    } else {
        const int nl = lane & 31, kh = lane >> 5;
#pragma unroll 8
        for (int i = 0; i < 32; ++i) { const int kk = 2 * i + kh, k = d.ks0 + kk; float x = 0.f;
            if (d.Wp) { x = d.Wp[(size_t)k * d.ld]; if (d.g1) x *= d.g1[k]; if (d.g2) x *= d.g2[k]; }
            scr[kk * 33 + nl] = x; }
    }
    LDS_WAIT(); asm volatile("" ::: "memory");
    const int c = lane & 7;
#pragma unroll
    for (int j = 0; j < 4; ++j) { const int n = (lane >> 3) + 8 * j; const LAS float* s = scr + (8 * c) * 33 + n;
        v4u o; o.x = cvtpk(s[0 * 33], s[1 * 33]); o.y = cvtpk(s[2 * 33], s[3 * 33]); o.z = cvtpk(s[4 * 33], s[5 * 33]); o.w = cvtpk(s[6 * 33], s[7 * 33]);
        *(GAS v4u*)(d.dst + (size_t)(d.n0 + n) * d.ldd + d.kd0 + 8 * c) = o; }
    LDS_WAIT(); asm volatile("" ::: "memory");
}
__device__ __forceinline__ void cv_decode(const Inputs& in, bf16* WB, int layer, int it, int lane, CvDesc& d) {
    const int kind = layer % 3, j = layer / 3, nl = lane & 31;
    constexpr int I_GU = (D / 64) * (2 * FF / 32), I_DN = (FF / 64) * (D / 32), I_FFN = 2 * (I_GU + I_DN);
    d.g1 = nullptr; d.g2 = nullptr; d.vec = true;
    int r = it;
    if (r < I_FFN) {
        const int half = r / (I_GU + I_DN); r -= half * (I_GU + I_DN);
        const size_t wsel = (size_t)(layer * 2 + half);
        if (r < I_GU) {
            const int nb = r % (2 * FF / 32), kb = r / (2 * FF / 32), n = nb * 32 + nl, tile = n >> 8, w = n & 255;
            d.Wp = (w < 128 ? in.ffn_w_gate : in.ffn_w_up) + wsel * D * FF + (tile * 128 + (w & 127)); d.ld = FF; d.ks0 = kb * 64; d.g1 = in.ffn_norm + wsel * D;
            d.dst = WB + (half ? WO_GU1 : WO_GU0); d.ldd = D; d.kd0 = kb * 64; d.n0 = nb * 32;
        } else { r -= I_GU;
            const int nb = r % (D / 32), kb = r / (D / 32), n = nb * 32 + nl;
            d.Wp = in.ffn_w_down + wsel * FF * D + n; d.ld = D; d.ks0 = kb * 64; d.dst = WB + (half ? WO_D1 : WO_D0); d.ldd = FF; d.kd0 = kb * 64; d.n0 = nb * 32; }
        return;
    }
    r -= I_FFN;
    const float* gmix = in.mix_norm + (size_t)layer * D;
    if (kind == 0) {
        if (r < 16 * 32) {
            const int nb = r % 32, kb = r / 32, n = nb * 32 + nl; int col = n;
            if (n >= 768 && n < 832) { const int jj = n - 768; col = 768 + (jj >> 1) + 32 * (jj & 1); }
            d.Wp = (n < LATN) ? in.mla_w_a + (size_t)j * D * LATN + col : nullptr; d.ld = LATN; d.ks0 = kb * 64; d.g1 = gmix; d.dst = WB + WM_A; d.ldd = 1024; d.kd0 = kb * 64; d.n0 = nb * 32;
            d.vec = (nb < 24 || nb >= 26); return; }
        r -= 16 * 32;
        if (r < 8 * 48) {
            const int nb = r % 48, kb = r / 48, n = nb * 32 + nl, hd = n / DQK, w = n - hd * DQK; int col = n;
            if (w >= NOPE) { const int jj = w - NOPE; col = hd * DQK + NOPE + (jj >> 1) + 32 * (jj & 1); }
            d.Wp = in.mla_w_qb + (size_t)j * QRANK * 1536 + col; d.ld = 1536; d.ks0 = kb * 64; d.g1 = in.mla_q_norm + (size_t)j * QRANK; d.dst = WB + WM_QB; d.ldd = 512; d.kd0 = kb * 64; d.n0 = nb * 32;
            d.vec = (nb % 6) < 4; return; }
        r -= 8 * 48;
        if (r < 4 * 64) {
            const int nb = r % 64, kb = r / 64, n = nb * 32 + nl;
            d.Wp = in.mla_w_kvb + (size_t)j * KVRANK * 2048 + n; d.ld = 2048; d.ks0 = kb * 64; d.g1 = in.mla_kv_norm + (size_t)j * KVRANK; d.dst = WB + WM_KVB; d.ldd = 256; d.kd0 = kb * 64; d.n0 = nb * 32; return; }
        r -= 4 * 64;
        { const int nb = r % 32, kb = r / 32, n = nb * 32 + nl;
          d.Wp = in.mla_w_o + (size_t)j * 1024 * 1024 + n; d.ld = 1024; d.ks0 = kb * 64; d.dst = WB + WM_O; d.ldd = 1024; d.kd0 = kb * 64; d.n0 = nb * 32; }
    } else if (kind == 1) {
        if (r < 16 * 104) {
            const int nb = r % 104, kb = r / 104, n = nb * 32 + nl;
            d.Wp = (n < ML_NIN) ? in.ml_w_in + (size_t)j * D * ML_NIN + n : nullptr; d.ld = ML_NIN; d.ks0 = kb * 64; d.g1 = gmix; d.dst = WB + WL_IN; d.ldd = 1024; d.kd0 = kb * 64; d.n0 = nb * 32;
            d.vec = (nb != 96); return; }
        r -= 16 * 104;
        { const int nb = r % 32, kb = r / 32, n = nb * 32 + nl;
          d.Wp = in.ml_w_o + (size_t)j * 1024 * 1024 + n; d.ld = 1024; d.ks0 = kb * 64; d.dst = WB + WL_O; d.ldd = 1024; d.kd0 = kb * 64; d.n0 = nb * 32; }
    } else {
        const float* mu = in.rw_mu + (size_t)j * 6 * D;
        if (r < 32 * 104) {
            const int nb = r % 104, kb = r / 104, n = nb * 32 + nl; const float* m;
            if (n < 1024) { d.Wp = in.rw_w_r + (size_t)j * D * D + n; d.ld = D; m = mu + 0 * D; }
            else if (n < 2048) { d.Wp = in.rw_w_k + (size_t)j * D * D + (n - 1024); d.ld = D; m = mu + 2 * D; }
            else if (n < 3072) { d.Wp = in.rw_w_v + (size_t)j * D * D + (n - 2048); d.ld = D; m = mu + 3 * D; }
            else if (n < 3136) { d.Wp = in.rw_w1 + (size_t)j * D * 64 + (n - 3072); d.ld = 64; m = mu + 1 * D; }
            else if (n < 3200) { d.Wp = in.rw_a1 + (size_t)j * D * 64 + (n - 3136); d.ld = 64; m = mu + 4 * D; }
            else { d.Wp = in.rw_g1 + (size_t)j * D * 128 + (n - 3200); d.ld = 128; m = mu + 5 * D; }
            d.ks0 = (kb & 15) * 64; d.g1 = gmix; d.g2 = (kb >= 16) ? m : nullptr; d.dst = WB + WR_BIG; d.ldd = 2048; d.kd0 = kb * 64; d.n0 = nb * 32; return; }
        r -= 32 * 104;
        if (r < 4 * 96) {
            const int nb = r % 96, kb = r / 96, n = nb * 32 + nl; d.Wp = nullptr; d.ld = 1024; d.ks0 = 0;
            if (n < 1024) { if (kb == 0) d.Wp = in.rw_w2 + (size_t)j * 64 * D + n; }
            else if (n < 2048) { if (kb == 1) d.Wp = in.rw_a2 + (size_t)j * 64 * D + (n - 1024); }
            else { if (kb >= 2) { d.Wp = in.rw_g2 + (size_t)j * 128 * D + (n - 2048); d.ks0 = (kb - 2) * 64; } }
            d.dst = WB + WR_UP; d.ldd = 256; d.kd0 = kb * 64; d.n0 = nb * 32; return; }
        r -= 4 * 96;
        { const int nb = r % 32, kb = r / 32, n = nb * 32 + nl;
          d.Wp = in.rw_w_o + (size_t)j * 1024 * 1024 + n; d.ld = 1024; d.ks0 = kb * 64; d.dst = WB + WR_O; d.ldd = 1024; d.kd0 = kb * 64; d.n0 = nb * 32; }
    }
}
__device__ __forceinline__ void conv_layer(Frame& F, const Inputs& in, int layer) {
    LAS float* scr = (LAS float*)(F.lds + F.wave * 16384);
    bf16* WB = (bf16*)(F.ws + WS_W);
    const int kind = layer % 3, lane = F.lane;
    constexpr int I_GU = (D / 64) * (2 * FF / 32), I_DN = (FF / 64) * (D / 32), I_FFN = 2 * (I_GU + I_DN);
    constexpr int I_MLA = (1024 / 64) * (1024 / 32) + (512 / 64) * (1536 / 32) + (256 / 64) * (2048 / 32) + (1024 / 64) * (1024 / 32);
    constexpr int I_ML = (1024 / 64) * (3328 / 32) + (1024 / 64) * (1024 / 32);
    constexpr int I_RW = (2048 / 64) * (3328 / 32) + (256 / 64) * (3072 / 32) + (1024 / 64) * (1024 / 32);
    const int n_items = I_FFN + (kind == 0 ? I_MLA : kind == 1 ? I_ML : I_RW);
    CvDesc dA, dB; f32x4 vA[8], vB[8]; float gA[8], gB[8];
    int it = F.gw;
    if (it < n_items) { cv_decode(in, WB, layer, it, lane, dA); if (dA.vec) cv_load(dA, vA, gA, lane); }
    for (; it < n_items; it += 2 * F.NGW) {
        const int itB = it + F.NGW, itC = it + 2 * F.NGW;
        if (itB < n_items) { cv_decode(in, WB, layer, itB, lane, dB); if (dB.vec) cv_load(dB, vB, gB, lane); }
        cv_finish(dA, vA, gA, scr, lane);
        if (itC < n_items) { cv_decode(in, WB, layer, itC, lane, dA); if (dA.vec) cv_load(dA, vA, gA, lane); }
        if (itB < n_items) cv_finish(dB, vB, gB, scr, lane);
    }
}

__device__ __forceinline__ void prologue(Frame& F, const Inputs& in) {
    for (int m = F.gw; m < T; m += F.NGW) {
        const GAS f32x4* xr = (const GAS f32x4*)(in.x + (size_t)m * D) + F.lane;
        GAS v2u* xb = (GAS v2u*)(F.XB + (size_t)m * D) + F.lane;
        float s = 0.f;
#pragma unroll
        for (int jj = 0; jj < 4; ++jj) { const f32x4 v = xr[64 * jj]; s += (v.x * v.x + v.y * v.y) + (v.z * v.z + v.w * v.w);
            v2u w; w.x = cvtpk(v.x, v.y); w.y = cvtpk(v.z, v.w); xb[64 * jj] = w; }
        s = wave_sum(s);
        if (F.lane < 16) F.SS[(size_t)m * 16 + F.lane] = (F.lane == 0) ? s : 0.f;
    }
    float* COS = (float*)(F.ws + WS_COS); float* SIN = (float*)(F.ws + WS_SIN);
    for (int e = F.gw * 64 + F.lane; e < T * 32; e += F.NGW * 64) {
        const int t = e >> 5, i = e & 31;
        const float inv_freq = __builtin_amdgcn_exp2f(-(float)i * 0.41524101186092029f);
        const float ang = (float)in.positions[t] * inv_freq;
        float sn, cs; fsincos_big(ang, sn, cs);
        COS[e] = cs; SIN[e] = sn;
    }
}

__device__ __forceinline__ float rstd16(const float* SS, int row) {
    const GAS f32x4* p = (const GAS f32x4*)(SS + (size_t)row * 16);
    const f32x4 a = p[0], b = p[1], c = p[2], d = p[3];
    const float s = ((a.x + a.y) + (a.z + a.w)) + ((b.x + b.y) + (b.z + b.w)) + ((c.x + c.y) + (c.z + c.w)) + ((d.x + d.y) + (d.z + d.w));
    return frsq(s * (1.f / D) + RMS_EPS);
}

#define EPI_ROWS(ai, m) (u.pm * 256 + (ai) * 128 + wr * 64 + (m) * 16 + fr)
typedef const f32x4 (&AccT)[2][2][4][2];
using pg8::Unit;


template <int NP> __device__ __forceinline__ void rstd_rows(const float* S, int row0  , int fq, float inv_n, float (&r)[8]) {
    float p[8];
#pragma unroll
    for (int ai = 0; ai < 2; ++ai)
#pragma unroll
        for (int m = 0; m < 4; ++m) { const int row = row0 + ai * 128 + m * 16;
            if constexpr (NP == 16) { const f32x4 a = *(const GAS f32x4*)(S + (size_t)row * 16 + fq * 4); p[ai * 4 + m] = (a.x + a.y) + (a.z + a.w); }
            else if constexpr (NP == 8) { const GAS float* q = (const GAS float*)(S + (size_t)row * 8 + fq * 2); p[ai * 4 + m] = q[0] + q[1]; }
            else { p[ai * 4 + m] = *(const GAS float*)(S + (size_t)row * 4 + fq); } }
#pragma unroll
    for (int i = 0; i < 8; ++i) { float s = p[i]; s += __shfl_xor(s, 16); s += __shfl_xor(s, 32); r[i] = frsq(s * inv_n + RMS_EPS); }
}
struct EpiSwiGLU { static constexpr bool PERM = true, AFTER_DRAIN = false; const float* SS; bf16* ACT;
    __device__ __forceinline__ void operator()(AccT acc, const Unit& u, int wr, int wc, int fr, int fq) const {
        const int col = u.pn * 128 + wc * 32 + fq * 8;
        float rs[8]; rstd_rows<16>(SS, u.pm * 256 + wr * 64 + fr, fq, 1.f / D, rs);
#pragma unroll
        for (int ai = 0; ai < 2; ++ai)
#pragma unroll
            for (int m = 0; m < 4; ++m) { const int row = EPI_ROWS(ai, m); const float r = rs[ai * 4 + m];
                float o[8];
#pragma unroll
                for (int n = 0; n < 2; ++n)
#pragma unroll
                    for (int e = 0; e < 4; ++e) { const float g = acc[ai][0][m][n][e] * r, up = acc[ai][1][m][n][e] * r; o[4 * n + e] = fsilu(g) * up; }
                *(GAS v4u*)(ACT + (size_t)row * FF + col) = pack8f(o); }
    }
};
struct EpiResidual { static constexpr bool PERM = true, AFTER_DRAIN = false; float* X; bf16* XB; float* SS; float scale;
    __device__ __forceinline__ void operator()(AccT acc, const Unit& u, int wr, int wc, int fr, int fq) const {
#pragma unroll
        for (int ai = 0; ai < 2; ++ai) { asm volatile("" ::: "memory");
            v4u xv[4][2];
#pragma unroll
            for (int m = 0; m < 4; ++m)
#pragma unroll
                for (int bj = 0; bj < 2; ++bj) xv[m][bj] = *(const GAS v4u*)(XB + (size_t)EPI_ROWS(ai, m) * D + u.pn * 256 + bj * 128 + wc * 32 + fq * 8);
#pragma unroll
            for (int m = 0; m < 4; ++m) { const int row = EPI_ROWS(ai, m); float ss = 0.f;
#pragma unroll
                for (int bj = 0; bj < 2; ++bj) { const int col = u.pn * 256 + bj * 128 + wc * 32 + fq * 8;
                    float xo[8]; unpack8(xv[m][bj], xo);
#pragma unroll
                    for (int e = 0; e < 4; ++e) { xo[e] += acc[ai][bj][m][0][e] * scale; xo[4 + e] += acc[ai][bj][m][1][e] * scale; }
#pragma unroll
                    for (int e = 0; e < 8; ++e) ss += xo[e] * xo[e];
                    *(GAS v4u*)(XB + (size_t)row * D + col) = pack8f(xo); }
                ss += __shfl_xor(ss, 16); ss += __shfl_xor(ss, 32);
                if (fq == 0) SS[(size_t)row * 16 + u.pn * 4 + wc] = ss; } }
    }
};
__device__ __forceinline__ void rope8(float* v, const float* COS, const float* SIN, int row, int p0) {
    const f32x4 c = *(const GAS f32x4*)(COS + (size_t)row * 32 + p0), s = *(const GAS f32x4*)(SIN + (size_t)row * 32 + p0);
#pragma unroll
    for (int p = 0; p < 4; ++p) { const float x1 = v[2 * p], x2 = v[2 * p + 1]; v[2 * p] = x1 * c[p] - x2 * s[p]; v[2 * p + 1] = x1 * s[p] + x2 * c[p]; }
}
struct EpiMlaA { static constexpr bool PERM = true, AFTER_DRAIN = false; const float* SS; bf16* LAT; float* SSQ; float* SSKV; bf16* KPE; const float* COS; const float* SIN;
    __device__ __forceinline__ void operator()(AccT acc, const Unit& u, int wr, int wc, int fr, int fq) const {
        float rs[8]; rstd_rows<16>(SS, u.pm * 256 + wr * 64 + fr, fq, 1.f / D, rs);
#pragma unroll
        for (int ai = 0; ai < 2; ++ai)
#pragma unroll
            for (int m = 0; m < 4; ++m) { const int row = EPI_ROWS(ai, m); const float r = rs[ai * 4 + m]; float ss = 0.f;
#pragma unroll
                for (int bj = 0; bj < 2; ++bj) { const int col = u.pn * 256 + bj * 128 + wc * 32 + fq * 8;
                    float v[8];
#pragma unroll
                    for (int n = 0; n < 2; ++n)
#pragma unroll
                        for (int e = 0; e < 4; ++e) { v[4 * n + e] = acc[ai][bj][m][n][e] * r; ss += v[4 * n + e] * v[4 * n + e]; }
                    *(GAS v4u*)(LAT + (size_t)row * 1024 + col) = pack8f(v);
                    if (u.pn == 3 && bj == 0 && wc < 2) { rope8(v, COS, SIN, row, wc * 16 + fq * 4); *(GAS v4u*)(KPE + (size_t)row * 64 + wc * 32 + fq * 8) = pack8f(v); } }
                ss += __shfl_xor(ss, 16); ss += __shfl_xor(ss, 32);
                if (fq == 0) { if (u.pn < 2) SSQ[(size_t)row * 8 + u.pn * 4 + wc] = ss; else if (u.pn == 2) SSKV[(size_t)row * 4 + wc] = ss; } }
    }
};
struct EpiMlaQ { static constexpr bool PERM = true, AFTER_DRAIN = false; const float* SSQ; bf16* Q; const float* COS; const float* SIN; float qscale;
    __device__ __forceinline__ void operator()(AccT acc, const Unit& u, int wr, int wc, int fr, int fq) const {
        float rs[8]; rstd_rows<8>(SSQ, u.pm * 256 + wr * 64 + fr, fq, 1.f / QRANK, rs);
#pragma unroll
        for (int ai = 0; ai < 2; ++ai)
#pragma unroll
            for (int m = 0; m < 4; ++m) { asm volatile("" ::: "memory"); const int row = EPI_ROWS(ai, m);
                const float r = rs[ai * 4 + m] * qscale;
#pragma unroll
                for (int bj = 0; bj < 2; ++bj) { const int col = u.pn * 256 + bj * 128 + wc * 32 + fq * 8, hd = col / DQK, w = col - hd * DQK;
                    float v[8];
#pragma unroll
                    for (int n = 0; n < 2; ++n)
#pragma unroll
                        for (int e = 0; e < 4; ++e) v[4 * n + e] = acc[ai][bj][m][n][e] * r;
                    if (w >= NOPE) rope8(v, COS, SIN, row, (w - NOPE) >> 1);
                    *(GAS v4u*)(Q + (size_t)row * 1536 + col) = pack8f(v); } }
    }
};
struct EpiMlaKV { static constexpr bool PERM = true, AFTER_DRAIN = false; const float* SSKV; bf16* KV;
    __device__ __forceinline__ void operator()(AccT acc, const Unit& u, int wr, int wc, int fr, int fq) const {
        float rs[8]; rstd_rows<4>(SSKV, u.pm * 256 + wr * 64 + fr, fq, 1.f / KVRANK, rs);
#pragma unroll
        for (int ai = 0; ai < 2; ++ai)
#pragma unroll
            for (int m = 0; m < 4; ++m) { const int row = EPI_ROWS(ai, m);
                const float r = rs[ai * 4 + m];
#pragma unroll
                for (int bj = 0; bj < 2; ++bj) { const int col = u.pn * 256 + bj * 128 + wc * 32 + fq * 8;
                    *(GAS v4u*)(KV + (size_t)row * 2048 + col) = pack8v(acc[ai][bj][m][0] * r, acc[ai][bj][m][1] * r); } }
    }
};
struct EpiMlIn { static constexpr bool PERM = true, AFTER_DRAIN = false; const float* SS; bf16* P; float* GATES;
    __device__ __forceinline__ void operator()(AccT acc, const Unit& u, int wr, int wc, int fr, int fq) const {
        float rs[8]; rstd_rows<16>(SS, u.pm * 256 + wr * 64 + fr, fq, 1.f / D, rs);
#pragma unroll
        for (int ai = 0; ai < 2; ++ai)
#pragma unroll
            for (int m = 0; m < 4; ++m) { const int row = EPI_ROWS(ai, m); const float r = rs[ai * 4 + m];
                if (u.pn < 12) {
#pragma unroll
                    for (int bj = 0; bj < 2; ++bj) { const int col = u.pn * 256 + bj * 128 + wc * 32 + fq * 8;
                        *(GAS v4u*)(P + (size_t)row * 3072 + col) = pack8v(acc[ai][bj][m][0] * r, acc[ai][bj][m][1] * r); }
                } else if (wc == 0 && fq < 2) {
                    GAS f32x4* g = (GAS f32x4*)(GATES + (size_t)row * 16 + fq * 8); g[0] = acc[ai][0][m][0] * r; g[1] = acc[ai][0][m][1] * r; } }
    }
};
struct EpiRwBig { static constexpr bool PERM = true, AFTER_DRAIN = false; bf16* RKV; bf16* LOR;
    __device__ __forceinline__ void operator()(AccT acc, const Unit& u, int wr, int wc, int fr, int fq) const {
#pragma unroll
        for (int ai = 0; ai < 2; ++ai)
#pragma unroll
            for (int m = 0; m < 4; ++m) { const int row = EPI_ROWS(ai, m);
#pragma unroll
                for (int bj = 0; bj < 2; ++bj) { const int cl = bj * 128 + wc * 32 + fq * 8;
                    if (u.pn < 12) { *(GAS v4u*)(RKV + (size_t)row * 3072 + u.pn * 256 + cl) = pack8v(acc[ai][bj][m][0], acc[ai][bj][m][1]); }
                    else { float v[8];
#pragma unroll
                        for (int n = 0; n < 2; ++n)
#pragma unroll
                            for (int e = 0; e < 4; ++e) { const float a = acc[ai][bj][m][n][e]; v[4 * n + e] = (cl < 64) ? ftanh(a) : (cl < 128) ? a : fsigmoid(a); }
                        *(GAS v4u*)(LOR + (size_t)row * 256 + cl) = pack8f(v); } } }
    }
};
struct EpiRwUp { static constexpr bool PERM = true, AFTER_DRAIN = false; float* LW; bf16* AA; bf16* GG; const float* w0; const float* a0;
    __device__ __forceinline__ void operator()(AccT acc, const Unit& u, int wr, int wc, int fr, int fq) const {
        const int sec = u.pn >> 2;
#pragma unroll
        for (int ai = 0; ai < 2; ++ai)
#pragma unroll
            for (int m = 0; m < 4; ++m) { asm volatile("" ::: "memory"); const int row = EPI_ROWS(ai, m);
#pragma unroll
                for (int bj = 0; bj < 2; ++bj) { const int col = (u.pn & 3) * 256 + bj * 128 + wc * 32 + fq * 8;
                    if (sec == 0) {
#pragma unroll
                        for (int n = 0; n < 2; ++n) { const f32x4 b = *(const GAS f32x4*)(w0 + col + 4 * n); f32x4 o;
#pragma unroll
                            for (int e = 0; e < 4; ++e) { const float z = -(acc[ai][bj][m][n][e] + b[e]); const float sp = fmaxf(z, 0.f) + flog(1.f + fexp(-fabsf(z))); o[e] = -fexp(-sp - 0.5f); }
                            *(GAS f32x4*)(LW + (size_t)row * 1024 + col + 4 * n) = o; } }
                    else if (sec == 1) { const f32x4 b0 = *(const GAS f32x4*)(a0 + col), b1 = *(const GAS f32x4*)(a0 + col + 4); float v[8];
#pragma unroll
                        for (int e = 0; e < 4; ++e) { v[e] = fsigmoid(acc[ai][bj][m][0][e] + b0[e]); v[4 + e] = fsigmoid(acc[ai][bj][m][1][e] + b1[e]); }
                        *(GAS v4u*)(AA + (size_t)row * 1024 + col) = pack8f(v); }
                    else { *(GAS v4u*)(GG + (size_t)row * 1024 + col) = pack8v(acc[ai][bj][m][0], acc[ai][bj][m][1]); } } }
    }
};

namespace att {
constexpr int SHM_K = 64 * DQK * 2  , SHM_V = 64 * DVH * 2  ;
constexpr int OFF_V = 0, OFF_K = 2 * SHM_V, OFF_WS = OFF_K + 2 * SHM_K, ATT_LDS = OFF_WS + NWAVES * 64 * 4;
static_assert(ATT_LDS <= RING_BYTES, "attention LDS");
#define KSWZ(row, colB) ((row) * 384 + ((colB) ^ (((row) & 7) << 4)))
#define SBAR() __builtin_amdgcn_sched_barrier(0)
__device__ __forceinline__ int v_st(int k, int c) { const int kk = (k & ~0xC) | ((k & 4) << 1) | ((k & 8) >> 1); return ((kk >> 3) * 4 + (c >> 5)) * 512 + ((kk & 7) * 32 + (c & 31)) * 2; }
__device__ __forceinline__ int v_rd_base(int lane) { return ((lane & 3) << 3) | (((lane >> 2) & 3) << 6) | (((lane >> 4) & 1) << 5) | (((lane >> 5) & 1) << 8); }
constexpr int v_rd_off(int d0, int ks, int half) { return d0 * 512 + ks * 4096 + half * 2048; }
__device__ __forceinline__ int crow(int r, int hi) { return (r & 3) + 8 * (r >> 2) + 4 * hi; }
__device__ __forceinline__ void mask_tile(f32x16& p0, f32x16& p1, int dq) {
    const float NEG = -__builtin_inff();
#pragma unroll
    for (int r = 0; r < 16; ++r) { const int c = (r & 3) + 8 * (r >> 2);
        if (dq - c < 0) p0[r] = NEG;
        if (dq - c - 32 < 0) p1[r] = NEG; }
}
constexpr float THR2 = 11.5f;
__device__ __forceinline__ void partialSM(f32x16& p0, f32x16& p1, float& m_reg, float& alpha) {
    float pmax = p0[0];
#pragma unroll
    for (int r = 1; r < 16; ++r) pmax = fmaxf(pmax, p0[r]);
#pragma unroll
    for (int r = 0; r < 16; ++r) pmax = fmaxf(pmax, p1[r]);
    { auto rr = __builtin_amdgcn_permlane32_swap(__float_as_uint(pmax), __float_as_uint(pmax), false, false);
      pmax = fmaxf(__uint_as_float(rr[0]), __uint_as_float(rr[1])); }
    float mn;
    if (__builtin_expect(__all((pmax - m_reg) <= THR2), 1)) { mn = m_reg; alpha = 1.f; }
    else { mn = fmaxf(m_reg, pmax); alpha = __builtin_amdgcn_exp2f(m_reg - mn); m_reg = mn; }
#pragma unroll
    for (int r = 0; r < 16; ++r) { p0[r] = __builtin_amdgcn_exp2f(p0[r] - mn); p1[r] = __builtin_amdgcn_exp2f(p1[r] - mn); }
}
__device__ __forceinline__ void finishSM(f32x16& p0, f32x16& p1, float alpha, float& l_reg, bf16x8& pa0, bf16x8& pa1, bf16x8& pa2, bf16x8& pa3) {
    float ps = 0;
#pragma unroll
    for (int r = 0; r < 16; ++r) ps += p0[r];
#pragma unroll
    for (int r = 0; r < 16; ++r) ps += p1[r];
    { auto rr = __builtin_amdgcn_permlane32_swap(__float_as_uint(ps), __float_as_uint(ps), false, false);
      ps = __uint_as_float(rr[0]) + __uint_as_float(rr[1]); }
    l_reg = l_reg * alpha + ps;
#define PK4(P, B_, OUT) do { unsigned a0 = cvtpk(P[B_+0], P[B_+1]), a1 = cvtpk(P[B_+2], P[B_+3]);                          \
        unsigned b0 = cvtpk(P[B_+4], P[B_+5]), b1 = cvtpk(P[B_+6], P[B_+7]);                                             \
        auto r0 = __builtin_amdgcn_permlane32_swap(a0, b0, false, false); auto r1 = __builtin_amdgcn_permlane32_swap(a1, b1, false, false); \
        v4u w = {r0[0], r1[0], r0[1], r1[1]}; OUT = __builtin_bit_cast(bf16x8, w); } while (0)
    PK4(p0, 0, pa0); PK4(p0, 8, pa1); PK4(p1, 0, pa2); PK4(p1, 8, pa3);
#undef PK4
}
__device__ __forceinline__ void qkt(f32x16& p0, f32x16& p1, const LAS char* Kb, int r32, int hi, const bf16x8* qr) {
    p0 = f32x16{}; p1 = f32x16{};
    const LAS char* kb[4];
#pragma unroll
    for (int dd = 0; dd < 4; ++dd) kb[dd] = Kb + r32 * 384 + ((dd * 32 + hi * 16) ^ ((r32 & 7) << 4));
#pragma unroll
    for (int d0 = 0; d0 < 12; ++d0) { const LAS char* a = kb[d0 & 3] + (d0 >> 2) * 128;
        const bf16x8 b0 = *(const LAS bf16x8*)(a);
        const bf16x8 b1 = *(const LAS bf16x8*)(a + 32 * 384);
        p0 = __builtin_amdgcn_mfma_f32_32x32x16_bf16(b0, qr[d0], p0, 0, 0, 0);
        p1 = __builtin_amdgcn_mfma_f32_32x32x16_bf16(b1, qr[d0], p1, 0, 0, 0); }
}
__device__ __forceinline__ void pv_tile(f32x16* o, int vb0, bf16x8 pa0, bf16x8 pa1, bf16x8 pa2, bf16x8 pa3) {
#define TRRD(dst, off) asm volatile("ds_read_b64_tr_b16 %0, %1 offset:%2" : "=&v"(dst) : "v"(vb0), "i"(off) : "memory")
#define PV_D0(d0) do { s16x4 l0, l1, l2, l3, h0, h1, h2, h3; constexpr int b_ = v_rd_off(d0, 0, 0); \
        TRRD(l0, b_); TRRD(h0, b_ + 2048); TRRD(l1, b_ + 4096); TRRD(h1, b_ + 6144); TRRD(l2, b_ + 8192); TRRD(h2, b_ + 10240); TRRD(l3, b_ + 12288); TRRD(h3, b_ + 14336); \
        asm volatile("s_waitcnt lgkmcnt(0)" ::: "memory"); SBAR(); \
        o[d0] = __builtin_amdgcn_mfma_f32_32x32x16_bf16(pa0, (bf16x8){l0[0], l0[1], l0[2], l0[3], h0[0], h0[1], h0[2], h0[3]}, o[d0], 0, 0, 0);   \
        o[d0] = __builtin_amdgcn_mfma_f32_32x32x16_bf16(pa1, (bf16x8){l1[0], l1[1], l1[2], l1[3], h1[0], h1[1], h1[2], h1[3]}, o[d0], 0, 0, 0);   \
        o[d0] = __builtin_amdgcn_mfma_f32_32x32x16_bf16(pa2, (bf16x8){l2[0], l2[1], l2[2], l2[3], h2[0], h2[1], h2[2], h2[3]}, o[d0], 0, 0, 0);   \
        o[d0] = __builtin_amdgcn_mfma_f32_32x32x16_bf16(pa3, (bf16x8){l3[0], l3[1], l3[2], l3[3], h3[0], h3[1], h3[2], h3[3]}, o[d0], 0, 0, 0); } while (0)
    PV_D0(0); PV_D0(1); PV_D0(2); PV_D0(3);
#undef PV_D0
#undef TRRD
}
__device__ __forceinline__ void attn_unit(int wid, int b, int h, int qb, const bf16* Q, const bf16* KV, const bf16* KPE, bf16* O, LAS char* lds) {
    const int lane = fresh_lane(), tid = wid * 64 + lane, r32 = lane & 31, hi = lane >> 5;
    const size_t rowbase = (size_t)b * SEQ; const int q0 = qb * 256;
    LAS char* V_lds = lds + OFF_V; LAS char* K_lds = lds + OFF_K;
    LAS float* wsf = (LAS float*)(lds + OFF_WS) + wid * 64; LAS float* li_l = wsf; LAS float* al_l = wsf + 32;
    bf16x8 qr[12];
    { const bf16* Qw = Q + (rowbase + q0 + wid * 32 + r32) * 1536 + h * DQK + hi * 8;
#pragma unroll
      for (int d0 = 0; d0 < 12; ++d0) qr[d0] = *(const GAS bf16x8*)(Qw + d0 * 16); }
    const int NT = 4 * (qb + 1);
    const bf16* ksrc[3]; int kdst[3]; int kstr[3];
#pragma unroll
    for (int i = 0; i < 3; ++i) { const int id = tid + 512 * i, row = id / 24, ch = id - row * 24;
        if (ch < 16) { ksrc[i] = KV + (rowbase + row) * 2048 + h * 256 + ch * 8; kstr[i] = 2048; }
        else { ksrc[i] = KPE + (rowbase + row) * 64 + (ch - 16) * 8; kstr[i] = 64; }
        kdst[i] = KSWZ(row, ch * 16); }
    const int sr = tid >> 4, sc = (tid & 15) * 8;
    const bf16* vsrc = KV + (rowbase + sr) * 2048 + h * 256 + 128 + sc;
    const int vst0 = v_st(sr, sc), vst1 = v_st(32 + sr, sc);
    const int vb0 = (int)(uintptr_t)V_lds + v_rd_base(lane);
    bf16x8 sk0, sk1, sk2, sv0, sv1;
#define SLOAD(t) do { sk0 = *(const GAS bf16x8*)(ksrc[0] + (size_t)(t) * 64 * kstr[0]); sk1 = *(const GAS bf16x8*)(ksrc[1] + (size_t)(t) * 64 * kstr[1]); sk2 = *(const GAS bf16x8*)(ksrc[2] + (size_t)(t) * 64 * kstr[2]); \
                      sv0 = *(const GAS bf16x8*)(vsrc + (size_t)(t) * 64 * 2048); sv1 = *(const GAS bf16x8*)(vsrc + (size_t)((t) * 64 + 32) * 2048); } while (0)
#define SWRITE(bf) do { *(LAS bf16x8*)(K_lds + (bf) * SHM_K + kdst[0]) = sk0; *(LAS bf16x8*)(K_lds + (bf) * SHM_K + kdst[1]) = sk1; *(LAS bf16x8*)(K_lds + (bf) * SHM_K + kdst[2]) = sk2; \
                        *(LAS bf16x8*)(V_lds + (bf) * SHM_V + vst0) = sv0; *(LAS bf16x8*)(V_lds + (bf) * SHM_V + vst1) = sv1; } while (0)
    float m_reg = -1e30f, l_reg = 0.f; f32x16 o[4] = {};
    const int qlo = q0 + wid * 32, qm = qlo + r32 - 4 * hi;
    SLOAD(0); SWRITE(0);
    __syncthreads();
    for (int t = 0; t < NT; ++t) {
        const int bf = t & 1;
        if (t + 1 < NT) SLOAD(t + 1);
        f32x16 p0, p1; float alpha; bf16x8 pa0, pa1, pa2, pa3;
        SBAR();
        qkt(p0, p1, K_lds + bf * SHM_K, r32, hi, qr);
        const int kb = t * 64;
        if (kb + 63 > qlo) mask_tile(p0, p1, qm - kb);
        partialSM(p0, p1, m_reg, alpha);
        if (__any(alpha < 1.f)) { if (hi == 0) al_l[r32] = alpha; LDS_WAIT();
#pragma unroll
            for (int d_ = 0; d_ < 4; ++d_)
#pragma unroll
                for (int r = 0; r < 16; ++r) o[d_][r] *= al_l[crow(r, hi)]; }
        finishSM(p0, p1, alpha, l_reg, pa0, pa1, pa2, pa3);
        SBAR();
        pv_tile(o, vb0 + bf * SHM_V, pa0, pa1, pa2, pa3);
        if (t + 1 < NT) SWRITE(bf ^ 1);
        __syncthreads();
    }
    if (hi == 0) li_l[r32] = l_reg; LDS_WAIT();
    bf16* Ow = O + (rowbase + q0 + wid * 32) * 1024 + h * DVH;
#pragma unroll
    for (int r = 0; r < 16; ++r) { const int orow = crow(r, hi); const float rl = frcp(li_l[orow]);
#pragma unroll
        for (int d0 = 0; d0 < 4; ++d0) { const float v = o[d0][r] * rl; const float vn = __shfl_xor(v, 1);
            if ((r32 & 1) == 0) *(GAS unsigned*)(Ow + (size_t)orow * 1024 + d0 * 32 + r32) = cvtpk(v, vn); } }
    __syncthreads();
#undef SLOAD
#undef SWRITE
}
#undef KSWZ
}

__device__ __forceinline__ void ml_conv_phase(Frame& F, const Inputs& in, int j) {
    const bf16* P = (const bf16*)(F.ws + WS_ARENA + A_P); const float* GATES = (const float*)(F.ws + WS_ARENA + A_GATES);
    float* QKC = (float*)(F.ws + WS_ARENA + A_QKC); float* IGLF = (float*)(F.ws + WS_ARENA + A_IGLF);
    const float* cw = in.ml_conv_w + (size_t)j * 4 * 1024; const float* cb = in.ml_conv_b + (size_t)j * 1024; const float* bif = in.ml_b_if + (size_t)j * 16;
    const int gt = F.gw * 64 + F.lane, NT_ = F.NGW * 64;
    for (int e = gt; e < T * 128; e += NT_) {
        const int t = e >> 7, c = (e & 127) * 8, s = t & (SEQ - 1);
        float acc[8];
        { const f32x4 b0 = *(const GAS f32x4*)(cb + c), b1 = *(const GAS f32x4*)(cb + c + 4);
#pragma unroll
          for (int q = 0; q < 4; ++q) { acc[q] = b0[q]; acc[4 + q] = b1[q]; } }
#pragma unroll
        for (int k = 0; k < 4; ++k) { const int dt = 3 - k;
            if (s - dt >= 0) { float pv[8]; unpack8(*(const GAS v4u*)(P + (size_t)(t - dt) * 3072 + c), pv);
                const f32x4 w0 = *(const GAS f32x4*)(cw + k * 1024 + c), w1 = *(const GAS f32x4*)(cw + k * 1024 + c + 4);
#pragma unroll
                for (int q = 0; q < 4; ++q) { acc[q] += w0[q] * pv[q]; acc[4 + q] += w1[q] * pv[4 + q]; } } }
        const float sc = (c >= 512) ? 0.125f : 1.f;
        f32x4 o0, o1;
#pragma unroll
        for (int q = 0; q < 4; ++q) { o0[q] = fsilu(acc[q]) * sc; o1[q] = fsilu(acc[4 + q]) * sc; }
        GAS f32x4* op = (GAS f32x4*)(QKC + (size_t)t * 1024 + c); op[0] = o0; op[1] = o1;
    }
    for (int e = gt; e < T * 16; e += NT_) { const int hcol = e & 15; const float g = GATES[e] + bif[hcol];
        float r = g;
        if (hcol >= 8) r = fminf(g, 0.f) - flog(1.f + fexp(-fabsf(g)));
        IGLF[e] = r; }
}
__device__ __forceinline__ void ml_seq_phase(Frame& F) {
    if ((int)blockIdx.x >= BATCH * ML_H) return;
    const int bh = blockIdx.x, b = bh >> 3, h = bh & 7, tid = F.tid, v = tid >> 2, kq = tid & 3;
    const bf16* P = (const bf16*)(F.ws + WS_ARENA + A_P); const float* QKC = (const float*)(F.ws + WS_ARENA + A_QKC); const float* IGLF = (const float*)(F.ws + WS_ARENA + A_IGLF);
    float* HRAW = (float*)(F.ws + WS_ARENA + A_HRAW);
    LAS float* s_q = (LAS float*)F.lds; LAS float* s_k = s_q + 64 * 64; LAS float* s_v = s_k + 64 * 64; LAS float* s_h = s_v + 64 * 128; LAS float* s_ig = s_h + 64 * 128; LAS float* s_lf = s_ig + 64;
    float C[16], n[16]; float mst = 0.f;
#pragma unroll
    for (int d = 0; d < 16; ++d) { C[d] = 0.f; n[d] = 0.f; }
    for (int blk = 0; blk < SEQ / 64; ++blk) {
        const size_t t0 = (size_t)b * SEQ + (size_t)blk * 64;
        __syncthreads();
        for (int e = tid; e < 64 * 16; e += 512) { const int tt = e >> 4, c4 = (e & 15) * 4;
            *(LAS f32x4*)(s_q + tt * 64 + c4) = *(const GAS f32x4*)(QKC + (t0 + tt) * 1024 + h * 64 + c4);
            *(LAS f32x4*)(s_k + tt * 64 + c4) = *(const GAS f32x4*)(QKC + (t0 + tt) * 1024 + 512 + h * 64 + c4); }
        for (int e = tid; e < 64 * 16; e += 512) { const int tt = e >> 4, c8 = (e & 15) * 8; float pv[8];
            unpack8(*(const GAS v4u*)(P + (t0 + tt) * 3072 + 1024 + h * 128 + c8), pv);
#pragma unroll
            for (int q = 0; q < 8; ++q) s_v[tt * 128 + c8 + q] = pv[q]; }
        if (tid < 64) { s_ig[tid] = IGLF[(t0 + tid) * 16 + h]; s_lf[tid] = IGLF[(t0 + tid) * 16 + 8 + h]; }
        __syncthreads();
        for (int tt = 0; tt < 64; ++tt) {
            const float lf = s_lf[tt], ig = s_ig[tt];
            const float mn = fmaxf(lf + mst, ig), fw = fexp(lf + mst - mn), iw = fexp(ig - mn); mst = mn;
            const float vv = s_v[tt * 128 + v] * iw;
            float num = 0.f, den = 0.f;
#pragma unroll
            for (int d4 = 0; d4 < 4; ++d4) { const f32x4 kk = *(const LAS f32x4*)(s_k + tt * 64 + kq * 16 + d4 * 4), qq = *(const LAS f32x4*)(s_q + tt * 64 + kq * 16 + d4 * 4);
#pragma unroll
                for (int q = 0; q < 4; ++q) { const int d = d4 * 4 + q; C[d] = fw * C[d] + vv * kk[q]; n[d] = fw * n[d] + iw * kk[q]; num += C[d] * qq[q]; den += n[d] * qq[q]; } }
            num += __shfl_xor(num, 1); num += __shfl_xor(num, 2); den += __shfl_xor(den, 1); den += __shfl_xor(den, 2);
            const float hv = num * frcp(fmaxf(fabsf(den), fexp(-mn)));
            if (kq == 0) s_h[tt * 128 + v] = hv;
        }
        __syncthreads();
        for (int e = tid; e < 64 * 32; e += 512) { const int tt = e >> 5, c4 = (e & 31) * 4;
            *(GAS f32x4*)(HRAW + (t0 + tt) * 1024 + h * 128 + c4) = *(const LAS f32x4*)(s_h + tt * 128 + c4); }
    }
}
__device__ __forceinline__ void ml_out_phase(Frame& F, const Inputs& in, int j) {
    const bf16* P = (const bf16*)(F.ws + WS_ARENA + A_P); const float* HRAW = (const float*)(F.ws + WS_ARENA + A_HRAW); bf16* HM = (bf16*)(F.ws + WS_ARENA + A_HM);
    const float* gn = in.ml_out_norm + (size_t)j * 1024;
    for (int m = F.gw; m < T; m += F.NGW) { const int c = F.lane * 16;
        float hv[16]; float ss = 0.f;
#pragma unroll
        for (int q = 0; q < 4; ++q) { const f32x4 x = *(const GAS f32x4*)(HRAW + (size_t)m * 1024 + c + 4 * q);
#pragma unroll
            for (int e = 0; e < 4; ++e) { hv[4 * q + e] = x[e]; ss += x[e] * x[e]; } }
        ss += __shfl_xor(ss, 1); ss += __shfl_xor(ss, 2); ss += __shfl_xor(ss, 4);
        const float r = frsq(ss * (1.f / 128.f) + RMS_EPS);
        float ov[16]; unpack8(*(const GAS v4u*)(P + (size_t)m * 3072 + 2048 + c), ov); unpack8(*(const GAS v4u*)(P + (size_t)m * 3072 + 2048 + c + 8), ov + 8);
        float res[16];
#pragma unroll
        for (int e = 0; e < 16; ++e) res[e] = hv[e] * r * gn[c + e] * fsigmoid(ov[e]);
        GAS v4u* op = (GAS v4u*)(HM + (size_t)m * 1024 + c); op[0] = pack8f(res); op[1] = pack8f(res + 8);
    }
}

__device__ __forceinline__ void rw_shift_phase(Frame& F) {
    bf16* HX = (bf16*)(F.ws + WS_ARENA + A_HX);
    for (int m = F.gw; m < T; m += F.NGW) { const int c = F.lane * 16, s = m & (SEQ - 1);
        const float r = rstd16(F.SS, m), rp = (s > 0) ? rstd16(F.SS, m - 1) : 0.f;
        float xc[16], xq[16], hv[16], xv[16];
        unpack8(*(const GAS v4u*)(F.XB + (size_t)m * D + c), xc); unpack8(*(const GAS v4u*)(F.XB + (size_t)m * D + c + 8), xc + 8);
#pragma unroll
        for (int e = 0; e < 16; ++e) xq[e] = 0.f;
        if (s > 0) { unpack8(*(const GAS v4u*)(F.XB + (size_t)(m - 1) * D + c), xq); unpack8(*(const GAS v4u*)(F.XB + (size_t)(m - 1) * D + c + 8), xq + 8); }
#pragma unroll
        for (int e = 0; e < 16; ++e) { hv[e] = xc[e] * r; xv[e] = xq[e] * rp - xc[e] * r; }
        GAS v4u* o1 = (GAS v4u*)(HX + (size_t)m * 2048 + c); o1[0] = pack8f(hv); o1[1] = pack8f(hv + 8);
        GAS v4u* o2 = (GAS v4u*)(HX + (size_t)m * 2048 + 1024 + c); o2[0] = pack8f(xv); o2[1] = pack8f(xv + 8);
    }
}
__device__ __forceinline__ void rw_seq_phase(Frame& F, const Inputs& in, int j) {
    if ((int)blockIdx.x >= BATCH * RW_H) return;
    const int bh = blockIdx.x, b = bh >> 4, h = bh & 15, tid = F.tid, i = tid >> 3, jr = tid & 7;
    const bf16* RKV = (const bf16*)(F.ws + WS_ARENA + A_RKV); const bf16* AA = (const bf16*)(F.ws + WS_XB); float* LW = (float*)(F.ws + WS_ARENA + A_LW);
    LAS float* s_r = (LAS float*)F.lds; LAS float* s_w = s_r + 4096; LAS float* s_k = s_w + 4096; LAS float* s_v = s_k + 4096; LAS float* s_a = s_v + 4096; LAS float* s_b = s_a + 4096; LAS float* s_y = s_b + 4096;
    float kkc[8], kac[8];
#pragma unroll
    for (int q = 0; q < 8; ++q) { kkc[q] = in.rw_k_k[(size_t)j * 1024 + h * 64 + jr * 8 + q]; kac[q] = in.rw_k_a[(size_t)j * 1024 + h * 64 + jr * 8 + q]; }
    float S[8];
#pragma unroll
    for (int q = 0; q < 8; ++q) S[q] = 0.f;
    for (int blk = 0; blk < SEQ / 64; ++blk) {
        const size_t t0 = (size_t)b * SEQ + (size_t)blk * 64;
        __syncthreads();
        { const int tt = tid >> 3; const size_t t = t0 + tt; const int c = h * 64 + jr * 8;
          float rv[8], kv[8], vv[8], av[8];
          unpack8(*(const GAS v4u*)(RKV + t * 3072 + c), rv); unpack8(*(const GAS v4u*)(RKV + t * 3072 + 1024 + c), kv); unpack8(*(const GAS v4u*)(RKV + t * 3072 + 2048 + c), vv);
          unpack8(*(const GAS v4u*)(AA + t * 1024 + c), av);
          const f32x4 l0 = *(const GAS f32x4*)(LW + t * 1024 + c), l1 = *(const GAS f32x4*)(LW + t * 1024 + c + 4);
          float kk[8]; float ss = 0.f;
#pragma unroll
          for (int q = 0; q < 8; ++q) { kk[q] = kv[q] * kkc[q]; ss += kk[q] * kk[q]; }
          ss += __shfl_xor(ss, 1); ss += __shfl_xor(ss, 2); ss += __shfl_xor(ss, 4);
          const float inv = frcp(fmaxf(fsqrt(ss), 1e-12f));
#pragma unroll
          for (int q = 0; q < 8; ++q) { const float kn = kk[q] * inv; const int o = tt * 64 + jr * 8 + q;
              s_r[o] = rv[q]; s_w[o] = fexp(q < 4 ? l0[q] : l1[q - 4]); s_k[o] = kv[q] * (1.f + (av[q] - 1.f) * kac[q]); s_v[o] = vv[q]; s_a[o] = -kn; s_b[o] = kn * av[q]; } }
        __syncthreads();
        for (int tt = 0; tt < 64; ++tt) {
            const int o = tt * 64 + jr * 8;
            const f32x4 a0 = *(const LAS f32x4*)(s_a + o), a1 = *(const LAS f32x4*)(s_a + o + 4), w0 = *(const LAS f32x4*)(s_w + o), w1 = *(const LAS f32x4*)(s_w + o + 4);
            const f32x4 b0 = *(const LAS f32x4*)(s_b + o), b1 = *(const LAS f32x4*)(s_b + o + 4), k0 = *(const LAS f32x4*)(s_k + o), k1 = *(const LAS f32x4*)(s_k + o + 4);
            const f32x4 r0 = *(const LAS f32x4*)(s_r + o), r1 = *(const LAS f32x4*)(s_r + o + 4);
            const float vi = s_v[tt * 64 + i];
            float sa = 0.f;
#pragma unroll
            for (int q = 0; q < 4; ++q) { sa += S[q] * a0[q]; sa += S[4 + q] * a1[q]; }
            sa += __shfl_xor(sa, 1); sa += __shfl_xor(sa, 2); sa += __shfl_xor(sa, 4);
            float y = 0.f;
#pragma unroll
            for (int q = 0; q < 4; ++q) { S[q] = S[q] * w0[q] + sa * b0[q] + vi * k0[q]; S[4 + q] = S[4 + q] * w1[q] + sa * b1[q] + vi * k1[q]; y += S[q] * r0[q]; y += S[4 + q] * r1[q]; }
            y += __shfl_xor(y, 1); y += __shfl_xor(y, 2); y += __shfl_xor(y, 4);
            if (jr == 0) s_y[tt * 64 + i] = y;
        }
        __syncthreads();
        for (int e = tid; e < 64 * 16; e += 512) { const int tt = e >> 4, c4 = (e & 15) * 4;
            *(GAS f32x4*)(LW + (t0 + tt) * 1024 + h * 64 + c4) = *(const LAS f32x4*)(s_y + tt * 64 + c4); }
    }
}
__device__ __forceinline__ void rw_out_phase(Frame& F, const Inputs& in, int j) {
    const bf16* RKV = (const bf16*)(F.ws + WS_ARENA + A_RKV); const bf16* AA = (const bf16*)(F.ws + WS_XB); const float* Y = (const float*)(F.ws + WS_ARENA + A_LW);
    const bf16* GG = (const bf16*)(F.ws + WS_ARENA + A_GG); bf16* YG = (bf16*)(F.ws + WS_ARENA + A_YG);
    const float* ka = in.rw_k_a + (size_t)j * 1024; const float* rk = in.rw_r_k + (size_t)j * 1024; const float* lnw = in.rw_ln_w + (size_t)j * 1024; const float* lnb = in.rw_ln_b + (size_t)j * 1024;
    for (int m = F.gw; m < T; m += F.NGW) { const int c = F.lane * 16;
        float yv[16]; float s1 = 0.f;
#pragma unroll
        for (int q = 0; q < 4; ++q) { const f32x4 x = *(const GAS f32x4*)(Y + (size_t)m * 1024 + c + 4 * q);
#pragma unroll
            for (int e = 0; e < 4; ++e) { yv[4 * q + e] = x[e]; s1 += x[e]; } }
        s1 += __shfl_xor(s1, 1); s1 += __shfl_xor(s1, 2); const float mean = s1 * (1.f / 64.f);
        float s2 = 0.f;
#pragma unroll
        for (int e = 0; e < 16; ++e) { yv[e] -= mean; s2 += yv[e] * yv[e]; }
        s2 += __shfl_xor(s2, 1); s2 += __shfl_xor(s2, 2); const float rs = frsq(s2 * (1.f / 64.f) + 64e-5f);
        float rv[16], kv[16], vv[16], av[16], gv[16];
        unpack8(*(const GAS v4u*)(RKV + (size_t)m * 3072 + c), rv); unpack8(*(const GAS v4u*)(RKV + (size_t)m * 3072 + c + 8), rv + 8);
        unpack8(*(const GAS v4u*)(RKV + (size_t)m * 3072 + 1024 + c), kv); unpack8(*(const GAS v4u*)(RKV + (size_t)m * 3072 + 1024 + c + 8), kv + 8);
        unpack8(*(const GAS v4u*)(RKV + (size_t)m * 3072 + 2048 + c), vv); unpack8(*(const GAS v4u*)(RKV + (size_t)m * 3072 + 2048 + c + 8), vv + 8);
        unpack8(*(const GAS v4u*)(AA + (size_t)m * 1024 + c), av); unpack8(*(const GAS v4u*)(AA + (size_t)m * 1024 + c + 8), av + 8);
        unpack8(*(const GAS v4u*)(GG + (size_t)m * 1024 + c), gv); unpack8(*(const GAS v4u*)(GG + (size_t)m * 1024 + c + 8), gv + 8);
        float bs = 0.f;
#pragma unroll
        for (int e = 0; e < 16; ++e) { const float kp = kv[e] * (1.f + (av[e] - 1.f) * ka[c + e]); bs += rv[e] * kp * rk[c + e]; }
        bs += __shfl_xor(bs, 1); bs += __shfl_xor(bs, 2);
        float res[16];
#pragma unroll
        for (int e = 0; e < 16; ++e) res[e] = (yv[e] * rs * lnw[c + e] + lnb[c + e] + bs * vv[e]) * gv[e];
        GAS v4u* op = (GAS v4u*)(YG + (size_t)m * 1024 + c); op[0] = pack8f(res); op[1] = pack8f(res + 8);
    }
}
__device__ __forceinline__ void final_norm_phase(Frame& F, const Inputs& in) {
    for (int m = F.gw; m < T; m += F.NGW) { const float r = rstd16(F.SS, m);
        GAS f32x4* op = (GAS f32x4*)(F.X + (size_t)m * D) + F.lane * 4; const GAS f32x4* gp = (const GAS f32x4*)in.final_norm + F.lane * 4;
        float xc[16]; unpack8(*(const GAS v4u*)(F.XB + (size_t)m * D + F.lane * 16), xc); unpack8(*(const GAS v4u*)(F.XB + (size_t)m * D + F.lane * 16 + 8), xc + 8);
#pragma unroll
        for (int q = 0; q < 4; ++q) { const f32x4 g = gp[q]; f32x4 o; o.x = xc[4 * q] * r * g.x; o.y = xc[4 * q + 1] * r * g.y; o.z = xc[4 * q + 2] * r * g.z; o.w = xc[4 * q + 3] * r * g.w; op[q] = o; } }
}

namespace mlc {
constexpr int NUNIT = BATCH * ML_H * (SEQ / 64);
constexpr size_t A_QKB = 97 * MiB;
constexpr size_t A_XT = 130 * MiB;
constexpr size_t A_CT = 194 * MiB;
constexpr size_t A_NX = 226 * MiB, A_NC = 227 * MiB;
constexpr size_t A_SC = 228 * MiB;
constexpr size_t A_HM2 = A_XT;
constexpr size_t A_IG2 = 129 * MiB;
constexpr int SLOT = 34816;
using att::v_st; using att::v_rd_base; using att::v_rd_off; using att::crow;
#define TRRD(dst, base, off) asm volatile("ds_read_b64_tr_b16 %0, %1 offset:%2" : "=&v"(dst) : "v"(base), "i"(off) : "memory")
#define FRAG(l, h) ((bf16x8){l[0], l[1], l[2], l[3], h[0], h[1], h[2], h[3]})
__device__ __forceinline__ float swap_add(float x) { auto rr = __builtin_amdgcn_permlane32_swap(__float_as_uint(x), __float_as_uint(x), false, false); return __uint_as_float(rr[0]) + __uint_as_float(rr[1]); }
__device__ __forceinline__ float wave_incl_scan_add(float v, int lane) {
#pragma unroll
    for (int o = 1; o < 64; o <<= 1) { const float t = __shfl_up(v, o); if (lane >= o) v += t; }
    return v;
}
__device__ __forceinline__ float wave_incl_scan_max(float v, int lane) {
#pragma unroll
    for (int o = 1; o < 64; o <<= 1) { const float t = __shfl_up(v, o); if (lane >= o) v = fmaxf(v, t); }
    return v;
}
__device__ __forceinline__ float wave_max(float v) {
#pragma unroll
    for (int o = 1; o < 64; o <<= 1) v = fmaxf(v, __shfl_xor(v, o));
    return v;
}
__device__ __forceinline__ void conv_phase(Frame& F, const Inputs& in, int j) {
    const bf16* P = (const bf16*)(F.ws + WS_ARENA + A_P); const float* GATES = (const float*)(F.ws + WS_ARENA + A_GATES);
    bf16* QKB = (bf16*)(F.ws + WS_ARENA + A_QKB); float* IGLF = (float*)(F.ws + WS_ARENA + mlc::A_IG2);
    const float* cw = in.ml_conv_w + (size_t)j * 4 * 1024; const float* cb = in.ml_conv_b + (size_t)j * 1024; const float* bif = in.ml_b_if + (size_t)j * 16;
    const int gt = F.gw * 64 + F.lane, NT_ = F.NGW * 64;
    for (int e = gt; e < T * 128; e += NT_) {
        const int t = e >> 7, c = (e & 127) * 8, s = t & (SEQ - 1);
        float acc[8];
        { const f32x4 b0 = *(const GAS f32x4*)(cb + c), b1 = *(const GAS f32x4*)(cb + c + 4);
#pragma unroll
          for (int q = 0; q < 4; ++q) { acc[q] = b0[q]; acc[4 + q] = b1[q]; } }
#pragma unroll
        for (int k = 0; k < 4; ++k) { const int dt = 3 - k;
            if (s - dt >= 0) { float pv[8]; unpack8(*(const GAS v4u*)(P + (size_t)(t - dt) * 3072 + c), pv);
                const f32x4 w0 = *(const GAS f32x4*)(cw + k * 1024 + c), w1 = *(const GAS f32x4*)(cw + k * 1024 + c + 4);
#pragma unroll
                for (int q = 0; q < 4; ++q) { acc[q] += w0[q] * pv[q]; acc[4 + q] += w1[q] * pv[4 + q]; } } }
        const float sc = (c >= 512) ? 0.125f : 1.f;
        float o[8];
#pragma unroll
        for (int q = 0; q < 8; ++q) o[q] = fsilu(acc[q]) * sc;
        *(GAS v4u*)(QKB + (size_t)t * 1024 + c) = pack8f(o);
    }
    for (int e = gt; e < T * 16; e += NT_) { const int hcol = e & 15; const float g = GATES[e] + bif[hcol];
        float r = g;
        if (hcol >= 8) r = fminf(g, 0.f) - flog(1.f + fexp(-fabsf(g)));
        IGLF[e] = r; }
}
__device__ __forceinline__ void stage_tr128(LAS char* tile, const bf16* src, int ld, int lt, int nthr) {
    for (int idx = lt; idx < 1024; idx += nthr) { const int row = idx >> 4, ch = idx & 15;
        *(LAS v4u*)(tile + v_st(row, ch * 8)) = *(const GAS v4u*)(src + (size_t)row * ld + ch * 8); }
}
__device__ __forceinline__ void xa_phase(Frame& F) {
    const bf16* P = (const bf16*)(F.ws + WS_ARENA + A_P); const bf16* QKB = (const bf16*)(F.ws + WS_ARENA + A_QKB); const float* IGLF = (const float*)(F.ws + WS_ARENA + mlc::A_IG2);
    float* XT = (float*)(F.ws + WS_ARENA + A_XT); float* NX = (float*)(F.ws + WS_ARENA + A_NX); float* SC = (float*)(F.ws + WS_ARENA + A_SC);
    const int lane = F.lane, wave = F.wave, r32 = lane & 31, hi = lane >> 5, us = wave >> 1, half = wave & 1, lt = half * 64 + lane;
    LAS char* slot = (LAS char*)F.lds + us * SLOT; LAS char* Vt = slot; LAS char* KWt = slot + 16384; LAS float* wsl = (LAS float*)(slot + 32768);
    for (int u0 = (int)blockIdx.x * 4; u0 < NUNIT; u0 += F.G * 4) {
        const int u = u0 + us, bh = u >> 7, c = u & 127, b = bh >> 3, h = bh & 7; const size_t t0 = (size_t)b * SEQ + (size_t)c * 64;
        const float lf = IGLF[(t0 + lane) * 16 + 8 + h], ig = IGLF[(t0 + lane) * 16 + h];
        const float Fc = wave_incl_scan_add(lf, lane), bs = ig - Fc, M = wave_max(bs), a = __shfl(Fc, 63), w = fexp(bs - M);
        if (half == 0) { wsl[lane] = w; if (lane == 0) { SC[u] = a; SC[NUNIT + u] = M; } }
        __syncthreads();
        stage_tr128(Vt, P + t0 * 3072 + 1024 + h * 128, 3072, lt, 128);
        for (int idx = lt; idx < 512; idx += 128) { const int row = idx >> 3, ch = idx & 7; float kv[8];
            unpack8(*(const GAS v4u*)(QKB + (t0 + row) * 1024 + 512 + h * 64 + ch * 8), kv); const float ww = wsl[row];
#pragma unroll
            for (int q = 0; q < 8; ++q) kv[q] *= ww;
            *(LAS v4u*)(KWt + v_st(row, ch * 8)) = pack8f(kv); }
        __syncthreads();
        const int vb = (int)(uintptr_t)Vt + v_rd_base(lane), kb = (int)(uintptr_t)KWt + v_rd_base(lane) + half * 512;
        f32x16 acc[4] = {};
#define XA_VT(vt) do { s16x4 vl0, vh0, vl1, vh1, vl2, vh2, vl3, vh3, kl0, kh0, kl1, kh1, kl2, kh2, kl3, kh3; constexpr int o_ = v_rd_off(vt, 0, 0); \
            TRRD(vl0, vb, o_); TRRD(vh0, vb, o_ + 2048); TRRD(vl1, vb, o_ + 4096); TRRD(vh1, vb, o_ + 6144); TRRD(vl2, vb, o_ + 8192); TRRD(vh2, vb, o_ + 10240); TRRD(vl3, vb, o_ + 12288); TRRD(vh3, vb, o_ + 14336); \
            TRRD(kl0, kb, 0); TRRD(kh0, kb, 2048); TRRD(kl1, kb, 4096); TRRD(kh1, kb, 6144); TRRD(kl2, kb, 8192); TRRD(kh2, kb, 10240); TRRD(kl3, kb, 12288); TRRD(kh3, kb, 14336); \
            asm volatile("s_waitcnt lgkmcnt(0)" ::: "memory"); __builtin_amdgcn_sched_barrier(0); \
            acc[vt] = __builtin_amdgcn_mfma_f32_32x32x16_bf16(FRAG(vl0, vh0), FRAG(kl0, kh0), acc[vt], 0, 0, 0); \
            acc[vt] = __builtin_amdgcn_mfma_f32_32x32x16_bf16(FRAG(vl1, vh1), FRAG(kl1, kh1), acc[vt], 0, 0, 0); \
            acc[vt] = __builtin_amdgcn_mfma_f32_32x32x16_bf16(FRAG(vl2, vh2), FRAG(kl2, kh2), acc[vt], 0, 0, 0); \
            acc[vt] = __builtin_amdgcn_mfma_f32_32x32x16_bf16(FRAG(vl3, vh3), FRAG(kl3, kh3), acc[vt], 0, 0, 0); } while (0)
        XA_VT(0); XA_VT(1); XA_VT(2); XA_VT(3);
#undef XA_VT
        { const int d = half * 32 + r32; float nx = 0.f;
#pragma unroll 8
          for (int s = 0; s < 32; ++s) nx += bf1(*(const LAS bf16*)(KWt + v_st(32 * hi + s, d & ~7) + (d & 7) * 2));
          nx = swap_add(nx);
          if (hi == 0) NX[(size_t)u * 64 + d] = nx; }
        { GAS float* xo = (GAS float*)(XT + (size_t)u * 8192 + half * 32 + r32 + hi * 256);
#pragma unroll
          for (int vt = 0; vt < 4; ++vt)
#pragma unroll
              for (int r4 = 0; r4 < 4; ++r4) { asm volatile("" : "+v"(xo));
#pragma unroll
                  for (int r0 = 0; r0 < 4; ++r0) xo[r0 * 64] = acc[vt][r4 * 4 + r0];
                  xo += 512; } }
        __syncthreads();
    }
}
__device__ __forceinline__ void xb_phase(Frame& F) {
    const float* XT = (const float*)(F.ws + WS_ARENA + A_XT); const float* NX = (const float*)(F.ws + WS_ARENA + A_NX); float* SC = (float*)(F.ws + WS_ARENA + A_SC);
    bf16* CT = (bf16*)(F.ws + WS_ARENA + A_CT); float* NC = (float*)(F.ws + WS_ARENA + A_NC);
    for (int g = (int)blockIdx.x * 512 + F.tid; g < BATCH * ML_H * 8192; g += F.G * 512) {
        const int bh = g >> 13, e = g & 8191;
        float m = 0.f, C = 0.f, n = 0.f;
#pragma unroll 8
        for (int c = 0; c < 128; ++c) { const int u = bh * 128 + c;
            const float a = SC[u], M = SC[NUNIT + u];
            const float x = XT[(size_t)u * 8192 + e];
            CT[(size_t)u * 8192 + e] = (bf16)(cvtpk(C, 0.f) & 0xffffu);
            const float mn = a + fmaxf(m, M), fC = fexp(a + m - mn), fX = fexp(a + M - mn);
            if (e < 64) { NC[(size_t)u * 64 + e] = n; n = fC * n + fX * NX[(size_t)u * 64 + e]; }
            if (e == 0) SC[2 * NUNIT + u] = m;
            C = fC * C + fX * x; m = mn; }
    }
}
__device__ __forceinline__ void xc_phase(Frame& F, const Inputs& in, int j) {
    const bf16* P = (const bf16*)(F.ws + WS_ARENA + A_P); const bf16* QKB = (const bf16*)(F.ws + WS_ARENA + A_QKB); const float* IGLF = (const float*)(F.ws + WS_ARENA + mlc::A_IG2);
    const bf16* CT = (const bf16*)(F.ws + WS_ARENA + A_CT); const float* NC = (const float*)(F.ws + WS_ARENA + A_NC); const float* SC = (const float*)(F.ws + WS_ARENA + A_SC);
    bf16* HM = (bf16*)(F.ws + WS_ARENA + A_HM2); const float* gn = in.ml_out_norm + (size_t)j * 1024;
    const int lane = F.lane, wave = F.wave, r32 = lane & 31, hi = lane >> 5, us = wave >> 1, th = wave & 1, lt = th * 64 + lane;
    LAS char* slot = (LAS char*)F.lds + us * SLOT; LAS char* Kt = slot; LAS char* Vt = slot + 8192;
    LAS float* sb = (LAS float*)(slot + 24576); LAS float* se = sb + 64; LAS float* sF = se + 64; LAS float* sn = sF + 64;
    LAS float* ob = (LAS float*)(slot + th * 16896);
    for (int u0 = (int)blockIdx.x * 4; u0 < NUNIT; u0 += F.G * 4) {
        const int u = u0 + us, bh = u >> 7, c = u & 127, b = bh >> 3, h = bh & 7; const size_t t0 = (size_t)b * SEQ + (size_t)c * 64;
        const float mc = SC[2 * NUNIT + u];
        { const float lf = IGLF[(t0 + lane) * 16 + 8 + h], ig = IGLF[(t0 + lane) * 16 + h];
          const float Fc = wave_incl_scan_add(lf, lane), bs = ig - Fc, Mt = wave_incl_scan_max(bs, lane);
          if (th == 0) { sb[lane] = bs; se[lane] = fmaxf(mc, Mt); sF[lane] = Fc; sn[lane] = NC[(size_t)u * 64 + lane]; } }
        for (int idx = lt; idx < 512; idx += 128) { const int row = idx >> 3, ch = idx & 7;
            *(LAS v4u*)(Kt + row * 128 + ((ch * 16) ^ ((row & 7) << 4))) = *(const GAS v4u*)(QKB + (t0 + row) * 1024 + 512 + h * 64 + ch * 8); }
        stage_tr128(Vt, P + t0 * 3072 + 1024 + h * 128, 3072, lt, 128);
        const int tl = th * 32 + r32;
        bf16x8 qr[4];
#pragma unroll
        for (int d0 = 0; d0 < 4; ++d0) qr[d0] = *(const GAS bf16x8*)(QKB + (t0 + tl) * 1024 + h * 64 + d0 * 16 + hi * 8);
        __syncthreads();
        const float et = se[tl], Fct = sF[tl], iw = fexp(mc - et);
        f32x16 p0 = {}, p1 = {};
#pragma unroll
        for (int d0 = 0; d0 < 4; ++d0) { const int cb = (d0 * 32 + hi * 16) ^ ((r32 & 7) << 4);
            const bf16x8 k0 = *(const LAS bf16x8*)(Kt + r32 * 128 + cb);
            p0 = __builtin_amdgcn_mfma_f32_32x32x16_bf16(k0, qr[d0], p0, 0, 0, 0);
            if (th) { const bf16x8 k1 = *(const LAS bf16x8*)(Kt + (32 + r32) * 128 + cb); p1 = __builtin_amdgcn_mfma_f32_32x32x16_bf16(k1, qr[d0], p1, 0, 0, 0); } }
        float dsum = 0.f;
#pragma unroll
        for (int r = 0; r < 16; ++r) { const int s0 = crow(r, hi);
            const float w0 = (s0 <= tl) ? fexp(sb[s0] - et) : 0.f; p0[r] *= w0; dsum += p0[r];
            const float w1 = (th && s0 + 32 <= tl) ? fexp(sb[s0 + 32] - et) : 0.f; p1[r] *= w1; dsum += p1[r]; }
        dsum = swap_add(dsum);
        bf16x8 pa0, pa1, pa2, pa3;
#define PK4(Pv, B_, OUT) do { unsigned a0 = cvtpk(Pv[B_+0], Pv[B_+1]), a1 = cvtpk(Pv[B_+2], Pv[B_+3]); unsigned b0 = cvtpk(Pv[B_+4], Pv[B_+5]), b1 = cvtpk(Pv[B_+6], Pv[B_+7]); \
        auto r0 = __builtin_amdgcn_permlane32_swap(a0, b0, false, false); auto r1 = __builtin_amdgcn_permlane32_swap(a1, b1, false, false); \
        v4u w_ = {r0[0], r1[0], r0[1], r1[1]}; OUT = __builtin_bit_cast(bf16x8, w_); } while (0)
        PK4(p0, 0, pa0); PK4(p0, 8, pa1); PK4(p1, 0, pa2); PK4(p1, 8, pa3);
#undef PK4
        float qn = 0.f;
#pragma unroll
        for (int d0 = 0; d0 < 4; ++d0) { float qv[8]; unpack8(__builtin_bit_cast(v4u, qr[d0]), qv);
#pragma unroll
            for (int q = 0; q < 8; ++q) qn += qv[q] * sn[d0 * 16 + hi * 8 + q]; }
        qn = swap_add(qn);
        f32x16 acc[4] = {};
        const bf16* ctp = CT + (size_t)u * 8192 + (size_t)r32 * 64 + hi * 8;
#pragma unroll
        for (int vt = 0; vt < 4; ++vt)
#pragma unroll
            for (int d0 = 0; d0 < 4; ++d0) { const bf16x8 cf = *(const GAS bf16x8*)(ctp + vt * 32 * 64 + d0 * 16);
                acc[vt] = __builtin_amdgcn_mfma_f32_32x32x16_bf16(cf, qr[d0], acc[vt], 0, 0, 0); }
#pragma unroll
        for (int vt = 0; vt < 4; ++vt)
#pragma unroll
            for (int r = 0; r < 16; ++r) acc[vt][r] *= iw;
        const int vb = (int)(uintptr_t)Vt + v_rd_base(lane);
#define XC_VT(vt) do { s16x4 vl0, vh0, vl1, vh1, vl2, vh2, vl3, vh3; constexpr int o_ = v_rd_off(vt, 0, 0); \
            TRRD(vl0, vb, o_); TRRD(vh0, vb, o_ + 2048); TRRD(vl1, vb, o_ + 4096); TRRD(vh1, vb, o_ + 6144); \
            if (th) { TRRD(vl2, vb, o_ + 8192); TRRD(vh2, vb, o_ + 10240); TRRD(vl3, vb, o_ + 12288); TRRD(vh3, vb, o_ + 14336); } \
            asm volatile("s_waitcnt lgkmcnt(0)" ::: "memory"); __builtin_amdgcn_sched_barrier(0); \
            acc[vt] = __builtin_amdgcn_mfma_f32_32x32x16_bf16(FRAG(vl0, vh0), pa0, acc[vt], 0, 0, 0); \
            acc[vt] = __builtin_amdgcn_mfma_f32_32x32x16_bf16(FRAG(vl1, vh1), pa1, acc[vt], 0, 0, 0); \
            if (th) { acc[vt] = __builtin_amdgcn_mfma_f32_32x32x16_bf16(FRAG(vl2, vh2), pa2, acc[vt], 0, 0, 0); \
                      acc[vt] = __builtin_amdgcn_mfma_f32_32x32x16_bf16(FRAG(vl3, vh3), pa3, acc[vt], 0, 0, 0); } } while (0)
        XC_VT(0); XC_VT(1); XC_VT(2); XC_VT(3);
#undef XC_VT
        const float den = dsum + iw * qn;
        const float hs = frcp(fmaxf(fabsf(den), fexp(-Fct - et)));
        float ss = 0.f;
#pragma unroll
        for (int vt = 0; vt < 4; ++vt)
#pragma unroll
            for (int r = 0; r < 16; ++r) { acc[vt][r] *= hs; ss += acc[vt][r] * acc[vt][r]; }
        ss = swap_add(ss);
        const float rn = frsq(ss * (1.f / 128.f) + RMS_EPS);
        __syncthreads();
#pragma unroll
        for (int vt = 0; vt < 4; ++vt)
#pragma unroll
            for (int r = 0; r < 16; ++r) ob[(vt * 32 + crow(r, hi)) * 33 + r32] = acc[vt][r] * rn;
        LDS_WAIT();
        { const int v2 = lane * 2; const float g0 = gn[h * 128 + v2], g1 = gn[h * 128 + v2 + 1];
#pragma unroll 4
          for (int tt = 0; tt < 32; ++tt) { const size_t t = t0 + th * 32 + tt;
              const unsigned ow = *(const GAS unsigned*)(P + t * 3072 + 2048 + h * 128 + v2);
              const float x0 = ob[v2 * 33 + tt] * g0 * fsigmoid(bf_lo(ow)), x1 = ob[(v2 + 1) * 33 + tt] * g1 * fsigmoid(bf_hi(ow));
              *(GAS unsigned*)(HM + t * 1024 + h * 128 + v2) = cvtpk(x0, x1); } }
        __syncthreads();
    }
}
#undef TRRD
#undef FRAG
}

namespace rwc {
constexpr int NU = BATCH * RW_H * (SEQ / 64);
constexpr size_t A_GL = 160 * MiB, A_BON = 161 * MiB;
constexpr int RMB = 9216, TRB = 8192;
constexpr int L_LWF = 0, L_AT_RM = 16384, L_BT_RM = L_AT_RM + RMB, L_KT_RM = L_BT_RM + RMB, L_RT_RM = L_KT_RM + RMB, L_KH_RM = L_RT_RM + RMB, L_T_RM = L_KH_RM + RMB, L_ARB_RM = L_T_RM + RMB,
              L_AT_TR = L_ARB_RM + RMB, L_BH_TR = L_AT_TR + TRB, L_V_TR = L_BH_TR + TRB, L_AAK_TR = L_V_TR + TRB, L_W2_TR = L_AAK_TR + TRB, L_H_TR = L_W2_TR + TRB, L_SEG = L_H_TR + TRB,
              L_P1_RM = L_BT_RM, L_P2_RM = L_KT_RM;
static_assert(L_SEG + 2048 <= LDSCTL_OFF, "RWKV LDS map");
using att::crow; using att::v_rd_base;
__device__ __forceinline__ int rm_off(int row, int col) { return row * 144 + col * 2; }
__device__ __forceinline__ int tr_off(int row, int col) { const int kk = (row & ~0xC) | ((row & 4) << 1) | ((row & 8) >> 1); return ((kk >> 3) * 2 + (col >> 5)) * 512 + ((kk & 7) * 32 + (col & 31)) * 2; }
__device__ __forceinline__ bf16x8 frag_rm(const LAS char* tile, int row, int kb, int hi) { return *(const LAS bf16x8*)(tile + rm_off(row, kb * 16 + hi * 8)); }
__device__ __forceinline__ void frag_tr4(bf16x8 (&f)[4], const LAS char* tile, int cb, int lane) {
    const int base = (int)(uintptr_t)tile + v_rd_base(lane) + cb * 512; s16x4 l[4], h[4];
#pragma unroll
    for (int kb = 0; kb < 4; ++kb) { asm volatile("ds_read_b64_tr_b16 %0, %1" : "=&v"(l[kb]) : "v"(base + kb * 2048) : "memory"); asm volatile("ds_read_b64_tr_b16 %0, %1" : "=&v"(h[kb]) : "v"(base + kb * 2048 + 1024) : "memory"); }
    asm volatile("s_waitcnt lgkmcnt(0)" ::: "memory"); __builtin_amdgcn_sched_barrier(0);
#pragma unroll
    for (int kb = 0; kb < 4; ++kb) f[kb] = (bf16x8){l[kb][0], l[kb][1], l[kb][2], l[kb][3], h[kb][0], h[kb][1], h[kb][2], h[kb][3]};
}
__device__ __forceinline__ void frag_rm4(bf16x8 (&f)[4], const LAS char* tile, int row, int hi) {
#pragma unroll
    for (int kb = 0; kb < 4; ++kb) f[kb] = frag_rm(tile, row, kb, hi);
}
__device__ __forceinline__ f32x16 mm4(const bf16x8 (&a)[4], const bf16x8 (&b)[4]) { f32x16 acc = {};
#pragma unroll
    for (int kb = 0; kb < 4; ++kb) acc = __builtin_amdgcn_mfma_f32_32x32x16_bf16(a[kb], b[kb], acc, 0, 0, 0);
    return acc; }
__device__ __forceinline__ bf16 tobf(float x) { return (bf16)(cvtpk(x, 0.f) & 0xffffu); }
#define STORE_RM(tile, acc, mt, nt) do { _Pragma("unroll") for (int r_ = 0; r_ < 16; ++r_) *(LAS bf16*)((tile) + rm_off(32 * (mt) + crow(r_, hi), 32 * (nt) + r32)) = tobf((acc)[r_]); } while (0)
#define STORE_TR(tile, acc, mt, nt) do { _Pragma("unroll") for (int r_ = 0; r_ < 16; ++r_) *(LAS bf16*)((tile) + tr_off(32 * (mt) + crow(r_, hi), 32 * (nt) + r32)) = tobf((acc)[r_]); } while (0)

__device__ __forceinline__ void ra_phase(Frame& F, const Inputs& in, int jl) {
    bf16* RKV = (bf16*)(F.ws + WS_ARENA + A_RKV); const bf16* AA = (const bf16*)(F.ws + WS_ARENA + A_AAZ); float* LW = (float*)(F.ws + WS_ARENA + A_LW);
    float* GL = (float*)(F.ws + WS_ARENA + A_GL); float* BON = (float*)(F.ws + WS_ARENA + A_BON);
    const float* k_k = in.rw_k_k + (size_t)jl * 1024; const float* k_a = in.rw_k_a + (size_t)jl * 1024; const float* r_k = in.rw_r_k + (size_t)jl * 1024;
    LAS char* L = (LAS char*)F.lds; LAS float* LWF = (LAS float*)(L + L_LWF); LAS float* SEG = (LAS float*)(L + L_SEG);
    const int w = F.wave;
#define FRESH() const int lane = fresh_lane(), r32 = lane & 31, hi = lane >> 5; (void)r32; (void)hi
    for (int u = (int)blockIdx.x; u < NU; u += F.G) {
        const int tid = w * 64 + fresh_lane();
        const int bh = u >> 7, c = u & 127, b = bh >> 4, h = bh & 15; const size_t t0 = (size_t)b * SEQ + (size_t)c * 64;
        const int t = tid >> 3, j0 = (tid & 7) * 8; const size_t row = t0 + t; const int col = h * 64 + j0;
        float rv[8], kp[8], vv[8], am[8], bb[8], lw[8];
        { float kv[8], av[8];
          unpack8(*(const GAS v4u*)(RKV + row * 3072 + col), rv); unpack8(*(const GAS v4u*)(RKV + row * 3072 + 1024 + col), kv); unpack8(*(const GAS v4u*)(RKV + row * 3072 + 2048 + col), vv);
          unpack8(*(const GAS v4u*)(AA + row * 1024 + col), av);
          const f32x4 l0 = *(const GAS f32x4*)(LW + row * 1024 + col), l1 = *(const GAS f32x4*)(LW + row * 1024 + col + 4);
          float ss = 0.f, bs = 0.f; float kk[8];
#pragma unroll
          for (int q = 0; q < 8; ++q) { lw[q] = q < 4 ? l0[q] : l1[q - 4]; kk[q] = kv[q] * k_k[col + q]; ss += kk[q] * kk[q]; kp[q] = kv[q] * (1.f + (av[q] - 1.f) * k_a[col + q]); bs += rv[q] * kp[q] * r_k[col + q]; }
          ss += __shfl_xor(ss, 1); ss += __shfl_xor(ss, 2); ss += __shfl_xor(ss, 4); bs += __shfl_xor(bs, 1); bs += __shfl_xor(bs, 2); bs += __shfl_xor(bs, 4);
          const float inv = frcp(fmaxf(fsqrt(ss), 1e-12f));
#pragma unroll
          for (int q = 0; q < 8; ++q) { const float kn = kk[q] * inv; am[q] = -kn; bb[q] = kn * av[q]; }
          if ((tid & 7) == 0) BON[row * 16 + h] = bs; }
        { LAS f32x4* lp = (LAS f32x4*)(LWF + t * 64 + j0); lp[0] = (f32x4){lw[0], lw[1], lw[2], lw[3]}; lp[1] = (f32x4){lw[4], lw[5], lw[6], lw[7]}; }
        __syncthreads();
        { const int jc = tid & 63, sg = tid >> 6; float run = 0.f;
#pragma unroll
          for (int q = 0; q < 8; ++q) { run += LWF[(sg * 8 + q) * 64 + jc]; LWF[(sg * 8 + q) * 64 + jc] = run; }
          SEG[sg * 64 + jc] = run; }
        __syncthreads();
        { const int jc = tid & 63, sg = tid >> 6; float pre = 0.f;
#pragma unroll
          for (int q = 0; q < 8; ++q) if (q < sg) pre += SEG[q * 64 + jc];
#pragma unroll
          for (int q = 0; q < 8; ++q) LWF[(sg * 8 + q) * 64 + jc] += pre; }
        __syncthreads();
        { float at[8], bt[8], kt[8], rt[8], bh_[8], kh[8];
#pragma unroll
          for (int q = 0; q < 8; ++q) { const float cum = LWF[t * 64 + j0 + q], cl = LWF[63 * 64 + j0 + q];
              const float ein = fexp(-cum), eL = fexp(cl - cum);
              at[q] = am[q] * fexp(cum - lw[q]); bt[q] = bb[q] * ein; kt[q] = kp[q] * ein; rt[q] = rv[q] * fexp(cum); bh_[q] = bb[q] * eL; kh[q] = kp[q] * eL;
              if (t == 63) GL[(size_t)u * 64 + j0 + q] = fexp(cl); }
          const int ro = rm_off(t, j0), to = tr_off(t, j0);
          *(LAS v4u*)(L + L_AT_RM + ro) = pack8f(at); *(LAS v4u*)(L + L_AT_TR + to) = pack8f(at); *(LAS v4u*)(L + L_BT_RM + ro) = pack8f(bt); *(LAS v4u*)(L + L_KT_RM + ro) = pack8f(kt);
          *(LAS v4u*)(L + L_RT_RM + ro) = pack8f(rt); *(LAS v4u*)(L + L_BH_TR + to) = pack8f(bh_); *(LAS v4u*)(L + L_KH_RM + ro) = pack8f(kh); *(LAS v4u*)(L + L_V_TR + to) = pack8f(vv); }
        __syncthreads();
        f32x16 rk[2];
        { FRESH(); const int p = w >> 1, mt = w & 1; const LAS char* At = L + ((p < 2) ? L_AT_RM : L_RT_RM); const LAS char* Bt = L + ((p & 1) ? L_KT_RM : L_BT_RM);
          bf16x8 fa[4]; frag_rm4(fa, At, 32 * mt + r32, hi);
#pragma unroll
          for (int nt = 0; nt < 2; ++nt) { f32x16 acc = {};
              if (nt <= mt) { bf16x8 fb[4]; frag_rm4(fb, Bt, 32 * nt + r32, hi); acc = mm4(fa, fb); }
#pragma unroll
              for (int r = 0; r < 16; ++r) { const int tt = 32 * mt + crow(r, hi), s = 32 * nt + r32; const bool keep = (p < 2) ? (s < tt) : (s <= tt); if (!keep) acc[r] = 0.f; }
              if (p == 0) {
#pragma unroll
                  for (int r = 0; r < 16; ++r) LWF[(32 * mt + crow(r, hi)) * 64 + 32 * nt + r32] = acc[r]; }
              else if (p == 1) STORE_TR(L + L_AAK_TR, acc, mt, nt);
              else if (p == 2) STORE_RM(L + L_ARB_RM, acc, mt, nt);
              rk[nt] = acc; } }
        __syncthreads();
        if (w == 0) { FRESH(); float Tc[64];
#pragma unroll
            for (int tt = 0; tt < 64; ++tt) { asm volatile("" ::: "memory"); float acc = (tt == lane) ? 1.f : 0.f;
#pragma unroll
                for (int s4 = 0; s4 < (tt + 3) / 4; ++s4) { const f32x4 a4 = *(const LAS f32x4*)(LWF + tt * 64 + s4 * 4);
#pragma unroll
                    for (int e = 0; e < 4; ++e) if (s4 * 4 + e < tt) acc += a4[e] * Tc[s4 * 4 + e]; }
                Tc[tt] = acc;
                *(LAS bf16*)(L + L_T_RM + rm_off(tt, lane)) = tobf(acc); } }
        __syncthreads();
        { FRESH(); const int q = w & 3, mt = q >> 1, nt = q & 1; bf16x8 fa[4], fb[4]; frag_rm4(fa, L + L_T_RM, 32 * mt + r32, hi);
          frag_tr4(fb, L + ((w < 4) ? L_AT_TR : L_AAK_TR), nt, lane);
          const f32x16 acc = mm4(fa, fb);
          if (w < 4) STORE_TR(L + L_W2_TR, acc, mt, nt); else STORE_TR(L + L_H_TR, acc, mt, nt); }
        __syncthreads();
        { FRESH(); const int g = w >> 1, mt = w & 1; bf16x8 fa[4];
          if (g == 0 || g == 3) frag_rm4(fa, L + L_ARB_RM, 32 * mt + r32, hi); else frag_tr4(fa, L + L_BH_TR, mt, lane);
#pragma unroll
          for (int nt = 0; nt < 2; ++nt) { bf16x8 fb[4]; frag_tr4(fb, L + ((g < 2) ? L_W2_TR : L_H_TR), nt, lane);
              f32x16 acc = mm4(fa, fb);
              if (g == 0) {
#pragma unroll
                  for (int r = 0; r < 16; ++r) { const int tt = 32 * mt + crow(r, hi), jj = 32 * nt + r32;
                      RKV[(t0 + tt) * 3072 + h * 64 + jj] = tobf(acc[r] + bf1(*(const LAS bf16*)(L + L_RT_RM + rm_off(tt, jj)))); } }
              else if (g == 1) {
#pragma unroll
                  for (int r = 0; r < 16; ++r) { const int jp = 32 * mt + crow(r, hi), jj = 32 * nt + r32; RKV[(t0 + jp) * 3072 + 1024 + h * 64 + jj] = tobf(acc[r]); } }
              else if (g == 2) {
#pragma unroll
                  for (int r = 0; r < 16; ++r) { const int jp = 32 * mt + crow(r, hi), s = 32 * nt + r32; acc[r] += bf1(*(const LAS bf16*)(L + L_KH_RM + rm_off(s, jp))); }
                  STORE_RM(L + L_P2_RM, acc, mt, nt); }
              else {
#pragma unroll
                  for (int r = 0; r < 16; ++r) acc[r] += rk[nt][r];
                  STORE_RM(L + L_P1_RM, acc, mt, nt); } } }
        __syncthreads();
        { FRESH(); const int q = w & 3, m_ = q >> 1, n_ = q & 1; bf16x8 fa[4], fb[4];
          if (w < 4) { frag_tr4(fa, L + L_V_TR, m_, lane); frag_rm4(fb, L + L_P1_RM, 32 * n_ + r32, hi); }
          else { frag_rm4(fa, L + L_P2_RM, 32 * m_ + r32, hi); frag_tr4(fb, L + L_V_TR, n_, lane); }
          const f32x16 acc = mm4(fa, fb);
          const int o = (q * 64 + lane) * 32, orow = o >> 7, owi = o & 127;
          GAS v4u* dst = (GAS v4u*)((GAS char*)LW + ((t0 + orow) * 1024 + h * 64) * 4 + ((w < 4) ? 0 : 128) + owi);
          float tmp[16];
#pragma unroll
          for (int r = 0; r < 16; ++r) tmp[r] = acc[r];
          dst[0] = pack8f(tmp); dst[1] = pack8f(tmp + 8); }
        __syncthreads();
    }
}
__device__ __forceinline__ void rb_phase(Frame& F) {
    if ((int)blockIdx.x >= BATCH * RW_H * 2) return;
    const bf16* RKV = (const bf16*)(F.ws + WS_ARENA + A_RKV); const float* LW = (const float*)(F.ws + WS_ARENA + A_LW); const float* GL = (const float*)(F.ws + WS_ARENA + A_GL);
    bf16* ZC = (bf16*)(F.ws + WS_ARENA + A_AAZ);
    const int lane = F.lane, r32 = lane & 31, hi = lane >> 5, task = blockIdx.x, bh = task >> 1, it = task & 1, b = bh >> 4, h = bh & 15;
    LAS float* sg = (LAS float*)F.lds;
    for (int e = F.tid; e < 128 * 16; e += 512) *(LAS f32x4*)(sg + e * 4) = *(const GAS f32x4*)(GL + (size_t)bh * 8192 + e * 4);
    __syncthreads();
    if (F.wave != 0) return;
    f32x16 Z[2] = {};
    bf16x8 mfA[2][4], mfB[2][4]; v4u nnA[2][2], nnB[2][2];
#define RB_LOAD(c_, mf_, nn_) do { const size_t t0_ = (size_t)b * SEQ + (size_t)(c_) * 64; \
        _Pragma("unroll") for (int mt = 0; mt < 2; ++mt) { const bf16* mrow = RKV + (t0_ + 32 * mt + r32) * 3072 + 1024 + h * 64 + 4 * hi; \
            _Pragma("unroll") for (int kb = 0; kb < 4; ++kb) { const v2u lo = *(const GAS v2u*)(mrow + kb * 16), hi2 = *(const GAS v2u*)(mrow + kb * 16 + 8); mf_[mt][kb] = __builtin_bit_cast(bf16x8, (v4u){lo.x, lo.y, hi2.x, hi2.y}); } \
            const int o = ((mt * 2 + it) * 64 + lane) * 32, orow = o >> 7, owi = o & 127; \
            const GAS v4u* np = (const GAS v4u*)((const GAS char*)LW + ((t0_ + orow) * 1024 + h * 64) * 4 + 128 + owi); nn_[mt][0] = np[0]; nn_[mt][1] = np[1]; } } while (0)
#define RB_STEP(c_, mf_, nn_) do { const int u = bh * 128 + (c_); \
        bf16x8 zh[4], zl[4]; \
        _Pragma("unroll") for (int kb = 0; kb < 4; ++kb) { float a8[8], l8[8]; \
            _Pragma("unroll") for (int e = 0; e < 8; ++e) a8[e] = Z[kb >> 1][(kb & 1) * 8 + e]; \
            const v4u hw = pack8f(a8); float h8[8]; unpack8(hw, h8); \
            _Pragma("unroll") for (int e = 0; e < 8; ++e) l8[e] = a8[e] - h8[e]; \
            zh[kb] = __builtin_bit_cast(bf16x8, hw); zl[kb] = __builtin_bit_cast(bf16x8, pack8f(l8)); \
            *(GAS v4u*)(ZC + (size_t)u * 4096 + ((kb * 2 + it) * 64 + lane) * 8) = hw; } \
        _Pragma("unroll") for (int mt = 0; mt < 2; ++mt) { f32x16 acc; float tmp[16]; unpack8(nn_[mt][0], tmp); unpack8(nn_[mt][1], tmp + 8); \
            _Pragma("unroll") for (int q = 0; q < 4; ++q) { const f32x4 g4 = *(const LAS f32x4*)(sg + (c_) * 64 + 32 * mt + 8 * q + 4 * hi); \
                _Pragma("unroll") for (int e = 0; e < 4; ++e) acc[4 * q + e] = tmp[4 * q + e] + g4[e] * Z[mt][4 * q + e]; } \
            _Pragma("unroll") for (int kb = 0; kb < 4; ++kb) { acc = __builtin_amdgcn_mfma_f32_32x32x16_bf16(mf_[mt][kb], zh[kb], acc, 0, 0, 0); acc = __builtin_amdgcn_mfma_f32_32x32x16_bf16(mf_[mt][kb], zl[kb], acc, 0, 0, 0); } \
            if (mt == 0) zn0 = acc; else Z[1] = acc; } \
        Z[0] = zn0; } while (0)
    f32x16 zn0;
    RB_LOAD(0, mfA, nnA);
    for (int c = 0; c < SEQ / 64; c += 2) {
        RB_LOAD(c + 1, mfB, nnB);
        RB_STEP(c, mfA, nnA);
        if (c + 2 < SEQ / 64) RB_LOAD(c + 2, mfA, nnA);
        RB_STEP(c + 1, mfB, nnB);
    }
#undef RB_LOAD
#undef RB_STEP
}
__device__ __forceinline__ void rc_phase(Frame& F, const Inputs& in, int jl) {
    const bf16* RKV = (const bf16*)(F.ws + WS_ARENA + A_RKV); const float* LW = (const float*)(F.ws + WS_ARENA + A_LW); const float* BON = (const float*)(F.ws + WS_ARENA + A_BON);
    const bf16* ZC = (const bf16*)(F.ws + WS_ARENA + A_AAZ); const bf16* GG = (const bf16*)(F.ws + WS_ARENA + A_GG); bf16* YG = (bf16*)(F.ws + WS_ARENA + A_YG);
    const float* lnw = in.rw_ln_w + (size_t)jl * 1024; const float* lnb = in.rw_ln_b + (size_t)jl * 1024;
    const int lane = F.lane, r32 = lane & 31, hi = lane >> 5;
    for (int task = F.gw; task < NU * 2; task += F.NGW) { const int u = task >> 1, tt = task & 1, bh = u >> 7, c = u & 127, b = bh >> 4, h = bh & 15; const size_t t0 = (size_t)b * SEQ + (size_t)c * 64, trow = t0 + 32 * tt + r32;
        bf16x8 yw[4];
        { const bf16* yrow = RKV + trow * 3072 + h * 64 + 4 * hi;
#pragma unroll
          for (int kb = 0; kb < 4; ++kb) { const v2u lo = *(const GAS v2u*)(yrow + kb * 16), hi2 = *(const GAS v2u*)(yrow + kb * 16 + 8); yw[kb] = __builtin_bit_cast(bf16x8, (v4u){lo.x, lo.y, hi2.x, hi2.y}); } }
        f32x16 y[2];
#pragma unroll
        for (int it = 0; it < 2; ++it) { const int o = ((it * 2 + tt) * 64 + lane) * 32, orow = o >> 7, owi = o & 127;
            const GAS v4u* yp = (const GAS v4u*)((const GAS char*)LW + ((t0 + orow) * 1024 + h * 64) * 4 + owi);
            float tmp[16]; unpack8(yp[0], tmp); unpack8(yp[1], tmp + 8);
#pragma unroll
            for (int r = 0; r < 16; ++r) y[it][r] = tmp[r];
#pragma unroll
            for (int kb = 0; kb < 4; ++kb) { const bf16x8 zf = *(const GAS bf16x8*)(ZC + (size_t)u * 4096 + ((kb * 2 + it) * 64 + lane) * 8);
                y[it] = __builtin_amdgcn_mfma_f32_32x32x16_bf16(zf, yw[kb], y[it], 0, 0, 0); } }
        float s1 = 0.f;
#pragma unroll
        for (int it = 0; it < 2; ++it)
#pragma unroll
            for (int r = 0; r < 16; ++r) s1 += y[it][r];
        const float mean = mlc::swap_add(s1) * (1.f / 64.f); float s2 = 0.f;
#pragma unroll
        for (int it = 0; it < 2; ++it)
#pragma unroll
            for (int r = 0; r < 16; ++r) { y[it][r] -= mean; s2 += y[it][r] * y[it][r]; }
        const float rs = frsq(mlc::swap_add(s2) * (1.f / 64.f) + 64e-5f), bon = BON[trow * 16 + h];
#pragma unroll
        for (int it = 0; it < 2; ++it)
#pragma unroll
            for (int q = 0; q < 4; ++q) { const int i0 = 32 * it + 8 * q + 4 * hi, col = h * 64 + i0;
                const f32x4 w4 = *(const GAS f32x4*)(lnw + col), b4 = *(const GAS f32x4*)(lnb + col);
                const v2u vw = *(const GAS v2u*)(RKV + trow * 3072 + 2048 + col), gw2 = *(const GAS v2u*)(GG + trow * 1024 + col);
                const float v4[4] = {bf_lo(vw.x), bf_hi(vw.x), bf_lo(vw.y), bf_hi(vw.y)}, g4[4] = {bf_lo(gw2.x), bf_hi(gw2.x), bf_lo(gw2.y), bf_hi(gw2.y)};
                float o4[4];
#pragma unroll
                for (int e = 0; e < 4; ++e) o4[e] = (y[it][4 * q + e] * rs * w4[e] + b4[e] + bon * v4[e]) * g4[e];
                v2u ow; ow.x = cvtpk(o4[0], o4[1]); ow.y = cvtpk(o4[2], o4[3]);
                *(GAS v2u*)(YG + trow * 1024 + col) = ow; }
    }
}
#undef STORE_RM
#undef STORE_TR
#undef FRESH
}

#ifndef MK_ONE_LAUNCH
#define MK_ONE_LAUNCH 1
#endif
template <class Epi> __device__ __forceinline__ void run_gemm(Frame& F, const bf16* A, int lda, const bf16* Bt, int ldb, int N, int K, const Epi& E) {
    pg8::Gemm g{A, Bt, T, N, K, lda, ldb, F.wave}; pg8::StaticOrder S; S.init(T, N, F.G, (int)blockIdx.x);
    pg8::gemm_phase<Epi, pg8::StaticOrder, true, true>(F.lds, g, S, E);
}
__host__ __device__ constexpr int mixer_phases(int kind) { return kind == 0 ? 4 : kind == 1 ? 6 : 7; }
constexpr int NPH = 4 * 3 + (mixer_phases(0) + 2) + (mixer_phases(1) + 2) + (mixer_phases(2) + 2) + (mixer_phases(0) + 2) + 1;

__global__ void __launch_bounds__(NWAVES * 64, 2) fwd(Args args) {
    extern __shared__ __attribute__((aligned(16))) unsigned char lds[];
    Frame F;
    F.lds = (LAS unsigned char*)lds;
    F.tid = threadIdx.x; F.lane = F.tid & 63; const int wave0 = __builtin_amdgcn_readfirstlane(F.tid >> 6); F.wave = wave0;
    F.G = gridDim.x; F.gw = (int)blockIdx.x * NWAVES + F.wave; F.NGW = F.G * NWAVES;
    F.ws = args.ws; F.ctl = (gu32*)(args.ws + WS_CTL);
    const Inputs& in = args.in;
    volatile LAS unsigned* MISC = (volatile LAS unsigned*)(F.lds + MISC_OFF);
    for (int u = F.tid; u < (LDS_BYTES - LDSCTL_OFF) / 4; u += NWAVES * 64) ((LAS unsigned*)(F.lds + LDSCTL_OFF))[u] = 0u;
    __syncthreads();
#if MK_ONE_LAUNCH
    XcdBarrier bar = xcd_barrier_post((unsigned*)(F.ctl + CW_BAR), MISC + 8);
#define GRID_BAR() xcd_barrier(bar)
#else
#define GRID_BAR() do { } while (0)
#endif
    const int lo = args.ph_lo, hi = args.ph_hi;
    int ph = 0;
#ifndef PHMASK
#define PHMASK 0xffffffffu
#endif
#ifndef PHREP
#define PHREP 0u
#endif
#define REP_LAST (rep_ + 1 == nrep_)
#define PH_BEGIN(id) if (ph >= lo && ph < hi) { if ((PHMASK >> (id)) & 1u) for (int rep_ = 0, nrep_ = ((((PHREP) >> (id)) & 1u) ? 2 : 1); rep_ < nrep_; ++rep_) { if (rep_) GRID_BAR(); { int w_ = wave0; asm volatile("" : "+s"(w_)); F.wave = w_; F.lane = fresh_lane(); F.tid = w_ * 64 + F.lane; F.gw = (int)blockIdx.x * NWAVES + w_; } unsigned char* ws = args.ws; asm volatile("" : "+s"(ws)); { float* xo_ = args.out; asm volatile("" : "+s"(xo_)); F.X = xo_; } F.ws = ws; F.ctl = (gu32*)(ws + WS_CTL); F.XB = (bf16*)(ws + WS_XB); F.SS = (float*)(ws + WS_SS); \
    bf16* const WB = (bf16*)(ws + WS_W); unsigned char* const AR = ws + WS_ARENA; float* const COS = (float*)(ws + WS_COS); float* const SIN = (float*)(ws + WS_SIN); float* const SSQ = (float*)(ws + WS_SSQ); float* const SSKV = (float*)(ws + WS_SSKV); (void)WB; (void)AR; (void)COS; (void)SIN; (void)SSQ; (void)SSKV;
#define PH_END } if (ph + 1 < hi) GRID_BAR(); } ++ph;

#ifdef DUMP
    if (lo == 1000) { unsigned char* ws = args.ws; unsigned char* const AR = ws + WS_ARENA; F.X = args.out; F.lane = fresh_lane();
#define HX ((bf16*)(AR + A_HX))
#define RKV ((bf16*)(AR + A_RKV))
#define LOR ((bf16*)(AR + A_LOR))
#define LW ((float*)(AR + A_LW))
#define AA ((bf16*)(AR + A_AAZ))
#define GG ((bf16*)(AR + A_GG))
#define YG ((bf16*)(AR + A_YG))
        for (int e = F.gw * 64 + F.lane; e < T * 1024; e += F.NGW * 64) { const int t = e >> 10, c = e & 1023; float v = 0.f;
            if (DUMP == 1) v = bf1(HX[(size_t)t * 2048 + c]) + bf1(HX[(size_t)t * 2048 + 1024 + c]);
            if (DUMP == 2) v = bf1(RKV[(size_t)t * 3072 + c]) + bf1(RKV[(size_t)t * 3072 + 1024 + c]) + bf1(RKV[(size_t)t * 3072 + 2048 + c]) + bf1(LOR[(size_t)t * 256 + (c & 255)]);
            if (DUMP == 3) v = LW[(size_t)t * 1024 + c] + bf1(AA[(size_t)t * 1024 + c]) + bf1(GG[(size_t)t * 1024 + c]);
            if (DUMP == 4) v = bf1(YG[(size_t)t * 1024 + c]);
            if (DUMP == 5) v = ((size_t)e < (size_t)3328 * 2048) ? bf1(((const bf16*)(ws + WS_W))[WR_BIG + e]) : 0.f;
            F.X[e] = v; }
#undef HX
#undef RKV
#undef LOR
#undef LW
#undef AA
#undef GG
#undef YG
        return; }
#endif
#pragma unroll
    for (int s = 0; s < 2 * DEPTH; ++s) {
        const int layer = s >> 1, half = s & 1, kind = layer % 3, j = layer / 3;
        if (half == 0) {
            PH_BEGIN(0)
                if (layer == 0) prologue(F, in);
                conv_layer(F, in, layer);
            PH_END
        } else if (kind == 0) {
#define LAT ((bf16*)(AR + A_LAT))
#define Q ((bf16*)(AR + A_Q))
#define KV ((bf16*)(AR + A_KV))
#define O ((bf16*)(AR + A_O))
#define KPE ((bf16*)(AR + A_KPE))
            PH_BEGIN(1)
                EpiMlaA E{F.SS, LAT, SSQ, SSKV, KPE, COS, SIN};
                run_gemm(F, F.XB, D, WB + WM_A, 1024, 1024, 1024, E);
            PH_END
            PH_BEGIN(2)
                { EpiMlaQ E{SSQ, Q, COS, SIN, 0.07216878364870322f * 1.4426950408889634f};
                  run_gemm(F, LAT, 1024, WB + WM_QB, 512, 1536, 512, E); }
                { EpiMlaKV E{SSKV, KV};
                  run_gemm(F, LAT + 512, 1024, WB + WM_KVB, 256, 2048, 256, E); }
            PH_END
            PH_BEGIN(3)
                for (int it = (int)blockIdx.x; it < BATCH * MLA_H * 16; it += F.G) { const int bh = it >> 4, xq = it & 15;
                    att::attn_unit(F.wave, bh >> 3, bh & 7, xq, Q, KV, KPE, O, (LAS char*)F.lds);
                    att::attn_unit(F.wave, bh >> 3, bh & 7, 31 - xq, Q, KV, KPE, O, (LAS char*)F.lds); }
            PH_END
            PH_BEGIN(4)
                EpiResidual E{F.X, F.XB, F.SS, REP_LAST ? 1.0f : 0.f};
                run_gemm(F, O, 1024, WB + WM_O, 1024, 1024, 1024, E);
            PH_END
        } else if (kind == 1) {
#define P ((bf16*)(AR + A_P))
#define GATES ((float*)(AR + A_GATES))
#define HM ((bf16*)(AR + A_HM))
            PH_BEGIN(5)
                EpiMlIn E{F.SS, P, GATES};
                run_gemm(F, F.XB, D, WB + WL_IN, 1024, 3328, 1024, E);
            PH_END
            PH_BEGIN(6)
                mlc::conv_phase(F, in, j);
            PH_END
            PH_BEGIN(7)
                mlc::xa_phase(F);
            PH_END
            PH_BEGIN(8)
                mlc::xb_phase(F);
            PH_END
            PH_BEGIN(19)
                mlc::xc_phase(F, in, j);
            PH_END
            PH_BEGIN(9)
                EpiResidual E{F.X, F.XB, F.SS, REP_LAST ? 1.0f : 0.f};
                run_gemm(F, (bf16*)(AR + mlc::A_HM2), 1024, WB + WL_O, 1024, 1024, 1024, E);
            PH_END
        } else {
#define HX ((bf16*)(AR + A_HX))
#define RKV ((bf16*)(AR + A_RKV))
#define LOR ((bf16*)(AR + A_LOR))
#define LW ((float*)(AR + A_LW))
#define AA ((bf16*)(AR + A_AAZ))
#define GG ((bf16*)(AR + A_GG))
#define YG ((bf16*)(AR + A_YG))
            PH_BEGIN(10)
                rw_shift_phase(F);
            PH_END
            PH_BEGIN(11)
                EpiRwBig E{RKV, LOR};
                run_gemm(F, HX, 2048, WB + WR_BIG, 2048, 3328, 2048, E);
            PH_END
            PH_BEGIN(12)
                EpiRwUp E{LW, AA, GG, in.rw_w0 + (size_t)j * 1024, in.rw_a0 + (size_t)j * 1024};
                run_gemm(F, LOR, 256, WB + WR_UP, 256, 3072, 256, E);
            PH_END
            PH_BEGIN(13)
                rwc::ra_phase(F, in, j);
            PH_END
            PH_BEGIN(14)
                rwc::rb_phase(F);
            PH_END
            PH_BEGIN(20)
                rwc::rc_phase(F, in, j);
            PH_END
            PH_BEGIN(15)
                EpiResidual E{F.X, F.XB, F.SS, REP_LAST ? 1.0f : 0.f};
                run_gemm(F, YG, 1024, WB + WR_O, 1024, 1024, 1024, E);
            PH_END
        }
#define ACT ((bf16*)(AR + A_ACT))
        PH_BEGIN(16)
            { EpiSwiGLU E{F.SS, ACT};
              run_gemm(F, F.XB, D, WB + (half ? WO_GU1 : WO_GU0), D, 2 * FF, D, E); }
        PH_END
        PH_BEGIN(17)
            EpiResidual E{F.X, F.XB, F.SS, REP_LAST ? 0.5f : 0.f};
            run_gemm(F, ACT, FF, WB + (half ? WO_D1 : WO_D0), FF, D, FF, E);
        PH_END
    }
    PH_BEGIN(18)
        final_norm_phase(F, in);
    PH_END
}

extern "C" void kernel_launch(void* const* d_in, const int* in_sizes, int n_in, void* d_out, int out_size, void* d_ws, size_t ws_size, hipStream_t stream) {
    static int grid = 0;
    if (grid == 0) {
        if (n_in != 38 || in_sizes[0] != T * D || out_size != T * D || ws_size < WS_END) { fprintf(stderr, "kernel_launch: unexpected shapes (n_in %d, in0 %d, out %d, ws %zu)\n", n_in, n_in > 0 ? in_sizes[0] : -1, out_size, ws_size); grid = -1; return; }
        int dev = 0, cus = 0, per_cu = 0;
        if (hipGetDevice(&dev) != hipSuccess || hipDeviceGetAttribute(&cus, hipDeviceAttributeMultiprocessorCount, dev) != hipSuccess) { grid = -1; return; }
        if (hipFuncSetAttribute((const void*)fwd, hipFuncAttributeMaxDynamicSharedMemorySize, LDS_BYTES) != hipSuccess) { fprintf(stderr, "kernel_launch: hipFuncSetAttribute failed\n"); grid = -1; return; }
        if (hipOccupancyMaxActiveBlocksPerMultiprocessor(&per_cu, (const void*)fwd, NWAVES * 64, LDS_BYTES) != hipSuccess || per_cu < 1)
            fprintf(stderr, "kernel_launch: occupancy query reports %d workgroups per CU\n", per_cu);
        (void)hipGetLastError();
        grid = cus;
    }
    if (grid < 0) return;
    if (hipMemsetAsync((char*)d_ws + WS_CTL, 0, CTL_ZERO_BYTES, stream) != hipSuccess) return;
    Args a{};
    const void** ip = (const void**)&a.in;
    for (int i = 0; i < 38; ++i) ip[i] = d_in[i];
    a.out = (float*)d_out; a.ws = (unsigned char*)d_ws;
#if MK_ONE_LAUNCH
    a.ph_lo = 0; a.ph_hi = NPH;
    hipLaunchKernelGGL(fwd, dim3(grid), dim3(NWAVES * 64), LDS_BYTES, stream, a);
#else
#ifdef DUMP
    for (int p = 0; p <= DUMP_LAST; ++p) { a.ph_lo = p; a.ph_hi = p + 1;
        hipLaunchKernelGGL(fwd, dim3(grid), dim3(NWAVES * 64), LDS_BYTES, stream, a); }
    a.ph_lo = 1000; a.ph_hi = 1001;
    hipLaunchKernelGGL(fwd, dim3(grid), dim3(NWAVES * 64), LDS_BYTES, stream, a);
#else
    for (int p = 0; p < NPH; ++p) { a.ph_lo = p; a.ph_hi = p + 1;
        hipLaunchKernelGGL(fwd, dim3(grid), dim3(NWAVES * 64), LDS_BYTES, stream, a); }
#endif
#endif
}
```

```cpp
#include <hip/hip_runtime.h>
#include <cstdio>
#include <cstdint>

__device__ __forceinline__ int fresh_lane() { int l; asm volatile("v_mbcnt_lo_u32_b32 %0, -1, 0\n\tv_mbcnt_hi_u32_b32 %0, -1, %0" : "=v"(l)); return l; }
namespace pg8 {
#define PG8_LAS __attribute__((address_space(3)))
typedef unsigned short bf16_t;
typedef short bf16x8 __attribute__((ext_vector_type(8)));
typedef float f32x4 __attribute__((ext_vector_type(4)));
typedef unsigned u32x4 __attribute__((ext_vector_type(4)));
typedef unsigned u32x2 __attribute__((ext_vector_type(2)));
constexpr int BM = 256, BK = 64, HALF = 128, HTB = HALF * BK * 2  , STAGE_BYTES = 8 * HTB, NXCD = 8, WGM = 8;

__host__ __device__ __forceinline__ int lds_byte(int r, int c) { const int st = (r >> 4) * 2 + (c >> 5), rr = r & 15, cc = c & 31, ob = rr * 64 + cc * 2; return st * 1024 + (ob ^ (((ob >> 9) & 1) << 5)); }
__host__ __device__ __forceinline__ void stage_rc(int b, int& R, int& C) { const int st = b / 1024, sb = b % 1024, swz = sb ^ (((sb >> 9) & 1) << 5); R = (st >> 1) * 16 + swz / 64; C = (st & 1) * 32 + (swz % 64) / 2; }
__host__ __device__ __forceinline__ int perm32(int rho) { const int n = rho >> 4, i = rho & 15; return 8 * (i >> 2) + 4 * n + (i & 3); }

struct Unit { int pm, pn, roff, nai, acol; };
struct Gemm { const bf16_t* A; const bf16_t* Bt; int M, N, K, lda, ldb, wave; };

struct StaticOrder {
    int nM, nN, nwg, G, c, lim;
    __host__ __device__ void init(int M, int N, int G_, int c_) { nM = M / BM; nN = N / BM; nwg = nM * nN; G = G_; c = c_; lim = nwg; }
    __host__ __device__ bool next(int i, Unit& u) const {
        const long L = (long)i * G + c; if (L >= lim) return false;
        u.roff = 0; u.nai = 2; u.acol = 0;
        int wgid = (int)L; { const int q = nwg / NXCD, r = nwg % NXCD, xcd = wgid % NXCD, off = wgid / NXCD; wgid = (xcd < r ? xcd * (q + 1) : r * (q + 1) + (xcd - r) * q) + off; }
        const int nig = WGM * nN, gid = wgid / nig, fm = gid * WGM, gsz = (nM - fm) < WGM ? (nM - fm) : WGM;
        u.pm = fm + ((wgid % nig) % gsz); u.pn = (wgid % nig) / gsz; return true;
    }
    __device__ __forceinline__ void a_ready(const Unit&) const {}
    __device__ __forceinline__ void done(const Unit&) const {}
};
struct TailOrder { StaticOrder S; int lim0;
    __host__ __device__ bool next(int i, Unit& u) const { if (i > 0) return false; const int L = lim0 + 8 * ((S.c >> 3) >> 1) + (S.c & 7); if (L >= S.nwg) return false;
        StaticOrder T = S; T.c = L % S.G; T.lim = S.nwg; const bool ok = T.next(L / S.G, u); u.roff = ((S.c >> 3) & 1) * 128; u.nai = 1; return ok; }
    __device__ __forceinline__ void a_ready(const Unit&) const {}
    __device__ __forceinline__ void done(const Unit&) const {}
};

template <class Epi, class Sched, bool ALIGN_EPI = false, bool SP2 = false, bool HALFM = false>
__device__ __forceinline__ void gemm_phase(PG8_LAS unsigned char* lds, const Gemm g, const Sched& S, const Epi& E) {
    const int wid = g.wave; const int tid = wid * 64 + fresh_lane(), lane = tid & 63, wr = wid >> 2, wc = wid & 3, fr = lane & 15, fq = lane >> 4;
    const int K = g.K, nt = K / BK;
    unsigned voffA[2], voffB[2];
#pragma unroll
    for (int i = 0; i < 2; ++i) { int R, C; stage_rc(tid * 16 + i * 8192, R, C); const int Rb = Epi::PERM ? ((R & ~31) + perm32(R & 31)) : R;
        voffA[i] = (unsigned)(R * g.lda + C) * 2u; voffB[i] = (unsigned)(Rb * g.ldb + C) * 2u; }
    const size_t kstep = (size_t)(BK * 2);
    const size_t hstepA = (size_t)HALF * g.lda * 2, hstepB = (size_t)HALF * g.ldb * 2;
    const size_t tstepA = 2 * hstepA, tstepB = 2 * hstepB;
    const unsigned ldsw = (unsigned)wid * 1024u;
    const int aoff = lds_byte(wr * 64 + fr, fq * 8), boff = lds_byte(wc * 32 + fr, fq * 8);
#define PG8_SA(b, h) (((b) * 2 + (h)) * HTB)
#define PG8_SB(b, h) ((4 + (b) * 2 + (h)) * HTB)
#define PG8_STAGE(bufoff, gbase, voff) do { _Pragma("unroll") for (int _i = 0; _i < 2; ++_i) \
        __builtin_amdgcn_global_load_lds((const unsigned*)((const char*)(gbase) + (voff)[_i]), (PG8_LAS unsigned*)(lds + (bufoff) + ldsw + _i * 8192), 16, 0, 0); } while (0)
#define PG8_LDA(dst, b, h) do { _Pragma("unroll") for (int m = 0; m < 4; ++m) _Pragma("unroll") for (int k = 0; k < 2; ++k) dst[m][k] = *(const PG8_LAS bf16x8*)(lds + PG8_SA(b, h) + aoff + m * 2048 + k * 1024); } while (0)
#define PG8_LDB(dst, b, h) do { _Pragma("unroll") for (int n = 0; n < 2; ++n) _Pragma("unroll") for (int k = 0; k < 2; ++k) dst[n][k] = *(const PG8_LAS bf16x8*)(lds + PG8_SB(b, h) + boff + n * 2048 + k * 1024); } while (0)
#define PG8_MMA(ai, bj, At, Bt) do { __builtin_amdgcn_s_setprio(1); _Pragma("unroll") for (int m = 0; m < 4; ++m) _Pragma("unroll") for (int n = 0; n < 2; ++n) _Pragma("unroll") for (int k = 0; k < 2; ++k) \
        acc[ai][bj][m][n] = __builtin_amdgcn_mfma_f32_16x16x32_bf16(Bt[n][k], At[m][k], acc[ai][bj][m][n], 0, 0, 0); __builtin_amdgcn_s_setprio(0); } while (0)
#define PG8_WAIT_V(n) asm volatile("s_waitcnt vmcnt(" #n ")" ::: "memory")
#define PG8_WAIT_L(n) asm volatile("s_waitcnt lgkmcnt(" #n ")" ::: "memory")
#define PG8_BAR __builtin_amdgcn_s_barrier()
#define PG8_SCHED __builtin_amdgcn_sched_barrier(0)
    Unit cur, nxt; int ui = 0;
    if (!S.next(0, cur)) return;
    f32x4 acc[2][2][4][2];
#pragma unroll
    for (int a = 0; a < 2; ++a)
#pragma unroll
        for (int b = 0; b < 2; ++b)
#pragma unroll
            for (int m = 0; m < 4; ++m)
#pragma unroll
                for (int n = 0; n < 2; ++n) acc[a][b][m][n] = (f32x4){0.f, 0.f, 0.f, 0.f};
    bf16x8 At[4][2], B0[2][2], B1[2][2];
    const char* cA = (const char*)g.A + (size_t)cur.pm * tstepA + (size_t)cur.roff * (size_t)g.lda * 2 + (size_t)cur.acol * 2; const char* cB = (const char*)g.Bt + (size_t)cur.pn * tstepB;
    S.a_ready(cur);
    if constexpr (SP2) {
        PG8_STAGE(PG8_SB(0, 0), cB, voffB); PG8_STAGE(PG8_SB(0, 1), cB + hstepB, voffB); PG8_STAGE(PG8_SA(0, 0), cA, voffA); PG8_STAGE(PG8_SA(0, 1), cA + hstepA, voffA);
        if (wr == 1) PG8_BAR;
        PG8_WAIT_V(2); PG8_BAR;
        PG8_STAGE(PG8_SB(1, 0), cB + kstep, voffB); PG8_STAGE(PG8_SA(1, 0), cA + kstep, voffA); PG8_STAGE(PG8_SB(1, 1), cB + hstepB + kstep, voffB);
        PG8_WAIT_V(6); PG8_BAR;
    } else {
        PG8_STAGE(PG8_SB(0, 0), cB, voffB); PG8_STAGE(PG8_SA(0, 0), cA, voffA); PG8_STAGE(PG8_SB(0, 1), cB + hstepB, voffB); PG8_STAGE(PG8_SA(0, 1), cA + hstepA, voffA);
        if (wr == 1) PG8_BAR;
        PG8_WAIT_V(4); PG8_BAR;
        PG8_STAGE(PG8_SB(1, 0), cB + kstep, voffB); PG8_STAGE(PG8_SA(1, 0), cA + kstep, voffA); PG8_STAGE(PG8_SB(1, 1), cB + hstepB + kstep, voffB);
        PG8_WAIT_V(6); PG8_BAR;
    }
    for (;;) {
        const bool has_next = S.next(ui + 1, nxt);
        const char* nA = has_next ? (const char*)g.A + (size_t)nxt.pm * tstepA + (size_t)nxt.roff * (size_t)g.lda * 2 + (size_t)nxt.acol * 2 : cA; const char* nB = has_next ? (const char*)g.Bt + (size_t)nxt.pn * tstepB : cB;
#pragma nounroll
        for (int t = 0; t < nt; t += 2) {
            const bool last = (t == nt - 2);
            const char* a1 = cA + (size_t)(t + 1) * kstep;
            const char* a2 = last ? nA : cA + (size_t)(t + 2) * kstep; const char* b2 = last ? nB : cB + (size_t)(t + 2) * kstep;
            const char* a3 = a2 + kstep; const char* b3 = b2 + kstep;
            if (last && has_next) S.a_ready(nxt);
            if constexpr (SP2) {
            PG8_LDB(B0, 0, 0); PG8_LDB(B1, 0, 1); PG8_SCHED; PG8_LDA(At, 0, 0); PG8_STAGE(PG8_SA(1, 1), a1 + hstepA, voffA);
            PG8_WAIT_V(8); PG8_WAIT_L(0); PG8_BAR; PG8_MMA(0, 0, At, B0); PG8_MMA(0, 1, At, B1); PG8_BAR; PG8_SCHED;
            if constexpr (!HALFM) PG8_LDA(At, 0, 1); PG8_STAGE(PG8_SB(0, 0), b2, voffB); PG8_STAGE(PG8_SB(0, 1), b2 + hstepB, voffB); PG8_STAGE(PG8_SA(0, 0), a2, voffA);
            PG8_WAIT_V(8); PG8_WAIT_L(0); PG8_BAR; if constexpr (!HALFM) { PG8_MMA(1, 0, At, B0); PG8_MMA(1, 1, At, B1); } PG8_BAR; PG8_SCHED;
            PG8_LDB(B0, 1, 0); PG8_LDB(B1, 1, 1); PG8_SCHED; PG8_LDA(At, 1, 0); PG8_STAGE(PG8_SA(0, 1), a2 + hstepA, voffA);
            PG8_WAIT_V(8); PG8_WAIT_L(0); PG8_BAR; PG8_MMA(0, 0, At, B0); PG8_MMA(0, 1, At, B1); PG8_BAR; PG8_SCHED;
            if constexpr (!HALFM) PG8_LDA(At, 1, 1); PG8_STAGE(PG8_SB(1, 0), b3, voffB); PG8_STAGE(PG8_SB(1, 1), b3 + hstepB, voffB); PG8_STAGE(PG8_SA(1, 0), a3, voffA);
            PG8_WAIT_V(8); PG8_WAIT_L(0); PG8_BAR; if constexpr (!HALFM) { PG8_MMA(1, 0, At, B0); PG8_MMA(1, 1, At, B1); } PG8_BAR; PG8_SCHED;
            } else {
            PG8_LDB(B0, 0, 0); PG8_SCHED; PG8_LDA(At, 0, 0); PG8_STAGE(PG8_SA(1, 1), a1 + hstepA, voffA);
            PG8_WAIT_L(8); PG8_BAR; PG8_WAIT_L(0); PG8_MMA(0, 0, At, B0); PG8_BAR; PG8_SCHED;
            PG8_LDB(B1, 0, 1); PG8_STAGE(PG8_SB(0, 0), b2, voffB);
            PG8_BAR; PG8_WAIT_L(0); PG8_MMA(0, 1, At, B1); PG8_BAR;
            PG8_LDA(At, 0, 1); PG8_STAGE(PG8_SA(0, 0), a2, voffA);
            PG8_BAR; PG8_WAIT_L(0); PG8_MMA(1, 0, At, B0); PG8_BAR; PG8_SCHED;
            PG8_STAGE(PG8_SB(0, 1), b2 + hstepB, voffB);
            PG8_WAIT_V(6); PG8_BAR; PG8_MMA(1, 1, At, B1); PG8_BAR;
            PG8_LDB(B0, 1, 0); PG8_SCHED; PG8_LDA(At, 1, 0); PG8_STAGE(PG8_SA(0, 1), a2 + hstepA, voffA);
            PG8_WAIT_L(8); PG8_BAR; PG8_WAIT_L(0); PG8_MMA(0, 0, At, B0); PG8_BAR; PG8_SCHED;
            PG8_LDB(B1, 1, 1); PG8_STAGE(PG8_SB(1, 0), b3, voffB);
            PG8_BAR; PG8_WAIT_L(0); PG8_MMA(0, 1, At, B1); PG8_BAR;
            PG8_LDA(At, 1, 1); PG8_STAGE(PG8_SA(1, 0), a3, voffA);
            PG8_BAR; PG8_WAIT_L(0); PG8_MMA(1, 0, At, B0); PG8_BAR; PG8_SCHED;
            PG8_STAGE(PG8_SB(1, 1), b3 + hstepB, voffB);
            PG8_WAIT_V(6); PG8_BAR; PG8_MMA(1, 1, At, B1); PG8_BAR;
            }
        }
        if constexpr (ALIGN_EPI) { if (wr == 0) PG8_BAR; }
        if constexpr (!Epi::AFTER_DRAIN) { E(acc, cur, wr, wc, fr, fq); S.done(cur); }
        if (!has_next) break;
#pragma unroll
        for (int a = 0; a < 2; ++a)
#pragma unroll
            for (int b = 0; b < 2; ++b)
#pragma unroll
                for (int m = 0; m < 4; ++m)
#pragma unroll
                    for (int n = 0; n < 2; ++n) acc[a][b][m][n] = (f32x4){0.f, 0.f, 0.f, 0.f};
        cur = nxt; cA = nA; cB = nB; ++ui;
        if constexpr (ALIGN_EPI) { if (wr == 1) PG8_BAR; }
    }
    PG8_WAIT_V(0);
    if constexpr (!ALIGN_EPI) { if (wr == 0) PG8_BAR; }
    PG8_BAR;
    if constexpr (Epi::AFTER_DRAIN) { E.fused(acc, cur, wr, wc, fr, fq, lds, wid, lane); S.done(cur); }
#undef PG8_SA
#undef PG8_SB
#undef PG8_STAGE
#undef PG8_LDA
#undef PG8_LDB
#undef PG8_MMA
#undef PG8_WAIT_V
#undef PG8_WAIT_L
#undef PG8_BAR
#undef PG8_SCHED
}
}

constexpr int NWAVES = 8;
constexpr int BATCH = 2, SEQ = 8192, D = 1024, T = BATCH * SEQ, FF = 2816, DEPTH = 4;
constexpr float RMS_EPS = 1e-6f;
constexpr int MLA_H = 8, QRANK = 512, KVRANK = 256, NOPE = 128, ROPE = 64, DVH = 128, DQK = NOPE + ROPE;
constexpr int LATN = QRANK + KVRANK + ROPE;
constexpr int ML_H = 8, ML_DK = 64, ML_DV = 128, ML_NIN = 3088;
constexpr int RW_H = 16, RW_N = 64;

constexpr size_t MiB = 1u << 20;
constexpr size_t WS_CTL = 0, CTL_ZERO_BYTES = 1 * MiB;
constexpr size_t WS_COS = 1 * MiB, WS_SIN = 3 * MiB;
constexpr size_t WS_SS = 5 * MiB;
constexpr size_t WS_SSQ = 6 * MiB;
constexpr size_t WS_SSKV = 6 * MiB + 512 * 1024;
constexpr size_t WS_W = 8 * MiB;
constexpr size_t WS_XB = 68 * MiB;
constexpr size_t WS_ARENA = 100 * MiB;
constexpr size_t WS_END = 352 * MiB;
constexpr size_t WS_ALT = 352 * MiB, WS_END_ALT = WS_ALT + 17 * MiB;
constexpr size_t WO_GU0 = 0, WO_D0 = WO_GU0 + (size_t)2 * FF * D, WO_GU1 = WO_D0 + (size_t)D * FF, WO_D1 = WO_GU1 + (size_t)2 * FF * D, WO_MIX = WO_D1 + (size_t)D * FF;
constexpr size_t WO_GU1A = (WS_ALT - WS_W) / 2, WO_D1A = WO_GU1A + (size_t)2 * FF * D;
constexpr size_t WM_A = WO_MIX, WM_QB = WM_A + (size_t)1024 * 1024, WM_KVB = WM_QB + (size_t)1536 * 512, WM_O = WM_KVB + (size_t)2048 * 256;
constexpr size_t WL_IN = WO_MIX, WL_O = WL_IN + (size_t)3328 * 1024;
constexpr size_t WR_BIG = WO_MIX  , WR_LORA = WR_BIG + (size_t)3072 * 1024  , WR_UP = WR_LORA + (size_t)256 * 2048, WR_O = WR_UP + (size_t)3072 * 256;
static_assert((WR_O + (size_t)1024 * 1024) * 2 <= 60 * MiB, "weight region");
constexpr size_t A_ACT = 0;
constexpr size_t A_LAT = 0, A_Q = 32 * MiB, A_KV = 80 * MiB, A_O = 144 * MiB, A_KPE = 176 * MiB;
constexpr size_t A_P = 0, A_GATES = 96 * MiB, A_QKC = 97 * MiB, A_IGLF = 161 * MiB, A_HRAW = 162 * MiB, A_HM = A_QKC;
constexpr size_t A_HX = 0, A_RKV = 128 * MiB, A_LOR = 224 * MiB, A_LW = 0, A_GG = 64 * MiB, A_YG = A_GG  , A_AAZ = 96 * MiB  ;
static_assert(WS_ARENA + A_HRAW + (size_t)T * 1024 * 4 <= WS_END && WS_ARENA + A_YG + (size_t)T * 1024 * 2 <= WS_END && WS_ARENA + A_KPE + (size_t)T * 64 * 2 <= WS_END, "arena");

constexpr int CW_TMO = 0, CW_CODE = 1, CW_BAR = 4096, CW_Q = 8192;
constexpr size_t WS_PTRS = 512 * 1024;

constexpr int RING_BYTES = 131072;
constexpr int LDSCTL_OFF = 146432, MISC_OFF = LDSCTL_OFF + 320;
constexpr int LDS_BYTES = 147456;

#define GAS __attribute__((address_space(1)))
#define LAS __attribute__((address_space(3)))
typedef unsigned short bf16;
typedef unsigned v4u __attribute__((ext_vector_type(4)));
typedef unsigned v2u __attribute__((ext_vector_type(2)));
typedef float f32x4 __attribute__((ext_vector_type(4)));
typedef float f32x16 __attribute__((ext_vector_type(16)));
typedef short bf16x8 __attribute__((ext_vector_type(8)));
typedef short s16x4 __attribute__((ext_vector_type(4)));
typedef GAS unsigned gu32;
#define RLX_AGENT __ATOMIC_RELAXED, __HIP_MEMORY_SCOPE_AGENT
#define LDS_WAIT() asm volatile("s_waitcnt lgkmcnt(0)" ::: "memory")
#define VM_WAIT() asm volatile("s_waitcnt vmcnt(0)" ::: "memory")
typedef float f32x2_t __attribute__((ext_vector_type(2))); typedef __bf16 bf16x2_t __attribute__((ext_vector_type(2)));
__device__ __forceinline__ unsigned cvtpk(float lo, float hi) { f32x2_t v = {lo, hi}; bf16x2_t b = __builtin_convertvector(v, bf16x2_t); return __builtin_bit_cast(unsigned, b); }
__device__ __forceinline__ float bf_lo(unsigned w) { return __builtin_bit_cast(float, w << 16); }
__device__ __forceinline__ float bf_hi(unsigned w) { return __builtin_bit_cast(float, w & 0xffff0000u); }
__device__ __forceinline__ float bf1(bf16 h) { return __builtin_bit_cast(float, (unsigned)h << 16); }
__device__ __forceinline__ v4u pack8f(const float* v) { v4u w; w.x = cvtpk(v[0], v[1]); w.y = cvtpk(v[2], v[3]); w.z = cvtpk(v[4], v[5]); w.w = cvtpk(v[6], v[7]); return w; }
__device__ __forceinline__ v4u pack8v(f32x4 a, f32x4 b) { v4u w; w.x = cvtpk(a[0], a[1]); w.y = cvtpk(a[2], a[3]); w.z = cvtpk(b[0], b[1]); w.w = cvtpk(b[2], b[3]); return w; }
__device__ __forceinline__ void unpack8(v4u w, float* v) { v[0] = bf_lo(w.x); v[1] = bf_hi(w.x); v[2] = bf_lo(w.y); v[3] = bf_hi(w.y); v[4] = bf_lo(w.z); v[5] = bf_hi(w.z); v[6] = bf_lo(w.w); v[7] = bf_hi(w.w); }
__device__ __forceinline__ float fexp(float x) { return __builtin_amdgcn_exp2f(x * 1.4426950408889634f); }
__device__ __forceinline__ float frcp(float x) { return __builtin_amdgcn_rcpf(x); }
__device__ __forceinline__ float flog(float x) { return __builtin_amdgcn_logf(x) * 0.6931471805599453f; }
__device__ __forceinline__ float ftanh(float x) { const float t = fexp(-2.f * fabsf(x)); const float r = (1.f - t) * frcp(1.f + t); return x < 0.f ? -r : r; }
__device__ __forceinline__ float fsigmoid(float x) { return frcp(1.f + fexp(-x)); }
__device__ __forceinline__ float frsq(float x) { return __builtin_amdgcn_rsqf(x); }
__device__ __forceinline__ float fsqrt(float x) { return __builtin_amdgcn_sqrtf(x); }
__device__ __forceinline__ void fsincos_big(float a, float& s, float& c) {
    const float k = __builtin_rintf(a * 0.15915494309189535f);
    float r = __builtin_fmaf(-k, 6.28125f, a); r = __builtin_fmaf(-k, 1.9353071795864769e-3f, r);
    const float rev = r * 0.15915494309189535f;
    s = __builtin_amdgcn_sinf(rev); c = __builtin_amdgcn_cosf(rev);
}
__device__ __forceinline__ float fsilu(float x) { return x * frcp(1.f + fexp(-x)); }
__device__ __forceinline__ float wave_sum(float v) {
#pragma unroll
    for (int o = 1; o < 64; o <<= 1) v += __shfl_xor(v, o);
    return v;
}

#define XB_TMO      128
#define XB_XCNT(j)  (256  + 64 * (j))
#define XB_XSUB(j)  (1280 + 64 * (j))
#define XB_XGEN(j)  (2304 + 64 * (j))
#define XB_TOP      3328
#define XB_TOPGEN   3392
#define XCD_BAR_WORDS 3456
#define XB_SPIN_CAP (1u << 18)

__device__ __forceinline__ unsigned xb_ld(unsigned* p)              { return __hip_atomic_load(p, __ATOMIC_RELAXED, __HIP_MEMORY_SCOPE_AGENT); }
__device__ __forceinline__ unsigned xb_add(unsigned* p, unsigned v) { return __hip_atomic_fetch_add(p, v, __ATOMIC_RELAXED, __HIP_MEMORY_SCOPE_AGENT); }
__device__ __forceinline__ unsigned xb_xcc_id() { return (unsigned)__builtin_amdgcn_s_getreg((3 << 11) | 20) & 0xFu; }
#define XB_SPIN(cond, bar) do { unsigned _sp = 0; while (cond) { __builtin_amdgcn_s_sleep(1); \
    if ((++_sp & 255u) == 0u) { if (xb_ld(&(bar)[XB_TMO])) break; if (_sp > XB_SPIN_CAP) { atomicAdd(&(bar)[XB_TMO], 1u); break; } } } } while (0)

struct XcdBarrier {
    unsigned* bar; unsigned x;
    volatile LAS unsigned* st;
};

__device__ __forceinline__ XcdBarrier xcd_barrier_post(unsigned* bar, volatile LAS unsigned* st) {
    XcdBarrier b; b.bar = bar; b.x = xb_xcc_id(); b.st = st;
    if (threadIdx.x == 0) (void)xb_add(&bar[XB_XCNT(b.x)], 1u);
    return b;
}
__device__ __forceinline__ void xcd_barrier_complete(unsigned* bar, unsigned x, unsigned& nloc, unsigned& nx) {
    const unsigned G = gridDim.x * gridDim.y * gridDim.z;
    unsigned sum, cnt, mine, sp = 0u;
    for (;;) {
        sum = 0u; cnt = 0u; mine = 0u;
#pragma unroll
        for (unsigned j = 0; j < 16; ++j) { const unsigned c = xb_ld(&bar[XB_XCNT(j)]); sum += c; cnt += (c > 0u) ? 1u : 0u; mine = (j == x) ? c : mine; }
        if (sum == G) break;
        __builtin_amdgcn_s_sleep(1);
        if ((++sp & 255u) == 0u) { if (xb_ld(&bar[XB_TMO])) break; if (sp > XB_SPIN_CAP) { atomicAdd(&bar[XB_TMO], 1u); break; } }
    }
    nloc = mine > 0u ? mine : 1u; nx = cnt > 0u ? cnt : 1u;
}

__device__ __forceinline__ void xcd_barrier(const XcdBarrier& b) {
    asm volatile("s_waitcnt vmcnt(0)" ::: "memory");
    __syncthreads();
    if (threadIdx.x == 0) {
        unsigned* bar = b.bar;
        __builtin_amdgcn_s_waitcnt(0);
        unsigned nloc = b.st[0], nx = b.st[1];
        if (nloc == 0u) { xcd_barrier_complete(bar, b.x, nloc, nx); b.st[0] = nloc; b.st[1] = nx; }
        const unsigned old = xb_add(&bar[XB_XSUB(b.x)], 1u);
        const unsigned gen = old / nloc;
        if (old + 1u == (gen + 1u) * nloc) {
            __builtin_amdgcn_fence(__ATOMIC_RELEASE, "agent");
            asm volatile("s_waitcnt vmcnt(0)" ::: "memory");
            const unsigned og = xb_add(&bar[XB_TOP], 1u);
            const unsigned tg = og / nx;
            if (og + 1u == (tg + 1u) * nx) xb_add(&bar[XB_TOPGEN], 1u);
            else XB_SPIN(xb_ld(&bar[XB_TOPGEN]) == tg, bar);
            __builtin_amdgcn_fence(__ATOMIC_ACQUIRE, "agent");
            xb_add(&bar[XB_XGEN(b.x)], 1u);
            asm volatile("s_waitcnt vmcnt(0)" ::: "memory");
        } else {
            XB_SPIN(xb_ld(&bar[XB_XGEN(b.x)]) == gen, bar);
            __builtin_amdgcn_fence(__ATOMIC_ACQUIRE, "agent");
            asm volatile("s_waitcnt vmcnt(0)" ::: "memory");
        }
    }
    __syncthreads();
}

struct Inputs {
    const float* x; const int* positions; const float* ffn_norm; const float* ffn_w_gate; const float* ffn_w_up; const float* ffn_w_down; const float* mix_norm; const float* final_norm;
    const float* mla_w_a; const float* mla_q_norm; const float* mla_w_qb; const float* mla_kv_norm; const float* mla_w_kvb; const float* mla_w_o;
    const float* ml_w_in; const float* ml_b_if; const float* ml_conv_w; const float* ml_conv_b; const float* ml_out_norm; const float* ml_w_o;
    const float* rw_mu; const float* rw_w_r; const float* rw_w_k; const float* rw_w_v; const float* rw_w0; const float* rw_w1; const float* rw_w2; const float* rw_a0; const float* rw_a1; const float* rw_a2;
    const float* rw_g1; const float* rw_g2; const float* rw_k_k; const float* rw_k_a; const float* rw_r_k; const float* rw_ln_w; const float* rw_ln_b; const float* rw_w_o;
};
struct Args { Inputs in; float* out; unsigned char* ws; int ph_lo, ph_hi, hide; };

struct Frame {
    LAS unsigned char* lds;
    gu32* ctl;
    int tid, lane, wave, G, gw, NGW;
    float* X;
    bf16* XB;
    float* SS;
    unsigned char* ws;
};

struct CvDesc { const float* Wp; const float* g1; const float* g2; const float* g3; bf16* dst; int ld, ks0, ldd, kd0, n0; bool vec; };
__device__ __forceinline__ void cv_load(const CvDesc& d, f32x4 (&v)[8], float (&g)[8], int lane) {
    const int kr = lane >> 3, nc = (lane & 7) * 4; const float* W0 = d.Wp ? d.Wp - (lane & 31) : nullptr; const int k0 = d.ks0 + 8 * kr;
#pragma unroll
    for (int i = 0; i < 8; ++i) v[i] = W0 ? *(const GAS f32x4*)(W0 + (size_t)(k0 + i) * d.ld + nc) : (f32x4){0.f, 0.f, 0.f, 0.f};
    f32x4 ga = {1.f, 1.f, 1.f, 1.f}, gb = ga;
    if (d.g1) { ga = *(const GAS f32x4*)(d.g1 + k0); gb = *(const GAS f32x4*)(d.g1 + k0 + 4); }
    if (d.g2) { f32x4 ma = *(const GAS f32x4*)(d.g2 + k0), mb = *(const GAS f32x4*)(d.g2 + k0 + 4); if (d.g3) { ma = ma - *(const GAS f32x4*)(d.g3 + k0); mb = mb - *(const GAS f32x4*)(d.g3 + k0 + 4); } ga = ga * ma; gb = gb * mb; }
#pragma unroll
    for (int i = 0; i < 4; ++i) { g[i] = ga[i]; g[4 + i] = gb[i]; }
}
__device__ __forceinline__ void cv_finish(const CvDesc& d, const f32x4 (&v)[8], const float (&g)[8], LAS float* scr, int lane) {
    const int kr = lane >> 3, nc = (lane & 7) * 4;
    if (d.vec) {
#pragma unroll
        for (int e = 0; e < 4; ++e) { v4u o; o.x = cvtpk(v[0][e] * g[0], v[1][e] * g[1]); o.y = cvtpk(v[2][e] * g[2], v[3][e] * g[3]); o.z = cvtpk(v[4][e] * g[4], v[5][e] * g[5]); o.w = cvtpk(v[6][e] * g[6], v[7][e] * g[7]);
            *(GAS v4u*)(d.dst + (size_t)(d.n0 + nc + e) * d.ldd + d.kd0 + 8 * kr) = o; }
        return;
    } else {
        const int nl = lane & 31, kh = lane >> 5;
#pragma unroll 8
        for (int i = 0; i < 32; ++i) { const int kk = 2 * i + kh, k = d.ks0 + kk; float x = 0.f;
            if (d.Wp) { x = d.Wp[(size_t)k * d.ld]; if (d.g1) x *= d.g1[k]; if (d.g2) x *= d.g2[k] - (d.g3 ? d.g3[k] : 0.f); }
            scr[kk * 33 + nl] = x; }
    }
    LDS_WAIT(); asm volatile("" ::: "memory");
    const int c = lane & 7;
#pragma unroll
    for (int j = 0; j < 4; ++j) { const int n = (lane >> 3) + 8 * j; const LAS float* s = scr + (8 * c) * 33 + n;
        v4u o; o.x = cvtpk(s[0 * 33], s[1 * 33]); o.y = cvtpk(s[2 * 33], s[3 * 33]); o.z = cvtpk(s[4 * 33], s[5 * 33]); o.w = cvtpk(s[6 * 33], s[7 * 33]);
        *(GAS v4u*)(d.dst + (size_t)(d.n0 + n) * d.ldd + d.kd0 + 8 * c) = o; }
    LDS_WAIT(); asm volatile("" ::: "memory");
}
__device__ __forceinline__ void cv_decode(const Inputs& in, bf16* WB, int layer, int it, int lane, CvDesc& d, bool alt = false) {
    const int kind = layer % 3, j = layer / 3, nl = lane & 31;
    constexpr int I_GU = (D / 64) * (2 * FF / 32), I_DN = (FF / 64) * (D / 32), I_FFN = 2 * (I_GU + I_DN);
    d.g1 = nullptr; d.g2 = nullptr; d.g3 = nullptr; d.vec = true;
    int r = it;
    if (r < I_FFN) {
        const int half = r / (I_GU + I_DN); r -= half * (I_GU + I_DN);
        const size_t wsel = (size_t)(layer * 2 + half);
        if (r < I_GU) {
            const int nb = r % (2 * FF / 32), kb = r / (2 * FF / 32), n = nb * 32 + nl, tile = n >> 8, w = n & 255;
            d.Wp = (w < 128 ? in.ffn_w_gate : in.ffn_w_up) + wsel * D * FF + (tile * 128 + (w & 127)); d.ld = FF; d.ks0 = kb * 64; d.g1 = in.ffn_norm + wsel * D;
            d.dst = WB + (half ? (alt ? WO_GU1A : WO_GU1) : WO_GU0); d.ldd = D; d.kd0 = kb * 64; d.n0 = nb * 32;
        } else { r -= I_GU;
            const int nb = r % (D / 32), kb = r / (D / 32), n = nb * 32 + nl;
            d.Wp = in.ffn_w_down + wsel * FF * D + n; d.ld = D; d.ks0 = kb * 64; d.dst = WB + (half ? (alt ? WO_D1A : WO_D1) : WO_D0); d.ldd = FF; d.kd0 = kb * 64; d.n0 = nb * 32; }
        return;
    }
    r -= I_FFN;
    const float* gmix = in.mix_norm + (size_t)layer * D;
    if (kind == 0) {
        if (r < 16 * 32) {
            const int nb = r % 32, kb = r / 32, n = nb * 32 + nl; int col = n;
            if (n >= 768 && n < 832) { const int jj = n - 768; col = 768 + (jj >> 1) + 32 * (jj & 1); }
            d.Wp = (n < LATN) ? in.mla_w_a + (size_t)j * D * LATN + col : nullptr; d.ld = LATN; d.ks0 = kb * 64; d.g1 = gmix; d.dst = WB + WM_A; d.ldd = 1024; d.kd0 = kb * 64; d.n0 = nb * 32;
            d.vec = (nb < 24 || nb >= 26); return; }
        r -= 16 * 32;
        if (r < 8 * 48) {
            const int nb = r % 48, kb = r / 48, n = nb * 32 + nl, hd = n / DQK, w = n - hd * DQK; int col = n;
            if (w >= NOPE) { const int jj = w - NOPE; col = hd * DQK + NOPE + (jj >> 1) + 32 * (jj & 1); }
            d.Wp = in.mla_w_qb + (size_t)j * QRANK * 1536 + col; d.ld = 1536; d.ks0 = kb * 64; d.g1 = in.mla_q_norm + (size_t)j * QRANK; d.dst = WB + WM_QB; d.ldd = 512; d.kd0 = kb * 64; d.n0 = nb * 32;
            d.vec = (nb % 6) < 4; return; }
        r -= 8 * 48;
        if (r < 4 * 64) {
            const int nb = r % 64, kb = r / 64, n = nb * 32 + nl;
            d.Wp = in.mla_w_kvb + (size_t)j * KVRANK * 2048 + n; d.ld = 2048; d.ks0 = kb * 64; d.g1 = in.mla_kv_norm + (size_t)j * KVRANK; d.dst = WB + WM_KVB; d.ldd = 256; d.kd0 = kb * 64; d.n0 = nb * 32; return; }
        r -= 4 * 64;
        { const int nb = r % 32, kb = r / 32, n = nb * 32 + nl;
          d.Wp = in.mla_w_o + (size_t)j * 1024 * 1024 + n; d.ld = 1024; d.ks0 = kb * 64; d.dst = WB + WM_O; d.ldd = 1024; d.kd0 = kb * 64; d.n0 = nb * 32; }
    } else if (kind == 1) {
        if (r < 16 * 104) {
            const int nb = r % 104, kb = r / 104, n = nb * 32 + nl;
            d.Wp = (n < ML_NIN) ? in.ml_w_in + (size_t)j * D * ML_NIN + n : nullptr; d.ld = ML_NIN; d.ks0 = kb * 64; d.g1 = gmix; d.dst = WB + WL_IN; d.ldd = 1024; d.kd0 = kb * 64; d.n0 = nb * 32;
            d.vec = (nb != 96); return; }
        r -= 16 * 104;
        { const int nb = r % 32, kb = r / 32, n = nb * 32 + nl;
          d.Wp = in.ml_w_o + (size_t)j * 1024 * 1024 + n; d.ld = 1024; d.ks0 = kb * 64; d.dst = WB + WL_O; d.ldd = 1024; d.kd0 = kb * 64; d.n0 = nb * 32; }
    } else {
        const float* mu = in.rw_mu + (size_t)j * 6 * D;
        if (r < 16 * 96) {
            const int nb = r % 96, kb = r / 96, n = nb * 32 + nl;
            if (n < 1024) d.Wp = in.rw_w_r + (size_t)j * D * D + n; else if (n < 2048) d.Wp = in.rw_w_k + (size_t)j * D * D + (n - 1024); else d.Wp = in.rw_w_v + (size_t)j * D * D + (n - 2048);
            d.ld = D;
            d.ks0 = kb * 64; d.g1 = gmix; d.dst = WB + WR_BIG; d.ldd = 1024; d.kd0 = kb * 64; d.n0 = nb * 32; return; }
        r -= 16 * 96;
        if (r < 32 * 8) {
            const int nb = r % 8, kb = r / 8, n = nb * 32 + nl; const float* m;
            if (n < 64) { d.Wp = in.rw_w1 + (size_t)j * D * 64 + n; d.ld = 64; m = mu + 1 * D; }
            else if (n < 128) { d.Wp = in.rw_a1 + (size_t)j * D * 64 + (n - 64); d.ld = 64; m = mu + 4 * D; }
            else { d.Wp = in.rw_g1 + (size_t)j * D * 128 + (n - 128); d.ld = 128; m = mu + 5 * D; }
            d.ks0 = (kb & 15) * 64; d.g1 = gmix; if (kb >= 16) { d.g2 = m; d.g3 = mu + 3 * D; } d.dst = WB + WR_LORA; d.ldd = 2048; d.kd0 = kb * 64; d.n0 = nb * 32; return; }
        r -= 32 * 8;
        if (r < 4 * 96) {
            const int nb = r % 96, kb = r / 96, n = nb * 32 + nl; d.Wp = nullptr; d.ld = 1024; d.ks0 = 0;
            if (n < 1024) { if (kb == 0) d.Wp = in.rw_w2 + (size_t)j * 64 * D + n; }
            else if (n < 2048) { if (kb == 1) d.Wp = in.rw_a2 + (size_t)j * 64 * D + (n - 1024); }
            else { if (kb >= 2) { d.Wp = in.rw_g2 + (size_t)j * 128 * D + (n - 2048); d.ks0 = (kb - 2) * 64; } }
            d.dst = WB + WR_UP; d.ldd = 256; d.kd0 = kb * 64; d.n0 = nb * 32; return; }
        r -= 4 * 96;
        { const int nb = r % 32, kb = r / 32, n = nb * 32 + nl;
          d.Wp = in.rw_w_o + (size_t)j * 1024 * 1024 + n; d.ld = 1024; d.ks0 = kb * 64; d.dst = WB + WR_O; d.ldd = 1024; d.kd0 = kb * 64; d.n0 = nb * 32; }
    }
}
__device__ __forceinline__ void conv_layer(Frame& F, const Inputs& in, int layer, int w0, int nw, bool alt) {
    LAS float* scr = (LAS float*)(F.lds + F.wave * 16384);
    bf16* WB = (bf16*)(F.ws + WS_W);
    const int kind = layer % 3, lane = F.lane;
    constexpr int I_GU = (D / 64) * (2 * FF / 32), I_DN = (FF / 64) * (D / 32), I_FFN = 2 * (I_GU + I_DN);
    constexpr int I_MLA = (1024 / 64) * (1024 / 32) + (512 / 64) * (1536 / 32) + (256 / 64) * (2048 / 32) + (1024 / 64) * (1024 / 32);
    constexpr int I_ML = (1024 / 64) * (3328 / 32) + (1024 / 64) * (1024 / 32);
    constexpr int I_RW = (1024 / 64) * (3072 / 32) + (2048 / 64) * (256 / 32) + (256 / 64) * (3072 / 32) + (1024 / 64) * (1024 / 32);
    const int n_items = I_FFN + (kind == 0 ? I_MLA : kind == 1 ? I_ML : I_RW);
    CvDesc dA, dB; f32x4 vA[8], vB[8]; float gA[8], gB[8];
    int it = w0;
    if (it < n_items) { cv_decode(in, WB, layer, it, lane, dA, alt); if (dA.vec) cv_load(dA, vA, gA, lane); }
    for (; it < n_items; it += 2 * nw) {
        const int itB = it + nw, itC = it + 2 * nw;
        if (itB < n_items) { cv_decode(in, WB, layer, itB, lane, dB, alt); if (dB.vec) cv_load(dB, vB, gB, lane); }
        cv_finish(dA, vA, gA, scr, lane);
        if (itC < n_items) { cv_decode(in, WB, layer, itC, lane, dA, alt); if (dA.vec) cv_load(dA, vA, gA, lane); }
        if (itB < n_items) cv_finish(dB, vB, gB, scr, lane);
    }
}

__device__ __forceinline__ void prologue(Frame& F, const Inputs& in) {
    for (int m = F.gw; m < T; m += F.NGW) {
        const GAS f32x4* xr = (const GAS f32x4*)(in.x + (size_t)m * D) + F.lane;
        GAS v2u* xb = (GAS v2u*)(F.XB + (size_t)m * D) + F.lane;
        float s = 0.f;
#pragma unroll
        for (int jj = 0; jj < 4; ++jj) { const f32x4 v = xr[64 * jj]; s += (v.x * v.x + v.y * v.y) + (v.z * v.z + v.w * v.w);
            v2u w; w.x = cvtpk(v.x, v.y); w.y = cvtpk(v.z, v.w); xb[64 * jj] = w; }
        s = wave_sum(s);
        if (F.lane < 16) F.SS[(size_t)m * 16 + F.lane] = (F.lane == 0) ? s : 0.f;
    }
    float* COS = (float*)(F.ws + WS_COS); float* SIN = (float*)(F.ws + WS_SIN);
    for (int e = F.gw * 64 + F.lane; e < T * 32; e += F.NGW * 64) {
        const int t = e >> 5, i = e & 31;
        const float inv_freq = __builtin_amdgcn_exp2f(-(float)i * 0.41524101186092029f);
        const float ang = (float)in.positions[t] * inv_freq;
        float sn, cs; fsincos_big(ang, sn, cs);
        COS[e] = cs; SIN[e] = sn;
    }
}

__device__ __forceinline__ float rstd16(const float* SS, int row) {
    const GAS f32x4* p = (const GAS f32x4*)(SS + (size_t)row * 16);
    const f32x4 a = p[0], b = p[1], c = p[2], d = p[3];
    const float s = ((a.x + a.y) + (a.z + a.w)) + ((b.x + b.y) + (b.z + b.w)) + ((c.x + c.y) + (c.z + c.w)) + ((d.x + d.y) + (d.z + d.w));
    return frsq(s * (1.f / D) + RMS_EPS);
}

#define EPI_ROWS(ai, m) (u.pm * 256 + u.roff + (ai) * 128 + wr * 64 + (m) * 16 + fr)
typedef const f32x4 (&AccT)[2][2][4][2];
using pg8::Unit;


template <int NP> __device__ __forceinline__ void rstd_rows(const float* S, int row0  , int fq, float inv_n, float (&r)[8]) {
    float p[8];
#pragma unroll
    for (int ai = 0; ai < 2; ++ai)
#pragma unroll
        for (int m = 0; m < 4; ++m) { const int row = row0 + ai * 128 + m * 16;
            if constexpr (NP == 16) { const f32x4 a = *(const GAS f32x4*)(S + (size_t)row * 16 + fq * 4); p[ai * 4 + m] = (a.x + a.y) + (a.z + a.w); }
            else if constexpr (NP == 8) { const GAS float* q = (const GAS float*)(S + (size_t)row * 8 + fq * 2); p[ai * 4 + m] = q[0] + q[1]; }
            else { p[ai * 4 + m] = *(const GAS float*)(S + (size_t)row * 4 + fq); } }
#pragma unroll
    for (int i = 0; i < 8; ++i) { float s = p[i]; s += __shfl_xor(s, 16); s += __shfl_xor(s, 32); r[i] = frsq(s * inv_n + RMS_EPS); }
}
constexpr int RSTD_LDS_OFF = 131072;
__device__ __forceinline__ void stage_rstd(Frame& F, const float* SS) {
    LAS float* rl = (LAS float*)(F.lds + RSTD_LDS_OFF); const int base = ((int)blockIdx.x & 7) * 2048;
    f32x4 a[4][4];
#pragma unroll
    for (int i = 0; i < 4; ++i)
#pragma unroll
        for (int q = 0; q < 4; ++q) a[i][q] = *((const GAS f32x4*)(SS + (size_t)(base + F.tid + 512 * i) * 16) + q);
#pragma unroll
    for (int i = 0; i < 4; ++i) { f32x4 s = (a[i][0] + a[i][1]) + (a[i][2] + a[i][3]); rl[F.tid + 512 * i] = frsq(((s.x + s.y) + (s.z + s.w)) * (1.f / D) + RMS_EPS); }
    __syncthreads();
}
__device__ __forceinline__ void rstd_get(const LAS float* rl, int rbase, const float* SS, const Unit& u, int wr, int fr, int fq, float (&rs)[8]) {
    if (rl) {
#pragma unroll
        for (int ai = 0; ai < 2; ++ai)
#pragma unroll
            for (int m = 0; m < 4; ++m) rs[ai * 4 + m] = rl[u.pm * 256 + ai * 128 + wr * 64 + m * 16 + fr - rbase];
    } else rstd_rows<16>(SS, u.pm * 256 + wr * 64 + fr, fq, 1.f / D, rs);
}
typedef float f32x2e __attribute__((ext_vector_type(2)));
struct EpiSwiGLU { static constexpr bool PERM = true, AFTER_DRAIN = false; const float* SS; bf16* ACT; const LAS float* rl; int rbase;
    __device__ __forceinline__ void operator()(AccT acc, const Unit& u, int wr, int wc, int fr, int fq) const {
        const int col = u.pn * 128 + wc * 32 + fq * 8;
        float rs[8];
        if (rl) {
#pragma unroll
            for (int ai = 0; ai < 2; ++ai)
#pragma unroll
                for (int m = 0; m < 4; ++m) rs[ai * 4 + m] = (ai < u.nai) ? rl[EPI_ROWS(ai, m) - rbase] : 0.f;
        } else rstd_rows<16>(SS, u.pm * 256 + u.roff * (2 - u.nai) + wr * 64 + fr, fq, 1.f / D, rs);
#pragma unroll
        for (int ai = 0; ai < 2; ++ai) if (ai < u.nai)
#pragma unroll
            for (int m = 0; m < 4; ++m) { const int row = EPI_ROWS(ai, m); const float r = rs[ai * 4 + m];
                unsigned w[4];
#pragma unroll
                for (int n = 0; n < 2; ++n)
#pragma unroll
                    for (int h2 = 0; h2 < 2; ++h2) {
                        const f32x2e g = (f32x2e){acc[ai][0][m][n][2 * h2], acc[ai][0][m][n][2 * h2 + 1]} * r, up = (f32x2e){acc[ai][1][m][n][2 * h2], acc[ai][1][m][n][2 * h2 + 1]} * r;
                        const f32x2e x = g * (-1.4426950408889634f); f32x2e d; d.x = __builtin_amdgcn_exp2f(x.x); d.y = __builtin_amdgcn_exp2f(x.y); d = d + 1.0f;
                        f32x2e q; q.x = __builtin_amdgcn_rcpf(d.x); q.y = __builtin_amdgcn_rcpf(d.y);
                        const f32x2e o = (g * up) * q; w[2 * n + h2] = cvtpk(o.x, o.y); }
                *(GAS v4u*)(ACT + (size_t)row * FF + col) = (v4u){w[0], w[1], w[2], w[3]}; }
    }
};
struct EpiResidual { static constexpr bool PERM = true, AFTER_DRAIN = false; float* X; bf16* XB; float* SS; float scale;
    __device__ __forceinline__ void operator()(AccT acc, const Unit& u, int wr, int wc, int fr, int fq) const {
#pragma unroll
        for (int ai = 0; ai < 2; ++ai) { asm volatile("" ::: "memory");
            v4u xv[4][2];
#pragma unroll
            for (int m = 0; m < 4; ++m)
#pragma unroll
                for (int bj = 0; bj < 2; ++bj) xv[m][bj] = *(const GAS v4u*)(XB + (size_t)EPI_ROWS(ai, m) * D + u.pn * 256 + bj * 128 + wc * 32 + fq * 8);
#pragma unroll
            for (int m = 0; m < 4; ++m) { const int row = EPI_ROWS(ai, m); float ss = 0.f;
#pragma unroll
                for (int bj = 0; bj < 2; ++bj) { const int col = u.pn * 256 + bj * 128 + wc * 32 + fq * 8;
                    float xo[8]; unpack8(xv[m][bj], xo);
#pragma unroll
                    for (int e = 0; e < 4; ++e) { xo[e] += acc[ai][bj][m][0][e] * scale; xo[4 + e] += acc[ai][bj][m][1][e] * scale; }
#pragma unroll
                    for (int e = 0; e < 8; ++e) ss += xo[e] * xo[e];
                    *(GAS v4u*)(XB + (size_t)row * D + col) = pack8f(xo); }
                ss += __shfl_xor(ss, 16); ss += __shfl_xor(ss, 32);
                if (fq == 0) SS[(size_t)row * 16 + u.pn * 4 + wc] = ss; } }
    }
};
__device__ __forceinline__ void rope8(float* v, const float* COS, const float* SIN, int row, int p0) {
    const f32x4 c = *(const GAS f32x4*)(COS + (size_t)row * 32 + p0), s = *(const GAS f32x4*)(SIN + (size_t)row * 32 + p0);
#pragma unroll
    for (int p = 0; p < 4; ++p) { const float x1 = v[2 * p], x2 = v[2 * p + 1]; v[2 * p] = x1 * c[p] - x2 * s[p]; v[2 * p + 1] = x1 * s[p] + x2 * c[p]; }
}
struct EpiMlaA { static constexpr bool PERM = true, AFTER_DRAIN = false; const float* SS; bf16* LAT; float* SSQ; float* SSKV; bf16* KPE; const float* COS; const float* SIN; const LAS float* rl; int rbase;
    __device__ __forceinline__ void operator()(AccT acc, const Unit& u, int wr, int wc, int fr, int fq) const {
        float rs[8]; rstd_get(rl, rbase, SS, u, wr, fr, fq, rs);
#pragma unroll
        for (int ai = 0; ai < 2; ++ai)
#pragma unroll
            for (int m = 0; m < 4; ++m) { const int row = EPI_ROWS(ai, m); const float r = rs[ai * 4 + m]; float ss = 0.f;
#pragma unroll
                for (int bj = 0; bj < 2; ++bj) { const int col = u.pn * 256 + bj * 128 + wc * 32 + fq * 8;
                    float v[8];
#pragma unroll
                    for (int n = 0; n < 2; ++n)
#pragma unroll
                        for (int e = 0; e < 4; ++e) { v[4 * n + e] = acc[ai][bj][m][n][e] * r; ss += v[4 * n + e] * v[4 * n + e]; }
                    *(GAS v4u*)(LAT + (size_t)row * 1024 + col) = pack8f(v);
                    if (u.pn == 3 && bj == 0 && wc < 2) { rope8(v, COS, SIN, row, wc * 16 + fq * 4); *(GAS v4u*)(KPE + (size_t)row * 64 + wc * 32 + fq * 8) = pack8f(v); } }
                ss += __shfl_xor(ss, 16); ss += __shfl_xor(ss, 32);
                if (fq == 0) { if (u.pn < 2) SSQ[(size_t)row * 8 + u.pn * 4 + wc] = ss; else if (u.pn == 2) SSKV[(size_t)row * 4 + wc] = ss; } }
    }
};
struct EpiMlaQ { static constexpr bool PERM = true, AFTER_DRAIN = false; const float* SSQ; bf16* Q; const float* COS; const float* SIN; float qscale;
    __device__ __forceinline__ void operator()(AccT acc, const Unit& u, int wr, int wc, int fr, int fq) const {
        float rs[8]; rstd_rows<8>(SSQ, u.pm * 256 + u.roff * (2 - u.nai) + wr * 64 + fr, fq, 1.f / QRANK, rs);
#pragma unroll
        for (int ai = 0; ai < 2; ++ai) if (ai < u.nai)
#pragma unroll
            for (int m = 0; m < 4; ++m) { asm volatile("" ::: "memory"); const int row = EPI_ROWS(ai, m);
                const float r = rs[ai * 4 + m] * qscale;
#pragma unroll
                for (int bj = 0; bj < 2; ++bj) { const int col = u.pn * 256 + bj * 128 + wc * 32 + fq * 8, hd = col / DQK, w = col - hd * DQK;
                    float v[8];
#pragma unroll
                    for (int n = 0; n < 2; ++n)
#pragma unroll
                        for (int e = 0; e < 4; ++e) v[4 * n + e] = acc[ai][bj][m][n][e] * r;
                    if (w >= NOPE) rope8(v, COS, SIN, row, (w - NOPE) >> 1);
                    *(GAS v4u*)(Q + (size_t)row * 1536 + col) = pack8f(v); } }
    }
};
struct EpiMlaKV { static constexpr bool PERM = true, AFTER_DRAIN = false; const float* SSKV; bf16* KV;
    __device__ __forceinline__ void operator()(AccT acc, const Unit& u, int wr, int wc, int fr, int fq) const {
        float rs[8]; rstd_rows<4>(SSKV, u.pm * 256 + wr * 64 + fr, fq, 1.f / KVRANK, rs);
#pragma unroll
        for (int ai = 0; ai < 2; ++ai)
#pragma unroll
            for (int m = 0; m < 4; ++m) { const int row = EPI_ROWS(ai, m);
                const float r = rs[ai * 4 + m];
#pragma unroll
                for (int bj = 0; bj < 2; ++bj) { const int col = u.pn * 256 + bj * 128 + wc * 32 + fq * 8;
                    *(GAS v4u*)(KV + (size_t)row * 2048 + col) = pack8v(acc[ai][bj][m][0] * r, acc[ai][bj][m][1] * r); } }
    }
};
struct EpiMlIn { static constexpr bool PERM = true, AFTER_DRAIN = false; const float* SS; bf16* P; float* GATES; const LAS float* rl; int rbase;
    template <bool STAGED> __device__ __forceinline__ void body(AccT acc, const Unit& u, int wr, int wc, int fr, int fq) const {
        float rs[8]; if constexpr (!STAGED) rstd_rows<16>(SS, u.pm * 256 + u.roff * (2 - u.nai) + wr * 64 + fr, fq, 1.f / D, rs);
#pragma unroll
        for (int ai = 0; ai < 2; ++ai) if (ai < u.nai)
#pragma unroll
            for (int m = 0; m < 4; ++m) { const int row = EPI_ROWS(ai, m); float r; if constexpr (STAGED) r = rl[row - rbase]; else r = rs[ai * 4 + m];
                if (u.pn < 12) {
#pragma unroll
                    for (int bj = 0; bj < 2; ++bj) { const int col = u.pn * 256 + bj * 128 + wc * 32 + fq * 8;
                        *(GAS v4u*)(P + (size_t)row * 3072 + col) = pack8v(acc[ai][bj][m][0] * r, acc[ai][bj][m][1] * r); }
                } else if (wc == 0 && fq < 2) {
                    GAS f32x4* g = (GAS f32x4*)(GATES + (size_t)row * 16 + fq * 8); g[0] = acc[ai][0][m][0] * r; g[1] = acc[ai][0][m][1] * r; } }
    }
    __device__ __forceinline__ void operator()(AccT acc, const Unit& u, int wr, int wc, int fr, int fq) const { if (rl) body<true>(acc, u, wr, wc, fr, fq); else body<false>(acc, u, wr, wc, fr, fq); }
};
struct EpiRwBig { static constexpr bool PERM = true, AFTER_DRAIN = false; bf16* RKV; bf16* LOR; int pn0;
    __device__ __forceinline__ void operator()(AccT acc, const Unit& u, int wr, int wc, int fr, int fq) const {
#pragma unroll
        for (int ai = 0; ai < 2; ++ai) if (ai < u.nai)
#pragma unroll
            for (int m = 0; m < 4; ++m) { const int row = EPI_ROWS(ai, m);
#pragma unroll
                for (int bj = 0; bj < 2; ++bj) { const int cl = bj * 128 + wc * 32 + fq * 8;
                    if (u.pn + pn0 < 12) { *(GAS v4u*)(RKV + (size_t)row * 3072 + (u.pn + pn0) * 256 + cl) = pack8v(acc[ai][bj][m][0], acc[ai][bj][m][1]); }
                    else { float v[8];
#pragma unroll
                        for (int n = 0; n < 2; ++n)
#pragma unroll
                            for (int e = 0; e < 4; ++e) { const float a = acc[ai][bj][m][n][e]; v[4 * n + e] = (cl < 64) ? ftanh(a) : (cl < 128) ? a : fsigmoid(a); }
                        *(GAS v4u*)(LOR + (size_t)row * 256 + cl) = pack8f(v); } } }
    }
};
struct EpiRwUp { static constexpr bool PERM = true, AFTER_DRAIN = false; float* LW; bf16* AA; bf16* GG; const float* w0; const float* a0;
    __device__ __forceinline__ void operator()(AccT acc, const Unit& u, int wr, int wc, int fr, int fq) const {
        const int sec = u.pn >> 2;
#pragma unroll
        for (int ai = 0; ai < 2; ++ai)
#pragma unroll
            for (int m = 0; m < 4; ++m) { asm volatile("" ::: "memory"); const int row = EPI_ROWS(ai, m);
#pragma unroll
                for (int bj = 0; bj < 2; ++bj) { const int col = (u.pn & 3) * 256 + bj * 128 + wc * 32 + fq * 8;
                    if (sec == 0) {
#pragma unroll
                        for (int n = 0; n < 2; ++n) { const f32x4 b = *(const GAS f32x4*)(w0 + col + 4 * n); f32x4 o;
#pragma unroll
                            for (int e = 0; e < 4; ++e) o[e] = -0.6065306597126334f * fsigmoid(acc[ai][bj][m][n][e] + b[e]);
                            *(GAS f32x4*)(LW + (size_t)row * 1024 + col + 4 * n) = o; } }
                    else if (sec == 1) { const f32x4 b0 = *(const GAS f32x4*)(a0 + col), b1 = *(const GAS f32x4*)(a0 + col + 4); float v[8];
#pragma unroll
                        for (int e = 0; e < 4; ++e) { v[e] = fsigmoid(acc[ai][bj][m][0][e] + b0[e]); v[4 + e] = fsigmoid(acc[ai][bj][m][1][e] + b1[e]); }
                        *(GAS v4u*)(AA + (size_t)row * 1024 + col) = pack8f(v); }
                    else { *(GAS v4u*)(GG + (size_t)row * 1024 + col) = pack8v(acc[ai][bj][m][0], acc[ai][bj][m][1]); } } }
    }
};

namespace att {
constexpr int SHM_K = 64 * DQK * 2  , SHM_V = 64 * DVH * 2  ;
constexpr int QPE_W = 32 * 144;
constexpr int OFF_V = 0, OFF_K = 3 * SHM_V, OFF_WS = OFF_K + 2 * SHM_K, OFF_QPE = OFF_WS + NWAVES * 64 * 4, ATT_LDS = OFF_QPE + NWAVES * QPE_W;
static_assert(ATT_LDS <= LDSCTL_OFF, "attention LDS");
#define KSWZ(row, colB) ((row) * 384 + ((colB) ^ (((row) & 7) << 4)))
#define SBAR() __builtin_amdgcn_sched_barrier(0)
__device__ __forceinline__ int v_st(int k, int c) { const int kk = (k & ~0xC) | ((k & 4) << 1) | ((k & 8) >> 1); return ((kk >> 3) * 4 + (c >> 5)) * 512 + ((kk & 7) * 32 + (c & 31)) * 2; }
__device__ __forceinline__ int v_rd_base(int lane) { return ((lane & 3) << 3) | (((lane >> 2) & 3) << 6) | (((lane >> 4) & 1) << 5) | (((lane >> 5) & 1) << 8); }
constexpr int v_rd_off(int d0, int ks, int half) { return d0 * 512 + ks * 4096 + half * 2048; }
__device__ __forceinline__ int crow(int r, int hi) { return (r & 3) + 8 * (r >> 2) + 4 * hi; }
__device__ __forceinline__ void mask_tile(f32x16& p0, f32x16& p1, int dq) {
    const float NEG = -__builtin_inff();
#pragma unroll
    for (int r = 0; r < 16; ++r) { const int c = (r & 3) + 8 * (r >> 2);
        if (dq - c < 0) p0[r] = NEG;
        if (dq - c - 32 < 0) p1[r] = NEG; }
}
constexpr float THR2 = 11.5f;
typedef float f32x2v __attribute__((ext_vector_type(2)));
__device__ __forceinline__ float max3f(float a, float b, float c) { return __builtin_fmaxf(__builtin_fmaxf(a, b), c); }
__device__ __forceinline__ float rowmax32(const f32x16& p0, const f32x16& p1) {
    float a = max3f(p0[0], p0[1], p0[2]), b = max3f(p1[0], p1[1], p1[2]);
#pragma unroll
    for (int r = 3; r < 15; r += 2) { a = max3f(a, p0[r], p0[r + 1]); b = max3f(b, p1[r], p1[r + 1]); }
    a = max3f(a, b, p0[15]); a = __builtin_fmaxf(a, p1[15]);
    auto rr = __builtin_amdgcn_permlane32_swap(__float_as_uint(a), __float_as_uint(a), false, false);
    return __builtin_fmaxf(__uint_as_float(rr[0]), __uint_as_float(rr[1]));
}
__device__ __forceinline__ void partialSM(f32x16& p0, f32x16& p1, float& m_reg, float& alpha) {
    const float pmax = rowmax32(p0, p1);
    float mn;
    if (__builtin_expect(__all((pmax - m_reg) <= THR2), 1)) { mn = m_reg; alpha = 1.f; }
    else { mn = fmaxf(m_reg, pmax); alpha = __builtin_amdgcn_exp2f(m_reg - mn); m_reg = mn; }
#pragma unroll
    for (int r = 0; r < 16; ++r) { p0[r] = __builtin_amdgcn_exp2f(p0[r] - mn); p1[r] = __builtin_amdgcn_exp2f(p1[r] - mn); }
}
__device__ __forceinline__ void finishSM(f32x16& p0, f32x16& p1, float alpha, float& l_reg, bf16x8& pa0, bf16x8& pa1, bf16x8& pa2, bf16x8& pa3) {
    f32x2v s2 = {p0[0], p0[1]};
#pragma unroll
    for (int r = 2; r < 16; r += 2) s2 += (f32x2v){p0[r], p0[r + 1]};
#pragma unroll
    for (int r = 0; r < 16; r += 2) s2 += (f32x2v){p1[r], p1[r + 1]};
    float ps = s2.x + s2.y;
    { auto rr = __builtin_amdgcn_permlane32_swap(__float_as_uint(ps), __float_as_uint(ps), false, false);
      ps = __uint_as_float(rr[0]) + __uint_as_float(rr[1]); }
    l_reg = l_reg * alpha + ps;
#define PK4(P, B_, OUT) do { unsigned a0 = cvtpk(P[B_+0], P[B_+1]), a1 = cvtpk(P[B_+2], P[B_+3]);                          \
        unsigned b0 = cvtpk(P[B_+4], P[B_+5]), b1 = cvtpk(P[B_+6], P[B_+7]);                                             \
        auto r0 = __builtin_amdgcn_permlane32_swap(a0, b0, false, false); auto r1 = __builtin_amdgcn_permlane32_swap(a1, b1, false, false); \
        v4u w = {r0[0], r1[0], r0[1], r1[1]}; OUT = __builtin_bit_cast(bf16x8, w); } while (0)
    PK4(p0, 0, pa0); PK4(p0, 8, pa1); PK4(p1, 0, pa2); PK4(p1, 8, pa3);
#undef PK4
}
__device__ __forceinline__ void qkt(f32x16& p0, f32x16& p1, const LAS char* Kb, int r32, int hi, const bf16x8* qr, const LAS char* qpe) {
    const LAS char* kb[4];
#pragma unroll
    for (int dd = 0; dd < 4; ++dd) kb[dd] = Kb + r32 * 256 + ((dd * 32 + hi * 16) ^ ((r32 & 7) << 4));
    const int delta = 16384 - r32 * 128;
#pragma unroll
    for (int d0 = 0; d0 < 12; ++d0) {
        bf16x8 b0, b1, qf;
        if (d0 < 8) { const LAS char* an = kb[d0 & 3] + (d0 >> 2) * 128; b0 = *(const LAS bf16x8*)(an); b1 = *(const LAS bf16x8*)(an + 8192); qf = qr[d0 < 8 ? d0 : 0]; }
        else { const LAS char* an = kb[d0 & 3] + delta; b0 = *(const LAS bf16x8*)(an); b1 = *(const LAS bf16x8*)(an + 4096); qf = *(const LAS bf16x8*)(qpe + (d0 - 8) * 32); }
        if (d0 == 0) { p0 = __builtin_amdgcn_mfma_f32_32x32x16_bf16(b0, qf, (f32x16){}, 0, 0, 0); p1 = __builtin_amdgcn_mfma_f32_32x32x16_bf16(b1, qf, (f32x16){}, 0, 0, 0); }
        else { p0 = __builtin_amdgcn_mfma_f32_32x32x16_bf16(b0, qf, p0, 0, 0, 0); p1 = __builtin_amdgcn_mfma_f32_32x32x16_bf16(b1, qf, p1, 0, 0, 0); }
        if ((d0 & 1) == 1) __builtin_amdgcn_sched_barrier(0); }
}
__device__ __forceinline__ void pv_tile(f32x16* o, int vb0, bf16x8 pa0, bf16x8 pa1, bf16x8 pa2, bf16x8 pa3) {
#define TRRD(dst, off) asm volatile("ds_read_b64_tr_b16 %0, %1 offset:%2" : "=&v"(dst) : "v"(vb0), "i"(off) : "memory")
#define PV_D0(d0) do { s16x4 l0, l1, l2, l3, h0, h1, h2, h3; constexpr int b_ = v_rd_off(d0, 0, 0); \
        TRRD(l0, b_); TRRD(h0, b_ + 2048); TRRD(l1, b_ + 4096); TRRD(h1, b_ + 6144); TRRD(l2, b_ + 8192); TRRD(h2, b_ + 10240); TRRD(l3, b_ + 12288); TRRD(h3, b_ + 14336); \
        asm volatile("s_waitcnt lgkmcnt(0)" ::: "memory"); SBAR(); \
        o[d0] = __builtin_amdgcn_mfma_f32_32x32x16_bf16(pa0, (bf16x8){l0[0], l0[1], l0[2], l0[3], h0[0], h0[1], h0[2], h0[3]}, o[d0], 0, 0, 0);   \
        o[d0] = __builtin_amdgcn_mfma_f32_32x32x16_bf16(pa1, (bf16x8){l1[0], l1[1], l1[2], l1[3], h1[0], h1[1], h1[2], h1[3]}, o[d0], 0, 0, 0);   \
        o[d0] = __builtin_amdgcn_mfma_f32_32x32x16_bf16(pa2, (bf16x8){l2[0], l2[1], l2[2], l2[3], h2[0], h2[1], h2[2], h2[3]}, o[d0], 0, 0, 0);   \
        o[d0] = __builtin_amdgcn_mfma_f32_32x32x16_bf16(pa3, (bf16x8){l3[0], l3[1], l3[2], l3[3], h3[0], h3[1], h3[2], h3[3]}, o[d0], 0, 0, 0); } while (0)
    PV_D0(0); PV_D0(1); PV_D0(2); PV_D0(3);
#undef PV_D0
#undef TRRD
}
__device__ __forceinline__ void attn_unit(int wid, int b, int h, int qb, const bf16* Q, const bf16* KV, const bf16* KPE, bf16* O, LAS char* lds) {
    const int lane = fresh_lane(), r32 = lane & 31, hi = lane >> 5;
    const size_t rowbase = (size_t)b * SEQ; const int q0 = qb * 256;
    LAS char* V_lds = lds + OFF_V; LAS char* K_lds = lds + OFF_K;
    LAS float* wsf = (LAS float*)(lds + OFF_WS) + wid * 64; LAS float* li_l = wsf; LAS float* al_l = wsf + 32;
    bf16x8 qr[8];
    LAS char* qpe = lds + OFF_QPE + wid * QPE_W + r32 * 144 + hi * 16;
    { const bf16* Qw = Q + (rowbase + q0 + wid * 32 + r32) * 1536 + h * DQK + hi * 8;
#pragma unroll
      for (int d0 = 0; d0 < 8; ++d0) qr[d0] = *(const GAS bf16x8*)(Qw + d0 * 16);
#pragma unroll
      for (int d0 = 8; d0 < 12; ++d0) *(LAS bf16x8*)(qpe + (d0 - 8) * 32) = *(const GAS bf16x8*)(Qw + d0 * 16); }
    const int NT = 4 * (qb + 1);
    unsigned offA[2], offB, offV[2];
#pragma unroll
    for (int i = 0; i < 2; ++i) { const int s_ = (wid + 8 * i) * 64 + lane, row = s_ >> 4, pos = s_ & 15, ch = (pos & 8) | ((pos & 7) ^ (row & 7)); offA[i] = (unsigned)(row * 2048 + ch * 8) * 2u; }
    { const int s_ = wid * 64 + lane, row = s_ >> 3, ch = (s_ & 7) ^ (row & 7); offB = (unsigned)(row * 64 + ch * 8) * 2u; }
#pragma unroll
    for (int i = 0; i < 2; ++i) { const int s_ = (wid + 8 * i) * 64 + lane, sub = s_ >> 5, within = s_ & 31, kk = (sub >> 2) * 8 + (within >> 2), key = (kk & ~0xC) | ((kk & 4) << 1) | ((kk & 8) >> 1), c = (sub & 3) * 32 + (within & 3) * 8;
        offV[i] = (unsigned)(key * 2048 + 128 + c) * 2u; }
    const char* const KVh = (const char*)(KV + rowbase * 2048 + h * 256); const char* const KPEb = (const char*)(KPE + rowbase * 64);
#define DMA_TILE(t_, kbuf_, vslot_) do { const char* kvt_ = KVh + (size_t)(t_) * (64 * 2048 * 2); const char* pet_ = KPEb + (size_t)(t_) * (64 * 64 * 2); \
        _Pragma("unroll") for (int i = 0; i < 2; ++i) __builtin_amdgcn_global_load_lds((const unsigned*)(kvt_ + offA[i]), (LAS unsigned*)(K_lds + (kbuf_) * SHM_K + (wid + 8 * i) * 1024), 16, 0, 0); \
        __builtin_amdgcn_global_load_lds((const unsigned*)(pet_ + offB), (LAS unsigned*)(K_lds + (kbuf_) * SHM_K + 16384 + wid * 1024), 16, 0, 0); \
        _Pragma("unroll") for (int i = 0; i < 2; ++i) __builtin_amdgcn_global_load_lds((const unsigned*)(kvt_ + offV[i]), (LAS unsigned*)(V_lds + (vslot_) * SHM_V + (wid + 8 * i) * 1024), 16, 0, 0); } while (0)
#define DMA_WAIT_BAR() do { asm volatile("s_waitcnt vmcnt(0)" ::: "memory"); __syncthreads(); } while (0)
    const int vb0 = (int)(uintptr_t)V_lds + v_rd_base(lane);
    float m_reg = -1e30f, l_reg = 0.f; f32x16 o[4] = {};
    const int qlo = q0 + wid * 32, qm = qlo + r32 - 4 * hi;
#define RESC(al_) do { if (__any((al_) < 1.f)) { if (hi == 0) al_l[r32] = (al_); LDS_WAIT(); \
        _Pragma("unroll") for (int d_ = 0; d_ < 4; ++d_) _Pragma("unroll") for (int r = 0; r < 16; ++r) o[d_][r] *= al_l[crow(r, hi)]; } } while (0)
    f32x16 pA0, pA1, pB0, pB1; float alA, alB;
    DMA_TILE(0, 0, 0);
    DMA_WAIT_BAR();
    DMA_TILE(1, 1, 1);
    qkt(pA0, pA1, K_lds, r32, hi, qr, qpe);
    if (63 > qlo) mask_tile(pA0, pA1, qm);
    partialSM(pA0, pA1, m_reg, alA);
#define STEP(X0, X1, alX, Y0, Y1, alY, t_, MASKED) do { const int tt_ = (t_); \
        DMA_WAIT_BAR();                                     \
        if (tt_ + 1 < NT) DMA_TILE(tt_ + 1, (tt_ + 1) & 1, (tt_ + 1) % 3); \
        SBAR(); \
        qkt(X0, X1, K_lds + (tt_ & 1) * SHM_K, r32, hi, qr, qpe); \
        bf16x8 pa0, pa1, pa2, pa3; \
        finishSM(Y0, Y1, alY, l_reg, pa0, pa1, pa2, pa3); \
        SBAR(); \
        pv_tile(o, vb0 + ((tt_ - 1) % 3) * SHM_V, pa0, pa1, pa2, pa3); \
        if (MASKED) { const int kb_ = tt_ * 64; if (kb_ + 63 > qlo) mask_tile(X0, X1, qm - kb_); } \
        partialSM(X0, X1, m_reg, alX); \
        RESC(alX); } while (0)
    int t = 1;
    for (; t + 1 < NT - 4; t += 2) { STEP(pB0, pB1, alB, pA0, pA1, alA, t, false); STEP(pA0, pA1, alA, pB0, pB1, alB, t + 1, false); }
    for (; t + 1 < NT; t += 2) { STEP(pB0, pB1, alB, pA0, pA1, alA, t, true); STEP(pA0, pA1, alA, pB0, pB1, alB, t + 1, true); }
    STEP(pB0, pB1, alB, pA0, pA1, alA, t, true);
    { bf16x8 pa0, pa1, pa2, pa3; finishSM(pB0, pB1, alB, l_reg, pa0, pa1, pa2, pa3); SBAR(); pv_tile(o, vb0 + ((NT - 1) % 3) * SHM_V, pa0, pa1, pa2, pa3); }
#undef STEP
#undef RESC
#undef DMA_TILE
#undef DMA_WAIT_BAR
    if (hi == 0) li_l[r32] = l_reg; LDS_WAIT();
    bf16* Ow = O + (rowbase + q0 + wid * 32) * 1024 + h * DVH;
#pragma unroll
    for (int r = 0; r < 16; ++r) { const int orow = crow(r, hi); const float rl = frcp(li_l[orow]);
#pragma unroll
        for (int d0 = 0; d0 < 4; ++d0) { const float v = o[d0][r] * rl; const float vn = __shfl_xor(v, 1);
            if ((r32 & 1) == 0) *(GAS unsigned*)(Ow + (size_t)orow * 1024 + d0 * 32 + r32) = cvtpk(v, vn); } }
    __syncthreads();
}
#undef KSWZ
}


__device__ __forceinline__ void ml_conv_phase(Frame& F, const Inputs& in, int j) {
    const bf16* P = (const bf16*)(F.ws + WS_ARENA + A_P); const float* GATES = (const float*)(F.ws + WS_ARENA + A_GATES);
    float* QKC = (float*)(F.ws + WS_ARENA + A_QKC); float* IGLF = (float*)(F.ws + WS_ARENA + A_IGLF);
    const float* cw = in.ml_conv_w + (size_t)j * 4 * 1024; const float* cb = in.ml_conv_b + (size_t)j * 1024; const float* bif = in.ml_b_if + (size_t)j * 16;
    const int gt = F.gw * 64 + F.lane, NT_ = F.NGW * 64;
    for (int e = gt; e < T * 128; e += NT_) {
        const int t = e >> 7, c = (e & 127) * 8, s = t & (SEQ - 1);
        float acc[8];
        { const f32x4 b0 = *(const GAS f32x4*)(cb + c), b1 = *(const GAS f32x4*)(cb + c + 4);
#pragma unroll
          for (int q = 0; q < 4; ++q) { acc[q] = b0[q]; acc[4 + q] = b1[q]; } }
#pragma unroll
        for (int k = 0; k < 4; ++k) { const int dt = 3 - k;
            if (s - dt >= 0) { float pv[8]; unpack8(*(const GAS v4u*)(P + (size_t)(t - dt) * 3072 + c), pv);
                const f32x4 w0 = *(const GAS f32x4*)(cw + k * 1024 + c), w1 = *(const GAS f32x4*)(cw + k * 1024 + c + 4);
#pragma unroll
                for (int q = 0; q < 4; ++q) { acc[q] += w0[q] * pv[q]; acc[4 + q] += w1[q] * pv[4 + q]; } } }
        const float sc = (c >= 512) ? 0.125f : 1.f;
        f32x4 o0, o1;
#pragma unroll
        for (int q = 0; q < 4; ++q) { o0[q] = fsilu(acc[q]) * sc; o1[q] = fsilu(acc[4 + q]) * sc; }
        GAS f32x4* op = (GAS f32x4*)(QKC + (size_t)t * 1024 + c); op[0] = o0; op[1] = o1;
    }
    for (int e = gt; e < T * 16; e += NT_) { const int hcol = e & 15; const float g = GATES[e] + bif[hcol];
        float r = g;
        if (hcol >= 8) r = fminf(g, 0.f) - flog(1.f + fexp(-fabsf(g)));
        IGLF[e] = r; }
}
__device__ __forceinline__ void ml_seq_phase(Frame& F) {
    if ((int)blockIdx.x >= BATCH * ML_H) return;
    const int bh = blockIdx.x, b = bh >> 3, h = bh & 7, tid = F.tid, v = tid >> 2, kq = tid & 3;
    const bf16* P = (const bf16*)(F.ws + WS_ARENA + A_P); const float* QKC = (const float*)(F.ws + WS_ARENA + A_QKC); const float* IGLF = (const float*)(F.ws + WS_ARENA + A_IGLF);
    float* HRAW = (float*)(F.ws + WS_ARENA + A_HRAW);
    LAS float* s_q = (LAS float*)F.lds; LAS float* s_k = s_q + 64 * 64; LAS float* s_v = s_k + 64 * 64; LAS float* s_h = s_v + 64 * 128; LAS float* s_ig = s_h + 64 * 128; LAS float* s_lf = s_ig + 64;
    float C[16], n[16]; float mst = 0.f;
#pragma unroll
    for (int d = 0; d < 16; ++d) { C[d] = 0.f; n[d] = 0.f; }
    for (int blk = 0; blk < SEQ / 64; ++blk) {
        const size_t t0 = (size_t)b * SEQ + (size_t)blk * 64;
        __syncthreads();
        for (int e = tid; e < 64 * 16; e += 512) { const int tt = e >> 4, c4 = (e & 15) * 4;
            *(LAS f32x4*)(s_q + tt * 64 + c4) = *(const GAS f32x4*)(QKC + (t0 + tt) * 1024 + h * 64 + c4);
            *(LAS f32x4*)(s_k + tt * 64 + c4) = *(const GAS f32x4*)(QKC + (t0 + tt) * 1024 + 512 + h * 64 + c4); }
        for (int e = tid; e < 64 * 16; e += 512) { const int tt = e >> 4, c8 = (e & 15) * 8; float pv[8];
            unpack8(*(const GAS v4u*)(P + (t0 + tt) * 3072 + 1024 + h * 128 + c8), pv);
#pragma unroll
            for (int q = 0; q < 8; ++q) s_v[tt * 128 + c8 + q] = pv[q]; }
        if (tid < 64) { s_ig[tid] = IGLF[(t0 + tid) * 16 + h]; s_lf[tid] = IGLF[(t0 + tid) * 16 + 8 + h]; }
        __syncthreads();
        for (int tt = 0; tt < 64; ++tt) {
            const float lf = s_lf[tt], ig = s_ig[tt];
            const float mn = fmaxf(lf + mst, ig), fw = fexp(lf + mst - mn), iw = fexp(ig - mn); mst = mn;
            const float vv = s_v[tt * 128 + v] * iw;
            float num = 0.f, den = 0.f;
#pragma unroll
            for (int d4 = 0; d4 < 4; ++d4) { const f32x4 kk = *(const LAS f32x4*)(s_k + tt * 64 + kq * 16 + d4 * 4), qq = *(const LAS f32x4*)(s_q + tt * 64 + kq * 16 + d4 * 4);
#pragma unroll
                for (int q = 0; q < 4; ++q) { const int d = d4 * 4 + q; C[d] = fw * C[d] + vv * kk[q]; n[d] = fw * n[d] + iw * kk[q]; num += C[d] * qq[q]; den += n[d] * qq[q]; } }
            num += __shfl_xor(num, 1); num += __shfl_xor(num, 2); den += __shfl_xor(den, 1); den += __shfl_xor(den, 2);
            const float hv = num * frcp(fmaxf(fabsf(den), fexp(-mn)));
            if (kq == 0) s_h[tt * 128 + v] = hv;
        }
        __syncthreads();
        for (int e = tid; e < 64 * 32; e += 512) { const int tt = e >> 5, c4 = (e & 31) * 4;
            *(GAS f32x4*)(HRAW + (t0 + tt) * 1024 + h * 128 + c4) = *(const LAS f32x4*)(s_h + tt * 128 + c4); }
    }
}
__device__ __forceinline__ void ml_out_phase(Frame& F, const Inputs& in, int j) {
    const bf16* P = (const bf16*)(F.ws + WS_ARENA + A_P); const float* HRAW = (const float*)(F.ws + WS_ARENA + A_HRAW); bf16* HM = (bf16*)(F.ws + WS_ARENA + A_HM);
    const float* gn = in.ml_out_norm + (size_t)j * 1024;
    for (int m = F.gw; m < T; m += F.NGW) { const int c = F.lane * 16;
        float hv[16]; float ss = 0.f;
#pragma unroll
        for (int q = 0; q < 4; ++q) { const f32x4 x = *(const GAS f32x4*)(HRAW + (size_t)m * 1024 + c + 4 * q);
#pragma unroll
            for (int e = 0; e < 4; ++e) { hv[4 * q + e] = x[e]; ss += x[e] * x[e]; } }
        ss += __shfl_xor(ss, 1); ss += __shfl_xor(ss, 2); ss += __shfl_xor(ss, 4);
        const float r = frsq(ss * (1.f / 128.f) + RMS_EPS);
        float ov[16]; unpack8(*(const GAS v4u*)(P + (size_t)m * 3072 + 2048 + c), ov); unpack8(*(const GAS v4u*)(P + (size_t)m * 3072 + 2048 + c + 8), ov + 8);
        float res[16];
#pragma unroll
        for (int e = 0; e < 16; ++e) res[e] = hv[e] * r * gn[c + e] * fsigmoid(ov[e]);
        GAS v4u* op = (GAS v4u*)(HM + (size_t)m * 1024 + c); op[0] = pack8f(res); op[1] = pack8f(res + 8);
    }
}

__device__ __forceinline__ void rw_shift_phase(Frame& F, const Inputs& in, int jl) {
    bf16* HX = (bf16*)(F.ws + WS_ARENA + A_HX);
    const int c = F.lane * 16; const float* mu = in.rw_mu + (size_t)jl * 6 * D + c;
    f32x4 mr[4], mk[4], mv[4];
#pragma unroll
    for (int q = 0; q < 4; ++q) { mr[q] = *(const GAS f32x4*)(mu + 0 * D + 4 * q); mk[q] = *(const GAS f32x4*)(mu + 2 * D + 4 * q); mv[q] = *(const GAS f32x4*)(mu + 3 * D + 4 * q); }
    for (int m = F.gw; m < T; m += F.NGW) { const int s = m & (SEQ - 1);
        const float r = rstd16(F.SS, m), rp = (s > 0) ? rstd16(F.SS, m - 1) : 0.f;
        float xc[16], xq[16], xv[16], ar[16], ak[16], av[16];
        unpack8(*(const GAS v4u*)(F.XB + (size_t)m * D + c), xc); unpack8(*(const GAS v4u*)(F.XB + (size_t)m * D + c + 8), xc + 8);
#pragma unroll
        for (int e = 0; e < 16; ++e) xq[e] = 0.f;
        if (s > 0) { unpack8(*(const GAS v4u*)(F.XB + (size_t)(m - 1) * D + c), xq); unpack8(*(const GAS v4u*)(F.XB + (size_t)(m - 1) * D + c + 8), xq + 8); }
#pragma unroll
        for (int e = 0; e < 16; ++e) { const float hv = xc[e] * r, x = xq[e] * rp - hv; xv[e] = x; ar[e] = hv + mr[e >> 2][e & 3] * x; ak[e] = hv + mk[e >> 2][e & 3] * x; av[e] = hv + mv[e >> 2][e & 3] * x; }
        GAS v4u* o = (GAS v4u*)(HX + (size_t)m * 4096 + c);
        o[0] = pack8f(ar); o[1] = pack8f(ar + 8); o[128] = pack8f(ak); o[129] = pack8f(ak + 8); o[256] = pack8f(av); o[257] = pack8f(av + 8); o[384] = pack8f(xv); o[385] = pack8f(xv + 8);
    }
}
__device__ __forceinline__ void rw_seq_phase(Frame& F, const Inputs& in, int j) {
    if ((int)blockIdx.x >= BATCH * RW_H) return;
    const int bh = blockIdx.x, b = bh >> 4, h = bh & 15, tid = F.tid, i = tid >> 3, jr = tid & 7;
    const bf16* RKV = (const bf16*)(F.ws + WS_ARENA + A_RKV); const bf16* AA = (const bf16*)(F.ws + WS_XB); float* LW = (float*)(F.ws + WS_ARENA + A_LW);
    LAS float* s_r = (LAS float*)F.lds; LAS float* s_w = s_r + 4096; LAS float* s_k = s_w + 4096; LAS float* s_v = s_k + 4096; LAS float* s_a = s_v + 4096; LAS float* s_b = s_a + 4096; LAS float* s_y = s_b + 4096;
    float kkc[8], kac[8];
#pragma unroll
    for (int q = 0; q < 8; ++q) { kkc[q] = in.rw_k_k[(size_t)j * 1024 + h * 64 + jr * 8 + q]; kac[q] = in.rw_k_a[(size_t)j * 1024 + h * 64 + jr * 8 + q]; }
    float S[8];
#pragma unroll
    for (int q = 0; q < 8; ++q) S[q] = 0.f;
    for (int blk = 0; blk < SEQ / 64; ++blk) {
        const size_t t0 = (size_t)b * SEQ + (size_t)blk * 64;
        __syncthreads();
        { const int tt = tid >> 3; const size_t t = t0 + tt; const int c = h * 64 + jr * 8;
          float rv[8], kv[8], vv[8], av[8];
          unpack8(*(const GAS v4u*)(RKV + t * 3072 + c), rv); unpack8(*(const GAS v4u*)(RKV + t * 3072 + 1024 + c), kv); unpack8(*(const GAS v4u*)(RKV + t * 3072 + 2048 + c), vv);
          unpack8(*(const GAS v4u*)(AA + t * 1024 + c), av);
          const f32x4 l0 = *(const GAS f32x4*)(LW + t * 1024 + c), l1 = *(const GAS f32x4*)(LW + t * 1024 + c + 4);
          float kk[8]; float ss = 0.f;
#pragma unroll
          for (int q = 0; q < 8; ++q) { kk[q] = kv[q] * kkc[q]; ss += kk[q] * kk[q]; }
          ss += __shfl_xor(ss, 1); ss += __shfl_xor(ss, 2); ss += __shfl_xor(ss, 4);
          const float inv = frcp(fmaxf(fsqrt(ss), 1e-12f));
#pragma unroll
          for (int q = 0; q < 8; ++q) { const float kn = kk[q] * inv; const int o = tt * 64 + jr * 8 + q;
              s_r[o] = rv[q]; s_w[o] = fexp(q < 4 ? l0[q] : l1[q - 4]); s_k[o] = kv[q] * (1.f + (av[q] - 1.f) * kac[q]); s_v[o] = vv[q]; s_a[o] = -kn; s_b[o] = kn * av[q]; } }
        __syncthreads();
        for (int tt = 0; tt < 64; ++tt) {
            const int o = tt * 64 + jr * 8;
            const f32x4 a0 = *(const LAS f32x4*)(s_a + o), a1 = *(const LAS f32x4*)(s_a + o + 4), w0 = *(const LAS f32x4*)(s_w + o), w1 = *(const LAS f32x4*)(s_w + o + 4);
            const f32x4 b0 = *(const LAS f32x4*)(s_b + o), b1 = *(const LAS f32x4*)(s_b + o + 4), k0 = *(const LAS f32x4*)(s_k + o), k1 = *(const LAS f32x4*)(s_k + o + 4);
            const f32x4 r0 = *(const LAS f32x4*)(s_r + o), r1 = *(const LAS f32x4*)(s_r + o + 4);
            const float vi = s_v[tt * 64 + i];
            float sa = 0.f;
#pragma unroll
            for (int q = 0; q < 4; ++q) { sa += S[q] * a0[q]; sa += S[4 + q] * a1[q]; }
            sa += __shfl_xor(sa, 1); sa += __shfl_xor(sa, 2); sa += __shfl_xor(sa, 4);
            float y = 0.f;
#pragma unroll
            for (int q = 0; q < 4; ++q) { S[q] = S[q] * w0[q] + sa * b0[q] + vi * k0[q]; S[4 + q] = S[4 + q] * w1[q] + sa * b1[q] + vi * k1[q]; y += S[q] * r0[q]; y += S[4 + q] * r1[q]; }
            y += __shfl_xor(y, 1); y += __shfl_xor(y, 2); y += __shfl_xor(y, 4);
            if (jr == 0) s_y[tt * 64 + i] = y;
        }
        __syncthreads();
        for (int e = tid; e < 64 * 16; e += 512) { const int tt = e >> 4, c4 = (e & 15) * 4;
            *(GAS f32x4*)(LW + (t0 + tt) * 1024 + h * 64 + c4) = *(const LAS f32x4*)(s_y + tt * 64 + c4); }
    }
}
__device__ __forceinline__ void rw_out_phase(Frame& F, const Inputs& in, int j) {
    const bf16* RKV = (const bf16*)(F.ws + WS_ARENA + A_RKV); const bf16* AA = (const bf16*)(F.ws + WS_XB); const float* Y = (const float*)(F.ws + WS_ARENA + A_LW);
    const bf16* GG = (const bf16*)(F.ws + WS_ARENA + A_GG); bf16* YG = (bf16*)(F.ws + WS_ARENA + A_YG);
    const float* ka = in.rw_k_a + (size_t)j * 1024; const float* rk = in.rw_r_k + (size_t)j * 1024; const float* lnw = in.rw_ln_w + (size_t)j * 1024; const float* lnb = in.rw_ln_b + (size_t)j * 1024;
    for (int m = F.gw; m < T; m += F.NGW) { const int c = F.lane * 16;
        float yv[16]; float s1 = 0.f;
#pragma unroll
        for (int q = 0; q < 4; ++q) { const f32x4 x = *(const GAS f32x4*)(Y + (size_t)m * 1024 + c + 4 * q);
#pragma unroll
            for (int e = 0; e < 4; ++e) { yv[4 * q + e] = x[e]; s1 += x[e]; } }
        s1 += __shfl_xor(s1, 1); s1 += __shfl_xor(s1, 2); const float mean = s1 * (1.f / 64.f);
        float s2 = 0.f;
#pragma unroll
        for (int e = 0; e < 16; ++e) { yv[e] -= mean; s2 += yv[e] * yv[e]; }
        s2 += __shfl_xor(s2, 1); s2 += __shfl_xor(s2, 2); const float rs = frsq(s2 * (1.f / 64.f) + 64e-5f);
        float rv[16], kv[16], vv[16], av[16], gv[16];
        unpack8(*(const GAS v4u*)(RKV + (size_t)m * 3072 + c), rv); unpack8(*(const GAS v4u*)(RKV + (size_t)m * 3072 + c + 8), rv + 8);
        unpack8(*(const GAS v4u*)(RKV + (size_t)m * 3072 + 1024 + c), kv); unpack8(*(const GAS v4u*)(RKV + (size_t)m * 3072 + 1024 + c + 8), kv + 8);
        unpack8(*(const GAS v4u*)(RKV + (size_t)m * 3072 + 2048 + c), vv); unpack8(*(const GAS v4u*)(RKV + (size_t)m * 3072 + 2048 + c + 8), vv + 8);
        unpack8(*(const GAS v4u*)(AA + (size_t)m * 1024 + c), av); unpack8(*(const GAS v4u*)(AA + (size_t)m * 1024 + c + 8), av + 8);
        unpack8(*(const GAS v4u*)(GG + (size_t)m * 1024 + c), gv); unpack8(*(const GAS v4u*)(GG + (size_t)m * 1024 + c + 8), gv + 8);
        float bs = 0.f;
#pragma unroll
        for (int e = 0; e < 16; ++e) { const float kp = kv[e] * (1.f + (av[e] - 1.f) * ka[c + e]); bs += rv[e] * kp * rk[c + e]; }
        bs += __shfl_xor(bs, 1); bs += __shfl_xor(bs, 2);
        float res[16];
#pragma unroll
        for (int e = 0; e < 16; ++e) res[e] = (yv[e] * rs * lnw[c + e] + lnb[c + e] + bs * vv[e]) * gv[e];
        GAS v4u* op = (GAS v4u*)(YG + (size_t)m * 1024 + c); op[0] = pack8f(res); op[1] = pack8f(res + 8);
    }
}
__device__ __forceinline__ void final_norm_phase(Frame& F, const Inputs& in) {
    const int l16 = F.lane * 16;
    f32x4 g[4];
#pragma unroll
    for (int q = 0; q < 4; ++q) g[q] = *((const GAS f32x4*)in.final_norm + F.lane * 4 + q);
    for (int m0 = F.gw * 4; m0 < T; m0 += F.NGW * 4) {
        v4u xa[4][2]; f32x4 sp[4];
#pragma unroll
        for (int i = 0; i < 4; ++i) { const int m = m0 + i; xa[i][0] = *(const GAS v4u*)(F.XB + (size_t)m * D + l16); xa[i][1] = *(const GAS v4u*)(F.XB + (size_t)m * D + l16 + 8);
            sp[i] = *(const GAS f32x4*)(F.SS + (size_t)m * 16 + (F.lane & 3) * 4); }
#pragma unroll
        for (int i = 0; i < 4; ++i) { const int m = m0 + i;
            float s = (sp[i].x + sp[i].y) + (sp[i].z + sp[i].w); s += __shfl_xor(s, 1); s += __shfl_xor(s, 2);
            const float r = frsq(s * (1.f / D) + RMS_EPS);
            float xc[16]; unpack8(xa[i][0], xc); unpack8(xa[i][1], xc + 8);
            GAS f32x4* op = (GAS f32x4*)(F.X + (size_t)m * D) + F.lane * 4;
#pragma unroll
            for (int q = 0; q < 4; ++q) { f32x4 o; o.x = xc[4 * q] * r * g[q].x; o.y = xc[4 * q + 1] * r * g[q].y; o.z = xc[4 * q + 2] * r * g[q].z; o.w = xc[4 * q + 3] * r * g[q].w; op[q] = o; } }
    }
}

namespace mlc {
constexpr int NUNIT = BATCH * ML_H * (SEQ / 64);
constexpr size_t A_QKB = 97 * MiB;
constexpr size_t A_XT = 130 * MiB;
constexpr size_t A_CT = 194 * MiB;
constexpr size_t A_NX = 226 * MiB, A_NC = 227 * MiB;
constexpr size_t A_SC = 228 * MiB;
constexpr size_t A_HM2 = A_XT;
constexpr size_t A_IG2 = 129 * MiB;
constexpr int SLOT = 34816;
using att::v_st; using att::v_rd_base; using att::v_rd_off; using att::crow;
#define TRRD(dst, base, off) asm volatile("ds_read_b64_tr_b16 %0, %1 offset:%2" : "=&v"(dst) : "v"(base), "i"(off) : "memory")
#define FRAG(l, h) ((bf16x8){l[0], l[1], l[2], l[3], h[0], h[1], h[2], h[3]})
__device__ __forceinline__ float swap_add(float x) { auto rr = __builtin_amdgcn_permlane32_swap(__float_as_uint(x), __float_as_uint(x), false, false); return __uint_as_float(rr[0]) + __uint_as_float(rr[1]); }
__device__ __forceinline__ float wave_incl_scan_add(float v, int lane) {
#pragma unroll
    for (int o = 1; o < 64; o <<= 1) { const float t = __shfl_up(v, o); if (lane >= o) v += t; }
    return v;
}
__device__ __forceinline__ float wave_incl_scan_max(float v, int lane) {
#pragma unroll
    for (int o = 1; o < 64; o <<= 1) { const float t = __shfl_up(v, o); if (lane >= o) v = fmaxf(v, t); }
    return v;
}
__device__ __forceinline__ float wave_max(float v) {
#pragma unroll
    for (int o = 1; o < 64; o <<= 1) v = fmaxf(v, __shfl_xor(v, o));
    return v;
}
__device__ __forceinline__ void conv_phase(Frame& F, const Inputs& in, int j) {
    const bf16* P = (const bf16*)(F.ws + WS_ARENA + A_P); const float* GATES = (const float*)(F.ws + WS_ARENA + A_GATES);
    bf16* QKB = (bf16*)(F.ws + WS_ARENA + A_QKB); float* IGLF = (float*)(F.ws + WS_ARENA + mlc::A_IG2);
    const float* cw = in.ml_conv_w + (size_t)j * 4 * 1024; const float* cb = in.ml_conv_b + (size_t)j * 1024; const float* bif = in.ml_b_if + (size_t)j * 16;
    const int gt = F.gw * 64 + F.lane, NT_ = F.NGW * 64;
    for (int e = gt; e < T * 128; e += NT_) {
        const int t = e >> 7, c = (e & 127) * 8, s = t & (SEQ - 1);
        float acc[8];
        { const f32x4 b0 = *(const GAS f32x4*)(cb + c), b1 = *(const GAS f32x4*)(cb + c + 4);
#pragma unroll
          for (int q = 0; q < 4; ++q) { acc[q] = b0[q]; acc[4 + q] = b1[q]; } }
#pragma unroll
        for (int k = 0; k < 4; ++k) { const int dt = 3 - k;
            if (s - dt >= 0) { float pv[8]; unpack8(*(const GAS v4u*)(P + (size_t)(t - dt) * 3072 + c), pv);
                const f32x4 w0 = *(const GAS f32x4*)(cw + k * 1024 + c), w1 = *(const GAS f32x4*)(cw + k * 1024 + c + 4);
#pragma unroll
                for (int q = 0; q < 4; ++q) { acc[q] += w0[q] * pv[q]; acc[4 + q] += w1[q] * pv[4 + q]; } } }
        const float sc = (c >= 512) ? 0.125f : 1.f;
        float o[8];
#pragma unroll
        for (int q = 0; q < 8; ++q) o[q] = fsilu(acc[q]) * sc;
        *(GAS v4u*)(QKB + (size_t)t * 1024 + c) = pack8f(o);
    }
    for (int e = gt; e < T * 16; e += NT_) { const int hcol = e & 15; const float g = GATES[e] + bif[hcol];
        float r = g;
        if (hcol >= 8) r = fminf(g, 0.f) - flog(1.f + fexp(-fabsf(g)));
        IGLF[e] = r; }
}
__device__ __forceinline__ void stage_tr128(LAS char* tile, const bf16* src, int ld, int lt, int nthr) {
    for (int idx = lt; idx < 1024; idx += nthr) { const int row = idx >> 4, ch = idx & 15;
        *(LAS v4u*)(tile + v_st(row, ch * 8)) = *(const GAS v4u*)(src + (size_t)row * ld + ch * 8); }
}
__device__ __forceinline__ void xa_phase(Frame& F) {
    const bf16* P = (const bf16*)(F.ws + WS_ARENA + A_P); const bf16* QKB = (const bf16*)(F.ws + WS_ARENA + A_QKB); const float* IGLF = (const float*)(F.ws + WS_ARENA + mlc::A_IG2);
    float* XT = (float*)(F.ws + WS_ARENA + A_XT); float* NX = (float*)(F.ws + WS_ARENA + A_NX); float* SC = (float*)(F.ws + WS_ARENA + A_SC);
    const int lane = F.lane, wave = F.wave, r32 = lane & 31, hi = lane >> 5, us = wave >> 1, half = wave & 1, lt = half * 64 + lane;
    LAS char* slot = (LAS char*)F.lds + us * SLOT; LAS char* Vt = slot; LAS char* KWt = slot + 16384; LAS float* wsl = (LAS float*)(slot + 32768);
    for (int u0 = (int)blockIdx.x * 4; u0 < NUNIT; u0 += F.G * 4) {
        const int u = u0 + us, bh = u >> 7, c = u & 127, b = bh >> 3, h = bh & 7; const size_t t0 = (size_t)b * SEQ + (size_t)c * 64;
        const float lf = IGLF[(t0 + lane) * 16 + 8 + h], ig = IGLF[(t0 + lane) * 16 + h];
        const float Fc = wave_incl_scan_add(lf, lane), bs = ig - Fc, M = wave_max(bs), a = __shfl(Fc, 63), w = fexp(bs - M);
        if (half == 0) { wsl[lane] = w; if (lane == 0) { SC[u] = a; SC[NUNIT + u] = M; } }
        __syncthreads();
        stage_tr128(Vt, P + t0 * 3072 + 1024 + h * 128, 3072, lt, 128);
        for (int idx = lt; idx < 512; idx += 128) { const int row = idx >> 3, ch = idx & 7; float kv[8];
            unpack8(*(const GAS v4u*)(QKB + (t0 + row) * 1024 + 512 + h * 64 + ch * 8), kv); const float ww = wsl[row];
#pragma unroll
            for (int q = 0; q < 8; ++q) kv[q] *= ww;
            *(LAS v4u*)(KWt + v_st(row, ch * 8)) = pack8f(kv); }
        __syncthreads();
        const int vb = (int)(uintptr_t)Vt + v_rd_base(lane), kb = (int)(uintptr_t)KWt + v_rd_base(lane) + half * 512;
        f32x16 acc[4] = {};
#define XA_VT(vt) do { s16x4 vl0, vh0, vl1, vh1, vl2, vh2, vl3, vh3, kl0, kh0, kl1, kh1, kl2, kh2, kl3, kh3; constexpr int o_ = v_rd_off(vt, 0, 0); \
            TRRD(vl0, vb, o_); TRRD(vh0, vb, o_ + 2048); TRRD(vl1, vb, o_ + 4096); TRRD(vh1, vb, o_ + 6144); TRRD(vl2, vb, o_ + 8192); TRRD(vh2, vb, o_ + 10240); TRRD(vl3, vb, o_ + 12288); TRRD(vh3, vb, o_ + 14336); \
            TRRD(kl0, kb, 0); TRRD(kh0, kb, 2048); TRRD(kl1, kb, 4096); TRRD(kh1, kb, 6144); TRRD(kl2, kb, 8192); TRRD(kh2, kb, 10240); TRRD(kl3, kb, 12288); TRRD(kh3, kb, 14336); \
            asm volatile("s_waitcnt lgkmcnt(0)" ::: "memory"); __builtin_amdgcn_sched_barrier(0); \
            acc[vt] = __builtin_amdgcn_mfma_f32_32x32x16_bf16(FRAG(vl0, vh0), FRAG(kl0, kh0), acc[vt], 0, 0, 0); \
            acc[vt] = __builtin_amdgcn_mfma_f32_32x32x16_bf16(FRAG(vl1, vh1), FRAG(kl1, kh1), acc[vt], 0, 0, 0); \
            acc[vt] = __builtin_amdgcn_mfma_f32_32x32x16_bf16(FRAG(vl2, vh2), FRAG(kl2, kh2), acc[vt], 0, 0, 0); \
            acc[vt] = __builtin_amdgcn_mfma_f32_32x32x16_bf16(FRAG(vl3, vh3), FRAG(kl3, kh3), acc[vt], 0, 0, 0); } while (0)
        XA_VT(0); XA_VT(1); XA_VT(2); XA_VT(3);
#undef XA_VT
        { const int d = half * 32 + r32; float nx = 0.f;
#pragma unroll 8
          for (int s = 0; s < 32; ++s) nx += bf1(*(const LAS bf16*)(KWt + v_st(32 * hi + s, d & ~7) + (d & 7) * 2));
          nx = swap_add(nx);
          if (hi == 0) NX[(size_t)u * 64 + d] = nx; }
        { GAS float* xo = (GAS float*)(XT + (size_t)u * 8192 + half * 32 + r32 + hi * 256);
#pragma unroll
          for (int vt = 0; vt < 4; ++vt)
#pragma unroll
              for (int r4 = 0; r4 < 4; ++r4) { asm volatile("" : "+v"(xo));
#pragma unroll
                  for (int r0 = 0; r0 < 4; ++r0) xo[r0 * 64] = acc[vt][r4 * 4 + r0];
                  xo += 512; } }
        __syncthreads();
    }
}
__device__ __forceinline__ void xb_phase(Frame& F) {
    const float* __restrict__ XT = (const float*)(F.ws + WS_ARENA + A_XT); const float* __restrict__ NX = (const float*)(F.ws + WS_ARENA + A_NX); float* SC = (float*)(F.ws + WS_ARENA + A_SC);
    bf16* __restrict__ CT = (bf16*)(F.ws + WS_ARENA + A_CT); float* __restrict__ NC = (float*)(F.ws + WS_ARENA + A_NC);
    for (int g = (int)blockIdx.x * 512 + F.tid; g < BATCH * ML_H * 8192; g += F.G * 512) {
        const int bh = g >> 13, e = g & 8191;
        float m = 0.f, C = 0.f, n = 0.f;
        for (int c0 = 0; c0 < 128; c0 += 16) {
            float x[16], a[16], M[16], nx[16];
#pragma unroll
            for (int i = 0; i < 16; ++i) { const int u = bh * 128 + c0 + i; x[i] = *(const GAS float*)(XT + (size_t)u * 8192 + e); a[i] = *(const GAS float*)(SC + u); M[i] = *(const GAS float*)(SC + NUNIT + u);
                nx[i] = (e < 64) ? *(const GAS float*)(NX + (size_t)u * 64 + e) : 0.f; }
#pragma unroll
            for (int i = 0; i < 16; ++i) { const int u = bh * 128 + c0 + i;
                *(GAS bf16*)(CT + (size_t)u * 8192 + e) = (bf16)(cvtpk(C, 0.f) & 0xffffu);
                const float mn = a[i] + fmaxf(m, M[i]), fC = fexp(a[i] + m - mn), fX = fexp(a[i] + M[i] - mn);
                if (e < 64) { *(GAS float*)(NC + (size_t)u * 64 + e) = n; n = fC * n + fX * nx[i]; }
                if (e == 0) *(GAS float*)(SC + 2 * NUNIT + u) = m;
                C = fC * C + fX * x[i]; m = mn; }
        }
    }
}
__device__ __forceinline__ void xc_phase(Frame& F, const Inputs& in, int j) {
    const bf16* P = (const bf16*)(F.ws + WS_ARENA + A_P); const bf16* QKB = (const bf16*)(F.ws + WS_ARENA + A_QKB); const float* IGLF = (const float*)(F.ws + WS_ARENA + mlc::A_IG2);
    const bf16* CT = (const bf16*)(F.ws + WS_ARENA + A_CT); const float* NC = (const float*)(F.ws + WS_ARENA + A_NC); const float* SC = (const float*)(F.ws + WS_ARENA + A_SC);
    bf16* HM = (bf16*)(F.ws + WS_ARENA + A_HM2); const float* gn = in.ml_out_norm + (size_t)j * 1024;
    const int lane = F.lane, wave = F.wave, r32 = lane & 31, hi = lane >> 5, us = wave >> 1, th = wave & 1, lt = th * 64 + lane;
    LAS char* slot = (LAS char*)F.lds + us * SLOT; LAS char* Kt = slot; LAS char* Vt = slot + 8192;
    LAS float* sb = (LAS float*)(slot + 24576); LAS float* se = sb + 64; LAS float* sF = se + 64; LAS float* sn = sF + 64;
    LAS float* ob = (LAS float*)(slot + th * 16896);
    for (int u0 = (int)blockIdx.x * 4; u0 < NUNIT; u0 += F.G * 4) {
        const int u = u0 + us, bh = u >> 7, c = u & 127, b = bh >> 3, h = bh & 7; const size_t t0 = (size_t)b * SEQ + (size_t)c * 64;
        const float mc = SC[2 * NUNIT + u];
        { const float lf = IGLF[(t0 + lane) * 16 + 8 + h], ig = IGLF[(t0 + lane) * 16 + h];
          const float Fc = wave_incl_scan_add(lf, lane), bs = ig - Fc, Mt = wave_incl_scan_max(bs, lane);
          if (th == 0) { sb[lane] = bs; se[lane] = fmaxf(mc, Mt); sF[lane] = Fc; sn[lane] = NC[(size_t)u * 64 + lane]; } }
        for (int idx = lt; idx < 512; idx += 128) { const int row = idx >> 3, ch = idx & 7;
            *(LAS v4u*)(Kt + row * 128 + ((ch * 16) ^ ((row & 7) << 4))) = *(const GAS v4u*)(QKB + (t0 + row) * 1024 + 512 + h * 64 + ch * 8); }
        stage_tr128(Vt, P + t0 * 3072 + 1024 + h * 128, 3072, lt, 128);
        const int tl = th * 32 + r32;
        bf16x8 qr[4];
#pragma unroll
        for (int d0 = 0; d0 < 4; ++d0) qr[d0] = *(const GAS bf16x8*)(QKB + (t0 + tl) * 1024 + h * 64 + d0 * 16 + hi * 8);
        __syncthreads();
        const float et = se[tl], Fct = sF[tl], iw = fexp(mc - et);
        f32x16 p0 = {}, p1 = {};
#pragma unroll
        for (int d0 = 0; d0 < 4; ++d0) { const int cb = (d0 * 32 + hi * 16) ^ ((r32 & 7) << 4);
            const bf16x8 k0 = *(const LAS bf16x8*)(Kt + r32 * 128 + cb);
            p0 = __builtin_amdgcn_mfma_f32_32x32x16_bf16(k0, qr[d0], p0, 0, 0, 0);
            if (th) { const bf16x8 k1 = *(const LAS bf16x8*)(Kt + (32 + r32) * 128 + cb); p1 = __builtin_amdgcn_mfma_f32_32x32x16_bf16(k1, qr[d0], p1, 0, 0, 0); } }
        float dsum = 0.f;
#pragma unroll
        for (int r = 0; r < 16; ++r) { const int s0 = crow(r, hi);
            const float w0 = (s0 <= tl) ? fexp(sb[s0] - et) : 0.f; p0[r] *= w0; dsum += p0[r];
            const float w1 = (th && s0 + 32 <= tl) ? fexp(sb[s0 + 32] - et) : 0.f; p1[r] *= w1; dsum += p1[r]; }
        dsum = swap_add(dsum);
        bf16x8 pa0, pa1, pa2, pa3;
#define PK4(Pv, B_, OUT) do { unsigned a0 = cvtpk(Pv[B_+0], Pv[B_+1]), a1 = cvtpk(Pv[B_+2], Pv[B_+3]); unsigned b0 = cvtpk(Pv[B_+4], Pv[B_+5]), b1 = cvtpk(Pv[B_+6], Pv[B_+7]); \
        auto r0 = __builtin_amdgcn_permlane32_swap(a0, b0, false, false); auto r1 = __builtin_amdgcn_permlane32_swap(a1, b1, false, false); \
        v4u w_ = {r0[0], r1[0], r0[1], r1[1]}; OUT = __builtin_bit_cast(bf16x8, w_); } while (0)
        PK4(p0, 0, pa0); PK4(p0, 8, pa1); PK4(p1, 0, pa2); PK4(p1, 8, pa3);
#undef PK4
        float qn = 0.f;
#pragma unroll
        for (int d0 = 0; d0 < 4; ++d0) { float qv[8]; unpack8(__builtin_bit_cast(v4u, qr[d0]), qv);
#pragma unroll
            for (int q = 0; q < 8; ++q) qn += qv[q] * sn[d0 * 16 + hi * 8 + q]; }
        qn = swap_add(qn);
        f32x16 acc[4] = {};
        const bf16* ctp = CT + (size_t)u * 8192 + (size_t)r32 * 64 + hi * 8;
#pragma unroll
        for (int vt = 0; vt < 4; ++vt)
#pragma unroll
            for (int d0 = 0; d0 < 4; ++d0) { const bf16x8 cf = *(const GAS bf16x8*)(ctp + vt * 32 * 64 + d0 * 16);
                acc[vt] = __builtin_amdgcn_mfma_f32_32x32x16_bf16(cf, qr[d0], acc[vt], 0, 0, 0); }
#pragma unroll
        for (int vt = 0; vt < 4; ++vt)
#pragma unroll
            for (int r = 0; r < 16; ++r) acc[vt][r] *= iw;
        const int vb = (int)(uintptr_t)Vt + v_rd_base(lane);
#define XC_VT(vt) do { s16x4 vl0, vh0, vl1, vh1, vl2, vh2, vl3, vh3; constexpr int o_ = v_rd_off(vt, 0, 0); \
            TRRD(vl0, vb, o_); TRRD(vh0, vb, o_ + 2048); TRRD(vl1, vb, o_ + 4096); TRRD(vh1, vb, o_ + 6144); \
            if (th) { TRRD(vl2, vb, o_ + 8192); TRRD(vh2, vb, o_ + 10240); TRRD(vl3, vb, o_ + 12288); TRRD(vh3, vb, o_ + 14336); } \
            asm volatile("s_waitcnt lgkmcnt(0)" ::: "memory"); __builtin_amdgcn_sched_barrier(0); \
            acc[vt] = __builtin_amdgcn_mfma_f32_32x32x16_bf16(FRAG(vl0, vh0), pa0, acc[vt], 0, 0, 0); \
            acc[vt] = __builtin_amdgcn_mfma_f32_32x32x16_bf16(FRAG(vl1, vh1), pa1, acc[vt], 0, 0, 0); \
            if (th) { acc[vt] = __builtin_amdgcn_mfma_f32_32x32x16_bf16(FRAG(vl2, vh2), pa2, acc[vt], 0, 0, 0); \
                      acc[vt] = __builtin_amdgcn_mfma_f32_32x32x16_bf16(FRAG(vl3, vh3), pa3, acc[vt], 0, 0, 0); } } while (0)
        XC_VT(0); XC_VT(1); XC_VT(2); XC_VT(3);
#undef XC_VT
        const float den = dsum + iw * qn;
        const float hs = frcp(fmaxf(fabsf(den), fexp(-Fct - et)));
        float ss = 0.f;
#pragma unroll
        for (int vt = 0; vt < 4; ++vt)
#pragma unroll
            for (int r = 0; r < 16; ++r) { acc[vt][r] *= hs; ss += acc[vt][r] * acc[vt][r]; }
        ss = swap_add(ss);
        const float rn = frsq(ss * (1.f / 128.f) + RMS_EPS);
        __syncthreads();
#pragma unroll
        for (int vt = 0; vt < 4; ++vt)
#pragma unroll
            for (int r = 0; r < 16; ++r) ob[(vt * 32 + crow(r, hi)) * 33 + r32] = acc[vt][r] * rn;
        LDS_WAIT();
        { const int v2 = lane * 2; const float g0 = gn[h * 128 + v2], g1 = gn[h * 128 + v2 + 1];
#pragma unroll 4
          for (int tt = 0; tt < 32; ++tt) { const size_t t = t0 + th * 32 + tt;
              const unsigned ow = *(const GAS unsigned*)(P + t * 3072 + 2048 + h * 128 + v2);
              const float x0 = ob[v2 * 33 + tt] * g0 * fsigmoid(bf_lo(ow)), x1 = ob[(v2 + 1) * 33 + tt] * g1 * fsigmoid(bf_hi(ow));
              *(GAS unsigned*)(HM + t * 1024 + h * 128 + v2) = cvtpk(x0, x1); } }
        __syncthreads();
    }
}
#undef TRRD
#undef FRAG
}

namespace rwc {
#ifdef SUBSTAMP
#define SUB_T0() unsigned long long sub_t_ = __builtin_amdgcn_s_memrealtime()
#define SUB_MARK(k) do { if (blockIdx.x == 0 && threadIdx.x == 0) { const unsigned long long n_ = __builtin_amdgcn_s_memrealtime(); if ((k) == SUBSTAMP) { const unsigned long long until_ = n_ + 8ull * (n_ - sub_t_); while (__builtin_amdgcn_s_memrealtime() < until_) __builtin_amdgcn_s_sleep(8); } } sub_t_ = __builtin_amdgcn_s_memrealtime(); } while (0)
#else
#define SUB_T0()
#define SUB_MARK(k)
#endif
constexpr int NU = BATCH * RW_H * (SEQ / 64);
constexpr size_t A_GL = A_LOR, A_BON = A_LOR + 1 * MiB;
constexpr int RMB = 9216, TRB = 8192;
constexpr int L_LWF = 0, L_AT_RM = 16384, L_BT_RM = L_AT_RM + RMB, L_KT_RM = L_BT_RM + RMB, L_RT_RM = L_KT_RM + RMB, L_KH_RM = L_RT_RM + RMB, L_T_RM = L_KH_RM + RMB, L_ARB_RM = L_T_RM + RMB,
              L_AT_TR = L_ARB_RM + RMB, L_BH_TR = L_AT_TR + TRB, L_V_TR = L_BH_TR + TRB, L_AAK_TR = L_V_TR + TRB, L_W2_TR = L_AAK_TR + TRB, L_H_TR = L_W2_TR + TRB, L_SEG = L_H_TR + TRB, L_TT_RM = L_SEG + 2048,
              L_P1_RM = L_BT_RM, L_P2_RM = L_KT_RM;
static_assert(L_TT_RM + RMB <= LDSCTL_OFF, "RWKV LDS map");
using att::crow; using att::v_rd_base;
__device__ __forceinline__ int rm_off(int row, int col) { return row * 144 + col * 2; }
__device__ __forceinline__ int tr_off(int row, int col) { const int kk = (row & ~0xC) | ((row & 4) << 1) | ((row & 8) >> 1); return ((kk >> 3) * 2 + (col >> 5)) * 512 + ((kk & 7) * 32 + (col & 31)) * 2; }
__device__ __forceinline__ bf16x8 frag_rm(const LAS char* tile, int row, int kb, int hi) { return *(const LAS bf16x8*)(tile + rm_off(row, kb * 16 + hi * 8)); }
__device__ __forceinline__ void frag_tr4(bf16x8 (&f)[4], const LAS char* tile, int cb, int lane) {
    const int base = (int)(uintptr_t)tile + v_rd_base(lane) + cb * 512; s16x4 l[4], h[4];
#pragma unroll
    for (int kb = 0; kb < 4; ++kb) { asm volatile("ds_read_b64_tr_b16 %0, %1" : "=&v"(l[kb]) : "v"(base + kb * 2048) : "memory"); asm volatile("ds_read_b64_tr_b16 %0, %1" : "=&v"(h[kb]) : "v"(base + kb * 2048 + 1024) : "memory"); }
    asm volatile("s_waitcnt lgkmcnt(0)" ::: "memory"); __builtin_amdgcn_sched_barrier(0);
#pragma unroll
    for (int kb = 0; kb < 4; ++kb) f[kb] = (bf16x8){l[kb][0], l[kb][1], l[kb][2], l[kb][3], h[kb][0], h[kb][1], h[kb][2], h[kb][3]};
}
__device__ __forceinline__ void frag_rm4(bf16x8 (&f)[4], const LAS char* tile, int row, int hi) {
#pragma unroll
    for (int kb = 0; kb < 4; ++kb) f[kb] = frag_rm(tile, row, kb, hi);
}
__device__ __forceinline__ f32x16 mm4(const bf16x8 (&a)[4], const bf16x8 (&b)[4]) { f32x16 acc = {};
#pragma unroll
    for (int kb = 0; kb < 4; ++kb) acc = __builtin_amdgcn_mfma_f32_32x32x16_bf16(a[kb], b[kb], acc, 0, 0, 0);
    return acc; }
__device__ __forceinline__ bf16 tobf(float x) { return (bf16)(cvtpk(x, 0.f) & 0xffffu); }
#define STORE_RM(tile, acc, mt, nt) do { _Pragma("unroll") for (int r_ = 0; r_ < 16; ++r_) *(LAS bf16*)((tile) + rm_off(32 * (mt) + crow(r_, hi), 32 * (nt) + r32)) = tobf((acc)[r_]); } while (0)
#define STORE_TR(tile, acc, mt, nt) do { _Pragma("unroll") for (int r_ = 0; r_ < 16; ++r_) *(LAS bf16*)((tile) + tr_off(32 * (mt) + crow(r_, hi), 32 * (nt) + r32)) = tobf((acc)[r_]); } while (0)

__device__ __forceinline__ void ra_phase(Frame& F, const Inputs& in, int jl) {
    bf16* RKV = (bf16*)(F.ws + WS_ARENA + A_RKV); const bf16* AA = (const bf16*)(F.ws + WS_ARENA + A_AAZ); float* LW = (float*)(F.ws + WS_ARENA + A_LW);
    float* GL = (float*)(F.ws + WS_ARENA + A_GL); float* BON = (float*)(F.ws + WS_ARENA + A_BON);
    const float* k_k = in.rw_k_k + (size_t)jl * 1024; const float* k_a = in.rw_k_a + (size_t)jl * 1024; const float* r_k = in.rw_r_k + (size_t)jl * 1024;
    LAS char* L = (LAS char*)F.lds; LAS float* LWF = (LAS float*)(L + L_LWF); LAS float* SEG = (LAS float*)(L + L_SEG);
    const int w = F.wave;
#define FRESH() const int lane = fresh_lane(), r32 = lane & 31, hi = lane >> 5; (void)r32; (void)hi
    v4u pr_r, pr_k, pr_v, pr_a; f32x4 pr_l0, pr_l1;
#define RA_PREFETCH(u_) do { const int tid_ = w * 64 + fresh_lane(), bh_ = (u_) >> 7, c_ = (u_) & 127; const size_t row_ = (size_t)(bh_ >> 4) * SEQ + (size_t)c_ * 64 + (tid_ >> 3); const int col_ = (bh_ & 15) * 64 + (tid_ & 7) * 8; \
        pr_r = *(const GAS v4u*)(RKV + row_ * 3072 + col_); pr_k = *(const GAS v4u*)(RKV + row_ * 3072 + 1024 + col_); pr_v = *(const GAS v4u*)(RKV + row_ * 3072 + 2048 + col_); pr_a = *(const GAS v4u*)(AA + row_ * 1024 + col_); \
        pr_l0 = *(const GAS f32x4*)(LW + row_ * 1024 + col_); pr_l1 = *(const GAS f32x4*)(LW + row_ * 1024 + col_ + 4); } while (0)
    if ((int)blockIdx.x < NU) RA_PREFETCH((int)blockIdx.x);
    for (int u = (int)blockIdx.x; u < NU; u += F.G) {
        const int tid = w * 64 + fresh_lane();
        const int bh = u >> 7, c = u & 127, b = bh >> 4, h = bh & 15; const size_t t0 = (size_t)b * SEQ + (size_t)c * 64;
        SUB_T0();
        const int t = tid >> 3, j0 = (tid & 7) * 8; const size_t row = t0 + t; const int col = h * 64 + j0;
        float rv[8], kp[8], vv[8], am[8], bb[8], lw[8];
        { float kv[8], av[8];
          unpack8(pr_r, rv); unpack8(pr_k, kv); unpack8(pr_v, vv); unpack8(pr_a, av);
          const f32x4 l0 = pr_l0, l1 = pr_l1;
          float ss = 0.f, bs = 0.f; float kk[8];
#pragma unroll
          for (int q = 0; q < 8; ++q) { lw[q] = q < 4 ? l0[q] : l1[q - 4]; kk[q] = kv[q] * k_k[col + q]; ss += kk[q] * kk[q]; kp[q] = kv[q] * (1.f + (av[q] - 1.f) * k_a[col + q]); bs += rv[q] * kp[q] * r_k[col + q]; }
          ss += __shfl_xor(ss, 1); ss += __shfl_xor(ss, 2); ss += __shfl_xor(ss, 4); bs += __shfl_xor(bs, 1); bs += __shfl_xor(bs, 2); bs += __shfl_xor(bs, 4);
          const float inv = frcp(fmaxf(fsqrt(ss), 1e-12f));
#pragma unroll
          for (int q = 0; q < 8; ++q) { const float kn = kk[q] * inv; am[q] = -kn; bb[q] = kn * av[q]; }
          if ((tid & 7) == 0) BON[row * 16 + h] = bs; }
        { LAS f32x4* lp = (LAS f32x4*)(LWF + t * 64 + j0); lp[0] = (f32x4){lw[0], lw[1], lw[2], lw[3]}; lp[1] = (f32x4){lw[4], lw[5], lw[6], lw[7]}; }
        __syncthreads();
        { const int jc = tid & 63, sg = tid >> 6; float run = 0.f;
#pragma unroll
          for (int q = 0; q < 8; ++q) { run += LWF[(sg * 8 + q) * 64 + jc]; LWF[(sg * 8 + q) * 64 + jc] = run; }
          SEG[sg * 64 + jc] = run; }
        __syncthreads();
        { const int jc = tid & 63, sg = tid >> 6; float pre = 0.f;
#pragma unroll
          for (int q = 0; q < 8; ++q) if (q < sg) pre += SEG[q * 64 + jc];
#pragma unroll
          for (int q = 0; q < 8; ++q) LWF[(sg * 8 + q) * 64 + jc] += pre; }
        __syncthreads();
        { float at[8], bt[8], kt[8], rt[8], bh_[8], kh[8];
#pragma unroll
          for (int q = 0; q < 8; ++q) { const float cum = LWF[t * 64 + j0 + q], cl = LWF[63 * 64 + j0 + q];
              const float ein = fexp(-cum), eL = fexp(cl - cum);
              at[q] = am[q] * fexp(cum - lw[q]); bt[q] = bb[q] * ein; kt[q] = kp[q] * ein; rt[q] = rv[q] * fexp(cum); bh_[q] = bb[q] * eL; kh[q] = kp[q] * eL;
              if (t == 63) GL[(size_t)u * 64 + j0 + q] = fexp(cl); }
          for (int z = tid; z < RMB / 16; z += 512) *(LAS v4u*)(L + L_T_RM + z * 16) = (v4u){0u, 0u, 0u, 0u};
          const int ro = rm_off(t, j0), to = tr_off(t, j0);
          *(LAS v4u*)(L + L_AT_RM + ro) = pack8f(at); *(LAS v4u*)(L + L_AT_TR + to) = pack8f(at); *(LAS v4u*)(L + L_BT_RM + ro) = pack8f(bt); *(LAS v4u*)(L + L_KT_RM + ro) = pack8f(kt);
          *(LAS v4u*)(L + L_RT_RM + ro) = pack8f(rt); *(LAS v4u*)(L + L_BH_TR + to) = pack8f(bh_); *(LAS v4u*)(L + L_KH_RM + ro) = pack8f(kh); *(LAS v4u*)(L + L_V_TR + to) = pack8f(vv); }
        __syncthreads(); SUB_MARK(0);
        if (u + F.G < NU) RA_PREFETCH(u + F.G);
        f32x16 rk[2];
        { FRESH(); const int p = w >> 1, mt = w & 1; const LAS char* At = L + ((p < 2) ? L_AT_RM : L_RT_RM); const LAS char* Bt = L + ((p & 1) ? L_KT_RM : L_BT_RM);
          bf16x8 fa[4]; frag_rm4(fa, At, 32 * mt + r32, hi);
#pragma unroll
          for (int nt = 0; nt < 2; ++nt) { f32x16 acc = {};
              if (nt <= mt) { bf16x8 fb[4]; frag_rm4(fb, Bt, 32 * nt + r32, hi); acc = mm4(fa, fb); }
#pragma unroll
              for (int r = 0; r < 16; ++r) { const int tt = 32 * mt + crow(r, hi), s = 32 * nt + r32; const bool keep = (p < 2) ? (s < tt) : (s <= tt); if (!keep) acc[r] = 0.f; }
              if (p == 0) {
#pragma unroll
                  for (int r = 0; r < 16; ++r) LWF[(32 * mt + crow(r, hi)) * 64 + 32 * nt + r32] = acc[r]; }
              else if (p == 1) STORE_TR(L + L_AAK_TR, acc, mt, nt);
              else if (p == 2) STORE_RM(L + L_ARB_RM, acc, mt, nt);
              rk[nt] = acc; } }
        __syncthreads(); SUB_MARK(1);
        { FRESH(); const int c16 = lane & 15, q4 = lane >> 4; LAS char* TT = L + L_TT_RM; LAS char* TM = L + L_T_RM;
          if (w < 4) { const int base = 16 * w; float Tc[16];
#pragma unroll
              for (int tt = 0; tt < 16; ++tt) { float acc = (tt == c16) ? 1.f : 0.f;
#pragma unroll
                  for (int s4 = 0; s4 < (tt + 3) / 4; ++s4) { const f32x4 a4 = *(const LAS f32x4*)(LWF + (base + tt) * 64 + base + s4 * 4);
#pragma unroll
                      for (int e = 0; e < 4; ++e) if (s4 * 4 + e < tt) acc += a4[e] * Tc[s4 * 4 + e]; }
                  Tc[tt] = acc; }
              if (lane < 16) {
#pragma unroll
                  for (int tt = 0; tt < 16; ++tt) *(LAS bf16*)(TM + rm_off(base + tt, base + c16)) = tobf(Tc[tt]);
                  *(LAS v4u*)(TT + rm_off(base + c16, base)) = pack8f(Tc); *(LAS v4u*)(TT + rm_off(base + c16, base + 8)) = pack8f(Tc + 8); } }
          __syncthreads();
#pragma unroll
          for (int d = 1; d < 4; ++d) {
              if (w < 4 - d) { const int ab = 16 * (w + d), bb = 16 * w; f32x4 x = {0.f, 0.f, 0.f, 0.f};
#pragma unroll
                  for (int step = 0; step < (d == 3 ? 2 : 1); ++step) { const int k0 = 32 * step + 8 * q4; const bool valid = k0 < 16 * d;
                      v4u af = {0u, 0u, 0u, 0u}, bfm = {0u, 0u, 0u, 0u};
                      if (valid) { const LAS f32x4* ap = (const LAS f32x4*)(LWF + (ab + c16) * 64 + bb + k0); af = pack8v(ap[0], ap[1]); bfm = *(const LAS v4u*)(TT + rm_off(bb + c16, bb + k0)); }
                      x = __builtin_amdgcn_mfma_f32_16x16x32_bf16(__builtin_bit_cast(bf16x8, af), __builtin_bit_cast(bf16x8, bfm), x, 0, 0, 0); }
                  LAS char* XS = L + L_KT_RM + w * 512;
                  { v2u xw; xw.x = cvtpk(x[0], x[1]); xw.y = cvtpk(x[2], x[3]); *(LAS v2u*)(XS + c16 * 32 + q4 * 8) = xw; }
                  LDS_WAIT();
                  v4u af2 = {0u, 0u, 0u, 0u}, bf2 = {0u, 0u, 0u, 0u};
                  if (q4 < 2) { af2 = *(const LAS v4u*)(TM + rm_off(ab + c16, ab + 8 * q4)); bf2 = *(const LAS v4u*)(XS + c16 * 32 + q4 * 16); }
                  const f32x4 tb = __builtin_amdgcn_mfma_f32_16x16x32_bf16(__builtin_bit_cast(bf16x8, af2), __builtin_bit_cast(bf16x8, bf2), (f32x4){0.f, 0.f, 0.f, 0.f}, 0, 0, 0);
#pragma unroll
                  for (int jx = 0; jx < 4; ++jx) *(LAS bf16*)(TM + rm_off(ab + 4 * q4 + jx, bb + c16)) = tobf(tb[jx]);
                  { v2u tw; tw.x = cvtpk(tb[0], tb[1]); tw.y = cvtpk(tb[2], tb[3]); *(LAS v2u*)(TT + rm_off(bb + c16, ab + 4 * q4)) = tw; } }
              __syncthreads();
          } }
        SUB_MARK(2);
        { FRESH(); const int q = w & 3, mt = q >> 1, nt = q & 1; bf16x8 fa[4], fb[4]; frag_rm4(fa, L + L_T_RM, 32 * mt + r32, hi);
          frag_tr4(fb, L + ((w < 4) ? L_AT_TR : L_AAK_TR), nt, lane);
          const f32x16 acc = mm4(fa, fb);
          if (w < 4) STORE_TR(L + L_W2_TR, acc, mt, nt); else STORE_TR(L + L_H_TR, acc, mt, nt); }
        __syncthreads(); SUB_MARK(3);
        { FRESH(); const int g = w >> 1, mt = w & 1; bf16x8 fa[4];
          if (g == 0 || g == 3) frag_rm4(fa, L + L_ARB_RM, 32 * mt + r32, hi); else frag_tr4(fa, L + L_BH_TR, mt, lane);
#pragma unroll
          for (int nt = 0; nt < 2; ++nt) { bf16x8 fb[4]; frag_tr4(fb, L + ((g < 2) ? L_W2_TR : L_H_TR), nt, lane);
              f32x16 acc = mm4(fa, fb);
              if (g == 0) {
#pragma unroll
                  for (int r = 0; r < 16; ++r) { const int tt = 32 * mt + crow(r, hi), jj = 32 * nt + r32;
                      RKV[(t0 + tt) * 3072 + h * 64 + jj] = tobf(acc[r] + bf1(*(const LAS bf16*)(L + L_RT_RM + rm_off(tt, jj)))); } }
              else if (g == 1) {
#pragma unroll
                  for (int r = 0; r < 16; ++r) { const int jp = 32 * mt + crow(r, hi), jj = 32 * nt + r32; RKV[(t0 + jp) * 3072 + 1024 + h * 64 + jj] = tobf(acc[r]); } }
              else if (g == 2) {
#pragma unroll
                  for (int r = 0; r < 16; ++r) { const int jp = 32 * mt + crow(r, hi), s = 32 * nt + r32; acc[r] += bf1(*(const LAS bf16*)(L + L_KH_RM + rm_off(s, jp))); }
                  STORE_RM(L + L_P2_RM, acc, mt, nt); }
              else {
#pragma unroll
                  for (int r = 0; r < 16; ++r) acc[r] += rk[nt][r];
                  STORE_RM(L + L_P1_RM, acc, mt, nt); } } }
        __syncthreads(); SUB_MARK(4);
        { FRESH(); const int q = w & 3, m_ = q >> 1, n_ = q & 1; bf16x8 fa[4], fb[4];
          if (w < 4) { frag_tr4(fa, L + L_V_TR, m_, lane); frag_rm4(fb, L + L_P1_RM, 32 * n_ + r32, hi); }
          else { frag_rm4(fa, L + L_P2_RM, 32 * m_ + r32, hi); frag_tr4(fb, L + L_V_TR, n_, lane); }
          const f32x16 acc = mm4(fa, fb);
          if (w < 4) {
              const int o = (q * 64 + lane) * 32, orow = o >> 7, owi = o & 127;
              GAS v4u* dst = (GAS v4u*)((GAS char*)LW + ((t0 + orow) * 1024 + h * 64) * 4 + owi);
              float tmp[16];
#pragma unroll
              for (int r = 0; r < 16; ++r) tmp[r] = acc[r];
              dst[0] = pack8f(tmp); dst[1] = pack8f(tmp + 8); }
          else {
              const int i_ = 32 * n_ + r32, it4 = i_ >> 4, nn_ = i_ & 15;
#pragma unroll
              for (int g4 = 0; g4 < 4; ++g4) {
                  const int jt = 2 * m_ + (g4 >> 1), qq = 2 * (g4 & 1) + hi;
                  const int o = ((it4 * 64 + nn_ + 16 * qq) * 16 + jt * 4) * 2, orow = o >> 7, owi = o & 127;
                  v2u wv; wv.x = cvtpk(acc[4 * g4], acc[4 * g4 + 1]); wv.y = cvtpk(acc[4 * g4 + 2], acc[4 * g4 + 3]);
                  *(GAS v2u*)((GAS char*)LW + ((t0 + orow) * 1024 + h * 64) * 4 + 128 + owi) = wv; } } }
        __syncthreads(); SUB_MARK(5);
    }
}
__device__ __forceinline__ void rb_phase(Frame& F) {
    if ((int)blockIdx.x >= BATCH * RW_H * 4) return;
    const bf16* RKV = (const bf16*)(F.ws + WS_ARENA + A_RKV); const float* LW = (const float*)(F.ws + WS_ARENA + A_LW); const float* GL = (const float*)(F.ws + WS_ARENA + A_GL);
    bf16* ZC = (bf16*)(F.ws + WS_ARENA + A_AAZ);
    const int lane = F.lane, n16 = lane & 15, q4 = lane >> 4, task = blockIdx.x, bh = task >> 2, it4 = task & 3, b = bh >> 4, h = bh & 15;
    LAS float* sg = (LAS float*)F.lds;
    for (int e = F.tid; e < 128 * 16; e += 512) *(LAS f32x4*)(sg + e * 4) = *(const GAS f32x4*)(GL + (size_t)bh * 8192 + e * 4);
    __syncthreads();
    if (F.wave != 0) return;
    f32x4 Z[4] = {};
    v4u mfA[4][2], mfB[4][2], mfC[4][2], mfD[4][2]; v4u nnA[2], nnB[2], nnC[2], nnD[2];
#define RB_LOAD(c_, mf_, nn_) do { const size_t t0_ = (size_t)b * SEQ + (size_t)((c_) < SEQ / 64 ? (c_) : SEQ / 64 - 1) * 64; \
        _Pragma("unroll") for (int jt = 0; jt < 4; ++jt) { const bf16* mrow = RKV + (t0_ + 16 * jt + n16) * 3072 + 1024 + h * 64 + 4 * q4; \
            _Pragma("unroll") for (int kb2 = 0; kb2 < 2; ++kb2) { const v2u lo = *(const GAS v2u*)(mrow + kb2 * 32), hi2 = *(const GAS v2u*)(mrow + kb2 * 32 + 16); mf_[jt][kb2] = (v4u){lo.x, lo.y, hi2.x, hi2.y}; } } \
        { const int o = ((it4 * 64 + lane) * 16) * 2, orow = o >> 7, owi = o & 127; \
          const GAS v4u* np = (const GAS v4u*)((const GAS char*)LW + ((t0_ + orow) * 1024 + h * 64) * 4 + 128 + owi); nn_[0] = np[0]; nn_[1] = np[1]; } } while (0)
#define RB_STEP(c_, mf_, nn_) do { const int u = bh * 128 + (c_); \
        v4u zh[2], zl[2]; \
        _Pragma("unroll") for (int kb2 = 0; kb2 < 2; ++kb2) { float a8[8], l8[8]; \
            _Pragma("unroll") for (int e = 0; e < 4; ++e) { a8[e] = Z[2 * kb2][e]; a8[4 + e] = Z[2 * kb2 + 1][e]; } \
            const v4u hw = pack8f(a8); float h8[8]; unpack8(hw, h8); \
            _Pragma("unroll") for (int e = 0; e < 8; ++e) l8[e] = a8[e] - h8[e]; \
            zh[kb2] = hw; zl[kb2] = pack8f(l8); \
              \
            _Pragma("unroll") for (int s_ = 0; s_ < 2; ++s_) { const int jt = 2 * kb2 + s_; v2u zw; zw.x = s_ ? hw.z : hw.x; zw.y = s_ ? hw.w : hw.y; \
                *(GAS v2u*)(ZC + (size_t)u * 4096 + ((jt * 2 + (it4 >> 1)) * 64 + 32 * (q4 & 1) + 16 * (it4 & 1) + n16) * 8 + 4 * (q4 >> 1)) = zw; } } \
        float nv[16]; unpack8(nn_[0], nv); unpack8(nn_[1], nv + 8); \
        _Pragma("unroll") for (int jt = 0; jt < 4; ++jt) { const f32x4 g4 = *(const LAS f32x4*)(sg + (c_) * 64 + 16 * jt + 4 * q4); f32x4 acc; \
            _Pragma("unroll") for (int e = 0; e < 4; ++e) acc[e] = nv[4 * jt + e] + g4[e] * Z[jt][e]; \
            _Pragma("unroll") for (int kb2 = 0; kb2 < 2; ++kb2) { \
                acc = __builtin_amdgcn_mfma_f32_16x16x32_bf16(__builtin_bit_cast(bf16x8, mf_[jt][kb2]), __builtin_bit_cast(bf16x8, zh[kb2]), acc, 0, 0, 0); \
                acc = __builtin_amdgcn_mfma_f32_16x16x32_bf16(__builtin_bit_cast(bf16x8, mf_[jt][kb2]), __builtin_bit_cast(bf16x8, zl[kb2]), acc, 0, 0, 0); } \
            zn[jt] = acc; } \
        _Pragma("unroll") for (int jt = 0; jt < 4; ++jt) Z[jt] = zn[jt]; } while (0)
    f32x4 zn[4];
    static_assert((SEQ / 64) % 4 == 0, "Rb pipeline: chunks = 4k");
    RB_LOAD(0, mfA, nnA); RB_LOAD(1, mfB, nnB); RB_LOAD(2, mfC, nnC);
#pragma nounroll
    for (int c = 0; c < SEQ / 64; c += 4) {
        RB_LOAD(c + 3, mfD, nnD); RB_STEP(c, mfA, nnA);
        RB_LOAD(c + 4, mfA, nnA); RB_STEP(c + 1, mfB, nnB);
        RB_LOAD(c + 5, mfB, nnB); RB_STEP(c + 2, mfC, nnC);
        RB_LOAD(c + 6, mfC, nnC); RB_STEP(c + 3, mfD, nnD);
    }
#undef RB_LOAD
#undef RB_STEP
}
__device__ __forceinline__ void rc_phase(Frame& F, const Inputs& in, int jl) {
    const bf16* RKV = (const bf16*)(F.ws + WS_ARENA + A_RKV); const float* LW = (const float*)(F.ws + WS_ARENA + A_LW); const float* BON = (const float*)(F.ws + WS_ARENA + A_BON);
    const bf16* ZC = (const bf16*)(F.ws + WS_ARENA + A_AAZ); const bf16* GG = (const bf16*)(F.ws + WS_ARENA + A_GG); bf16* YG = (bf16*)(F.ws + WS_ARENA + A_YG);
    const float* lnw = in.rw_ln_w + (size_t)jl * 1024; const float* lnb = in.rw_ln_b + (size_t)jl * 1024;
    const int lane = F.lane, r32 = lane & 31, hi = lane >> 5;
    for (int task = F.gw; task < NU * 2; task += F.NGW) { const int u = task >> 1, tt = task & 1, bh = u >> 7, c = u & 127, b = bh >> 4, h = bh & 15; const size_t t0 = (size_t)b * SEQ + (size_t)c * 64, trow = t0 + 32 * tt + r32;
        bf16x8 yw[4];
        { const bf16* yrow = RKV + trow * 3072 + h * 64 + 4 * hi;
#pragma unroll
          for (int kb = 0; kb < 4; ++kb) { const v2u lo = *(const GAS v2u*)(yrow + kb * 16), hi2 = *(const GAS v2u*)(yrow + kb * 16 + 8); yw[kb] = __builtin_bit_cast(bf16x8, (v4u){lo.x, lo.y, hi2.x, hi2.y}); } }
        f32x16 y[2];
#pragma unroll
        for (int it = 0; it < 2; ++it) { const int o = ((it * 2 + tt) * 64 + lane) * 32, orow = o >> 7, owi = o & 127;
            const GAS v4u* yp = (const GAS v4u*)((const GAS char*)LW + ((t0 + orow) * 1024 + h * 64) * 4 + owi);
            float tmp[16]; unpack8(yp[0], tmp); unpack8(yp[1], tmp + 8);
#pragma unroll
            for (int r = 0; r < 16; ++r) y[it][r] = tmp[r];
#pragma unroll
            for (int kb = 0; kb < 4; ++kb) { const bf16x8 zf = *(const GAS bf16x8*)(ZC + (size_t)u * 4096 + ((kb * 2 + it) * 64 + lane) * 8);
                y[it] = __builtin_amdgcn_mfma_f32_32x32x16_bf16(zf, yw[kb], y[it], 0, 0, 0); } }
        float s1 = 0.f;
#pragma unroll
        for (int it = 0; it < 2; ++it)
#pragma unroll
            for (int r = 0; r < 16; ++r) s1 += y[it][r];
        const float mean = mlc::swap_add(s1) * (1.f / 64.f); float s2 = 0.f;
#pragma unroll
        for (int it = 0; it < 2; ++it)
#pragma unroll
            for (int r = 0; r < 16; ++r) { y[it][r] -= mean; s2 += y[it][r] * y[it][r]; }
        const float rs = frsq(mlc::swap_add(s2) * (1.f / 64.f) + 64e-5f);
        LAS float* zb = (LAS float*)F.lds + F.wave * (64 * 33 + 32);
#pragma unroll
        for (int it = 0; it < 2; ++it)
#pragma unroll
            for (int r = 0; r < 16; ++r) zb[(32 * it + crow(r, hi)) * 33 + r32] = y[it][r] * rs;
        if (hi == 0) zb[64 * 33 + r32] = BON[trow * 16 + h];
        LDS_WAIT();
        { const int half = lane >> 5, c2 = (lane & 31) * 2, col = h * 64 + c2;
          const float w0 = lnw[col], w1 = lnw[col + 1], b0 = lnb[col], b1 = lnb[col + 1];
#pragma unroll 4
          for (int k = 0; k < 16; ++k) { const int tl = 2 * k + half; const size_t tr = t0 + 32 * tt + tl;
              const unsigned vw = *(const GAS unsigned*)(RKV + tr * 3072 + 2048 + col), gw = *(const GAS unsigned*)(GG + tr * 1024 + col);
              const float bon = zb[64 * 33 + tl];
              const float o0 = (zb[c2 * 33 + tl] * w0 + b0 + bon * bf_lo(vw)) * bf_lo(gw), o1 = (zb[(c2 + 1) * 33 + tl] * w1 + b1 + bon * bf_hi(vw)) * bf_hi(gw);
              *(GAS unsigned*)(YG + tr * 1024 + col) = cvtpk(o0, o1); } }
        LDS_WAIT();
    }
}
#undef STORE_RM
#undef STORE_TR
#undef FRESH
#undef RA_PREFETCH
}

#ifndef MK_ONE_LAUNCH
#define MK_ONE_LAUNCH 1
#endif
template <class Epi> __device__ __forceinline__ void run_gemm(Frame& F, const bf16* A, int lda, const bf16* Bt, int ldb, int N, int K, const Epi& E) {
    pg8::Gemm g{A, Bt, T, N, K, lda, ldb, F.wave}; pg8::StaticOrder S; S.init(T, N, F.G, (int)blockIdx.x);
    pg8::gemm_phase<Epi, pg8::StaticOrder, true, true>(F.lds, g, S, E);
}
template <class Epi> __device__ __forceinline__ void run_gemm_tail(Frame& F, const bf16* A, int lda, const bf16* Bt, int ldb, int N, int K, const Epi& E, int lim0) {
    pg8::Gemm g{A, Bt, T, N, K, lda, ldb, F.wave}; pg8::StaticOrder S; S.init(T, N, F.G, (int)blockIdx.x);
    int g_ = F.G; asm volatile("" : "+s"(g_)); const bool tail = (g_ == 256);
    if (tail) S.lim = lim0;
    pg8::gemm_phase<Epi, pg8::StaticOrder, true, true>(F.lds, g, S, E);
    if (tail) { pg8::TailOrder TO{S, lim0}; pg8::gemm_phase<Epi, pg8::TailOrder, true, true, true>(F.lds, g, TO, E); }
}
struct RwOrder { pg8::StaticOrder S;
    __device__ bool next(int i, pg8::Unit& u) const { const bool ok = S.next(i, u); u.acol = (u.pn >> 2) * 1024; return ok; }
    __device__ __forceinline__ void a_ready(const pg8::Unit&) const {}
    __device__ __forceinline__ void done(const pg8::Unit&) const {} };
__host__ __device__ constexpr int mixer_phases(int kind) { return kind == 0 ? 4 : kind == 1 ? 6 : 7; }
constexpr int NPH = 4 * 3 + (mixer_phases(0) + 2) + (mixer_phases(1) + 2) + (mixer_phases(2) + 2) + (mixer_phases(0) + 2) + 1;

__global__ void __launch_bounds__(NWAVES * 64, 2) fwd(Args args) {
    extern __shared__ __attribute__((aligned(16))) unsigned char lds[];
    Frame F;
    F.lds = (LAS unsigned char*)lds;
    F.tid = threadIdx.x; F.lane = F.tid & 63; const int wave0 = __builtin_amdgcn_readfirstlane(F.tid >> 6); F.wave = wave0;
    F.G = gridDim.x; F.gw = (int)blockIdx.x * NWAVES + F.wave; F.NGW = F.G * NWAVES;
    F.ws = args.ws; F.ctl = (gu32*)(args.ws + WS_CTL);
    const Inputs& in = args.in;
    volatile LAS unsigned* MISC = (volatile LAS unsigned*)(F.lds + MISC_OFF);
    for (int u = F.tid; u < (LDS_BYTES - LDSCTL_OFF) / 4; u += NWAVES * 64) ((LAS unsigned*)(F.lds + LDSCTL_OFF))[u] = 0u;
    __syncthreads();
#if MK_ONE_LAUNCH
    XcdBarrier bar = xcd_barrier_post((unsigned*)(F.ctl + CW_BAR), MISC + 8);
#define GRID_BAR() xcd_barrier(bar)
#else
#define GRID_BAR() do { } while (0)
#endif
    const int lo = args.ph_lo, hi = args.ph_hi;
    int ph = 0;
#ifndef PHMASK
#define PHMASK 0xffffffffu
#endif
#ifndef PHREP
#define PHREP 0u
#endif
#define REP_LAST (rep_ + 1 == nrep_)
#ifdef STAMP_ID
#define ST_BEGIN(id) if ((id) == STAMP_ID && blockIdx.x == 0 && threadIdx.x == 0) *(volatile LAS unsigned long long*)(F.lds + MISC_OFF + 64) = __builtin_amdgcn_s_memrealtime();
#define ST_END(id) if ((id) == STAMP_ID && blockIdx.x == 0 && threadIdx.x == 0) { const unsigned long long t1_ = __builtin_amdgcn_s_memrealtime(), until_ = t1_ + (unsigned long long)STAMP_MULT * (t1_ - *(volatile LAS unsigned long long*)(F.lds + MISC_OFF + 64)); while (__builtin_amdgcn_s_memrealtime() < until_) __builtin_amdgcn_s_sleep(8); }
#else
#define ST_BEGIN(id)
#define ST_END(id)
#endif
#define PH_BEGIN(id) if (ph >= lo && ph < hi) { ST_BEGIN(id) if ((PHMASK >> (id)) & 1u) for (int rep_ = 0, nrep_ = ((((PHREP) >> (id)) & 1u) ? 2 : 1); rep_ < nrep_; ++rep_) { if (rep_) GRID_BAR(); { int w_ = wave0; asm volatile("" : "+s"(w_)); F.wave = w_; F.lane = fresh_lane(); F.tid = w_ * 64 + F.lane; F.gw = (int)blockIdx.x * NWAVES + w_; } unsigned char* ws = args.ws; asm volatile("" : "+s"(ws)); { float* xo_ = args.out; asm volatile("" : "+s"(xo_)); F.X = xo_; } F.ws = ws; F.ctl = (gu32*)(ws + WS_CTL); F.XB = (bf16*)(ws + WS_XB); F.SS = (float*)(ws + WS_SS); \
    bf16* const WB = (bf16*)(ws + WS_W); unsigned char* const AR = ws + WS_ARENA; float* const COS = (float*)(ws + WS_COS); float* const SIN = (float*)(ws + WS_SIN); float* const SSQ = (float*)(ws + WS_SSQ); float* const SSKV = (float*)(ws + WS_SSKV); (void)WB; (void)AR; (void)COS; (void)SIN; (void)SSQ; (void)SSKV;
#define PH_END(id) } if (ph + 1 < hi) GRID_BAR(); ST_END(id) } ++ph;

#ifdef DUMP
    if (lo == 1000) { unsigned char* ws = args.ws; unsigned char* const AR = ws + WS_ARENA; F.X = args.out; F.lane = fresh_lane();
#define HX ((bf16*)(AR + A_HX))
#define RKV ((bf16*)(AR + A_RKV))
#define LOR ((bf16*)(AR + A_LOR))
#define LW ((float*)(AR + A_LW))
#define AA ((bf16*)(AR + A_AAZ))
#define GG ((bf16*)(AR + A_GG))
#define YG ((bf16*)(AR + A_YG))
        for (int e = F.gw * 64 + F.lane; e < T * 1024; e += F.NGW * 64) { const int t = e >> 10, c = e & 1023; float v = 0.f;
            if (DUMP == 1) v = bf1(HX[(size_t)t * 2048 + c]) + bf1(HX[(size_t)t * 2048 + 1024 + c]);
            if (DUMP == 2) v = bf1(RKV[(size_t)t * 3072 + c]) + bf1(RKV[(size_t)t * 3072 + 1024 + c]) + bf1(RKV[(size_t)t * 3072 + 2048 + c]) + bf1(LOR[(size_t)t * 256 + (c & 255)]);
            if (DUMP == 3) v = LW[(size_t)t * 1024 + c] + bf1(AA[(size_t)t * 1024 + c]) + bf1(GG[(size_t)t * 1024 + c]);
            if (DUMP == 4) v = bf1(YG[(size_t)t * 1024 + c]);
            if (DUMP == 5) v = ((size_t)e < (size_t)3328 * 2048) ? bf1(((const bf16*)(ws + WS_W))[WR_BIG + e]) : 0.f;
            F.X[e] = v; }
#undef HX
#undef RKV
#undef LOR
#undef LW
#undef AA
#undef GG
#undef YG
        return; }
#endif
#pragma unroll
    for (int s = 0; s < 2 * DEPTH; ++s) {
        const int layer = s >> 1, half = s & 1, kind = layer % 3, j = layer / 3;
        int hide_ = args.hide; asm volatile("" : "+s"(hide_));
        const bool pre = (layer >= 1 && (layer - 1) % 3 == 2) && hide_ != 0;
        if (half == 0) {
            if (!pre) {
            PH_BEGIN(0)
                if (layer == 0) prologue(F, in);
                conv_layer(F, in, layer, F.gw, F.NGW, false);
            PH_END(0)
            }
        } else if (kind == 0) {
#define LAT ((bf16*)(AR + A_LAT))
#define Q ((bf16*)(AR + A_Q))
#define KV ((bf16*)(AR + A_KV))
#define O ((bf16*)(AR + A_O))
#define KPE ((bf16*)(AR + A_KPE))
            PH_BEGIN(1)
                int g_ = F.G; asm volatile("" : "+s"(g_)); const bool staged = (g_ == 256); if (staged) stage_rstd(F, F.SS);
                EpiMlaA E{F.SS, LAT, SSQ, SSKV, KPE, COS, SIN, staged ? (const LAS float*)(F.lds + RSTD_LDS_OFF) : nullptr, ((int)blockIdx.x & 7) * 2048};
                run_gemm(F, F.XB, D, WB + WM_A, 1024, 1024, 1024, E);
            PH_END(1)
            PH_BEGIN(2)
                { EpiMlaQ E{SSQ, Q, COS, SIN, 0.07216878364870322f * 1.4426950408889634f};
                  run_gemm_tail(F, LAT, 1024, WB + WM_QB, 512, 1536, 512, E, 256); }
                { EpiMlaKV E{SSKV, KV};
                  run_gemm(F, LAT + 512, 1024, WB + WM_KVB, 256, 2048, 256, E); }
            PH_END(2)
            PH_BEGIN(3)
                for (int it = (int)blockIdx.x; it < BATCH * MLA_H * 16; it += F.G) { const int bh = it >> 4, xq = it & 15;
                    att::attn_unit(F.wave, bh >> 3, bh & 7, xq, Q, KV, KPE, O, (LAS char*)F.lds);
                    att::attn_unit(F.wave, bh >> 3, bh & 7, 31 - xq, Q, KV, KPE, O, (LAS char*)F.lds); }
            PH_END(3)
            PH_BEGIN(4)
                EpiResidual E{F.X, F.XB, F.SS, REP_LAST ? 1.0f : 0.f};
                run_gemm(F, O, 1024, WB + WM_O, 1024, 1024, 1024, E);
            PH_END(4)
        } else if (kind == 1) {
#define P ((bf16*)(AR + A_P))
#define GATES ((float*)(AR + A_GATES))
#define HM ((bf16*)(AR + A_HM))
            PH_BEGIN(5)
                int g_ = F.G; asm volatile("" : "+s"(g_)); const bool staged = (g_ == 256); if (staged) stage_rstd(F, F.SS);
                EpiMlIn E{F.SS, P, GATES, staged ? (const LAS float*)(F.lds + RSTD_LDS_OFF) : nullptr, ((int)blockIdx.x & 7) * 2048};
                run_gemm_tail(F, F.XB, D, WB + WL_IN, 1024, 3328, 1024, E, 768);
            PH_END(5)
            PH_BEGIN(6)
                mlc::conv_phase(F, in, j);
            PH_END(6)
            PH_BEGIN(7)
                mlc::xa_phase(F);
            PH_END(7)
            PH_BEGIN(8)
                mlc::xb_phase(F);
            PH_END(8)
            PH_BEGIN(19)
                mlc::xc_phase(F, in, j);
            PH_END(19)
            PH_BEGIN(9)
                EpiResidual E{F.X, F.XB, F.SS, REP_LAST ? 1.0f : 0.f};
                run_gemm(F, (bf16*)(AR + mlc::A_HM2), 1024, WB + WL_O, 1024, 1024, 1024, E);
            PH_END(9)
        } else {
#define HX ((bf16*)(AR + A_HX))
#define RKV ((bf16*)(AR + A_RKV))
#define LOR ((bf16*)(AR + A_LOR))
#define LW ((float*)(AR + A_LW))
#define AA ((bf16*)(AR + A_AAZ))
#define GG ((bf16*)(AR + A_GG))
#define YG ((bf16*)(AR + A_YG))
            PH_BEGIN(10)
                rw_shift_phase(F, in, j);
            PH_END(10)
            PH_BEGIN(11)
                { EpiRwBig E{RKV, LOR, 0}; pg8::Gemm g{HX, WB + WR_BIG, T, 3072, 1024, 4096, 1024, F.wave}; RwOrder S; S.S.init(T, 3072, F.G, (int)blockIdx.x);
                  pg8::gemm_phase<EpiRwBig, RwOrder, true, true>(F.lds, g, S, E); }
                { EpiRwBig E{RKV, LOR, 12}; pg8::Gemm g{HX + 2048, WB + WR_LORA, T, 256, 2048, 4096, 2048, F.wave}; pg8::StaticOrder S; S.init(T, 256, F.G, (int)blockIdx.x);
                  int g_ = F.G; asm volatile("" : "+s"(g_));
                  if (g_ == 256) { pg8::TailOrder TO{S, 0}; pg8::gemm_phase<EpiRwBig, pg8::TailOrder, true, true, true>(F.lds, g, TO, E); }
                  else pg8::gemm_phase<EpiRwBig, pg8::StaticOrder, true, true>(F.lds, g, S, E); }
            PH_END(11)
            PH_BEGIN(12)
                EpiRwUp E{LW, AA, GG, in.rw_w0 + (size_t)j * 1024, in.rw_a0 + (size_t)j * 1024};
                run_gemm(F, LOR, 256, WB + WR_UP, 256, 3072, 256, E);
            PH_END(12)
            PH_BEGIN(13)
                rwc::ra_phase(F, in, j);
            PH_END(13)
            PH_BEGIN(14)
                if (hide_ != 0 && layer + 1 < DEPTH && (int)blockIdx.x >= BATCH * RW_H * 4) conv_layer(F, in, layer + 1, ((int)blockIdx.x - BATCH * RW_H * 4) * NWAVES + F.wave, (F.G - BATCH * RW_H * 4) * NWAVES, true);
                else rwc::rb_phase(F);
            PH_END(14)
            PH_BEGIN(20)
                rwc::rc_phase(F, in, j);
            PH_END(20)
            PH_BEGIN(15)
                EpiResidual E{F.X, F.XB, F.SS, REP_LAST ? 1.0f : 0.f};
                run_gemm(F, YG, 1024, WB + WR_O, 1024, 1024, 1024, E);
            PH_END(15)
        }
#define ACT ((bf16*)(AR + A_ACT))
        PH_BEGIN(16)
            { int g_ = F.G; asm volatile("" : "+s"(g_)); const bool staged = (g_ == 256); if (staged) stage_rstd(F, F.SS);
              EpiSwiGLU E{F.SS, ACT, staged ? (const LAS float*)(F.lds + RSTD_LDS_OFF) : nullptr, ((int)blockIdx.x & 7) * 2048};
              pg8::Gemm g{F.XB, WB + (half ? (pre ? WO_GU1A : WO_GU1) : WO_GU0), T, 2 * FF, D, D, D, F.wave}; pg8::StaticOrder S; S.init(T, 2 * FF, F.G, (int)blockIdx.x);
              const bool tail = staged;
              if (tail) S.lim = 5 * 256;
              pg8::gemm_phase<EpiSwiGLU, pg8::StaticOrder, true, true>(F.lds, g, S, E);
              if (tail) { pg8::TailOrder TO{S, 5 * 256}; pg8::gemm_phase<EpiSwiGLU, pg8::TailOrder, true, true, true>(F.lds, g, TO, E); } }
        PH_END(16)
        PH_BEGIN(17)
            EpiResidual E{F.X, F.XB, F.SS, REP_LAST ? 0.5f : 0.f};
            run_gemm(F, ACT, FF, WB + (half ? (pre ? WO_D1A : WO_D1) : WO_D0), FF, D, FF, E);
        PH_END(17)
    }
    PH_BEGIN(18)
        final_norm_phase(F, in);
    PH_END(18)
}

extern "C" void kernel_launch(void* const* d_in, const int* in_sizes, int n_in, void* d_out, int out_size, void* d_ws, size_t ws_size, hipStream_t stream) {
    static int grid = 0;
    if (grid == 0) {
        if (n_in != 38 || in_sizes[0] != T * D || out_size != T * D || ws_size < WS_END) { fprintf(stderr, "kernel_launch: unexpected shapes (n_in %d, in0 %d, out %d, ws %zu)\n", n_in, n_in > 0 ? in_sizes[0] : -1, out_size, ws_size); grid = -1; return; }
        int dev = 0, cus = 0, per_cu = 0;
        if (hipGetDevice(&dev) != hipSuccess || hipDeviceGetAttribute(&cus, hipDeviceAttributeMultiprocessorCount, dev) != hipSuccess) { grid = -1; return; }
        if (hipFuncSetAttribute((const void*)fwd, hipFuncAttributeMaxDynamicSharedMemorySize, LDS_BYTES) != hipSuccess) { fprintf(stderr, "kernel_launch: hipFuncSetAttribute failed\n"); grid = -1; return; }
        if (hipOccupancyMaxActiveBlocksPerMultiprocessor(&per_cu, (const void*)fwd, NWAVES * 64, LDS_BYTES) != hipSuccess || per_cu < 1)
            fprintf(stderr, "kernel_launch: occupancy query reports %d workgroups per CU\n", per_cu);
        (void)hipGetLastError();
        grid = cus;
    }
    if (grid < 0) return;
    if (hipMemsetAsync((char*)d_ws + WS_CTL, 0, CTL_ZERO_BYTES, stream) != hipSuccess) return;
    Args a{};
    const void** ip = (const void**)&a.in;
    for (int i = 0; i < 38; ++i) ip[i] = d_in[i];
    a.out = (float*)d_out; a.ws = (unsigned char*)d_ws;
    a.hide = (grid == 256 && ws_size >= WS_END_ALT && DEPTH == 4) ? 1 : 0;
#if MK_ONE_LAUNCH
    a.ph_lo = 0; a.ph_hi = NPH - a.hide;
    hipLaunchKernelGGL(fwd, dim3(grid), dim3(NWAVES * 64), LDS_BYTES, stream, a);
#else
#ifdef DUMP
    for (int p = 0; p <= DUMP_LAST; ++p) { a.ph_lo = p; a.ph_hi = p + 1;
        hipLaunchKernelGGL(fwd, dim3(grid), dim3(NWAVES * 64), LDS_BYTES, stream, a); }
    a.ph_lo = 1000; a.ph_hi = 1001;
    hipLaunchKernelGGL(fwd, dim3(grid), dim3(NWAVES * 64), LDS_BYTES, stream, a);
#else
    for (int p = 0; p < NPH; ++p) { a.ph_lo = p; a.ph_hi = p + 1;
        hipLaunchKernelGGL(fwd, dim3(grid), dim3(NWAVES * 64), LDS_BYTES, stream, a); }
#endif
#endif
}
```

```cpp
#include <hip/hip_runtime.h>
#include <cstdio>
#include <cstdint>

__device__ __forceinline__ int fresh_lane() { int l; asm volatile("v_mbcnt_lo_u32_b32 %0, -1, 0\n\tv_mbcnt_hi_u32_b32 %0, -1, %0" : "=v"(l)); return l; }
namespace pg8 {
#define PG8_LAS __attribute__((address_space(3)))
typedef unsigned short bf16_t;
typedef short bf16x8 __attribute__((ext_vector_type(8)));
typedef float f32x4 __attribute__((ext_vector_type(4)));
typedef unsigned u32x4 __attribute__((ext_vector_type(4)));
typedef unsigned u32x2 __attribute__((ext_vector_type(2)));
constexpr int BM = 256, BK = 64, HALF = 128, HTB = HALF * BK * 2  , STAGE_BYTES = 8 * HTB, NXCD = 8, WGM = 8;

__host__ __device__ __forceinline__ int lds_byte(int r, int c) { const int st = (r >> 4) * 2 + (c >> 5), rr = r & 15, cc = c & 31, ob = rr * 64 + cc * 2; return st * 1024 + (ob ^ (((ob >> 9) & 1) << 5)); }
__host__ __device__ __forceinline__ void stage_rc(int b, int& R, int& C) { const int st = b / 1024, sb = b % 1024, swz = sb ^ (((sb >> 9) & 1) << 5); R = (st >> 1) * 16 + swz / 64; C = (st & 1) * 32 + (swz % 64) / 2; }
__host__ __device__ __forceinline__ int perm32(int rho) { const int n = rho >> 4, i = rho & 15; return 8 * (i >> 2) + 4 * n + (i & 3); }

struct Unit { int pm, pn, roff, nai, acol; };
struct Gemm { const bf16_t* A; const bf16_t* Bt; int M, N, K, lda, ldb, wave; };

struct StaticOrder {
    int nM, nN, nwg, G, c, lim;
    __host__ __device__ void init(int M, int N, int G_, int c_) { nM = M / BM; nN = N / BM; nwg = nM * nN; G = G_; c = c_; lim = nwg; }
    __host__ __device__ bool next(int i, Unit& u) const {
        const long L = (long)i * G + c; if (L >= lim) return false;
        u.roff = 0; u.nai = 2; u.acol = 0;
        int wgid = (int)L; { const int q = nwg / NXCD, r = nwg % NXCD, xcd = wgid % NXCD, off = wgid / NXCD; wgid = (xcd < r ? xcd * (q + 1) : r * (q + 1) + (xcd - r) * q) + off; }
        const int nig = WGM * nN, gid = wgid / nig, fm = gid * WGM, gsz = (nM - fm) < WGM ? (nM - fm) : WGM;
        u.pm = fm + ((wgid % nig) % gsz); u.pn = (wgid % nig) / gsz; return true;
    }
    __host__ __device__ bool post(Unit& u) const { if (lim >= nwg) return false; const int L = lim + 8 * ((c >> 3) >> 1) + (c & 7); if (L >= nwg) return false;
        StaticOrder T = *this; T.c = L % G; T.lim = nwg; const bool ok = T.next(L / G, u); u.roff = ((c >> 3) & 1) * 128; u.nai = 1; return ok; }
    __device__ __forceinline__ void a_ready(const Unit&) const {}
    __device__ __forceinline__ void done(const Unit&) const {}
};
struct TailOrder { StaticOrder S; int lim0;
    __host__ __device__ bool next(int i, Unit& u) const { if (i > 0) return false; const int L = lim0 + 8 * ((S.c >> 3) >> 1) + (S.c & 7); if (L >= S.nwg) return false;
        StaticOrder T = S; T.c = L % S.G; T.lim = S.nwg; const bool ok = T.next(L / S.G, u); u.roff = ((S.c >> 3) & 1) * 128; u.nai = 1; return ok; }
    __host__ __device__ bool post(Unit&) const { return false; }
    __device__ __forceinline__ void a_ready(const Unit&) const {}
    __device__ __forceinline__ void done(const Unit&) const {}
};

struct NoPre { __device__ __forceinline__ void operator()(PG8_LAS unsigned char*, int) const {} };
template <class Epi, class Sched, bool ALIGN_EPI = false, bool SP2 = false, bool HALFM = false, class Pre = NoPre, bool PRELOADED = false>
__device__ __forceinline__ void gemm_phase(PG8_LAS unsigned char* lds, const Gemm g, const Sched& S, const Epi& E, const Pre pre = Pre()) {
    const int wid = g.wave; const int tid = wid * 64 + fresh_lane(), lane = tid & 63, wr = wid >> 2, wc = wid & 3, fr = lane & 15, fq = lane >> 4;
    const int K = g.K, nt = K / BK;
    unsigned voffA[2], voffB[2];
#pragma unroll
    for (int i = 0; i < 2; ++i) { int R, C; stage_rc(tid * 16 + i * 8192, R, C); const int Rb = Epi::PERM ? ((R & ~31) + perm32(R & 31)) : R;
        voffA[i] = (unsigned)(R * g.lda + C) * 2u; voffB[i] = (unsigned)(Rb * g.ldb + C) * 2u; }
    const size_t kstep = (size_t)(BK * 2);
    const size_t hstepA = (size_t)HALF * g.lda * 2, hstepB = (size_t)HALF * g.ldb * 2;
    const size_t tstepA = 2 * hstepA, tstepB = 2 * hstepB;
    const unsigned ldsw = (unsigned)wid * 1024u;
    const int aoff = lds_byte(wr * 64 + fr, fq * 8), boff = lds_byte(wc * 32 + fr, fq * 8);
#define PG8_SA(b, h) (((b) * 2 + (h)) * HTB)
#define PG8_SB(b, h) ((4 + (b) * 2 + (h)) * HTB)
#define PG8_STAGE(bufoff, gbase, voff) do { _Pragma("unroll") for (int _i = 0; _i < 2; ++_i) \
        __builtin_amdgcn_global_load_lds((const unsigned*)((const char*)(gbase) + (voff)[_i]), (PG8_LAS unsigned*)(lds + (bufoff) + ldsw + _i * 8192), 16, 0, 0); } while (0)
#define PG8_LDA(dst, b, h) do { _Pragma("unroll") for (int m = 0; m < 4; ++m) _Pragma("unroll") for (int k = 0; k < 2; ++k) dst[m][k] = *(const PG8_LAS bf16x8*)(lds + PG8_SA(b, h) + aoff + m * 2048 + k * 1024); } while (0)
#define PG8_LDB(dst, b, h) do { _Pragma("unroll") for (int n = 0; n < 2; ++n) _Pragma("unroll") for (int k = 0; k < 2; ++k) dst[n][k] = *(const PG8_LAS bf16x8*)(lds + PG8_SB(b, h) + boff + n * 2048 + k * 1024); } while (0)
#define PG8_MMA(ai, bj, At, Bt) do { __builtin_amdgcn_s_setprio(1); _Pragma("unroll") for (int m = 0; m < 4; ++m) _Pragma("unroll") for (int n = 0; n < 2; ++n) _Pragma("unroll") for (int k = 0; k < 2; ++k) \
        acc[ai][bj][m][n] = __builtin_amdgcn_mfma_f32_16x16x32_bf16(Bt[n][k], At[m][k], acc[ai][bj][m][n], 0, 0, 0); __builtin_amdgcn_s_setprio(0); } while (0)
#define PG8_WAIT_V(n) asm volatile("s_waitcnt vmcnt(" #n ")" ::: "memory")
#define PG8_WAIT_L(n) asm volatile("s_waitcnt lgkmcnt(" #n ")" ::: "memory")
#define PG8_BAR __builtin_amdgcn_s_barrier()
#define PG8_SCHED __builtin_amdgcn_sched_barrier(0)
    Unit cur, nxt; int ui = 0;
    if (!S.next(0, cur)) return;
    f32x4 acc[2][2][4][2];
#pragma unroll
    for (int a = 0; a < 2; ++a)
#pragma unroll
        for (int b = 0; b < 2; ++b)
#pragma unroll
            for (int m = 0; m < 4; ++m)
#pragma unroll
                for (int n = 0; n < 2; ++n) acc[a][b][m][n] = (f32x4){0.f, 0.f, 0.f, 0.f};
    bf16x8 At[4][2], B0[2][2], B1[2][2];
    const char* cA = (const char*)g.A + (size_t)cur.pm * tstepA + (size_t)cur.roff * (size_t)g.lda * 2 + (size_t)cur.acol * 2; const char* cB = (const char*)g.Bt + (size_t)cur.pn * tstepB;
    S.a_ready(cur);
    if constexpr (SP2) {
        if constexpr (!PRELOADED) { PG8_STAGE(PG8_SB(0, 0), cB, voffB); PG8_STAGE(PG8_SB(0, 1), cB + hstepB, voffB); PG8_STAGE(PG8_SA(0, 0), cA, voffA); PG8_STAGE(PG8_SA(0, 1), cA + hstepA, voffA); }
        PG8_SCHED; pre(lds, tid); PG8_SCHED;
        if (wr == 1) PG8_BAR;
        PG8_WAIT_V(2); PG8_BAR;
        if constexpr (!PRELOADED) { PG8_STAGE(PG8_SB(1, 0), cB + kstep, voffB); PG8_STAGE(PG8_SA(1, 0), cA + kstep, voffA); PG8_STAGE(PG8_SB(1, 1), cB + hstepB + kstep, voffB); }
        PG8_WAIT_V(6); PG8_BAR;
    } else {
        PG8_STAGE(PG8_SB(0, 0), cB, voffB); PG8_STAGE(PG8_SA(0, 0), cA, voffA); PG8_STAGE(PG8_SB(0, 1), cB + hstepB, voffB); PG8_STAGE(PG8_SA(0, 1), cA + hstepA, voffA);
        if (wr == 1) PG8_BAR;
        PG8_WAIT_V(4); PG8_BAR;
        PG8_STAGE(PG8_SB(1, 0), cB + kstep, voffB); PG8_STAGE(PG8_SA(1, 0), cA + kstep, voffA); PG8_STAGE(PG8_SB(1, 1), cB + hstepB + kstep, voffB);
        PG8_WAIT_V(6); PG8_BAR;
    }
    for (;;) {
        const bool has_next = S.next(ui + 1, nxt);
        bool hn = has_next; if (!has_next) hn = S.post(nxt);
        const char* nA = hn ? (const char*)g.A + (size_t)nxt.pm * tstepA + (size_t)nxt.roff * (size_t)g.lda * 2 + (size_t)nxt.acol * 2 : cA; const char* nB = hn ? (const char*)g.Bt + (size_t)nxt.pn * tstepB : cB;
#pragma nounroll
        for (int t = 0; t < nt; t += 2) {
            const bool last = (t == nt - 2);
            const char* a1 = cA + (size_t)(t + 1) * kstep;
            const char* a2 = last ? nA : cA + (size_t)(t + 2) * kstep; const char* b2 = last ? nB : cB + (size_t)(t + 2) * kstep;
            const char* a3 = a2 + kstep; const char* b3 = b2 + kstep;
            if (last && has_next) S.a_ready(nxt);
            if constexpr (SP2) {
            PG8_LDB(B0, 0, 0); PG8_LDB(B1, 0, 1); PG8_SCHED; PG8_LDA(At, 0, 0); PG8_STAGE(PG8_SA(1, 1), a1 + hstepA, voffA);
            PG8_WAIT_V(8); PG8_WAIT_L(0); PG8_BAR; PG8_MMA(0, 0, At, B0); PG8_MMA(0, 1, At, B1); PG8_BAR; PG8_SCHED;
            if constexpr (!HALFM) PG8_LDA(At, 0, 1); PG8_STAGE(PG8_SB(0, 0), b2, voffB); PG8_STAGE(PG8_SB(0, 1), b2 + hstepB, voffB); PG8_STAGE(PG8_SA(0, 0), a2, voffA);
            PG8_WAIT_V(8); PG8_WAIT_L(0); PG8_BAR; if constexpr (!HALFM) { PG8_MMA(1, 0, At, B0); PG8_MMA(1, 1, At, B1); } PG8_BAR; PG8_SCHED;
            PG8_LDB(B0, 1, 0); PG8_LDB(B1, 1, 1); PG8_SCHED; PG8_LDA(At, 1, 0); PG8_STAGE(PG8_SA(0, 1), a2 + hstepA, voffA);
            PG8_WAIT_V(8); PG8_WAIT_L(0); PG8_BAR; PG8_MMA(0, 0, At, B0); PG8_MMA(0, 1, At, B1); PG8_BAR; PG8_SCHED;
            if constexpr (!HALFM) PG8_LDA(At, 1, 1); PG8_STAGE(PG8_SB(1, 0), b3, voffB); PG8_STAGE(PG8_SB(1, 1), b3 + hstepB, voffB); PG8_STAGE(PG8_SA(1, 0), a3, voffA);
            PG8_WAIT_V(8); PG8_WAIT_L(0); PG8_BAR; if constexpr (!HALFM) { PG8_MMA(1, 0, At, B0); PG8_MMA(1, 1, At, B1); } PG8_BAR; PG8_SCHED;
            } else {
            PG8_LDB(B0, 0, 0); PG8_SCHED; PG8_LDA(At, 0, 0); PG8_STAGE(PG8_SA(1, 1), a1 + hstepA, voffA);
            PG8_WAIT_L(8); PG8_BAR; PG8_WAIT_L(0); PG8_MMA(0, 0, At, B0); PG8_BAR; PG8_SCHED;
            PG8_LDB(B1, 0, 1); PG8_STAGE(PG8_SB(0, 0), b2, voffB);
            PG8_BAR; PG8_WAIT_L(0); PG8_MMA(0, 1, At, B1); PG8_BAR;
            PG8_LDA(At, 0, 1); PG8_STAGE(PG8_SA(0, 0), a2, voffA);
            PG8_BAR; PG8_WAIT_L(0); PG8_MMA(1, 0, At, B0); PG8_BAR; PG8_SCHED;
            PG8_STAGE(PG8_SB(0, 1), b2 + hstepB, voffB);
            PG8_WAIT_V(6); PG8_BAR; PG8_MMA(1, 1, At, B1); PG8_BAR;
            PG8_LDB(B0, 1, 0); PG8_SCHED; PG8_LDA(At, 1, 0); PG8_STAGE(PG8_SA(0, 1), a2 + hstepA, voffA);
            PG8_WAIT_L(8); PG8_BAR; PG8_WAIT_L(0); PG8_MMA(0, 0, At, B0); PG8_BAR; PG8_SCHED;
            PG8_LDB(B1, 1, 1); PG8_STAGE(PG8_SB(1, 0), b3, voffB);
            PG8_BAR; PG8_WAIT_L(0); PG8_MMA(0, 1, At, B1); PG8_BAR;
            PG8_LDA(At, 1, 1); PG8_STAGE(PG8_SA(1, 0), a3, voffA);
            PG8_BAR; PG8_WAIT_L(0); PG8_MMA(1, 0, At, B0); PG8_BAR; PG8_SCHED;
            PG8_STAGE(PG8_SB(1, 1), b3 + hstepB, voffB);
            PG8_WAIT_V(6); PG8_BAR; PG8_MMA(1, 1, At, B1); PG8_BAR;
            }
        }
        if constexpr (ALIGN_EPI) { if (wr == 0) PG8_BAR; }
        if constexpr (!Epi::AFTER_DRAIN) { E(acc, cur, wr, wc, fr, fq); S.done(cur); }
        if (!has_next) break;
#pragma unroll
        for (int a = 0; a < 2; ++a)
#pragma unroll
            for (int b = 0; b < 2; ++b)
#pragma unroll
                for (int m = 0; m < 4; ++m)
#pragma unroll
                    for (int n = 0; n < 2; ++n) acc[a][b][m][n] = (f32x4){0.f, 0.f, 0.f, 0.f};
        cur = nxt; cA = nA; cB = nB; ++ui;
        if constexpr (ALIGN_EPI) { if (wr == 1) PG8_BAR; }
    }
    PG8_WAIT_V(0);
    if constexpr (!ALIGN_EPI) { if (wr == 0) PG8_BAR; }
    PG8_BAR;
    if constexpr (Epi::AFTER_DRAIN) { E.fused(acc, cur, wr, wc, fr, fq, lds, wid, lane); S.done(cur); }
#undef PG8_SA
#undef PG8_SB
#undef PG8_STAGE
#undef PG8_LDA
#undef PG8_LDB
#undef PG8_MMA
#undef PG8_WAIT_V
#undef PG8_WAIT_L
#undef PG8_BAR
#undef PG8_SCHED
}
}

constexpr int NWAVES = 8;
constexpr int BATCH = 2, SEQ = 8192, D = 1024, T = BATCH * SEQ, FF = 2816, DEPTH = 4;
constexpr float RMS_EPS = 1e-6f;
constexpr int MLA_H = 8, QRANK = 512, KVRANK = 256, NOPE = 128, ROPE = 64, DVH = 128, DQK = NOPE + ROPE;
constexpr int LATN = QRANK + KVRANK + ROPE;
constexpr int ML_H = 8, ML_DK = 64, ML_DV = 128, ML_NIN = 3088;
constexpr int RW_H = 16, RW_N = 64;

constexpr size_t MiB = 1u << 20;
constexpr size_t WS_CTL = 0, CTL_ZERO_BYTES = 1 * MiB;
constexpr size_t WS_COS = 1 * MiB, WS_SIN = 3 * MiB;
constexpr size_t WS_SS = 5 * MiB;
constexpr size_t WS_SSQ = 6 * MiB;
constexpr size_t WS_SSKV = 6 * MiB + 512 * 1024;
constexpr size_t WS_W = 8 * MiB;
constexpr size_t WS_XB = 68 * MiB;
constexpr size_t WS_ARENA = 100 * MiB;
constexpr size_t WS_END = 352 * MiB;
constexpr size_t WS_ALT = 352 * MiB, WS_END_ALT = WS_ALT + 17 * MiB;
constexpr size_t WO_GU0 = 0, WO_D0 = WO_GU0 + (size_t)2 * FF * D, WO_GU1 = WO_D0 + (size_t)D * FF, WO_D1 = WO_GU1 + (size_t)2 * FF * D, WO_MIX = WO_D1 + (size_t)D * FF;
constexpr size_t WO_GU1A = (WS_ALT - WS_W) / 2, WO_D1A = WO_GU1A + (size_t)2 * FF * D;
constexpr size_t WM_A = WO_MIX, WM_QB = WM_A + (size_t)1024 * 1024, WM_KVB = WM_QB + (size_t)1536 * 512, WM_O = WM_KVB + (size_t)2048 * 256;
constexpr size_t WL_IN = WO_MIX, WL_O = WL_IN + (size_t)3328 * 1024;
constexpr size_t WR_BIG = WO_MIX  , WR_LORA = WR_BIG + (size_t)3072 * 1024  , WR_UP = WR_LORA + (size_t)256 * 2048, WR_O = WR_UP + (size_t)3072 * 256;
static_assert((WR_O + (size_t)1024 * 1024) * 2 <= 60 * MiB, "weight region");
constexpr size_t A_ACT = 0;
constexpr size_t A_LAT = 0, A_Q = 32 * MiB, A_KV = 80 * MiB, A_O = 144 * MiB, A_KPE = 176 * MiB;
constexpr size_t A_P = 0, A_GATES = 96 * MiB, A_QKC = 97 * MiB, A_IGLF = 161 * MiB, A_HRAW = 162 * MiB, A_HM = A_QKC;
constexpr size_t A_HX = 0, A_RKV = 128 * MiB, A_LOR = 224 * MiB, A_LW = 0, A_GG = 64 * MiB, A_YG = A_GG  , A_AAZ = 96 * MiB  ;
static_assert(WS_ARENA + A_HRAW + (size_t)T * 1024 * 4 <= WS_END && WS_ARENA + A_YG + (size_t)T * 1024 * 2 <= WS_END && WS_ARENA + A_KPE + (size_t)T * 64 * 2 <= WS_END, "arena");

constexpr int CW_TMO = 0, CW_CODE = 1, CW_BAR = 4096, CW_Q = 8192;
constexpr size_t WS_PTRS = 512 * 1024;

constexpr int RING_BYTES = 131072;
constexpr int LDSCTL_OFF = 146432, MISC_OFF = LDSCTL_OFF + 320;
constexpr int LDS_BYTES = 147456;

#define GAS __attribute__((address_space(1)))
#define LAS __attribute__((address_space(3)))
typedef unsigned short bf16;
typedef unsigned v4u __attribute__((ext_vector_type(4)));
typedef unsigned v2u __attribute__((ext_vector_type(2)));
typedef float f32x4 __attribute__((ext_vector_type(4)));
typedef float f32x16 __attribute__((ext_vector_type(16)));
typedef short bf16x8 __attribute__((ext_vector_type(8)));
typedef short s16x4 __attribute__((ext_vector_type(4)));
typedef GAS unsigned gu32;
#define RLX_AGENT __ATOMIC_RELAXED, __HIP_MEMORY_SCOPE_AGENT
#define LDS_WAIT() asm volatile("s_waitcnt lgkmcnt(0)" ::: "memory")
#define VM_WAIT() asm volatile("s_waitcnt vmcnt(0)" ::: "memory")
typedef float f32x2_t __attribute__((ext_vector_type(2))); typedef __bf16 bf16x2_t __attribute__((ext_vector_type(2)));
__device__ __forceinline__ unsigned cvtpk(float lo, float hi) { f32x2_t v = {lo, hi}; bf16x2_t b = __builtin_convertvector(v, bf16x2_t); return __builtin_bit_cast(unsigned, b); }
__device__ __forceinline__ float bf_lo(unsigned w) { return __builtin_bit_cast(float, w << 16); }
__device__ __forceinline__ float bf_hi(unsigned w) { return __builtin_bit_cast(float, w & 0xffff0000u); }
__device__ __forceinline__ float bf1(bf16 h) { return __builtin_bit_cast(float, (unsigned)h << 16); }
__device__ __forceinline__ v4u pack8f(const float* v) { v4u w; w.x = cvtpk(v[0], v[1]); w.y = cvtpk(v[2], v[3]); w.z = cvtpk(v[4], v[5]); w.w = cvtpk(v[6], v[7]); return w; }
__device__ __forceinline__ v4u pack8v(f32x4 a, f32x4 b) { v4u w; w.x = cvtpk(a[0], a[1]); w.y = cvtpk(a[2], a[3]); w.z = cvtpk(b[0], b[1]); w.w = cvtpk(b[2], b[3]); return w; }
__device__ __forceinline__ void unpack8(v4u w, float* v) { v[0] = bf_lo(w.x); v[1] = bf_hi(w.x); v[2] = bf_lo(w.y); v[3] = bf_hi(w.y); v[4] = bf_lo(w.z); v[5] = bf_hi(w.z); v[6] = bf_lo(w.w); v[7] = bf_hi(w.w); }
__device__ __forceinline__ float fexp(float x) { return __builtin_amdgcn_exp2f(x * 1.4426950408889634f); }
__device__ __forceinline__ float frcp(float x) { return __builtin_amdgcn_rcpf(x); }
__device__ __forceinline__ float flog(float x) { return __builtin_amdgcn_logf(x) * 0.6931471805599453f; }
__device__ __forceinline__ float ftanh(float x) { const float t = fexp(-2.f * fabsf(x)); const float r = (1.f - t) * frcp(1.f + t); return x < 0.f ? -r : r; }
__device__ __forceinline__ float fsigmoid(float x) { return frcp(1.f + fexp(-x)); }
__device__ __forceinline__ float frsq(float x) { return __builtin_amdgcn_rsqf(x); }
__device__ __forceinline__ float fsqrt(float x) { return __builtin_amdgcn_sqrtf(x); }
__device__ __forceinline__ void fsincos_big(float a, float& s, float& c) {
    const float k = __builtin_rintf(a * 0.15915494309189535f);
    float r = __builtin_fmaf(-k, 6.28125f, a); r = __builtin_fmaf(-k, 1.9353071795864769e-3f, r);
    const float rev = r * 0.15915494309189535f;
    s = __builtin_amdgcn_sinf(rev); c = __builtin_amdgcn_cosf(rev);
}
__device__ __forceinline__ float fsilu(float x) { return x * frcp(1.f + fexp(-x)); }
__device__ __forceinline__ float wave_sum(float v) {
#pragma unroll
    for (int o = 1; o < 64; o <<= 1) v += __shfl_xor(v, o);
    return v;
}

#define XB_TMO      128
#define XB_XCNT(j)  (256  + 64 * (j))
#define XB_XSUB(j)  (1280 + 64 * (j))
#define XB_XGEN(j)  (2304 + 64 * (j))
#define XB_TOP      3328
#define XB_TOPGEN   3392
#define XCD_BAR_WORDS 3456
#define XB_SPIN_CAP (1u << 18)

__device__ __forceinline__ unsigned xb_ld(unsigned* p)              { return __hip_atomic_load(p, __ATOMIC_RELAXED, __HIP_MEMORY_SCOPE_AGENT); }
__device__ __forceinline__ unsigned xb_add(unsigned* p, unsigned v) { return __hip_atomic_fetch_add(p, v, __ATOMIC_RELAXED, __HIP_MEMORY_SCOPE_AGENT); }
__device__ __forceinline__ unsigned xb_xcc_id() { return (unsigned)__builtin_amdgcn_s_getreg((3 << 11) | 20) & 0xFu; }
#define XB_SPIN(cond, bar) do { unsigned _sp = 0; while (cond) { __builtin_amdgcn_s_sleep(1); \
    if ((++_sp & 255u) == 0u) { if (xb_ld(&(bar)[XB_TMO])) break; if (_sp > XB_SPIN_CAP) { atomicAdd(&(bar)[XB_TMO], 1u); break; } } } } while (0)

struct XcdBarrier {
    unsigned* bar; unsigned x;
    volatile LAS unsigned* st;
};

__device__ __forceinline__ XcdBarrier xcd_barrier_post(unsigned* bar, volatile LAS unsigned* st) {
    XcdBarrier b; b.bar = bar; b.x = xb_xcc_id(); b.st = st;
    if (threadIdx.x == 0) (void)xb_add(&bar[XB_XCNT(b.x)], 1u);
    return b;
}
__device__ __forceinline__ void xcd_barrier_complete(unsigned* bar, unsigned x, unsigned& nloc, unsigned& nx) {
    const unsigned G = gridDim.x * gridDim.y * gridDim.z;
    unsigned sum, cnt, mine, sp = 0u;
    for (;;) {
        sum = 0u; cnt = 0u; mine = 0u;
#pragma unroll
        for (unsigned j = 0; j < 16; ++j) { const unsigned c = xb_ld(&bar[XB_XCNT(j)]); sum += c; cnt += (c > 0u) ? 1u : 0u; mine = (j == x) ? c : mine; }
        if (sum == G) break;
        __builtin_amdgcn_s_sleep(1);
        if ((++sp & 255u) == 0u) { if (xb_ld(&bar[XB_TMO])) break; if (sp > XB_SPIN_CAP) { atomicAdd(&bar[XB_TMO], 1u); break; } }
    }
    nloc = mine > 0u ? mine : 1u; nx = cnt > 0u ? cnt : 1u;
}

__device__ __forceinline__ void xcd_barrier(const XcdBarrier& b) {
    asm volatile("s_waitcnt vmcnt(0)" ::: "memory");
    __syncthreads();
    if (threadIdx.x == 0) {
        unsigned* bar = b.bar;
        __builtin_amdgcn_s_waitcnt(0);
        unsigned nloc = b.st[0], nx = b.st[1];
        if (nloc == 0u) { xcd_barrier_complete(bar, b.x, nloc, nx); b.st[0] = nloc; b.st[1] = nx; }
        const unsigned old = xb_add(&bar[XB_XSUB(b.x)], 1u);
        const unsigned gen = old / nloc;
        if (old + 1u == (gen + 1u) * nloc) {
            __builtin_amdgcn_fence(__ATOMIC_RELEASE, "agent");
            asm volatile("s_waitcnt vmcnt(0)" ::: "memory");
            const unsigned og = xb_add(&bar[XB_TOP], 1u);
            const unsigned tg = og / nx;
            if (og + 1u == (tg + 1u) * nx) xb_add(&bar[XB_TOPGEN], 1u);
            else XB_SPIN(xb_ld(&bar[XB_TOPGEN]) == tg, bar);
            __builtin_amdgcn_fence(__ATOMIC_ACQUIRE, "agent");
            xb_add(&bar[XB_XGEN(b.x)], 1u);
            asm volatile("s_waitcnt vmcnt(0)" ::: "memory");
        } else {
            XB_SPIN(xb_ld(&bar[XB_XGEN(b.x)]) == gen, bar);
            __builtin_amdgcn_fence(__ATOMIC_ACQUIRE, "agent");
            asm volatile("s_waitcnt vmcnt(0)" ::: "memory");
        }
    }
    __syncthreads();
}

struct Inputs {
    const float* x; const int* positions; const float* ffn_norm; const float* ffn_w_gate; const float* ffn_w_up; const float* ffn_w_down; const float* mix_norm; const float* final_norm;
    const float* mla_w_a; const float* mla_q_norm; const float* mla_w_qb; const float* mla_kv_norm; const float* mla_w_kvb; const float* mla_w_o;
    const float* ml_w_in; const float* ml_b_if; const float* ml_conv_w; const float* ml_conv_b; const float* ml_out_norm; const float* ml_w_o;
    const float* rw_mu; const float* rw_w_r; const float* rw_w_k; const float* rw_w_v; const float* rw_w0; const float* rw_w1; const float* rw_w2; const float* rw_a0; const float* rw_a1; const float* rw_a2;
    const float* rw_g1; const float* rw_g2; const float* rw_k_k; const float* rw_k_a; const float* rw_r_k; const float* rw_ln_w; const float* rw_ln_b; const float* rw_w_o;
};
struct Args { Inputs in; float* out; unsigned char* ws; int ph_lo, ph_hi, hide; };

struct Frame {
    LAS unsigned char* lds;
    gu32* ctl;
    int tid, lane, wave, G, gw, NGW;
    float* X;
    bf16* XB;
    float* SS;
    unsigned char* ws;
};

struct CvDesc { const float* Wp; const float* g1; const float* g2; const float* g3; bf16* dst; int ld, ks0, ldd, kd0, n0, nval; bool vec, pair; };
__device__ __forceinline__ void cv_load(const CvDesc& d, f32x4 (&v)[8], float (&g)[8], int lane) {
    const int kr = lane >> 3, nc = (lane & 7) * 4; const float* W0 = d.Wp ? d.Wp - (lane & 31) : nullptr; const int k0 = d.ks0 + 8 * kr;
#pragma unroll
    for (int i = 0; i < 8; ++i) {
        if (d.pair) { const GAS f32x2_t* q = (const GAS f32x2_t*)(W0 + (size_t)(k0 + i) * d.ld + (nc >> 1)); const f32x2_t lo = q[0], hi2 = q[16]; v[i] = (f32x4){lo.x, hi2.x, lo.y, hi2.y}; }
        else v[i] = (W0 && nc < d.nval) ? *(const GAS f32x4*)(W0 + (size_t)(k0 + i) * d.ld + nc) : (f32x4){0.f, 0.f, 0.f, 0.f}; }
    f32x4 ga = {1.f, 1.f, 1.f, 1.f}, gb = ga;
    if (d.g1) { ga = *(const GAS f32x4*)(d.g1 + k0); gb = *(const GAS f32x4*)(d.g1 + k0 + 4); }
    if (d.g2) { f32x4 ma = *(const GAS f32x4*)(d.g2 + k0), mb = *(const GAS f32x4*)(d.g2 + k0 + 4); if (d.g3) { ma = ma - *(const GAS f32x4*)(d.g3 + k0); mb = mb - *(const GAS f32x4*)(d.g3 + k0 + 4); } ga = ga * ma; gb = gb * mb; }
#pragma unroll
    for (int i = 0; i < 4; ++i) { g[i] = ga[i]; g[4 + i] = gb[i]; }
}
__device__ __forceinline__ void cv_finish(const CvDesc& d, const f32x4 (&v)[8], const float (&g)[8], LAS float* scr, int lane) {
    const int kr = lane >> 3, nc = (lane & 7) * 4;
    if (d.vec) {
#pragma unroll
        for (int e = 0; e < 4; ++e) { v4u o; o.x = cvtpk(v[0][e] * g[0], v[1][e] * g[1]); o.y = cvtpk(v[2][e] * g[2], v[3][e] * g[3]); o.z = cvtpk(v[4][e] * g[4], v[5][e] * g[5]); o.w = cvtpk(v[6][e] * g[6], v[7][e] * g[7]);
            *(GAS v4u*)(d.dst + (size_t)(d.n0 + nc + e) * d.ldd + d.kd0 + 8 * kr) = o; }
        return;
    } else {
        const int nl = lane & 31, kh = lane >> 5;
#pragma unroll 8
        for (int i = 0; i < 32; ++i) { const int kk = 2 * i + kh, k = d.ks0 + kk; float x = 0.f;
            if (d.Wp) { x = d.Wp[(size_t)k * d.ld]; if (d.g1) x *= d.g1[k]; if (d.g2) x *= d.g2[k] - (d.g3 ? d.g3[k] : 0.f); }
            scr[kk * 33 + nl] = x; }
    }
    LDS_WAIT(); asm volatile("" ::: "memory");
    const int c = lane & 7;
#pragma unroll
    for (int j = 0; j < 4; ++j) { const int n = (lane >> 3) + 8 * j; const LAS float* s = scr + (8 * c) * 33 + n;
        v4u o; o.x = cvtpk(s[0 * 33], s[1 * 33]); o.y = cvtpk(s[2 * 33], s[3 * 33]); o.z = cvtpk(s[4 * 33], s[5 * 33]); o.w = cvtpk(s[6 * 33], s[7 * 33]);
        *(GAS v4u*)(d.dst + (size_t)(d.n0 + n) * d.ldd + d.kd0 + 8 * c) = o; }
    LDS_WAIT(); asm volatile("" ::: "memory");
}
__device__ __forceinline__ void cv_decode(const Inputs& in, bf16* WB, int layer, int it, int lane, CvDesc& d, bool alt = false) {
    const int kind = layer % 3, j = layer / 3, nl = lane & 31;
    constexpr int I_GU = (D / 64) * (2 * FF / 32), I_DN = (FF / 64) * (D / 32), I_FFN = 2 * (I_GU + I_DN);
    d.g1 = nullptr; d.g2 = nullptr; d.g3 = nullptr; d.vec = true; d.pair = false; d.nval = 32;
    int r = it;
    if (r < I_FFN) {
        const int half = r / (I_GU + I_DN); r -= half * (I_GU + I_DN);
        const size_t wsel = (size_t)(layer * 2 + half);
        if (r < I_GU) {
            const int nb = r % (2 * FF / 32), kb = r / (2 * FF / 32), n = nb * 32 + nl, tile = n >> 8, w = n & 255;
            d.Wp = (w < 128 ? in.ffn_w_gate : in.ffn_w_up) + wsel * D * FF + (tile * 128 + (w & 127)); d.ld = FF; d.ks0 = kb * 64; d.g1 = in.ffn_norm + wsel * D;
            d.dst = WB + (half ? (alt ? WO_GU1A : WO_GU1) : WO_GU0); d.ldd = D; d.kd0 = kb * 64; d.n0 = nb * 32;
        } else { r -= I_GU;
            const int nb = r % (D / 32), kb = r / (D / 32), n = nb * 32 + nl;
            d.Wp = in.ffn_w_down + wsel * FF * D + n; d.ld = D; d.ks0 = kb * 64; d.dst = WB + (half ? (alt ? WO_D1A : WO_D1) : WO_D0); d.ldd = FF; d.kd0 = kb * 64; d.n0 = nb * 32; }
        return;
    }
    r -= I_FFN;
    const float* gmix = in.mix_norm + (size_t)layer * D;
    if (kind == 0) {
        if (r < 16 * 32) {
            const int nb = r % 32, kb = r / 32, n = nb * 32 + nl; int col = n;
            if (n >= 768 && n < 832) { const int jj = n - 768; col = 768 + (jj >> 1) + 32 * (jj & 1); }
            d.Wp = (n < LATN) ? in.mla_w_a + (size_t)j * D * LATN + col : nullptr; d.ld = LATN; d.ks0 = kb * 64; d.g1 = gmix; d.dst = WB + WM_A; d.ldd = 1024; d.kd0 = kb * 64; d.n0 = nb * 32;
            if (nb == 24 || nb == 25) { d.pair = true; d.Wp = in.mla_w_a + (size_t)j * D * LATN + 768 + (nb - 24) * 16 + nl; }
            return; }
        r -= 16 * 32;
        if (r < 8 * 48) {
            const int nb = r % 48, kb = r / 48, n = nb * 32 + nl, hd = n / DQK, w = n - hd * DQK; int col = n;
            if (w >= NOPE) { const int jj = w - NOPE; col = hd * DQK + NOPE + (jj >> 1) + 32 * (jj & 1); }
            d.Wp = in.mla_w_qb + (size_t)j * QRANK * 1536 + col; d.ld = 1536; d.ks0 = kb * 64; d.g1 = in.mla_q_norm + (size_t)j * QRANK; d.dst = WB + WM_QB; d.ldd = 512; d.kd0 = kb * 64; d.n0 = nb * 32;
            if ((nb % 6) >= 4) { d.pair = true; d.Wp = in.mla_w_qb + (size_t)j * QRANK * 1536 + (nb / 6) * DQK + NOPE + ((nb % 6) - 4) * 16 + nl; }
            return; }
        r -= 8 * 48;
        if (r < 4 * 64) {
            const int nb = r % 64, kb = r / 64, n = nb * 32 + nl;
            d.Wp = in.mla_w_kvb + (size_t)j * KVRANK * 2048 + n; d.ld = 2048; d.ks0 = kb * 64; d.g1 = in.mla_kv_norm + (size_t)j * KVRANK; d.dst = WB + WM_KVB; d.ldd = 256; d.kd0 = kb * 64; d.n0 = nb * 32; return; }
        r -= 4 * 64;
        { const int nb = r % 32, kb = r / 32, n = nb * 32 + nl;
          d.Wp = in.mla_w_o + (size_t)j * 1024 * 1024 + n; d.ld = 1024; d.ks0 = kb * 64; d.dst = WB + WM_O; d.ldd = 1024; d.kd0 = kb * 64; d.n0 = nb * 32; }
    } else if (kind == 1) {
        if (r < 16 * 104) {
            const int nb = r % 104, kb = r / 104, n = nb * 32 + nl;
            d.Wp = (n < ML_NIN) ? in.ml_w_in + (size_t)j * D * ML_NIN + n : nullptr; d.ld = ML_NIN; d.ks0 = kb * 64; d.g1 = gmix; d.dst = WB + WL_IN; d.ldd = 1024; d.kd0 = kb * 64; d.n0 = nb * 32;
            if (nb == 96) { d.Wp = in.ml_w_in + (size_t)j * D * ML_NIN + nb * 32 + nl; d.nval = ML_NIN - 96 * 32; }
            return; }
        r -= 16 * 104;
        { const int nb = r % 32, kb = r / 32, n = nb * 32 + nl;
          d.Wp = in.ml_w_o + (size_t)j * 1024 * 1024 + n; d.ld = 1024; d.ks0 = kb * 64; d.dst = WB + WL_O; d.ldd = 1024; d.kd0 = kb * 64; d.n0 = nb * 32; }
    } else {
        const float* mu = in.rw_mu + (size_t)j * 6 * D;
        if (r < 16 * 96) {
            const int nb = r % 96, kb = r / 96, n = nb * 32 + nl;
            if (n < 1024) d.Wp = in.rw_w_r + (size_t)j * D * D + n; else if (n < 2048) d.Wp = in.rw_w_k + (size_t)j * D * D + (n - 1024); else d.Wp = in.rw_w_v + (size_t)j * D * D + (n - 2048);
            d.ld = D;
            d.ks0 = kb * 64; d.g1 = gmix; d.dst = WB + WR_BIG; d.ldd = 1024; d.kd0 = kb * 64; d.n0 = nb * 32; return; }
        r -= 16 * 96;
        if (r < 32 * 8) {
            const int nb = r % 8, kb = r / 8, n = nb * 32 + nl; const float* m;
            if (n < 64) { d.Wp = in.rw_w1 + (size_t)j * D * 64 + n; d.ld = 64; m = mu + 1 * D; }
            else if (n < 128) { d.Wp = in.rw_a1 + (size_t)j * D * 64 + (n - 64); d.ld = 64; m = mu + 4 * D; }
            else { d.Wp = in.rw_g1 + (size_t)j * D * 128 + (n - 128); d.ld = 128; m = mu + 5 * D; }
            d.ks0 = (kb & 15) * 64; d.g1 = gmix; if (kb >= 16) { d.g2 = m; d.g3 = mu + 3 * D; } d.dst = WB + WR_LORA; d.ldd = 2048; d.kd0 = kb * 64; d.n0 = nb * 32; return; }
        r -= 32 * 8;
        if (r < 4 * 96) {
            const int nb = r % 96, kb = r / 96, n = nb * 32 + nl; d.Wp = nullptr; d.ld = 1024; d.ks0 = 0;
            if (n < 1024) { if (kb == 0) d.Wp = in.rw_w2 + (size_t)j * 64 * D + n; }
            else if (n < 2048) { if (kb == 1) d.Wp = in.rw_a2 + (size_t)j * 64 * D + (n - 1024); }
            else { if (kb >= 2) { d.Wp = in.rw_g2 + (size_t)j * 128 * D + (n - 2048); d.ks0 = (kb - 2) * 64; } }
            d.dst = WB + WR_UP; d.ldd = 256; d.kd0 = kb * 64; d.n0 = nb * 32; return; }
        r -= 4 * 96;
        { const int nb = r % 32, kb = r / 32, n = nb * 32 + nl;
          d.Wp = in.rw_w_o + (size_t)j * 1024 * 1024 + n; d.ld = 1024; d.ks0 = kb * 64; d.dst = WB + WR_O; d.ldd = 1024; d.kd0 = kb * 64; d.n0 = nb * 32; }
    }
}
__device__ __forceinline__ void conv_layer(Frame& F, const Inputs& in, int layer, int w0, int nw, bool alt) {
    LAS float* scr = (LAS float*)(F.lds + F.wave * 16384);
    bf16* WB = (bf16*)(F.ws + WS_W);
    const int kind = layer % 3, lane = F.lane;
    constexpr int I_GU = (D / 64) * (2 * FF / 32), I_DN = (FF / 64) * (D / 32), I_FFN = 2 * (I_GU + I_DN);
    constexpr int I_MLA = (1024 / 64) * (1024 / 32) + (512 / 64) * (1536 / 32) + (256 / 64) * (2048 / 32) + (1024 / 64) * (1024 / 32);
    constexpr int I_ML = (1024 / 64) * (3328 / 32) + (1024 / 64) * (1024 / 32);
    constexpr int I_RW = (1024 / 64) * (3072 / 32) + (2048 / 64) * (256 / 32) + (256 / 64) * (3072 / 32) + (1024 / 64) * (1024 / 32);
    const int n_items = I_FFN + (kind == 0 ? I_MLA : kind == 1 ? I_ML : I_RW);
    CvDesc dA, dB; f32x4 vA[8], vB[8]; float gA[8], gB[8];
    int it = 2 * w0;
    if (it < n_items) { cv_decode(in, WB, layer, it, lane, dA, alt); if (dA.vec) cv_load(dA, vA, gA, lane); }
    for (; it < n_items; it += 2 * nw) {
        const int itB = it + 1, itC = it + 2 * nw;
        if (itB < n_items) { cv_decode(in, WB, layer, itB, lane, dB, alt); if (dB.vec) cv_load(dB, vB, gB, lane); }
        cv_finish(dA, vA, gA, scr, lane);
        if (itC < n_items) { cv_decode(in, WB, layer, itC, lane, dA, alt); if (dA.vec) cv_load(dA, vA, gA, lane); }
        if (itB < n_items) cv_finish(dB, vB, gB, scr, lane);
    }
}

__device__ __forceinline__ void prologue(Frame& F, const Inputs& in) {
    for (int m0 = F.gw * 4; m0 < T; m0 += F.NGW * 4) {
        f32x4 v[4][4];
#pragma unroll
        for (int i = 0; i < 4; ++i)
#pragma unroll
            for (int jj = 0; jj < 4; ++jj) v[i][jj] = __builtin_nontemporal_load((const GAS f32x4*)(in.x + (size_t)(m0 + i) * D) + F.lane + 64 * jj);
#pragma unroll
        for (int i = 0; i < 4; ++i) { const int m = m0 + i;
            GAS v2u* xb = (GAS v2u*)(F.XB + (size_t)m * D) + F.lane;
            float s = 0.f;
#pragma unroll
            for (int jj = 0; jj < 4; ++jj) { const f32x4 a = v[i][jj]; s += (a.x * a.x + a.y * a.y) + (a.z * a.z + a.w * a.w);
                v2u w; w.x = cvtpk(a.x, a.y); w.y = cvtpk(a.z, a.w); xb[64 * jj] = w; }
            s = wave_sum(s);
            if (F.lane < 16) F.SS[(size_t)m * 16 + F.lane] = (F.lane == 0) ? s : 0.f; }
    }
    float* COS = (float*)(F.ws + WS_COS); float* SIN = (float*)(F.ws + WS_SIN);
    for (int e = F.gw * 64 + F.lane; e < T * 32; e += F.NGW * 64) {
        const int t = e >> 5, i = e & 31;
        const float inv_freq = __builtin_amdgcn_exp2f(-(float)i * 0.41524101186092029f);
        const float ang = (float)in.positions[t] * inv_freq;
        float sn, cs; fsincos_big(ang, sn, cs);
        COS[e] = cs; SIN[e] = sn;
    }
}

__device__ __forceinline__ float rstd16(const float* SS, int row) {
    const GAS f32x4* p = (const GAS f32x4*)(SS + (size_t)row * 16);
    const f32x4 a = p[0], b = p[1], c = p[2], d = p[3];
    const float s = ((a.x + a.y) + (a.z + a.w)) + ((b.x + b.y) + (b.z + b.w)) + ((c.x + c.y) + (c.z + c.w)) + ((d.x + d.y) + (d.z + d.w));
    return frsq(s * (1.f / D) + RMS_EPS);
}

#define EPI_ROWS(ai, m) (u.pm * 256 + u.roff + (ai) * 128 + wr * 64 + (m) * 16 + fr)
typedef const f32x4 (&AccT)[2][2][4][2];
using pg8::Unit;


template <int NP> __device__ __forceinline__ void rstd_rows(const float* S, int row0  , int fq, float inv_n, float (&r)[8]) {
    float p[8];
#pragma unroll
    for (int ai = 0; ai < 2; ++ai)
#pragma unroll
        for (int m = 0; m < 4; ++m) { const int row = row0 + ai * 128 + m * 16;
            if constexpr (NP == 16) { const f32x4 a = *(const GAS f32x4*)(S + (size_t)row * 16 + fq * 4); p[ai * 4 + m] = (a.x + a.y) + (a.z + a.w); }
            else if constexpr (NP == 8) { const GAS float* q = (const GAS float*)(S + (size_t)row * 8 + fq * 2); p[ai * 4 + m] = q[0] + q[1]; }
            else { p[ai * 4 + m] = *(const GAS float*)(S + (size_t)row * 4 + fq); } }
#pragma unroll
    for (int i = 0; i < 8; ++i) { float s = p[i]; s += __shfl_xor(s, 16); s += __shfl_xor(s, 32); r[i] = frsq(s * inv_n + RMS_EPS); }
}
constexpr int RSTD_LDS_OFF = 131072;
__device__ __forceinline__ void stage_rstd(Frame& F, const float* SS) {
    LAS float* rl = (LAS float*)(F.lds + RSTD_LDS_OFF); const int base = ((int)blockIdx.x & 7) * 2048;
    f32x4 a[4][4];
#pragma unroll
    for (int i = 0; i < 4; ++i)
#pragma unroll
        for (int q = 0; q < 4; ++q) a[i][q] = *((const GAS f32x4*)(SS + (size_t)(base + F.tid + 512 * i) * 16) + q);
#pragma unroll
    for (int i = 0; i < 4; ++i) { f32x4 s = (a[i][0] + a[i][1]) + (a[i][2] + a[i][3]); rl[F.tid + 512 * i] = frsq(((s.x + s.y) + (s.z + s.w)) * (1.f / D) + RMS_EPS); }
    __syncthreads();
}
struct RstdPre { f32x4 a0, a1, a2, a3, b0, b1, b2, b3, c0, c1, c2, c3, d0, d1, d2, d3;
    __device__ __forceinline__ void issue(const float* SS, int tid) { const GAS f32x4* p = (const GAS f32x4*)(SS + (size_t)(((int)blockIdx.x & 7) * 2048 + tid) * 16);
        a0 = p[0]; a1 = p[1]; a2 = p[2]; a3 = p[3]; b0 = p[2048]; b1 = p[2049]; b2 = p[2050]; b3 = p[2051]; c0 = p[4096]; c1 = p[4097]; c2 = p[4098]; c3 = p[4099]; d0 = p[6144]; d1 = p[6145]; d2 = p[6146]; d3 = p[6147]; }
    static __device__ __forceinline__ float red(const f32x4& x0, const f32x4& x1, const f32x4& x2, const f32x4& x3) { const f32x4 s = (x0 + x1) + (x2 + x3); return frsq(((s.x + s.y) + (s.z + s.w)) * (1.f / D) + RMS_EPS); }
    __device__ __forceinline__ void operator()(LAS unsigned char* lds, int tid) const { LAS float* rl = (LAS float*)(lds + RSTD_LDS_OFF);
        rl[tid] = red(a0, a1, a2, a3); rl[tid + 512] = red(b0, b1, b2, b3); rl[tid + 1024] = red(c0, c1, c2, c3); rl[tid + 1536] = red(d0, d1, d2, d3); }
};
template <int NP> struct RstdPreN { f32x4 a0, a1, b0, b1, c0, c1, d0, d1; float inv_n;
    __device__ __forceinline__ void issue(const float* S, int tid, float inv) { inv_n = inv; const GAS f32x4* p = (const GAS f32x4*)(S + (size_t)(((int)blockIdx.x & 7) * 2048 + tid) * NP); constexpr int RS = 512 * NP / 4;
        a0 = p[0]; b0 = p[RS]; c0 = p[2 * RS]; d0 = p[3 * RS];
        if (NP == 8) { a1 = p[1]; b1 = p[RS + 1]; c1 = p[2 * RS + 1]; d1 = p[3 * RS + 1]; } else { a1 = b1 = c1 = d1 = (f32x4){0.f, 0.f, 0.f, 0.f}; } }
    __device__ __forceinline__ float red(const f32x4& x0, const f32x4& x1) const { const f32x4 s = x0 + x1; return frsq(((s.x + s.y) + (s.z + s.w)) * inv_n + RMS_EPS); }
    __device__ __forceinline__ void operator()(LAS unsigned char* lds, int tid) const { LAS float* rl = (LAS float*)(lds + RSTD_LDS_OFF);
        rl[tid] = red(a0, a1); rl[tid + 512] = red(b0, b1); rl[tid + 1024] = red(c0, c1); rl[tid + 1536] = red(d0, d1); }
};
__device__ __forceinline__ void rstd_get(const LAS float* rl, int rbase, const float* SS, const Unit& u, int wr, int fr, int fq, float (&rs)[8]) {
    if (rl) {
#pragma unroll
        for (int ai = 0; ai < 2; ++ai)
#pragma unroll
            for (int m = 0; m < 4; ++m) rs[ai * 4 + m] = rl[u.pm * 256 + ai * 128 + wr * 64 + m * 16 + fr - rbase];
    } else rstd_rows<16>(SS, u.pm * 256 + wr * 64 + fr, fq, 1.f / D, rs);
}
typedef float f32x2e __attribute__((ext_vector_type(2)));
struct EpiSwiGLU { static constexpr bool PERM = true, AFTER_DRAIN = false; const float* SS; bf16* ACT; const LAS float* rl; int rbase;
    __device__ __forceinline__ void operator()(AccT acc, const Unit& u, int wr, int wc, int fr, int fq) const {
        const int col = u.pn * 128 + wc * 32 + fq * 8;
        float rs[8];
        if (rl) {
#pragma unroll
            for (int ai = 0; ai < 2; ++ai)
#pragma unroll
                for (int m = 0; m < 4; ++m) rs[ai * 4 + m] = (ai < u.nai) ? rl[EPI_ROWS(ai, m) - rbase] : 0.f;
        } else rstd_rows<16>(SS, u.pm * 256 + u.roff * (2 - u.nai) + wr * 64 + fr, fq, 1.f / D, rs);
#pragma unroll
        for (int ai = 0; ai < 2; ++ai) if (ai < u.nai)
#pragma unroll
            for (int m = 0; m < 4; ++m) { const int row = EPI_ROWS(ai, m); const float r = rs[ai * 4 + m];
                unsigned w[4];
#pragma unroll
                for (int n = 0; n < 2; ++n)
#pragma unroll
                    for (int h2 = 0; h2 < 2; ++h2) {
                        const f32x2e g = (f32x2e){acc[ai][0][m][n][2 * h2], acc[ai][0][m][n][2 * h2 + 1]} * r, up = (f32x2e){acc[ai][1][m][n][2 * h2], acc[ai][1][m][n][2 * h2 + 1]} * r;
                        const f32x2e x = g * (-1.4426950408889634f); f32x2e d; d.x = __builtin_amdgcn_exp2f(x.x); d.y = __builtin_amdgcn_exp2f(x.y); d = d + 1.0f;
                        f32x2e q; q.x = __builtin_amdgcn_rcpf(d.x); q.y = __builtin_amdgcn_rcpf(d.y);
                        const f32x2e o = (g * up) * q; w[2 * n + h2] = cvtpk(o.x, o.y); }
                *(GAS v4u*)(ACT + (size_t)row * FF + col) = (v4u){w[0], w[1], w[2], w[3]}; }
    }
};
struct EpiResidual { static constexpr bool PERM = true, AFTER_DRAIN = false; float* X; bf16* XB; float* SS; float scale;
    __device__ __forceinline__ void operator()(AccT acc, const Unit& u, int wr, int wc, int fr, int fq) const {
#pragma unroll
        for (int ai = 0; ai < 2; ++ai) { asm volatile("" ::: "memory");
            v4u xv[4][2];
#pragma unroll
            for (int m = 0; m < 4; ++m)
#pragma unroll
                for (int bj = 0; bj < 2; ++bj) xv[m][bj] = *(const GAS v4u*)(XB + (size_t)EPI_ROWS(ai, m) * D + u.pn * 256 + bj * 128 + wc * 32 + fq * 8);
#pragma unroll
            for (int m = 0; m < 4; ++m) { const int row = EPI_ROWS(ai, m); float ss = 0.f;
#pragma unroll
                for (int bj = 0; bj < 2; ++bj) { const int col = u.pn * 256 + bj * 128 + wc * 32 + fq * 8;
                    float xo[8]; unpack8(xv[m][bj], xo);
#pragma unroll
                    for (int e = 0; e < 4; ++e) { xo[e] += acc[ai][bj][m][0][e] * scale; xo[4 + e] += acc[ai][bj][m][1][e] * scale; }
#pragma unroll
                    for (int e = 0; e < 8; ++e) ss += xo[e] * xo[e];
                    *(GAS v4u*)(XB + (size_t)row * D + col) = pack8f(xo); }
                ss += __shfl_xor(ss, 16); ss += __shfl_xor(ss, 32);
                if (fq == 0) SS[(size_t)row * 16 + u.pn * 4 + wc] = ss; } }
    }
};
__device__ __forceinline__ void rope8(float* v, const float* COS, const float* SIN, int row, int p0) {
    const f32x4 c = *(const GAS f32x4*)(COS + (size_t)row * 32 + p0), s = *(const GAS f32x4*)(SIN + (size_t)row * 32 + p0);
#pragma unroll
    for (int p = 0; p < 4; ++p) { const float x1 = v[2 * p], x2 = v[2 * p + 1]; v[2 * p] = x1 * c[p] - x2 * s[p]; v[2 * p + 1] = x1 * s[p] + x2 * c[p]; }
}
struct EpiMlaA { static constexpr bool PERM = true, AFTER_DRAIN = false; const float* SS; bf16* LAT; float* SSQ; float* SSKV; bf16* KPE; const float* COS; const float* SIN; const LAS float* rl; int rbase;
    __device__ __forceinline__ void operator()(AccT acc, const Unit& u, int wr, int wc, int fr, int fq) const {
        float rs[8]; rstd_get(rl, rbase, SS, u, wr, fr, fq, rs);
#pragma unroll
        for (int ai = 0; ai < 2; ++ai)
#pragma unroll
            for (int m = 0; m < 4; ++m) { const int row = EPI_ROWS(ai, m); const float r = rs[ai * 4 + m]; float ss = 0.f;
#pragma unroll
                for (int bj = 0; bj < 2; ++bj) { const int col = u.pn * 256 + bj * 128 + wc * 32 + fq * 8;
                    float v[8];
#pragma unroll
                    for (int n = 0; n < 2; ++n)
#pragma unroll
                        for (int e = 0; e < 4; ++e) { v[4 * n + e] = acc[ai][bj][m][n][e] * r; ss += v[4 * n + e] * v[4 * n + e]; }
                    *(GAS v4u*)(LAT + (size_t)row * 1024 + col) = pack8f(v);
                    if (u.pn == 3 && bj == 0 && wc < 2) { rope8(v, COS, SIN, row, wc * 16 + fq * 4); *(GAS v4u*)(KPE + (size_t)row * 64 + wc * 32 + fq * 8) = pack8f(v); } }
                ss += __shfl_xor(ss, 16); ss += __shfl_xor(ss, 32);
                if (fq == 0) { if (u.pn < 2) SSQ[(size_t)row * 8 + u.pn * 4 + wc] = ss; else if (u.pn == 2) SSKV[(size_t)row * 4 + wc] = ss; } }
    }
};
struct EpiMlaQ { static constexpr bool PERM = true, AFTER_DRAIN = false; const float* SSQ; bf16* Q; const float* COS; const float* SIN; float qscale; const LAS float* rl; int rbase;
    __device__ __forceinline__ void operator()(AccT acc, const Unit& u, int wr, int wc, int fr, int fq) const {
        float rs[8];
        if (rl) {
#pragma unroll
            for (int ai = 0; ai < 2; ++ai)
#pragma unroll
                for (int m = 0; m < 4; ++m) rs[ai * 4 + m] = (ai < u.nai) ? rl[EPI_ROWS(ai, m) - rbase] : 0.f;
        } else rstd_rows<8>(SSQ, u.pm * 256 + u.roff * (2 - u.nai) + wr * 64 + fr, fq, 1.f / QRANK, rs);
#pragma unroll
        for (int ai = 0; ai < 2; ++ai) if (ai < u.nai)
#pragma unroll
            for (int m = 0; m < 4; ++m) { asm volatile("" ::: "memory"); const int row = EPI_ROWS(ai, m);
                const float r = rs[ai * 4 + m] * qscale;
#pragma unroll
                for (int bj = 0; bj < 2; ++bj) { const int col = u.pn * 256 + bj * 128 + wc * 32 + fq * 8, hd = col / DQK, w = col - hd * DQK;
                    float v[8];
#pragma unroll
                    for (int n = 0; n < 2; ++n)
#pragma unroll
                        for (int e = 0; e < 4; ++e) v[4 * n + e] = acc[ai][bj][m][n][e] * r;
                    if (w >= NOPE) rope8(v, COS, SIN, row, (w - NOPE) >> 1);
                    *(GAS v4u*)(Q + (size_t)row * 1536 + col) = pack8f(v); } }
    }
};
struct EpiMlaKV { static constexpr bool PERM = true, AFTER_DRAIN = false; const float* SSKV; bf16* KV; const LAS float* rl; int rbase;
    __device__ __forceinline__ void operator()(AccT acc, const Unit& u, int wr, int wc, int fr, int fq) const {
        float rs[8];
        if (rl) {
#pragma unroll
            for (int ai = 0; ai < 2; ++ai)
#pragma unroll
                for (int m = 0; m < 4; ++m) rs[ai * 4 + m] = rl[EPI_ROWS(ai, m) - rbase];
        } else rstd_rows<4>(SSKV, u.pm * 256 + wr * 64 + fr, fq, 1.f / KVRANK, rs);
#pragma unroll
        for (int ai = 0; ai < 2; ++ai)
#pragma unroll
            for (int m = 0; m < 4; ++m) { const int row = EPI_ROWS(ai, m);
                const float r = rs[ai * 4 + m];
#pragma unroll
                for (int bj = 0; bj < 2; ++bj) { const int col = u.pn * 256 + bj * 128 + wc * 32 + fq * 8;
                    *(GAS v4u*)(KV + (size_t)row * 2048 + col) = pack8v(acc[ai][bj][m][0] * r, acc[ai][bj][m][1] * r); } }
    }
};
struct EpiMlIn { static constexpr bool PERM = true, AFTER_DRAIN = false; const float* SS; bf16* P; float* GATES; const LAS float* rl; int rbase;
    template <bool STAGED> __device__ __forceinline__ void body(AccT acc, const Unit& u, int wr, int wc, int fr, int fq) const {
        float rs[8]; if constexpr (!STAGED) rstd_rows<16>(SS, u.pm * 256 + u.roff * (2 - u.nai) + wr * 64 + fr, fq, 1.f / D, rs);
#pragma unroll
        for (int ai = 0; ai < 2; ++ai) if (ai < u.nai)
#pragma unroll
            for (int m = 0; m < 4; ++m) { const int row = EPI_ROWS(ai, m); float r; if constexpr (STAGED) r = rl[row - rbase]; else r = rs[ai * 4 + m];
                if (u.pn < 12) {
#pragma unroll
                    for (int bj = 0; bj < 2; ++bj) { const int col = u.pn * 256 + bj * 128 + wc * 32 + fq * 8;
                        *(GAS v4u*)(P + (size_t)row * 3072 + col) = pack8v(acc[ai][bj][m][0] * r, acc[ai][bj][m][1] * r); }
                } else if (wc == 0 && fq < 2) {
                    GAS f32x4* g = (GAS f32x4*)(GATES + (size_t)row * 16 + fq * 8); g[0] = acc[ai][0][m][0] * r; g[1] = acc[ai][0][m][1] * r; } }
    }
    __device__ __forceinline__ void operator()(AccT acc, const Unit& u, int wr, int wc, int fr, int fq) const { if (rl) body<true>(acc, u, wr, wc, fr, fq); else body<false>(acc, u, wr, wc, fr, fq); }
};
struct EpiRwBig { static constexpr bool PERM = true, AFTER_DRAIN = false; bf16* RKV; bf16* LOR; int pn0;
    __device__ __forceinline__ void operator()(AccT acc, const Unit& u, int wr, int wc, int fr, int fq) const {
#pragma unroll
        for (int ai = 0; ai < 2; ++ai) if (ai < u.nai)
#pragma unroll
            for (int m = 0; m < 4; ++m) { const int row = EPI_ROWS(ai, m);
#pragma unroll
                for (int bj = 0; bj < 2; ++bj) { const int cl = bj * 128 + wc * 32 + fq * 8;
                    if (u.pn + pn0 < 12) { *(GAS v4u*)(RKV + (size_t)row * 3072 + (u.pn + pn0) * 256 + cl) = pack8v(acc[ai][bj][m][0], acc[ai][bj][m][1]); }
                    else { float v[8];
#pragma unroll
                        for (int n = 0; n < 2; ++n)
#pragma unroll
                            for (int e = 0; e < 4; ++e) { const float a = acc[ai][bj][m][n][e]; v[4 * n + e] = (cl < 64) ? ftanh(a) : (cl < 128) ? a : fsigmoid(a); }
                        *(GAS v4u*)(LOR + (size_t)row * 256 + cl) = pack8f(v); } } }
    }
};
struct EpiRwUp { static constexpr bool PERM = true, AFTER_DRAIN = false; float* LW; bf16* AA; bf16* GG; const float* w0; const float* a0;
    __device__ __forceinline__ void operator()(AccT acc, const Unit& u, int wr, int wc, int fr, int fq) const {
        const int sec = u.pn >> 2;
#pragma unroll
        for (int ai = 0; ai < 2; ++ai)
#pragma unroll
            for (int m = 0; m < 4; ++m) { asm volatile("" ::: "memory"); const int row = EPI_ROWS(ai, m);
#pragma unroll
                for (int bj = 0; bj < 2; ++bj) { const int col = (u.pn & 3) * 256 + bj * 128 + wc * 32 + fq * 8;
                    if (sec == 0) {
#pragma unroll
                        for (int n = 0; n < 2; ++n) { const f32x4 b = *(const GAS f32x4*)(w0 + col + 4 * n); f32x4 o;
#pragma unroll
                            for (int e = 0; e < 4; ++e) o[e] = -0.6065306597126334f * fsigmoid(acc[ai][bj][m][n][e] + b[e]);
                            *(GAS f32x4*)(LW + (size_t)row * 1024 + col + 4 * n) = o; } }
                    else if (sec == 1) { const f32x4 b0 = *(const GAS f32x4*)(a0 + col), b1 = *(const GAS f32x4*)(a0 + col + 4); float v[8];
#pragma unroll
                        for (int e = 0; e < 4; ++e) { v[e] = fsigmoid(acc[ai][bj][m][0][e] + b0[e]); v[4 + e] = fsigmoid(acc[ai][bj][m][1][e] + b1[e]); }
                        *(GAS v4u*)(AA + (size_t)row * 1024 + col) = pack8f(v); }
                    else { *(GAS v4u*)(GG + (size_t)row * 1024 + col) = pack8v(acc[ai][bj][m][0], acc[ai][bj][m][1]); } } }
    }
};

namespace att {
constexpr int SHM_K = 64 * DQK * 2  , SHM_V = 64 * DVH * 2  ;
constexpr int QPE_W = 32 * 144;
constexpr int OFF_V = 0, OFF_K = 3 * SHM_V, OFF_WS = OFF_K + 2 * SHM_K, OFF_QPE = OFF_WS + NWAVES * 64 * 4, ATT_LDS = OFF_QPE + NWAVES * QPE_W;
static_assert(ATT_LDS <= LDSCTL_OFF, "attention LDS");
#define KSWZ(row, colB) ((row) * 384 + ((colB) ^ (((row) & 7) << 4)))
#define SBAR() __builtin_amdgcn_sched_barrier(0)
__device__ __forceinline__ int v_st(int k, int c) { const int kk = (k & ~0xC) | ((k & 4) << 1) | ((k & 8) >> 1); return ((kk >> 3) * 4 + (c >> 5)) * 512 + ((kk & 7) * 32 + (c & 31)) * 2; }
__device__ __forceinline__ int v_rd_base(int lane) { return ((lane & 3) << 3) | (((lane >> 2) & 3) << 6) | (((lane >> 4) & 1) << 5) | (((lane >> 5) & 1) << 8); }
constexpr int v_rd_off(int d0, int ks, int half) { return d0 * 512 + ks * 4096 + half * 2048; }
__device__ __forceinline__ int crow(int r, int hi) { return (r & 3) + 8 * (r >> 2) + 4 * hi; }
__device__ __forceinline__ void mask_tile(f32x16& p0, f32x16& p1, int dq) {
    const float NEG = -__builtin_inff();
#pragma unroll
    for (int r = 0; r < 16; ++r) { const int c = (r & 3) + 8 * (r >> 2);
        if (dq - c < 0) p0[r] = NEG;
        if (dq - c - 32 < 0) p1[r] = NEG; }
}
constexpr float THR2 = 11.5f;
typedef float f32x2v __attribute__((ext_vector_type(2)));
__device__ __forceinline__ float max3f(float a, float b, float c) { return __builtin_fmaxf(__builtin_fmaxf(a, b), c); }
__device__ __forceinline__ float rowmax32(const f32x16& p0, const f32x16& p1) {
    float a = max3f(p0[0], p0[1], p0[2]), b = max3f(p1[0], p1[1], p1[2]);
#pragma unroll
    for (int r = 3; r < 15; r += 2) { a = max3f(a, p0[r], p0[r + 1]); b = max3f(b, p1[r], p1[r + 1]); }
    a = max3f(a, b, p0[15]); a = __builtin_fmaxf(a, p1[15]);
    auto rr = __builtin_amdgcn_permlane32_swap(__float_as_uint(a), __float_as_uint(a), false, false);
    return __builtin_fmaxf(__uint_as_float(rr[0]), __uint_as_float(rr[1]));
}
__device__ __forceinline__ void partialSM(f32x16& p0, f32x16& p1, float& m_reg, float& alpha) {
    const float pmax = rowmax32(p0, p1);
    float mn;
    if (__builtin_expect(__all((pmax - m_reg) <= THR2), 1)) { mn = m_reg; alpha = 1.f; }
    else { mn = fmaxf(m_reg, pmax); alpha = __builtin_amdgcn_exp2f(m_reg - mn); m_reg = mn; }
#pragma unroll
    for (int r = 0; r < 16; ++r) { p0[r] = __builtin_amdgcn_exp2f(p0[r] - mn); p1[r] = __builtin_amdgcn_exp2f(p1[r] - mn); }
}
__device__ __forceinline__ void finishSM(f32x16& p0, f32x16& p1, float alpha, float& l_reg, bf16x8& pa0, bf16x8& pa1, bf16x8& pa2, bf16x8& pa3) {
    f32x2v s2 = {p0[0], p0[1]};
#pragma unroll
    for (int r = 2; r < 16; r += 2) s2 += (f32x2v){p0[r], p0[r + 1]};
#pragma unroll
    for (int r = 0; r < 16; r += 2) s2 += (f32x2v){p1[r], p1[r + 1]};
    float ps = s2.x + s2.y;
    { auto rr = __builtin_amdgcn_permlane32_swap(__float_as_uint(ps), __float_as_uint(ps), false, false);
      ps = __uint_as_float(rr[0]) + __uint_as_float(rr[1]); }
    l_reg = l_reg * alpha + ps;
#define PK4(P, B_, OUT) do { unsigned a0 = cvtpk(P[B_+0], P[B_+1]), a1 = cvtpk(P[B_+2], P[B_+3]);                          \
        unsigned b0 = cvtpk(P[B_+4], P[B_+5]), b1 = cvtpk(P[B_+6], P[B_+7]);                                             \
        auto r0 = __builtin_amdgcn_permlane32_swap(a0, b0, false, false); auto r1 = __builtin_amdgcn_permlane32_swap(a1, b1, false, false); \
        v4u w = {r0[0], r1[0], r0[1], r1[1]}; OUT = __builtin_bit_cast(bf16x8, w); } while (0)
    PK4(p0, 0, pa0); PK4(p0, 8, pa1); PK4(p1, 0, pa2); PK4(p1, 8, pa3);
#undef PK4
}
__device__ __forceinline__ void qkt(f32x16& p0, f32x16& p1, const LAS char* Kb, int r32, int hi, const bf16x8* qr, const LAS char* qpe) {
    const LAS char* kb[4];
#pragma unroll
    for (int dd = 0; dd < 4; ++dd) kb[dd] = Kb + r32 * 256 + ((dd * 32 + hi * 16) ^ ((r32 & 7) << 4));
    const int delta = 16384 - r32 * 128;
#pragma unroll
    for (int d0 = 0; d0 < 12; ++d0) {
        bf16x8 b0, b1, qf;
        if (d0 < 8) { const LAS char* an = kb[d0 & 3] + (d0 >> 2) * 128; b0 = *(const LAS bf16x8*)(an); b1 = *(const LAS bf16x8*)(an + 8192); qf = qr[d0 < 8 ? d0 : 0]; }
        else { const LAS char* an = kb[d0 & 3] + delta; b0 = *(const LAS bf16x8*)(an); b1 = *(const LAS bf16x8*)(an + 4096); qf = *(const LAS bf16x8*)(qpe + (d0 - 8) * 32); }
        if (d0 == 0) { p0 = __builtin_amdgcn_mfma_f32_32x32x16_bf16(b0, qf, (f32x16){}, 0, 0, 0); p1 = __builtin_amdgcn_mfma_f32_32x32x16_bf16(b1, qf, (f32x16){}, 0, 0, 0); }
        else { p0 = __builtin_amdgcn_mfma_f32_32x32x16_bf16(b0, qf, p0, 0, 0, 0); p1 = __builtin_amdgcn_mfma_f32_32x32x16_bf16(b1, qf, p1, 0, 0, 0); }
        if ((d0 & 1) == 1) __builtin_amdgcn_sched_barrier(0); }
}
__device__ __forceinline__ void pv_tile(f32x16* o, int vb0, bf16x8 pa0, bf16x8 pa1, bf16x8 pa2, bf16x8 pa3) {
#define TRRD(dst, off) asm volatile("ds_read_b64_tr_b16 %0, %1 offset:%2" : "=&v"(dst) : "v"(vb0), "i"(off) : "memory")
#define PV_D0(d0) do { s16x4 l0, l1, l2, l3, h0, h1, h2, h3; constexpr int b_ = v_rd_off(d0, 0, 0); \
        TRRD(l0, b_); TRRD(h0, b_ + 2048); TRRD(l1, b_ + 4096); TRRD(h1, b_ + 6144); TRRD(l2, b_ + 8192); TRRD(h2, b_ + 10240); TRRD(l3, b_ + 12288); TRRD(h3, b_ + 14336); \
        asm volatile("s_waitcnt lgkmcnt(0)" ::: "memory"); SBAR(); \
        o[d0] = __builtin_amdgcn_mfma_f32_32x32x16_bf16(pa0, (bf16x8){l0[0], l0[1], l0[2], l0[3], h0[0], h0[1], h0[2], h0[3]}, o[d0], 0, 0, 0);   \
        o[d0] = __builtin_amdgcn_mfma_f32_32x32x16_bf16(pa1, (bf16x8){l1[0], l1[1], l1[2], l1[3], h1[0], h1[1], h1[2], h1[3]}, o[d0], 0, 0, 0);   \
        o[d0] = __builtin_amdgcn_mfma_f32_32x32x16_bf16(pa2, (bf16x8){l2[0], l2[1], l2[2], l2[3], h2[0], h2[1], h2[2], h2[3]}, o[d0], 0, 0, 0);   \
        o[d0] = __builtin_amdgcn_mfma_f32_32x32x16_bf16(pa3, (bf16x8){l3[0], l3[1], l3[2], l3[3], h3[0], h3[1], h3[2], h3[3]}, o[d0], 0, 0, 0); } while (0)
    PV_D0(0); PV_D0(1); PV_D0(2); PV_D0(3);
#undef PV_D0
#undef TRRD
}
__device__ __forceinline__ void attn_unit(int wid, int b, int h, int qb, const bf16* Q, const bf16* KV, const bf16* KPE, bf16* O, LAS char* lds) {
    const int lane = fresh_lane(), r32 = lane & 31, hi = lane >> 5;
    const size_t rowbase = (size_t)b * SEQ; const int q0 = qb * 256;
    LAS char* V_lds = lds + OFF_V; LAS char* K_lds = lds + OFF_K;
    LAS float* wsf = (LAS float*)(lds + OFF_WS) + wid * 64; LAS float* li_l = wsf; LAS float* al_l = wsf + 32;
    bf16x8 qr[8];
    LAS char* qpe = lds + OFF_QPE + wid * QPE_W + r32 * 144 + hi * 16;
    { const bf16* Qw = Q + (rowbase + q0 + wid * 32 + r32) * 1536 + h * DQK + hi * 8;
#pragma unroll
      for (int d0 = 0; d0 < 8; ++d0) qr[d0] = *(const GAS bf16x8*)(Qw + d0 * 16);
#pragma unroll
      for (int d0 = 8; d0 < 12; ++d0) *(LAS bf16x8*)(qpe + (d0 - 8) * 32) = *(const GAS bf16x8*)(Qw + d0 * 16); }
    const int NT = 4 * (qb + 1);
    unsigned offA[2], offB, offV[2];
#pragma unroll
    for (int i = 0; i < 2; ++i) { const int s_ = (wid + 8 * i) * 64 + lane, row = s_ >> 4, pos = s_ & 15, ch = (pos & 8) | ((pos & 7) ^ (row & 7)); offA[i] = (unsigned)(row * 2048 + ch * 8) * 2u; }
    { const int s_ = wid * 64 + lane, row = s_ >> 3, ch = (s_ & 7) ^ (row & 7); offB = (unsigned)(row * 64 + ch * 8) * 2u; }
#pragma unroll
    for (int i = 0; i < 2; ++i) { const int s_ = (wid + 8 * i) * 64 + lane, sub = s_ >> 5, within = s_ & 31, kk = (sub >> 2) * 8 + (within >> 2), key = (kk & ~0xC) | ((kk & 4) << 1) | ((kk & 8) >> 1), c = (sub & 3) * 32 + (within & 3) * 8;
        offV[i] = (unsigned)(key * 2048 + 128 + c) * 2u; }
    const char* const KVh = (const char*)(KV + rowbase * 2048 + h * 256); const char* const KPEb = (const char*)(KPE + rowbase * 64);
#define DMA_TILE(t_, kbuf_, vslot_) do { const char* kvt_ = KVh + (size_t)(t_) * (64 * 2048 * 2); const char* pet_ = KPEb + (size_t)(t_) * (64 * 64 * 2); \
        _Pragma("unroll") for (int i = 0; i < 2; ++i) __builtin_amdgcn_global_load_lds((const unsigned*)(kvt_ + offA[i]), (LAS unsigned*)(K_lds + (kbuf_) * SHM_K + (wid + 8 * i) * 1024), 16, 0, 0); \
        __builtin_amdgcn_global_load_lds((const unsigned*)(pet_ + offB), (LAS unsigned*)(K_lds + (kbuf_) * SHM_K + 16384 + wid * 1024), 16, 0, 0); \
        _Pragma("unroll") for (int i = 0; i < 2; ++i) __builtin_amdgcn_global_load_lds((const unsigned*)(kvt_ + offV[i]), (LAS unsigned*)(V_lds + (vslot_) * SHM_V + (wid + 8 * i) * 1024), 16, 0, 0); } while (0)
#define DMA_WAIT_BAR() do { asm volatile("s_waitcnt vmcnt(0)" ::: "memory"); __syncthreads(); } while (0)
    const int vb0 = (int)(uintptr_t)V_lds + v_rd_base(lane);
    float m_reg = -1e30f, l_reg = 0.f; f32x16 o[4] = {};
    const int qlo = q0 + wid * 32, qm = qlo + r32 - 4 * hi;
#define RESC(al_) do { if (__any((al_) < 1.f)) { if (hi == 0) al_l[r32] = (al_); LDS_WAIT(); \
        _Pragma("unroll") for (int d_ = 0; d_ < 4; ++d_) _Pragma("unroll") for (int r = 0; r < 16; ++r) o[d_][r] *= al_l[crow(r, hi)]; } } while (0)
    f32x16 pA0, pA1, pB0, pB1; float alA, alB;
    DMA_TILE(0, 0, 0);
    DMA_WAIT_BAR();
    DMA_TILE(1, 1, 1);
    qkt(pA0, pA1, K_lds, r32, hi, qr, qpe);
    if (63 > qlo) mask_tile(pA0, pA1, qm);
    partialSM(pA0, pA1, m_reg, alA);
#define STEP(X0, X1, alX, Y0, Y1, alY, t_, MASKED) do { const int tt_ = (t_); \
        DMA_WAIT_BAR();                                     \
        if (tt_ + 1 < NT) DMA_TILE(tt_ + 1, (tt_ + 1) & 1, (tt_ + 1) % 3); \
        SBAR(); \
        qkt(X0, X1, K_lds + (tt_ & 1) * SHM_K, r32, hi, qr, qpe); \
        bf16x8 pa0, pa1, pa2, pa3; \
        finishSM(Y0, Y1, alY, l_reg, pa0, pa1, pa2, pa3); \
        SBAR(); \
        pv_tile(o, vb0 + ((tt_ - 1) % 3) * SHM_V, pa0, pa1, pa2, pa3); \
        if (MASKED) { const int kb_ = tt_ * 64; if (kb_ + 63 > qlo) mask_tile(X0, X1, qm - kb_); } \
        partialSM(X0, X1, m_reg, alX); \
        RESC(alX); } while (0)
    int t = 1;
    for (; t + 1 < NT - 4; t += 2) { STEP(pB0, pB1, alB, pA0, pA1, alA, t, false); STEP(pA0, pA1, alA, pB0, pB1, alB, t + 1, false); }
    for (; t + 1 < NT; t += 2) { STEP(pB0, pB1, alB, pA0, pA1, alA, t, true); STEP(pA0, pA1, alA, pB0, pB1, alB, t + 1, true); }
    STEP(pB0, pB1, alB, pA0, pA1, alA, t, true);
    { bf16x8 pa0, pa1, pa2, pa3; finishSM(pB0, pB1, alB, l_reg, pa0, pa1, pa2, pa3); SBAR(); pv_tile(o, vb0 + ((NT - 1) % 3) * SHM_V, pa0, pa1, pa2, pa3); }
#undef STEP
#undef RESC
#undef DMA_TILE
#undef DMA_WAIT_BAR
    if (hi == 0) li_l[r32] = l_reg;
    __syncthreads();
    bf16* Ow = O + (rowbase + q0 + wid * 32) * 1024 + h * DVH;
    LAS char* ost = lds + wid * 8192;
#pragma unroll
    for (int r = 0; r < 16; ++r) { const int orow = crow(r, hi); const float rl = frcp(li_l[orow]);
#pragma unroll
        for (int d0 = 0; d0 < 4; ++d0) *(LAS bf16*)(ost + orow * 256 + (d0 * 32 + r32) * 2) = (bf16)(cvtpk(o[d0][r] * rl, 0.f) & 0xffffu); }
    LDS_WAIT();
#pragma unroll
    for (int i = 0; i < 8; ++i) { const int p_ = lane + 64 * i, row_ = p_ >> 4, ch = p_ & 15;
        *(GAS v4u*)(Ow + (size_t)row_ * 1024 + ch * 8) = *(const LAS v4u*)(ost + row_ * 256 + ch * 16); }
    __syncthreads();
}
#undef KSWZ
}


__device__ __forceinline__ void ml_conv_phase(Frame& F, const Inputs& in, int j) {
    const bf16* P = (const bf16*)(F.ws + WS_ARENA + A_P); const float* GATES = (const float*)(F.ws + WS_ARENA + A_GATES);
    float* QKC = (float*)(F.ws + WS_ARENA + A_QKC); float* IGLF = (float*)(F.ws + WS_ARENA + A_IGLF);
    const float* cw = in.ml_conv_w + (size_t)j * 4 * 1024; const float* cb = in.ml_conv_b + (size_t)j * 1024; const float* bif = in.ml_b_if + (size_t)j * 16;
    const int gt = F.gw * 64 + F.lane, NT_ = F.NGW * 64;
    for (int e = gt; e < T * 128; e += NT_) {
        const int t = e >> 7, c = (e & 127) * 8, s = t & (SEQ - 1);
        float acc[8];
        { const f32x4 b0 = *(const GAS f32x4*)(cb + c), b1 = *(const GAS f32x4*)(cb + c + 4);
#pragma unroll
          for (int q = 0; q < 4; ++q) { acc[q] = b0[q]; acc[4 + q] = b1[q]; } }
#pragma unroll
        for (int k = 0; k < 4; ++k) { const int dt = 3 - k;
            if (s - dt >= 0) { float pv[8]; unpack8(*(const GAS v4u*)(P + (size_t)(t - dt) * 3072 + c), pv);
                const f32x4 w0 = *(const GAS f32x4*)(cw + k * 1024 + c), w1 = *(const GAS f32x4*)(cw + k * 1024 + c + 4);
#pragma unroll
                for (int q = 0; q < 4; ++q) { acc[q] += w0[q] * pv[q]; acc[4 + q] += w1[q] * pv[4 + q]; } } }
        const float sc = (c >= 512) ? 0.125f : 1.f;
        f32x4 o0, o1;
#pragma unroll
        for (int q = 0; q < 4; ++q) { o0[q] = fsilu(acc[q]) * sc; o1[q] = fsilu(acc[4 + q]) * sc; }
        GAS f32x4* op = (GAS f32x4*)(QKC + (size_t)t * 1024 + c); op[0] = o0; op[1] = o1;
    }
    for (int e = gt; e < T * 16; e += NT_) { const int hcol = e & 15; const float g = GATES[e] + bif[hcol];
        float r = g;
        if (hcol >= 8) r = fminf(g, 0.f) - flog(1.f + fexp(-fabsf(g)));
        IGLF[e] = r; }
}
__device__ __forceinline__ void ml_seq_phase(Frame& F) {
    if ((int)blockIdx.x >= BATCH * ML_H) return;
    const int bh = blockIdx.x, b = bh >> 3, h = bh & 7, tid = F.tid, v = tid >> 2, kq = tid & 3;
    const bf16* P = (const bf16*)(F.ws + WS_ARENA + A_P); const float* QKC = (const float*)(F.ws + WS_ARENA + A_QKC); const float* IGLF = (const float*)(F.ws + WS_ARENA + A_IGLF);
    float* HRAW = (float*)(F.ws + WS_ARENA + A_HRAW);
    LAS float* s_q = (LAS float*)F.lds; LAS float* s_k = s_q + 64 * 64; LAS float* s_v = s_k + 64 * 64; LAS float* s_h = s_v + 64 * 128; LAS float* s_ig = s_h + 64 * 128; LAS float* s_lf = s_ig + 64;
    float C[16], n[16]; float mst = 0.f;
#pragma unroll
    for (int d = 0; d < 16; ++d) { C[d] = 0.f; n[d] = 0.f; }
    for (int blk = 0; blk < SEQ / 64; ++blk) {
        const size_t t0 = (size_t)b * SEQ + (size_t)blk * 64;
        __syncthreads();
        for (int e = tid; e < 64 * 16; e += 512) { const int tt = e >> 4, c4 = (e & 15) * 4;
            *(LAS f32x4*)(s_q + tt * 64 + c4) = *(const GAS f32x4*)(QKC + (t0 + tt) * 1024 + h * 64 + c4);
            *(LAS f32x4*)(s_k + tt * 64 + c4) = *(const GAS f32x4*)(QKC + (t0 + tt) * 1024 + 512 + h * 64 + c4); }
        for (int e = tid; e < 64 * 16; e += 512) { const int tt = e >> 4, c8 = (e & 15) * 8; float pv[8];
            unpack8(*(const GAS v4u*)(P + (t0 + tt) * 3072 + 1024 + h * 128 + c8), pv);
#pragma unroll
            for (int q = 0; q < 8; ++q) s_v[tt * 128 + c8 + q] = pv[q]; }
        if (tid < 64) { s_ig[tid] = IGLF[(t0 + tid) * 16 + h]; s_lf[tid] = IGLF[(t0 + tid) * 16 + 8 + h]; }
        __syncthreads();
        for (int tt = 0; tt < 64; ++tt) {
            const float lf = s_lf[tt], ig = s_ig[tt];
            const float mn = fmaxf(lf + mst, ig), fw = fexp(lf + mst - mn), iw = fexp(ig - mn); mst = mn;
            const float vv = s_v[tt * 128 + v] * iw;
            float num = 0.f, den = 0.f;
#pragma unroll
            for (int d4 = 0; d4 < 4; ++d4) { const f32x4 kk = *(const LAS f32x4*)(s_k + tt * 64 + kq * 16 + d4 * 4), qq = *(const LAS f32x4*)(s_q + tt * 64 + kq * 16 + d4 * 4);
#pragma unroll
                for (int q = 0; q < 4; ++q) { const int d = d4 * 4 + q; C[d] = fw * C[d] + vv * kk[q]; n[d] = fw * n[d] + iw * kk[q]; num += C[d] * qq[q]; den += n[d] * qq[q]; } }
            num += __shfl_xor(num, 1); num += __shfl_xor(num, 2); den += __shfl_xor(den, 1); den += __shfl_xor(den, 2);
            const float hv = num * frcp(fmaxf(fabsf(den), fexp(-mn)));
            if (kq == 0) s_h[tt * 128 + v] = hv;
        }
        __syncthreads();
        for (int e = tid; e < 64 * 32; e += 512) { const int tt = e >> 5, c4 = (e & 31) * 4;
            *(GAS f32x4*)(HRAW + (t0 + tt) * 1024 + h * 128 + c4) = *(const LAS f32x4*)(s_h + tt * 128 + c4); }
    }
}
__device__ __forceinline__ void ml_out_phase(Frame& F, const Inputs& in, int j) {
    const bf16* P = (const bf16*)(F.ws + WS_ARENA + A_P); const float* HRAW = (const float*)(F.ws + WS_ARENA + A_HRAW); bf16* HM = (bf16*)(F.ws + WS_ARENA + A_HM);
    const float* gn = in.ml_out_norm + (size_t)j * 1024;
    for (int m = F.gw; m < T; m += F.NGW) { const int c = F.lane * 16;
        float hv[16]; float ss = 0.f;
#pragma unroll
        for (int q = 0; q < 4; ++q) { const f32x4 x = *(const GAS f32x4*)(HRAW + (size_t)m * 1024 + c + 4 * q);
#pragma unroll
            for (int e = 0; e < 4; ++e) { hv[4 * q + e] = x[e]; ss += x[e] * x[e]; } }
        ss += __shfl_xor(ss, 1); ss += __shfl_xor(ss, 2); ss += __shfl_xor(ss, 4);
        const float r = frsq(ss * (1.f / 128.f) + RMS_EPS);
        float ov[16]; unpack8(*(const GAS v4u*)(P + (size_t)m * 3072 + 2048 + c), ov); unpack8(*(const GAS v4u*)(P + (size_t)m * 3072 + 2048 + c + 8), ov + 8);
        float res[16];
#pragma unroll
        for (int e = 0; e < 16; ++e) res[e] = hv[e] * r * gn[c + e] * fsigmoid(ov[e]);
        GAS v4u* op = (GAS v4u*)(HM + (size_t)m * 1024 + c); op[0] = pack8f(res); op[1] = pack8f(res + 8);
    }
}

__device__ __forceinline__ void rw_shift_phase(Frame& F, const Inputs& in, int jl) {
    bf16* HX = (bf16*)(F.ws + WS_ARENA + A_HX);
    const int l8 = F.lane * 8; const float* mu = in.rw_mu + (size_t)jl * 6 * D + l8;
    f32x4 mr[2][2], mk[2][2], mv[2][2];
#pragma unroll
    for (int g = 0; g < 2; ++g)
#pragma unroll
        for (int q = 0; q < 2; ++q) { mr[g][q] = *(const GAS f32x4*)(mu + 0 * D + 512 * g + 4 * q); mk[g][q] = *(const GAS f32x4*)(mu + 2 * D + 512 * g + 4 * q); mv[g][q] = *(const GAS f32x4*)(mu + 3 * D + 512 * g + 4 * q); }
    for (int m0 = F.gw * 8; m0 < T; m0 += F.NGW * 8) {
        float rs;
        { const int rr = m0 - 1 + (F.lane >> 2); float s = 0.f;
          if (F.lane < 36 && rr >= 0) { const f32x4 a = *(const GAS f32x4*)(F.SS + (size_t)rr * 16 + (F.lane & 3) * 4); s = (a.x + a.y) + (a.z + a.w); }
          s += __shfl_xor(s, 1); s += __shfl_xor(s, 2); rs = frsq(s * (1.f / D) + RMS_EPS); }
        v4u xr[9][2];
#pragma unroll
        for (int i = 0; i < 9; ++i)
#pragma unroll
            for (int g = 0; g < 2; ++g) xr[i][g] = (m0 - 1 + i >= 0) ? *(const GAS v4u*)(F.XB + (size_t)(m0 - 1 + i) * D + 512 * g + l8) : (v4u){0u, 0u, 0u, 0u};
#pragma unroll
        for (int i = 1; i < 9; ++i) { const int m = m0 + i - 1; const bool first = (m & (SEQ - 1)) == 0;
            const float r = __builtin_bit_cast(float, __builtin_amdgcn_readlane(__builtin_bit_cast(int, rs), 4 * i));
            const float rp = first ? 0.f : __builtin_bit_cast(float, __builtin_amdgcn_readlane(__builtin_bit_cast(int, rs), 4 * (i - 1)));
#pragma unroll
            for (int g = 0; g < 2; ++g) { float xc[8], xq[8], xv[8], ar[8], ak[8], av[8];
                unpack8(xr[i][g], xc); unpack8(xr[i - 1][g], xq);
#pragma unroll
                for (int e = 0; e < 8; ++e) { const float hv = xc[e] * r, x = xq[e] * rp - hv; xv[e] = x; ar[e] = hv + mr[g][e >> 2][e & 3] * x; ak[e] = hv + mk[g][e >> 2][e & 3] * x; av[e] = hv + mv[g][e >> 2][e & 3] * x; }
                bf16* o = HX + (size_t)m * 4096 + 512 * g + l8;
                *(GAS v4u*)o = pack8f(ar); *(GAS v4u*)(o + 1024) = pack8f(ak); *(GAS v4u*)(o + 2048) = pack8f(av); *(GAS v4u*)(o + 3072) = pack8f(xv); } }
    }
}
__device__ __forceinline__ void rw_seq_phase(Frame& F, const Inputs& in, int j) {
    if ((int)blockIdx.x >= BATCH * RW_H) return;
    const int bh = blockIdx.x, b = bh >> 4, h = bh & 15, tid = F.tid, i = tid >> 3, jr = tid & 7;
    const bf16* RKV = (const bf16*)(F.ws + WS_ARENA + A_RKV); const bf16* AA = (const bf16*)(F.ws + WS_XB); float* LW = (float*)(F.ws + WS_ARENA + A_LW);
    LAS float* s_r = (LAS float*)F.lds; LAS float* s_w = s_r + 4096; LAS float* s_k = s_w + 4096; LAS float* s_v = s_k + 4096; LAS float* s_a = s_v + 4096; LAS float* s_b = s_a + 4096; LAS float* s_y = s_b + 4096;
    float kkc[8], kac[8];
#pragma unroll
    for (int q = 0; q < 8; ++q) { kkc[q] = in.rw_k_k[(size_t)j * 1024 + h * 64 + jr * 8 + q]; kac[q] = in.rw_k_a[(size_t)j * 1024 + h * 64 + jr * 8 + q]; }
    float S[8];
#pragma unroll
    for (int q = 0; q < 8; ++q) S[q] = 0.f;
    for (int blk = 0; blk < SEQ / 64; ++blk) {
        const size_t t0 = (size_t)b * SEQ + (size_t)blk * 64;
        __syncthreads();
        { const int tt = tid >> 3; const size_t t = t0 + tt; const int c = h * 64 + jr * 8;
          float rv[8], kv[8], vv[8], av[8];
          unpack8(*(const GAS v4u*)(RKV + t * 3072 + c), rv); unpack8(*(const GAS v4u*)(RKV + t * 3072 + 1024 + c), kv); unpack8(*(const GAS v4u*)(RKV + t * 3072 + 2048 + c), vv);
          unpack8(*(const GAS v4u*)(AA + t * 1024 + c), av);
          const f32x4 l0 = *(const GAS f32x4*)(LW + t * 1024 + c), l1 = *(const GAS f32x4*)(LW + t * 1024 + c + 4);
          float kk[8]; float ss = 0.f;
#pragma unroll
          for (int q = 0; q < 8; ++q) { kk[q] = kv[q] * kkc[q]; ss += kk[q] * kk[q]; }
          ss += __shfl_xor(ss, 1); ss += __shfl_xor(ss, 2); ss += __shfl_xor(ss, 4);
          const float inv = frcp(fmaxf(fsqrt(ss), 1e-12f));
#pragma unroll
          for (int q = 0; q < 8; ++q) { const float kn = kk[q] * inv; const int o = tt * 64 + jr * 8 + q;
              s_r[o] = rv[q]; s_w[o] = fexp(q < 4 ? l0[q] : l1[q - 4]); s_k[o] = kv[q] * (1.f + (av[q] - 1.f) * kac[q]); s_v[o] = vv[q]; s_a[o] = -kn; s_b[o] = kn * av[q]; } }
        __syncthreads();
        for (int tt = 0; tt < 64; ++tt) {
            const int o = tt * 64 + jr * 8;
            const f32x4 a0 = *(const LAS f32x4*)(s_a + o), a1 = *(const LAS f32x4*)(s_a + o + 4), w0 = *(const LAS f32x4*)(s_w + o), w1 = *(const LAS f32x4*)(s_w + o + 4);
            const f32x4 b0 = *(const LAS f32x4*)(s_b + o), b1 = *(const LAS f32x4*)(s_b + o + 4), k0 = *(const LAS f32x4*)(s_k + o), k1 = *(const LAS f32x4*)(s_k + o + 4);
            const f32x4 r0 = *(const LAS f32x4*)(s_r + o), r1 = *(const LAS f32x4*)(s_r + o + 4);
            const float vi = s_v[tt * 64 + i];
            float sa = 0.f;
#pragma unroll
            for (int q = 0; q < 4; ++q) { sa += S[q] * a0[q]; sa += S[4 + q] * a1[q]; }
            sa += __shfl_xor(sa, 1); sa += __shfl_xor(sa, 2); sa += __shfl_xor(sa, 4);
            float y = 0.f;
#pragma unroll
            for (int q = 0; q < 4; ++q) { S[q] = S[q] * w0[q] + sa * b0[q] + vi * k0[q]; S[4 + q] = S[4 + q] * w1[q] + sa * b1[q] + vi * k1[q]; y += S[q] * r0[q]; y += S[4 + q] * r1[q]; }
            y += __shfl_xor(y, 1); y += __shfl_xor(y, 2); y += __shfl_xor(y, 4);
            if (jr == 0) s_y[tt * 64 + i] = y;
        }
        __syncthreads();
        for (int e = tid; e < 64 * 16; e += 512) { const int tt = e >> 4, c4 = (e & 15) * 4;
            *(GAS f32x4*)(LW + (t0 + tt) * 1024 + h * 64 + c4) = *(const LAS f32x4*)(s_y + tt * 64 + c4); }
    }
}
__device__ __forceinline__ void rw_out_phase(Frame& F, const Inputs& in, int j) {
    const bf16* RKV = (const bf16*)(F.ws + WS_ARENA + A_RKV); const bf16* AA = (const bf16*)(F.ws + WS_XB); const float* Y = (const float*)(F.ws + WS_ARENA + A_LW);
    const bf16* GG = (const bf16*)(F.ws + WS_ARENA + A_GG); bf16* YG = (bf16*)(F.ws + WS_ARENA + A_YG);
    const float* ka = in.rw_k_a + (size_t)j * 1024; const float* rk = in.rw_r_k + (size_t)j * 1024; const float* lnw = in.rw_ln_w + (size_t)j * 1024; const float* lnb = in.rw_ln_b + (size_t)j * 1024;
    for (int m = F.gw; m < T; m += F.NGW) { const int c = F.lane * 16;
        float yv[16]; float s1 = 0.f;
#pragma unroll
        for (int q = 0; q < 4; ++q) { const f32x4 x = *(const GAS f32x4*)(Y + (size_t)m * 1024 + c + 4 * q);
#pragma unroll
            for (int e = 0; e < 4; ++e) { yv[4 * q + e] = x[e]; s1 += x[e]; } }
        s1 += __shfl_xor(s1, 1); s1 += __shfl_xor(s1, 2); const float mean = s1 * (1.f / 64.f);
        float s2 = 0.f;
#pragma unroll
        for (int e = 0; e < 16; ++e) { yv[e] -= mean; s2 += yv[e] * yv[e]; }
        s2 += __shfl_xor(s2, 1); s2 += __shfl_xor(s2, 2); const float rs = frsq(s2 * (1.f / 64.f) + 64e-5f);
        float rv[16], kv[16], vv[16], av[16], gv[16];
        unpack8(*(const GAS v4u*)(RKV + (size_t)m * 3072 + c), rv); unpack8(*(const GAS v4u*)(RKV + (size_t)m * 3072 + c + 8), rv + 8);
        unpack8(*(const GAS v4u*)(RKV + (size_t)m * 3072 + 1024 + c), kv); unpack8(*(const GAS v4u*)(RKV + (size_t)m * 3072 + 1024 + c + 8), kv + 8);
        unpack8(*(const GAS v4u*)(RKV + (size_t)m * 3072 + 2048 + c), vv); unpack8(*(const GAS v4u*)(RKV + (size_t)m * 3072 + 2048 + c + 8), vv + 8);
        unpack8(*(const GAS v4u*)(AA + (size_t)m * 1024 + c), av); unpack8(*(const GAS v4u*)(AA + (size_t)m * 1024 + c + 8), av + 8);
        unpack8(*(const GAS v4u*)(GG + (size_t)m * 1024 + c), gv); unpack8(*(const GAS v4u*)(GG + (size_t)m * 1024 + c + 8), gv + 8);
        float bs = 0.f;
#pragma unroll
        for (int e = 0; e < 16; ++e) { const float kp = kv[e] * (1.f + (av[e] - 1.f) * ka[c + e]); bs += rv[e] * kp * rk[c + e]; }
        bs += __shfl_xor(bs, 1); bs += __shfl_xor(bs, 2);
        float res[16];
#pragma unroll
        for (int e = 0; e < 16; ++e) res[e] = (yv[e] * rs * lnw[c + e] + lnb[c + e] + bs * vv[e]) * gv[e];
        GAS v4u* op = (GAS v4u*)(YG + (size_t)m * 1024 + c); op[0] = pack8f(res); op[1] = pack8f(res + 8);
    }
}
__device__ __forceinline__ void final_norm_phase(Frame& F, const Inputs& in) {
    const int l4 = F.lane * 4;
    f32x4 g[4];
#pragma unroll
    for (int q = 0; q < 4; ++q) g[q] = *(const GAS f32x4*)(in.final_norm + 256 * q + l4);
    for (int m0 = F.gw * 8; m0 < T; m0 += F.NGW * 8) {
        v2u xa[8][4]; f32x4 sp[8];
#pragma unroll
        for (int i = 0; i < 8; ++i) { const int m = m0 + i;
#pragma unroll
            for (int q = 0; q < 4; ++q) xa[i][q] = *(const GAS v2u*)(F.XB + (size_t)m * D + 256 * q + l4);
            sp[i] = *(const GAS f32x4*)(F.SS + (size_t)m * 16 + (F.lane & 3) * 4); }
#pragma unroll
        for (int i = 0; i < 8; ++i) { const int m = m0 + i;
            float s = (sp[i].x + sp[i].y) + (sp[i].z + sp[i].w); s += __shfl_xor(s, 1); s += __shfl_xor(s, 2);
            const float r = frsq(s * (1.f / D) + RMS_EPS);
            GAS f32x4* op = (GAS f32x4*)(F.X + (size_t)m * D + l4);
#pragma unroll
            for (int q = 0; q < 4; ++q) { const v2u w = xa[i][q]; f32x4 o; o.x = bf_lo(w.x) * r * g[q].x; o.y = bf_hi(w.x) * r * g[q].y; o.z = bf_lo(w.y) * r * g[q].z; o.w = bf_hi(w.y) * r * g[q].w;
                __builtin_nontemporal_store(o, op + 64 * q); } }
    }
}

namespace mlc {
constexpr int NUNIT = BATCH * ML_H * (SEQ / 64);
constexpr size_t A_QKB = 97 * MiB;
constexpr size_t A_XT = 130 * MiB;
constexpr size_t A_CT = 194 * MiB;
constexpr size_t A_NX = 226 * MiB, A_NC = 227 * MiB;
constexpr size_t A_SC = 228 * MiB;
constexpr size_t A_HM2 = A_XT;
constexpr size_t A_IG2 = 129 * MiB;
constexpr int SLOT = 34816;
using att::v_st; using att::v_rd_base; using att::v_rd_off; using att::crow;
#define TRRD(dst, base, off) asm volatile("ds_read_b64_tr_b16 %0, %1 offset:%2" : "=&v"(dst) : "v"(base), "i"(off) : "memory")
#define FRAG(l, h) ((bf16x8){l[0], l[1], l[2], l[3], h[0], h[1], h[2], h[3]})
__device__ __forceinline__ float swap_add(float x) { auto rr = __builtin_amdgcn_permlane32_swap(__float_as_uint(x), __float_as_uint(x), false, false); return __uint_as_float(rr[0]) + __uint_as_float(rr[1]); }
__device__ __forceinline__ float wave_incl_scan_add(float v, int lane) {
#pragma unroll
    for (int o = 1; o < 64; o <<= 1) { const float t = __shfl_up(v, o); if (lane >= o) v += t; }
    return v;
}
__device__ __forceinline__ float wave_incl_scan_max(float v, int lane) {
#pragma unroll
    for (int o = 1; o < 64; o <<= 1) { const float t = __shfl_up(v, o); if (lane >= o) v = fmaxf(v, t); }
    return v;
}
__device__ __forceinline__ float wave_max(float v) {
#pragma unroll
    for (int o = 1; o < 64; o <<= 1) v = fmaxf(v, __shfl_xor(v, o));
    return v;
}
__device__ __forceinline__ void conv_phase(Frame& F, const Inputs& in, int j) {
    const bf16* P = (const bf16*)(F.ws + WS_ARENA + A_P); const float* GATES = (const float*)(F.ws + WS_ARENA + A_GATES);
    bf16* QKB = (bf16*)(F.ws + WS_ARENA + A_QKB); float* IGLF = (float*)(F.ws + WS_ARENA + mlc::A_IG2);
    const float* cw = in.ml_conv_w + (size_t)j * 4 * 1024; const float* cb = in.ml_conv_b + (size_t)j * 1024; const float* bif = in.ml_b_if + (size_t)j * 16;
    const int gt = F.gw * 64 + F.lane, NT_ = F.NGW * 64;
    {
        const int c = (gt & 127) * 8;
        f32x4 bw[2], cwv[4][2];
#pragma unroll
        for (int q = 0; q < 2; ++q) { bw[q] = *(const GAS f32x4*)(cb + c + 4 * q);
#pragma unroll
            for (int k = 0; k < 4; ++k) cwv[k][q] = *(const GAS f32x4*)(cw + k * 1024 + c + 4 * q); }
        const float sc = (c >= 512) ? 0.125f : 1.f;
        for (int e0 = gt; e0 < T * 128; e0 += 4 * NT_) {
            v4u pvr[4][4];
#pragma unroll
            for (int i = 0; i < 4; ++i) { const int e = e0 + i * NT_, t = e >> 7, s = t & (SEQ - 1);
#pragma unroll
                for (int k = 0; k < 4; ++k) { const int dt = 3 - k; pvr[i][k] = (e < T * 128 && s - dt >= 0) ? *(const GAS v4u*)(P + (size_t)(t - dt) * 3072 + c) : (v4u){0u, 0u, 0u, 0u}; } }
#pragma unroll
            for (int i = 0; i < 4; ++i) { const int e = e0 + i * NT_, t = e >> 7;
                float acc[8];
#pragma unroll
                for (int q = 0; q < 4; ++q) { acc[q] = bw[0][q]; acc[4 + q] = bw[1][q]; }
#pragma unroll
                for (int k = 0; k < 4; ++k) { float pv[8]; unpack8(pvr[i][k], pv);
#pragma unroll
                    for (int q = 0; q < 4; ++q) { acc[q] += cwv[k][0][q] * pv[q]; acc[4 + q] += cwv[k][1][q] * pv[4 + q]; } }
                float o[8];
#pragma unroll
                for (int q = 0; q < 8; ++q) o[q] = fsilu(acc[q]) * sc;
                if (e < T * 128) *(GAS v4u*)(QKB + (size_t)t * 1024 + c) = pack8f(o); }
        }
    }
    for (int e = gt; e < T * 16; e += NT_) { const int hcol = e & 15; const float g = GATES[e] + bif[hcol];
        float r = g;
        if (hcol >= 8) r = fminf(g, 0.f) - flog(1.f + fexp(-fabsf(g)));
        IGLF[e] = r; }
}
__device__ __forceinline__ void stage_tr128(LAS char* tile, const bf16* src, int ld, int lt, int nthr) {
    for (int idx = lt; idx < 1024; idx += nthr) { const int row = idx >> 4, ch = idx & 15;
        *(LAS v4u*)(tile + v_st(row, ch * 8)) = *(const GAS v4u*)(src + (size_t)row * ld + ch * 8); }
}
__device__ __forceinline__ void xa_phase(Frame& F) {
    const bf16* P = (const bf16*)(F.ws + WS_ARENA + A_P); const bf16* QKB = (const bf16*)(F.ws + WS_ARENA + A_QKB); const float* IGLF = (const float*)(F.ws + WS_ARENA + mlc::A_IG2);
    float* XT = (float*)(F.ws + WS_ARENA + A_XT); float* NX = (float*)(F.ws + WS_ARENA + A_NX); float* SC = (float*)(F.ws + WS_ARENA + A_SC);
    const int lane = F.lane, wave = F.wave, r32 = lane & 31, hi = lane >> 5, us = wave >> 1, half = wave & 1, lt = half * 64 + lane;
    LAS char* slot = (LAS char*)F.lds + us * SLOT; LAS char* Vt = slot; LAS char* KWt = slot + 16384; LAS float* wsl = (LAS float*)(slot + 32768);
    for (int u0 = (int)blockIdx.x * 4; u0 < NUNIT; u0 += F.G * 4) {
        const int u = u0 + us, bh = u >> 7, c = u & 127, b = bh >> 3, h = bh & 7; const size_t t0 = (size_t)b * SEQ + (size_t)c * 64;
        v4u vst[8], kst[4];
#pragma unroll
        for (int i = 0; i < 8; ++i) { const int idx = lt + 128 * i, row = idx >> 4, ch = idx & 15; vst[i] = *(const GAS v4u*)(P + (t0 + row) * 3072 + 1024 + h * 128 + ch * 8); }
#pragma unroll
        for (int i = 0; i < 4; ++i) { const int idx = lt + 128 * i, row = idx >> 3, ch = idx & 7; kst[i] = *(const GAS v4u*)(QKB + (t0 + row) * 1024 + 512 + h * 64 + ch * 8); }
        const float lf = IGLF[(t0 + lane) * 16 + 8 + h], ig = IGLF[(t0 + lane) * 16 + h];
        const float Fc = wave_incl_scan_add(lf, lane), bs = ig - Fc, M = wave_max(bs), a = __shfl(Fc, 63), w = fexp(bs - M);
        if (half == 0) { wsl[lane] = w; if (lane == 0) { SC[u] = a; SC[NUNIT + u] = M; } }
        __syncthreads();
#pragma unroll
        for (int i = 0; i < 8; ++i) { const int idx = lt + 128 * i, row = idx >> 4, ch = idx & 15; *(LAS v4u*)(Vt + v_st(row, ch * 8)) = vst[i]; }
#pragma unroll
        for (int i = 0; i < 4; ++i) { const int idx = lt + 128 * i, row = idx >> 3, ch = idx & 7; float kv[8];
            unpack8(kst[i], kv); const float ww = wsl[row];
#pragma unroll
            for (int q = 0; q < 8; ++q) kv[q] *= ww;
            *(LAS v4u*)(KWt + v_st(row, ch * 8)) = pack8f(kv); }
        __syncthreads();
        const int vb = (int)(uintptr_t)Vt + v_rd_base(lane), kb = (int)(uintptr_t)KWt + v_rd_base(lane) + half * 512;
        f32x16 acc[4] = {};
#define XA_VT(vt) do { s16x4 vl0, vh0, vl1, vh1, vl2, vh2, vl3, vh3, kl0, kh0, kl1, kh1, kl2, kh2, kl3, kh3; constexpr int o_ = v_rd_off(vt, 0, 0); \
            TRRD(vl0, vb, o_); TRRD(vh0, vb, o_ + 2048); TRRD(vl1, vb, o_ + 4096); TRRD(vh1, vb, o_ + 6144); TRRD(vl2, vb, o_ + 8192); TRRD(vh2, vb, o_ + 10240); TRRD(vl3, vb, o_ + 12288); TRRD(vh3, vb, o_ + 14336); \
            TRRD(kl0, kb, 0); TRRD(kh0, kb, 2048); TRRD(kl1, kb, 4096); TRRD(kh1, kb, 6144); TRRD(kl2, kb, 8192); TRRD(kh2, kb, 10240); TRRD(kl3, kb, 12288); TRRD(kh3, kb, 14336); \
            asm volatile("s_waitcnt lgkmcnt(0)" ::: "memory"); __builtin_amdgcn_sched_barrier(0); \
            acc[vt] = __builtin_amdgcn_mfma_f32_32x32x16_bf16(FRAG(vl0, vh0), FRAG(kl0, kh0), acc[vt], 0, 0, 0); \
            acc[vt] = __builtin_amdgcn_mfma_f32_32x32x16_bf16(FRAG(vl1, vh1), FRAG(kl1, kh1), acc[vt], 0, 0, 0); \
            acc[vt] = __builtin_amdgcn_mfma_f32_32x32x16_bf16(FRAG(vl2, vh2), FRAG(kl2, kh2), acc[vt], 0, 0, 0); \
            acc[vt] = __builtin_amdgcn_mfma_f32_32x32x16_bf16(FRAG(vl3, vh3), FRAG(kl3, kh3), acc[vt], 0, 0, 0); } while (0)
        XA_VT(0); XA_VT(1); XA_VT(2); XA_VT(3);
#undef XA_VT
        { const int d = half * 32 + r32; float nx = 0.f;
#pragma unroll 8
          for (int s = 0; s < 32; ++s) nx += bf1(*(const LAS bf16*)(KWt + v_st(32 * hi + s, d & ~7) + (d & 7) * 2));
          nx = swap_add(nx);
          if (hi == 0) NX[(size_t)u * 64 + d] = nx; }
        { GAS float* xo = (GAS float*)(XT + (size_t)u * 8192 + half * 32 + r32 + hi * 256);
#pragma unroll
          for (int vt = 0; vt < 4; ++vt)
#pragma unroll
              for (int r4 = 0; r4 < 4; ++r4) { asm volatile("" : "+v"(xo));
#pragma unroll
                  for (int r0 = 0; r0 < 4; ++r0) xo[r0 * 64] = acc[vt][r4 * 4 + r0];
                  xo += 512; } }
        __syncthreads();
    }
}
__device__ __forceinline__ void xb_phase(Frame& F) {
    const float* __restrict__ XT = (const float*)(F.ws + WS_ARENA + A_XT); const float* __restrict__ NX = (const float*)(F.ws + WS_ARENA + A_NX); float* SC = (float*)(F.ws + WS_ARENA + A_SC);
    bf16* __restrict__ CT = (bf16*)(F.ws + WS_ARENA + A_CT); float* __restrict__ NC = (float*)(F.ws + WS_ARENA + A_NC);
    for (int g = (int)blockIdx.x * 512 + F.tid; g < BATCH * ML_H * 8192; g += F.G * 512) {
        const int bh = g >> 13, e = g & 8191;
        float m = 0.f, C = 0.f, n = 0.f;
        float xA[16], aA[16], MA[16], nA[16], xB[16], aB[16], MB[16], nB[16];
#define XB_LOAD(c0_, x_, a_, M_, nx_) do { _Pragma("unroll") for (int i = 0; i < 16; ++i) { const int u = bh * 128 + (c0_) + i; x_[i] = *(const GAS float*)(XT + (size_t)u * 8192 + e); a_[i] = *(const GAS float*)(SC + u); M_[i] = *(const GAS float*)(SC + NUNIT + u); \
            nx_[i] = (e < 64) ? *(const GAS float*)(NX + (size_t)u * 64 + e) : 0.f; } } while (0)
#define XB_RUN(c0_, x_, a_, M_, nx_) do { _Pragma("unroll") for (int i = 0; i < 16; ++i) { const int u = bh * 128 + (c0_) + i; \
            *(GAS bf16*)(CT + (size_t)u * 8192 + e) = (bf16)(cvtpk(C, 0.f) & 0xffffu); \
            const float mn = a_[i] + fmaxf(m, M_[i]), fC = fexp(a_[i] + m - mn), fX = fexp(a_[i] + M_[i] - mn); \
            if (e < 64) { *(GAS float*)(NC + (size_t)u * 64 + e) = n; n = fC * n + fX * nx_[i]; } \
            if (e == 0) *(GAS float*)(SC + 2 * NUNIT + u) = m; \
            C = fC * C + fX * x_[i]; m = mn; } } while (0)
        XB_LOAD(0, xA, aA, MA, nA);
#pragma nounroll
        for (int c0 = 0; c0 < 128; c0 += 32) {
            XB_LOAD(c0 + 16, xB, aB, MB, nB);
            XB_RUN(c0, xA, aA, MA, nA);
            if (c0 + 32 < 128) XB_LOAD(c0 + 32, xA, aA, MA, nA);
            XB_RUN(c0 + 16, xB, aB, MB, nB);
        }
#undef XB_LOAD
#undef XB_RUN
    }
}
__device__ __forceinline__ void xc_phase(Frame& F, const Inputs& in, int j) {
    const bf16* P = (const bf16*)(F.ws + WS_ARENA + A_P); const bf16* QKB = (const bf16*)(F.ws + WS_ARENA + A_QKB); const float* IGLF = (const float*)(F.ws + WS_ARENA + mlc::A_IG2);
    const bf16* CT = (const bf16*)(F.ws + WS_ARENA + A_CT); const float* NC = (const float*)(F.ws + WS_ARENA + A_NC); const float* SC = (const float*)(F.ws + WS_ARENA + A_SC);
    bf16* HM = (bf16*)(F.ws + WS_ARENA + A_HM2); const float* gn = in.ml_out_norm + (size_t)j * 1024;
    const int lane = F.lane, wave = F.wave, r32 = lane & 31, hi = lane >> 5, us = wave >> 1, th = wave & 1, lt = th * 64 + lane;
    LAS char* slot = (LAS char*)F.lds + us * SLOT; LAS char* Kt = slot; LAS char* Vt = slot + 8192;
    LAS float* sb = (LAS float*)(slot + 24576); LAS float* se = sb + 64; LAS float* sF = se + 64; LAS float* sn = sF + 64;
    LAS float* ob = (LAS float*)(slot + th * 16896);
    for (int u0 = (int)blockIdx.x * 4; u0 < NUNIT; u0 += F.G * 4) {
        const int u = u0 + us, bh = u >> 7, c = u & 127, b = bh >> 3, h = bh & 7; const size_t t0 = (size_t)b * SEQ + (size_t)c * 64;
        const float mc = SC[2 * NUNIT + u];
        { const float lf = IGLF[(t0 + lane) * 16 + 8 + h], ig = IGLF[(t0 + lane) * 16 + h];
          const float Fc = wave_incl_scan_add(lf, lane), bs = ig - Fc, Mt = wave_incl_scan_max(bs, lane);
          if (th == 0) { sb[lane] = bs; se[lane] = fmaxf(mc, Mt); sF[lane] = Fc; sn[lane] = NC[(size_t)u * 64 + lane]; } }
        for (int idx = lt; idx < 512; idx += 128) { const int row = idx >> 3, ch = idx & 7;
            *(LAS v4u*)(Kt + row * 128 + ((ch * 16) ^ ((row & 7) << 4))) = *(const GAS v4u*)(QKB + (t0 + row) * 1024 + 512 + h * 64 + ch * 8); }
        stage_tr128(Vt, P + t0 * 3072 + 1024 + h * 128, 3072, lt, 128);
        const int tl = th * 32 + r32;
        bf16x8 qr[4];
#pragma unroll
        for (int d0 = 0; d0 < 4; ++d0) qr[d0] = *(const GAS bf16x8*)(QKB + (t0 + tl) * 1024 + h * 64 + d0 * 16 + hi * 8);
        unsigned ows[32];
#pragma unroll
        for (int tt = 0; tt < 32; ++tt) ows[tt] = *(const GAS unsigned*)(P + (t0 + th * 32 + tt) * 3072 + 2048 + h * 128 + lane * 2);
        __syncthreads();
        const float et = se[tl], Fct = sF[tl], iw = fexp(mc - et);
        f32x16 p0 = {}, p1 = {};
#pragma unroll
        for (int d0 = 0; d0 < 4; ++d0) { const int cb = (d0 * 32 + hi * 16) ^ ((r32 & 7) << 4);
            const bf16x8 k0 = *(const LAS bf16x8*)(Kt + r32 * 128 + cb);
            p0 = __builtin_amdgcn_mfma_f32_32x32x16_bf16(k0, qr[d0], p0, 0, 0, 0);
            if (th) { const bf16x8 k1 = *(const LAS bf16x8*)(Kt + (32 + r32) * 128 + cb); p1 = __builtin_amdgcn_mfma_f32_32x32x16_bf16(k1, qr[d0], p1, 0, 0, 0); } }
        float dsum = 0.f;
#pragma unroll
        for (int r = 0; r < 16; ++r) { const int s0 = crow(r, hi);
            const float w0 = (s0 <= tl) ? fexp(sb[s0] - et) : 0.f; p0[r] *= w0; dsum += p0[r];
            const float w1 = (th && s0 + 32 <= tl) ? fexp(sb[s0 + 32] - et) : 0.f; p1[r] *= w1; dsum += p1[r]; }
        dsum = swap_add(dsum);
        bf16x8 pa0, pa1, pa2, pa3;
#define PK4(Pv, B_, OUT) do { unsigned a0 = cvtpk(Pv[B_+0], Pv[B_+1]), a1 = cvtpk(Pv[B_+2], Pv[B_+3]); unsigned b0 = cvtpk(Pv[B_+4], Pv[B_+5]), b1 = cvtpk(Pv[B_+6], Pv[B_+7]); \
        auto r0 = __builtin_amdgcn_permlane32_swap(a0, b0, false, false); auto r1 = __builtin_amdgcn_permlane32_swap(a1, b1, false, false); \
        v4u w_ = {r0[0], r1[0], r0[1], r1[1]}; OUT = __builtin_bit_cast(bf16x8, w_); } while (0)
        PK4(p0, 0, pa0); PK4(p0, 8, pa1); PK4(p1, 0, pa2); PK4(p1, 8, pa3);
#undef PK4
        float qn = 0.f;
#pragma unroll
        for (int d0 = 0; d0 < 4; ++d0) { float qv[8]; unpack8(__builtin_bit_cast(v4u, qr[d0]), qv);
#pragma unroll
            for (int q = 0; q < 8; ++q) qn += qv[q] * sn[d0 * 16 + hi * 8 + q]; }
        qn = swap_add(qn);
        f32x16 acc[4] = {};
        const bf16* ctp = CT + (size_t)u * 8192 + (size_t)r32 * 64 + hi * 8;
#pragma unroll
        for (int vt = 0; vt < 4; ++vt)
#pragma unroll
            for (int d0 = 0; d0 < 4; ++d0) { const bf16x8 cf = *(const GAS bf16x8*)(ctp + vt * 32 * 64 + d0 * 16);
                acc[vt] = __builtin_amdgcn_mfma_f32_32x32x16_bf16(cf, qr[d0], acc[vt], 0, 0, 0); }
#pragma unroll
        for (int vt = 0; vt < 4; ++vt)
#pragma unroll
            for (int r = 0; r < 16; ++r) acc[vt][r] *= iw;
        const int vb = (int)(uintptr_t)Vt + v_rd_base(lane);
#define XC_VT(vt) do { s16x4 vl0, vh0, vl1, vh1, vl2, vh2, vl3, vh3; constexpr int o_ = v_rd_off(vt, 0, 0); \
            TRRD(vl0, vb, o_); TRRD(vh0, vb, o_ + 2048); TRRD(vl1, vb, o_ + 4096); TRRD(vh1, vb, o_ + 6144); \
            if (th) { TRRD(vl2, vb, o_ + 8192); TRRD(vh2, vb, o_ + 10240); TRRD(vl3, vb, o_ + 12288); TRRD(vh3, vb, o_ + 14336); } \
            asm volatile("s_waitcnt lgkmcnt(0)" ::: "memory"); __builtin_amdgcn_sched_barrier(0); \
            acc[vt] = __builtin_amdgcn_mfma_f32_32x32x16_bf16(FRAG(vl0, vh0), pa0, acc[vt], 0, 0, 0); \
            acc[vt] = __builtin_amdgcn_mfma_f32_32x32x16_bf16(FRAG(vl1, vh1), pa1, acc[vt], 0, 0, 0); \
            if (th) { acc[vt] = __builtin_amdgcn_mfma_f32_32x32x16_bf16(FRAG(vl2, vh2), pa2, acc[vt], 0, 0, 0); \
                      acc[vt] = __builtin_amdgcn_mfma_f32_32x32x16_bf16(FRAG(vl3, vh3), pa3, acc[vt], 0, 0, 0); } } while (0)
        XC_VT(0); XC_VT(1); XC_VT(2); XC_VT(3);
#undef XC_VT
        const float den = dsum + iw * qn;
        const float hs = frcp(fmaxf(fabsf(den), fexp(-Fct - et)));
        float ss = 0.f;
#pragma unroll
        for (int vt = 0; vt < 4; ++vt)
#pragma unroll
            for (int r = 0; r < 16; ++r) { acc[vt][r] *= hs; ss += acc[vt][r] * acc[vt][r]; }
        ss = swap_add(ss);
        const float rn = frsq(ss * (1.f / 128.f) + RMS_EPS);
        __syncthreads();
#pragma unroll
        for (int vt = 0; vt < 4; ++vt)
#pragma unroll
            for (int r = 0; r < 16; ++r) ob[(vt * 32 + crow(r, hi)) * 33 + r32] = acc[vt][r] * rn;
        LDS_WAIT();
        { const int v2 = lane * 2; const float g0 = gn[h * 128 + v2], g1 = gn[h * 128 + v2 + 1];
#pragma unroll
          for (int tt = 0; tt < 32; ++tt) { const size_t t = t0 + th * 32 + tt;
              const unsigned ow = ows[tt];
              const float x0 = ob[v2 * 33 + tt] * g0 * fsigmoid(bf_lo(ow)), x1 = ob[(v2 + 1) * 33 + tt] * g1 * fsigmoid(bf_hi(ow));
              *(GAS unsigned*)(HM + t * 1024 + h * 128 + v2) = cvtpk(x0, x1); } }
        __syncthreads();
    }
}
#undef TRRD
#undef FRAG
}

namespace rwc {
#ifdef SUBSTAMP
#define SUB_T0() unsigned long long sub_t_ = __builtin_amdgcn_s_memrealtime()
#define SUB_MARK(k) do { if (blockIdx.x == 0 && threadIdx.x == 0) { const unsigned long long n_ = __builtin_amdgcn_s_memrealtime(); if ((k) == SUBSTAMP) { const unsigned long long until_ = n_ + 8ull * (n_ - sub_t_); while (__builtin_amdgcn_s_memrealtime() < until_) __builtin_amdgcn_s_sleep(8); } } sub_t_ = __builtin_amdgcn_s_memrealtime(); } while (0)
#else
#define SUB_T0()
#define SUB_MARK(k)
#endif
constexpr int NU = BATCH * RW_H * (SEQ / 64);
constexpr size_t A_GL = A_LOR, A_BON = A_LOR + 1 * MiB;
constexpr int RMB = 9216, TRB = 8192;
constexpr int L_LWF = 0, L_AT_RM = 16384, L_BT_RM = L_AT_RM + RMB, L_KT_RM = L_BT_RM + RMB, L_RT_RM = L_KT_RM + RMB, L_KH_RM = L_RT_RM + RMB, L_T_RM = L_KH_RM + RMB, L_ARB_RM = L_T_RM + RMB,
              L_AT_TR = L_ARB_RM + RMB, L_BH_TR = L_AT_TR + TRB, L_V_TR = L_BH_TR + TRB, L_AAK_TR = L_V_TR + TRB, L_W2_TR = L_AAK_TR + TRB, L_H_TR = L_W2_TR + TRB, L_SEG = L_H_TR + TRB, L_TT_RM = L_SEG + 2048,
              L_P1_RM = L_BT_RM, L_P2_RM = L_KT_RM;
static_assert(L_TT_RM + RMB <= LDSCTL_OFF, "RWKV LDS map");
using att::crow; using att::v_rd_base;
__device__ __forceinline__ int rm_off(int row, int col) { return row * 144 + col * 2; }
__device__ __forceinline__ int tr_off(int row, int col) { const int kk = (row & ~0xC) | ((row & 4) << 1) | ((row & 8) >> 1); return ((kk >> 3) * 2 + (col >> 5)) * 512 + ((kk & 7) * 32 + (col & 31)) * 2; }
__device__ __forceinline__ bf16x8 frag_rm(const LAS char* tile, int row, int kb, int hi) { return *(const LAS bf16x8*)(tile + rm_off(row, kb * 16 + hi * 8)); }
__device__ __forceinline__ void frag_tr4(bf16x8 (&f)[4], const LAS char* tile, int cb, int lane) {
    const int base = (int)(uintptr_t)tile + v_rd_base(lane) + cb * 512; s16x4 l[4], h[4];
#pragma unroll
    for (int kb = 0; kb < 4; ++kb) { asm volatile("ds_read_b64_tr_b16 %0, %1" : "=&v"(l[kb]) : "v"(base + kb * 2048) : "memory"); asm volatile("ds_read_b64_tr_b16 %0, %1" : "=&v"(h[kb]) : "v"(base + kb * 2048 + 1024) : "memory"); }
    asm volatile("s_waitcnt lgkmcnt(0)" ::: "memory"); __builtin_amdgcn_sched_barrier(0);
#pragma unroll
    for (int kb = 0; kb < 4; ++kb) f[kb] = (bf16x8){l[kb][0], l[kb][1], l[kb][2], l[kb][3], h[kb][0], h[kb][1], h[kb][2], h[kb][3]};
}
__device__ __forceinline__ void frag_rm4(bf16x8 (&f)[4], const LAS char* tile, int row, int hi) {
#pragma unroll
    for (int kb = 0; kb < 4; ++kb) f[kb] = frag_rm(tile, row, kb, hi);
}
__device__ __forceinline__ f32x16 mm4(const bf16x8 (&a)[4], const bf16x8 (&b)[4]) { f32x16 acc = {};
#pragma unroll
    for (int kb = 0; kb < 4; ++kb) acc = __builtin_amdgcn_mfma_f32_32x32x16_bf16(a[kb], b[kb], acc, 0, 0, 0);
    return acc; }
__device__ __forceinline__ bf16 tobf(float x) { return (bf16)(cvtpk(x, 0.f) & 0xffffu); }
#define STORE_RM(tile, acc, mt, nt) do { _Pragma("unroll") for (int r_ = 0; r_ < 16; ++r_) *(LAS bf16*)((tile) + rm_off(32 * (mt) + crow(r_, hi), 32 * (nt) + r32)) = tobf((acc)[r_]); } while (0)
#define STORE_TR(tile, acc, mt, nt) do { _Pragma("unroll") for (int r_ = 0; r_ < 16; ++r_) *(LAS bf16*)((tile) + tr_off(32 * (mt) + crow(r_, hi), 32 * (nt) + r32)) = tobf((acc)[r_]); } while (0)

__device__ __forceinline__ void ra_phase(Frame& F, const Inputs& in, int jl) {
    bf16* RKV = (bf16*)(F.ws + WS_ARENA + A_RKV); const bf16* AA = (const bf16*)(F.ws + WS_ARENA + A_AAZ); float* LW = (float*)(F.ws + WS_ARENA + A_LW);
    float* GL = (float*)(F.ws + WS_ARENA + A_GL); float* BON = (float*)(F.ws + WS_ARENA + A_BON);
    const float* k_k = in.rw_k_k + (size_t)jl * 1024; const float* k_a = in.rw_k_a + (size_t)jl * 1024; const float* r_k = in.rw_r_k + (size_t)jl * 1024;
    LAS char* L = (LAS char*)F.lds; LAS float* LWF = (LAS float*)(L + L_LWF); LAS float* SEG = (LAS float*)(L + L_SEG);
    const int w = F.wave;
#define FRESH() const int lane = fresh_lane(), r32 = lane & 31, hi = lane >> 5; (void)r32; (void)hi
    v4u pr_r, pr_k, pr_v, pr_a; f32x4 pr_l0, pr_l1, pr_kk0, pr_kk1, pr_ka0, pr_ka1, pr_rk0, pr_rk1;
#define RA_PREFETCH(u_) do { const int tid_ = w * 64 + fresh_lane(), bh_ = (u_) >> 7, c_ = (u_) & 127; const size_t row_ = (size_t)(bh_ >> 4) * SEQ + (size_t)c_ * 64 + (tid_ >> 3); const int col_ = (bh_ & 15) * 64 + (tid_ & 7) * 8; \
        pr_r = *(const GAS v4u*)(RKV + row_ * 3072 + col_); pr_k = *(const GAS v4u*)(RKV + row_ * 3072 + 1024 + col_); pr_v = *(const GAS v4u*)(RKV + row_ * 3072 + 2048 + col_); pr_a = *(const GAS v4u*)(AA + row_ * 1024 + col_); \
        pr_l0 = *(const GAS f32x4*)(LW + row_ * 1024 + col_); pr_l1 = *(const GAS f32x4*)(LW + row_ * 1024 + col_ + 4); \
        pr_kk0 = *(const GAS f32x4*)(k_k + col_); pr_kk1 = *(const GAS f32x4*)(k_k + col_ + 4); pr_ka0 = *(const GAS f32x4*)(k_a + col_); pr_ka1 = *(const GAS f32x4*)(k_a + col_ + 4); pr_rk0 = *(const GAS f32x4*)(r_k + col_); pr_rk1 = *(const GAS f32x4*)(r_k + col_ + 4); } while (0)
    if ((int)blockIdx.x < NU) RA_PREFETCH((int)blockIdx.x);
    for (int u = (int)blockIdx.x; u < NU; u += F.G) {
        const int tid = w * 64 + fresh_lane();
        const int bh = u >> 7, c = u & 127, b = bh >> 4, h = bh & 15; const size_t t0 = (size_t)b * SEQ + (size_t)c * 64;
        SUB_T0();
        const int t = tid >> 3, j0 = (tid & 7) * 8; const size_t row = t0 + t; const int col = h * 64 + j0;
        float rv[8], kp[8], vv[8], am[8], bb[8], lw[8];
        { float kv[8], av[8];
          unpack8(pr_r, rv); unpack8(pr_k, kv); unpack8(pr_v, vv); unpack8(pr_a, av);
          const f32x4 l0 = pr_l0, l1 = pr_l1;
          float ss = 0.f, bs = 0.f; float kk[8];
#pragma unroll
          for (int q = 0; q < 8; ++q) { const float ck = q < 4 ? pr_kk0[q] : pr_kk1[q - 4], ca = q < 4 ? pr_ka0[q] : pr_ka1[q - 4], cr = q < 4 ? pr_rk0[q] : pr_rk1[q - 4];
              lw[q] = q < 4 ? l0[q] : l1[q - 4]; kk[q] = kv[q] * ck; ss += kk[q] * kk[q]; kp[q] = kv[q] * (1.f + (av[q] - 1.f) * ca); bs += rv[q] * kp[q] * cr; }
          ss += __shfl_xor(ss, 1); ss += __shfl_xor(ss, 2); ss += __shfl_xor(ss, 4); bs += __shfl_xor(bs, 1); bs += __shfl_xor(bs, 2); bs += __shfl_xor(bs, 4);
          const float inv = frcp(fmaxf(fsqrt(ss), 1e-12f));
#pragma unroll
          for (int q = 0; q < 8; ++q) { const float kn = kk[q] * inv; am[q] = -kn; bb[q] = kn * av[q]; }
          if ((tid & 7) == 0) BON[row * 16 + h] = bs; }
        { LAS f32x4* lp = (LAS f32x4*)(LWF + t * 64 + j0); lp[0] = (f32x4){lw[0], lw[1], lw[2], lw[3]}; lp[1] = (f32x4){lw[4], lw[5], lw[6], lw[7]}; }
        __syncthreads();
        { const int jc = tid & 63, sg = tid >> 6; float run = 0.f;
#pragma unroll
          for (int q = 0; q < 8; ++q) { run += LWF[(sg * 8 + q) * 64 + jc]; LWF[(sg * 8 + q) * 64 + jc] = run; }
          SEG[sg * 64 + jc] = run; }
        __syncthreads();
        { const int jc = tid & 63, sg = tid >> 6; float pre = 0.f;
#pragma unroll
          for (int q = 0; q < 8; ++q) if (q < sg) pre += SEG[q * 64 + jc];
#pragma unroll
          for (int q = 0; q < 8; ++q) LWF[(sg * 8 + q) * 64 + jc] += pre; }
        __syncthreads();
        { float at[8], bt[8], kt[8], rt[8], bh_[8], kh[8];
#pragma unroll
          for (int q = 0; q < 8; ++q) { const float cum = LWF[t * 64 + j0 + q], cl = LWF[63 * 64 + j0 + q];
              const float ein = fexp(-cum), eL = fexp(cl - cum);
              at[q] = am[q] * fexp(cum - lw[q]); bt[q] = bb[q] * ein; kt[q] = kp[q] * ein; rt[q] = rv[q] * fexp(cum); bh_[q] = bb[q] * eL; kh[q] = kp[q] * eL;
              if (t == 63) GL[(size_t)u * 64 + j0 + q] = fexp(cl); }
          { unsigned z0 = 0u; asm volatile("" : "+v"(z0));
            for (int z = tid; z < RMB / 16; z += 512) *(LAS v4u*)(L + L_T_RM + z * 16) = (v4u){z0, z0, z0, z0}; }
          const int ro = rm_off(t, j0), to = tr_off(t, j0);
          *(LAS v4u*)(L + L_AT_RM + ro) = pack8f(at); *(LAS v4u*)(L + L_AT_TR + to) = pack8f(at); *(LAS v4u*)(L + L_BT_RM + ro) = pack8f(bt); *(LAS v4u*)(L + L_KT_RM + ro) = pack8f(kt);
          *(LAS v4u*)(L + L_RT_RM + ro) = pack8f(rt); *(LAS v4u*)(L + L_BH_TR + to) = pack8f(bh_); *(LAS v4u*)(L + L_KH_RM + ro) = pack8f(kh); *(LAS v4u*)(L + L_V_TR + to) = pack8f(vv); }
        __syncthreads(); SUB_MARK(0);
        if (u + F.G < NU) RA_PREFETCH(u + F.G);
        f32x16 rk[2];
        { FRESH(); const int p = w >> 1, mt = w & 1; const LAS char* At = L + ((p < 2) ? L_AT_RM : L_RT_RM); const LAS char* Bt = L + ((p & 1) ? L_KT_RM : L_BT_RM);
          bf16x8 fa[4]; frag_rm4(fa, At, 32 * mt + r32, hi);
#pragma unroll
          for (int nt = 0; nt < 2; ++nt) { f32x16 acc = {};
              if (nt <= mt) { bf16x8 fb[4]; frag_rm4(fb, Bt, 32 * nt + r32, hi); acc = mm4(fa, fb); }
#pragma unroll
              for (int r = 0; r < 16; ++r) { const int tt = 32 * mt + crow(r, hi), s = 32 * nt + r32; const bool keep = (p < 2) ? (s < tt) : (s <= tt); if (!keep) acc[r] = 0.f; }
              if (p == 0) {
#pragma unroll
                  for (int r = 0; r < 16; ++r) LWF[(32 * mt + crow(r, hi)) * 64 + 32 * nt + r32] = acc[r]; }
              else if (p == 1) STORE_TR(L + L_AAK_TR, acc, mt, nt);
              else if (p == 2) STORE_RM(L + L_ARB_RM, acc, mt, nt);
              rk[nt] = acc; } }
        __syncthreads(); SUB_MARK(1);
        { FRESH(); const int c16 = lane & 15, q4 = lane >> 4; LAS char* TT = L + L_TT_RM; LAS char* TM = L + L_T_RM;
          if (w < 4) { const int base = 16 * w; float Tc[16];
#pragma unroll
              for (int tt = 0; tt < 16; ++tt) { float acc = (tt == c16) ? 1.f : 0.f;
#pragma unroll
                  for (int s4 = 0; s4 < (tt + 3) / 4; ++s4) { const f32x4 a4 = *(const LAS f32x4*)(LWF + (base + tt) * 64 + base + s4 * 4);
#pragma unroll
                      for (int e = 0; e < 4; ++e) if (s4 * 4 + e < tt) acc += a4[e] * Tc[s4 * 4 + e]; }
                  Tc[tt] = acc; }
              if (lane < 16) {
#pragma unroll
                  for (int tt = 0; tt < 16; ++tt) *(LAS bf16*)(TM + rm_off(base + tt, base + c16)) = tobf(Tc[tt]);
                  *(LAS v4u*)(TT + rm_off(base + c16, base)) = pack8f(Tc); *(LAS v4u*)(TT + rm_off(base + c16, base + 8)) = pack8f(Tc + 8); } }
          __syncthreads();
#pragma unroll
          for (int d = 1; d < 4; ++d) {
              if (w < 4 - d) { const int ab = 16 * (w + d), bb = 16 * w; f32x4 x = {0.f, 0.f, 0.f, 0.f};
#pragma unroll
                  for (int step = 0; step < (d == 3 ? 2 : 1); ++step) { const int k0 = 32 * step + 8 * q4; const bool valid = k0 < 16 * d;
                      v4u af = {0u, 0u, 0u, 0u}, bfm = {0u, 0u, 0u, 0u};
                      if (valid) { const LAS f32x4* ap = (const LAS f32x4*)(LWF + (ab + c16) * 64 + bb + k0); af = pack8v(ap[0], ap[1]); bfm = *(const LAS v4u*)(TT + rm_off(bb + c16, bb + k0)); }
                      x = __builtin_amdgcn_mfma_f32_16x16x32_bf16(__builtin_bit_cast(bf16x8, af), __builtin_bit_cast(bf16x8, bfm), x, 0, 0, 0); }
                  LAS char* XS = L + L_KT_RM + w * 512;
                  { v2u xw; xw.x = cvtpk(x[0], x[1]); xw.y = cvtpk(x[2], x[3]); *(LAS v2u*)(XS + c16 * 32 + q4 * 8) = xw; }
                  LDS_WAIT();
                  v4u af2 = {0u, 0u, 0u, 0u}, bf2 = {0u, 0u, 0u, 0u};
                  if (q4 < 2) { af2 = *(const LAS v4u*)(TM + rm_off(ab + c16, ab + 8 * q4)); bf2 = *(const LAS v4u*)(XS + c16 * 32 + q4 * 16); }
                  const f32x4 tb = __builtin_amdgcn_mfma_f32_16x16x32_bf16(__builtin_bit_cast(bf16x8, af2), __builtin_bit_cast(bf16x8, bf2), (f32x4){0.f, 0.f, 0.f, 0.f}, 0, 0, 0);
#pragma unroll
                  for (int jx = 0; jx < 4; ++jx) *(LAS bf16*)(TM + rm_off(ab + 4 * q4 + jx, bb + c16)) = tobf(tb[jx]);
                  { v2u tw; tw.x = cvtpk(tb[0], tb[1]); tw.y = cvtpk(tb[2], tb[3]); *(LAS v2u*)(TT + rm_off(bb + c16, ab + 4 * q4)) = tw; } }
              __syncthreads();
          } }
        SUB_MARK(2);
        { FRESH(); const int q = w & 3, mt = q >> 1, nt = q & 1; bf16x8 fa[4], fb[4]; frag_rm4(fa, L + L_T_RM, 32 * mt + r32, hi);
          frag_tr4(fb, L + ((w < 4) ? L_AT_TR : L_AAK_TR), nt, lane);
          const f32x16 acc = mm4(fa, fb);
          if (w < 4) STORE_TR(L + L_W2_TR, acc, mt, nt); else STORE_TR(L + L_H_TR, acc, mt, nt); }
        __syncthreads(); SUB_MARK(3);
        { FRESH(); const int g = w >> 1, mt = w & 1; bf16x8 fa[4];
          if (g == 0 || g == 3) frag_rm4(fa, L + L_ARB_RM, 32 * mt + r32, hi); else frag_tr4(fa, L + L_BH_TR, mt, lane);
#pragma unroll
          for (int nt = 0; nt < 2; ++nt) { bf16x8 fb[4]; frag_tr4(fb, L + ((g < 2) ? L_W2_TR : L_H_TR), nt, lane);
              f32x16 acc = mm4(fa, fb);
              if (g == 0) {
#pragma unroll
                  for (int r = 0; r < 16; ++r) { const int tt = 32 * mt + crow(r, hi), jj = 32 * nt + r32;
                      *(LAS bf16*)(L + L_T_RM + rm_off(tt, jj)) = tobf(acc[r] + bf1(*(const LAS bf16*)(L + L_RT_RM + rm_off(tt, jj)))); } }
              else if (g == 1) {
#pragma unroll
                  for (int r = 0; r < 16; ++r) { const int jp = 32 * mt + crow(r, hi), jj = 32 * nt + r32; *(LAS bf16*)(L + L_TT_RM + rm_off(jp, jj)) = tobf(acc[r]); } }
              else if (g == 2) {
#pragma unroll
                  for (int r = 0; r < 16; ++r) { const int jp = 32 * mt + crow(r, hi), s = 32 * nt + r32; acc[r] += bf1(*(const LAS bf16*)(L + L_KH_RM + rm_off(s, jp))); }
                  STORE_RM(L + L_P2_RM, acc, mt, nt); }
              else {
#pragma unroll
                  for (int r = 0; r < 16; ++r) acc[r] += rk[nt][r];
                  STORE_RM(L + L_P1_RM, acc, mt, nt); } } }
        __syncthreads(); SUB_MARK(4);
        { const int tid_ = w * 64 + fresh_lane();
#pragma unroll
          for (int i = 0; i < 2; ++i) { const int p_ = tid_ + 512 * i, tile = p_ >> 9, row_ = (p_ >> 3) & 63, ch = p_ & 7;
              const v4u x = *(const LAS v4u*)(L + (tile ? L_TT_RM : L_T_RM) + rm_off(row_, ch * 8));
              *(GAS v4u*)(RKV + (t0 + row_) * 3072 + tile * 1024 + h * 64 + ch * 8) = x; } }
        { FRESH(); const int q = w & 3, m_ = q >> 1, n_ = q & 1; bf16x8 fa[4], fb[4];
          if (w < 4) { frag_tr4(fa, L + L_V_TR, m_, lane); frag_rm4(fb, L + L_P1_RM, 32 * n_ + r32, hi); }
          else { frag_rm4(fa, L + L_P2_RM, 32 * m_ + r32, hi); frag_tr4(fb, L + L_V_TR, n_, lane); }
          const f32x16 acc = mm4(fa, fb);
          if (w < 4) {
              const int o = (q * 64 + lane) * 32, orow = o >> 7, owi = o & 127;
              GAS v4u* dst = (GAS v4u*)((GAS char*)LW + ((t0 + orow) * 1024 + h * 64) * 4 + owi);
              float tmp[16];
#pragma unroll
              for (int r = 0; r < 16; ++r) tmp[r] = acc[r];
              dst[0] = pack8f(tmp); dst[1] = pack8f(tmp + 8); }
          else {
              const int i_ = 32 * n_ + r32, it4 = i_ >> 4, nn_ = i_ & 15;
#pragma unroll
              for (int g4 = 0; g4 < 4; ++g4) {
                  const int jt = 2 * m_ + (g4 >> 1), qq = 2 * (g4 & 1) + hi;
                  const int o = ((it4 * 64 + nn_ + 16 * qq) * 16 + jt * 4) * 2, orow = o >> 7, owi = o & 127;
                  v2u wv; wv.x = cvtpk(acc[4 * g4], acc[4 * g4 + 1]); wv.y = cvtpk(acc[4 * g4 + 2], acc[4 * g4 + 3]);
                  *(GAS v2u*)((GAS char*)LW + ((t0 + orow) * 1024 + h * 64) * 4 + 128 + owi) = wv; } } }
        __syncthreads(); SUB_MARK(5);
    }
}
__device__ __forceinline__ void rb_phase(Frame& F) {
    if ((int)blockIdx.x >= BATCH * RW_H * 4) return;
    const bf16* RKV = (const bf16*)(F.ws + WS_ARENA + A_RKV); const float* LW = (const float*)(F.ws + WS_ARENA + A_LW); const float* GL = (const float*)(F.ws + WS_ARENA + A_GL);
    bf16* ZC = (bf16*)(F.ws + WS_ARENA + A_AAZ);
    const int lane = F.lane, n16 = lane & 15, q4 = lane >> 4, task = blockIdx.x, bh = task >> 2, it4 = task & 3, b = bh >> 4, h = bh & 15;
    LAS float* sg = (LAS float*)F.lds;
    for (int e = F.tid; e < 128 * 16; e += 512) *(LAS f32x4*)(sg + e * 4) = *(const GAS f32x4*)(GL + (size_t)bh * 8192 + e * 4);
    __syncthreads();
    if (F.wave != 0) return;
    f32x4 Z[4] = {};
    v4u mfA[4][2], mfB[4][2], mfC[4][2], mfD[4][2]; v4u nnA[2], nnB[2], nnC[2], nnD[2];
#define RB_LOAD(c_, mf_, nn_) do { const size_t t0_ = (size_t)b * SEQ + (size_t)((c_) < SEQ / 64 ? (c_) : SEQ / 64 - 1) * 64; \
        _Pragma("unroll") for (int jt = 0; jt < 4; ++jt) { const bf16* mrow = RKV + (t0_ + 16 * jt + n16) * 3072 + 1024 + h * 64 + 4 * q4; \
            _Pragma("unroll") for (int kb2 = 0; kb2 < 2; ++kb2) { const v2u lo = *(const GAS v2u*)(mrow + kb2 * 32), hi2 = *(const GAS v2u*)(mrow + kb2 * 32 + 16); mf_[jt][kb2] = (v4u){lo.x, lo.y, hi2.x, hi2.y}; } } \
        { const int o = ((it4 * 64 + lane) * 16) * 2, orow = o >> 7, owi = o & 127; \
          const GAS v4u* np = (const GAS v4u*)((const GAS char*)LW + ((t0_ + orow) * 1024 + h * 64) * 4 + 128 + owi); nn_[0] = np[0]; nn_[1] = np[1]; } } while (0)
#define RB_STEP(c_, mf_, nn_) do { const int u = bh * 128 + (c_); \
        v4u zh[2], zl[2]; \
        _Pragma("unroll") for (int kb2 = 0; kb2 < 2; ++kb2) { float a8[8], l8[8]; \
            _Pragma("unroll") for (int e = 0; e < 4; ++e) { a8[e] = Z[2 * kb2][e]; a8[4 + e] = Z[2 * kb2 + 1][e]; } \
            const v4u hw = pack8f(a8); float h8[8]; unpack8(hw, h8); \
            _Pragma("unroll") for (int e = 0; e < 8; ++e) l8[e] = a8[e] - h8[e]; \
            zh[kb2] = hw; zl[kb2] = pack8f(l8); \
              \
            _Pragma("unroll") for (int s_ = 0; s_ < 2; ++s_) { const int jt = 2 * kb2 + s_; v2u zw; zw.x = s_ ? hw.z : hw.x; zw.y = s_ ? hw.w : hw.y; \
                *(GAS v2u*)(ZC + (size_t)u * 4096 + ((jt * 2 + (it4 >> 1)) * 64 + 32 * (q4 & 1) + 16 * (it4 & 1) + n16) * 8 + 4 * (q4 >> 1)) = zw; } } \
        float nv[16]; unpack8(nn_[0], nv); unpack8(nn_[1], nv + 8); \
        _Pragma("unroll") for (int jt = 0; jt < 4; ++jt) { const f32x4 g4 = *(const LAS f32x4*)(sg + (c_) * 64 + 16 * jt + 4 * q4); f32x4 acc; \
            _Pragma("unroll") for (int e = 0; e < 4; ++e) acc[e] = nv[4 * jt + e] + g4[e] * Z[jt][e]; \
            _Pragma("unroll") for (int kb2 = 0; kb2 < 2; ++kb2) { \
                acc = __builtin_amdgcn_mfma_f32_16x16x32_bf16(__builtin_bit_cast(bf16x8, mf_[jt][kb2]), __builtin_bit_cast(bf16x8, zh[kb2]), acc, 0, 0, 0); \
                acc = __builtin_amdgcn_mfma_f32_16x16x32_bf16(__builtin_bit_cast(bf16x8, mf_[jt][kb2]), __builtin_bit_cast(bf16x8, zl[kb2]), acc, 0, 0, 0); } \
            zn[jt] = acc; } \
        _Pragma("unroll") for (int jt = 0; jt < 4; ++jt) Z[jt] = zn[jt]; } while (0)
    f32x4 zn[4];
    static_assert((SEQ / 64) % 4 == 0, "Rb pipeline: chunks = 4k");
    RB_LOAD(0, mfA, nnA); RB_LOAD(1, mfB, nnB); RB_LOAD(2, mfC, nnC);
#pragma nounroll
    for (int c = 0; c < SEQ / 64; c += 4) {
        RB_LOAD(c + 3, mfD, nnD); RB_STEP(c, mfA, nnA);
        RB_LOAD(c + 4, mfA, nnA); RB_STEP(c + 1, mfB, nnB);
        RB_LOAD(c + 5, mfB, nnB); RB_STEP(c + 2, mfC, nnC);
        RB_LOAD(c + 6, mfC, nnC); RB_STEP(c + 3, mfD, nnD);
    }
#undef RB_LOAD
#undef RB_STEP
}
__device__ __forceinline__ void rc_phase(Frame& F, const Inputs& in, int jl) {
    const bf16* RKV = (const bf16*)(F.ws + WS_ARENA + A_RKV); const float* LW = (const float*)(F.ws + WS_ARENA + A_LW); const float* BON = (const float*)(F.ws + WS_ARENA + A_BON);
    const bf16* ZC = (const bf16*)(F.ws + WS_ARENA + A_AAZ); const bf16* GG = (const bf16*)(F.ws + WS_ARENA + A_GG); bf16* YG = (bf16*)(F.ws + WS_ARENA + A_YG);
    const float* lnw = in.rw_ln_w + (size_t)jl * 1024; const float* lnb = in.rw_ln_b + (size_t)jl * 1024;
    const int lane = F.lane, r32 = lane & 31, hi = lane >> 5;
    for (int task = F.gw; task < NU * 2; task += F.NGW) { const int u = task >> 1, tt = task & 1, bh = u >> 7, c = u & 127, b = bh >> 4, h = bh & 15; const size_t t0 = (size_t)b * SEQ + (size_t)c * 64, trow = t0 + 32 * tt + r32;
        bf16x8 yw[4];
        { const bf16* yrow = RKV + trow * 3072 + h * 64 + 4 * hi;
#pragma unroll
          for (int kb = 0; kb < 4; ++kb) { const v2u lo = *(const GAS v2u*)(yrow + kb * 16), hi2 = *(const GAS v2u*)(yrow + kb * 16 + 8); yw[kb] = __builtin_bit_cast(bf16x8, (v4u){lo.x, lo.y, hi2.x, hi2.y}); } }
        unsigned vws[16], gws[16];
        { const int half = lane >> 5, col = h * 64 + (lane & 31) * 2;
#pragma unroll
          for (int k = 0; k < 16; ++k) { const size_t tr = t0 + 32 * tt + 2 * k + half; vws[k] = *(const GAS unsigned*)(RKV + tr * 3072 + 2048 + col); gws[k] = *(const GAS unsigned*)(GG + tr * 1024 + col); } }
        f32x16 y[2];
#pragma unroll
        for (int it = 0; it < 2; ++it) { const int o = ((it * 2 + tt) * 64 + lane) * 32, orow = o >> 7, owi = o & 127;
            const GAS v4u* yp = (const GAS v4u*)((const GAS char*)LW + ((t0 + orow) * 1024 + h * 64) * 4 + owi);
            float tmp[16]; unpack8(yp[0], tmp); unpack8(yp[1], tmp + 8);
#pragma unroll
            for (int r = 0; r < 16; ++r) y[it][r] = tmp[r];
#pragma unroll
            for (int kb = 0; kb < 4; ++kb) { const bf16x8 zf = *(const GAS bf16x8*)(ZC + (size_t)u * 4096 + ((kb * 2 + it) * 64 + lane) * 8);
                y[it] = __builtin_amdgcn_mfma_f32_32x32x16_bf16(zf, yw[kb], y[it], 0, 0, 0); } }
        float s1 = 0.f;
#pragma unroll
        for (int it = 0; it < 2; ++it)
#pragma unroll
            for (int r = 0; r < 16; ++r) s1 += y[it][r];
        const float mean = mlc::swap_add(s1) * (1.f / 64.f); float s2 = 0.f;
#pragma unroll
        for (int it = 0; it < 2; ++it)
#pragma unroll
            for (int r = 0; r < 16; ++r) { y[it][r] -= mean; s2 += y[it][r] * y[it][r]; }
        const float rs = frsq(mlc::swap_add(s2) * (1.f / 64.f) + 64e-5f);
        LAS float* zb = (LAS float*)F.lds + F.wave * (64 * 33 + 32);
#pragma unroll
        for (int it = 0; it < 2; ++it)
#pragma unroll
            for (int r = 0; r < 16; ++r) zb[(32 * it + crow(r, hi)) * 33 + r32] = y[it][r] * rs;
        if (hi == 0) zb[64 * 33 + r32] = BON[trow * 16 + h];
        LDS_WAIT();
        { const int half = lane >> 5, c2 = (lane & 31) * 2, col = h * 64 + c2;
          const float w0 = lnw[col], w1 = lnw[col + 1], b0 = lnb[col], b1 = lnb[col + 1];
#pragma unroll
          for (int k = 0; k < 16; ++k) { const int tl = 2 * k + half; const size_t tr = t0 + 32 * tt + tl;
              const unsigned vw = vws[k], gw = gws[k];
              const float bon = zb[64 * 33 + tl];
              const float o0 = (zb[c2 * 33 + tl] * w0 + b0 + bon * bf_lo(vw)) * bf_lo(gw), o1 = (zb[(c2 + 1) * 33 + tl] * w1 + b1 + bon * bf_hi(vw)) * bf_hi(gw);
              *(GAS unsigned*)(YG + tr * 1024 + col) = cvtpk(o0, o1); } }
        LDS_WAIT();
    }
}
#undef STORE_RM
#undef STORE_TR
#undef FRESH
#undef RA_PREFETCH
}

#ifndef MK_ONE_LAUNCH
#define MK_ONE_LAUNCH 1
#endif
template <class Epi, class Pre = pg8::NoPre> __device__ __forceinline__ void run_gemm(Frame& F, const bf16* A, int lda, const bf16* Bt, int ldb, int N, int K, const Epi& E, const Pre pre = Pre()) {
    pg8::Gemm g{A, Bt, T, N, K, lda, ldb, F.wave}; pg8::StaticOrder S; S.init(T, N, F.G, (int)blockIdx.x);
    pg8::gemm_phase<Epi, pg8::StaticOrder, true, true, false, Pre>(F.lds, g, S, E, pre);
}
template <class Epi, class Pre = pg8::NoPre> __device__ __forceinline__ void run_gemm_tail(Frame& F, const bf16* A, int lda, const bf16* Bt, int ldb, int N, int K, const Epi& E, int lim0, const Pre& pre = Pre()) {
    pg8::Gemm g{A, Bt, T, N, K, lda, ldb, F.wave}; pg8::StaticOrder S; S.init(T, N, F.G, (int)blockIdx.x);
    int g_ = F.G; asm volatile("" : "+s"(g_)); const bool tail = (g_ == 256);
    if (tail) S.lim = lim0;
    pg8::gemm_phase<Epi, pg8::StaticOrder, true, true, false, Pre>(F.lds, g, S, E, pre);
    if (tail) { pg8::TailOrder TO{S, lim0}; pg8::gemm_phase<Epi, pg8::TailOrder, true, true, true, pg8::NoPre, true>(F.lds, g, TO, E); }
}
struct RwOrder { pg8::StaticOrder S;
    __device__ bool next(int i, pg8::Unit& u) const { const bool ok = S.next(i, u); u.acol = (u.pn >> 2) * 1024; return ok; }
    __device__ bool post(pg8::Unit&) const { return false; }
    __device__ __forceinline__ void a_ready(const pg8::Unit&) const {}
    __device__ __forceinline__ void done(const pg8::Unit&) const {} };
__host__ __device__ constexpr int mixer_phases(int kind) { return kind == 0 ? 4 : kind == 1 ? 6 : 7; }
constexpr int NPH = 4 * 3 + (mixer_phases(0) + 2) + (mixer_phases(1) + 2) + (mixer_phases(2) + 2) + (mixer_phases(0) + 2) + 1;

__global__ void __launch_bounds__(NWAVES * 64, 2) fwd(Args args) {
    extern __shared__ __attribute__((aligned(16))) unsigned char lds[];
    Frame F;
    F.lds = (LAS unsigned char*)lds;
    F.tid = threadIdx.x; F.lane = F.tid & 63; const int wave0 = __builtin_amdgcn_readfirstlane(F.tid >> 6); F.wave = wave0;
    F.G = gridDim.x; F.gw = (int)blockIdx.x * NWAVES + F.wave; F.NGW = F.G * NWAVES;
    F.ws = args.ws; F.ctl = (gu32*)(args.ws + WS_CTL);
    const Inputs& in = args.in;
    volatile LAS unsigned* MISC = (volatile LAS unsigned*)(F.lds + MISC_OFF);
    for (int u = F.tid; u < (LDS_BYTES - LDSCTL_OFF) / 4; u += NWAVES * 64) ((LAS unsigned*)(F.lds + LDSCTL_OFF))[u] = 0u;
    __syncthreads();
#if MK_ONE_LAUNCH
    XcdBarrier bar = xcd_barrier_post((unsigned*)(F.ctl + CW_BAR), MISC + 8);
#define GRID_BAR() xcd_barrier(bar)
#else
#define GRID_BAR() do { } while (0)
#endif
    const int lo = args.ph_lo, hi = args.ph_hi;
    int ph = 0;
#ifndef PHMASK
#define PHMASK 0xffffffffu
#endif
#ifndef PHREP
#define PHREP 0u
#endif
#define REP_LAST (rep_ + 1 == nrep_)
#ifdef STAMP_ID
#define ST_BEGIN(id) if ((id) == STAMP_ID && blockIdx.x == 0 && threadIdx.x == 0) *(volatile LAS unsigned long long*)(F.lds + MISC_OFF + 64) = __builtin_amdgcn_s_memrealtime();
#define ST_END(id) if ((id) == STAMP_ID && blockIdx.x == 0 && threadIdx.x == 0) { const unsigned long long t1_ = __builtin_amdgcn_s_memrealtime(), until_ = t1_ + (unsigned long long)STAMP_MULT * (t1_ - *(volatile LAS unsigned long long*)(F.lds + MISC_OFF + 64)); while (__builtin_amdgcn_s_memrealtime() < until_) __builtin_amdgcn_s_sleep(8); }
#else
#define ST_BEGIN(id)
#define ST_END(id)
#endif
#define PH_BEGIN(id) if (ph >= lo && ph < hi) { ST_BEGIN(id) if ((PHMASK >> (id)) & 1u) for (int rep_ = 0, nrep_ = ((((PHREP) >> (id)) & 1u) ? 2 : 1); rep_ < nrep_; ++rep_) { if (rep_) GRID_BAR(); { int w_ = wave0; asm volatile("" : "+s"(w_)); F.wave = w_; F.lane = fresh_lane(); F.tid = w_ * 64 + F.lane; F.gw = (int)blockIdx.x * NWAVES + w_; } unsigned char* ws = args.ws; asm volatile("" : "+s"(ws)); { float* xo_ = args.out; asm volatile("" : "+s"(xo_)); F.X = xo_; } F.ws = ws; F.ctl = (gu32*)(ws + WS_CTL); F.XB = (bf16*)(ws + WS_XB); F.SS = (float*)(ws + WS_SS); \
    bf16* const WB = (bf16*)(ws + WS_W); unsigned char* const AR = ws + WS_ARENA; float* const COS = (float*)(ws + WS_COS); float* const SIN = (float*)(ws + WS_SIN); float* const SSQ = (float*)(ws + WS_SSQ); float* const SSKV = (float*)(ws + WS_SSKV); (void)WB; (void)AR; (void)COS; (void)SIN; (void)SSQ; (void)SSKV;
#define PH_END(id) } if (ph + 1 < hi) GRID_BAR(); ST_END(id) } ++ph;

#ifdef DUMP
    if (lo == 1000) { unsigned char* ws = args.ws; unsigned char* const AR = ws + WS_ARENA; F.X = args.out; F.lane = fresh_lane();
#define HX ((bf16*)(AR + A_HX))
#define RKV ((bf16*)(AR + A_RKV))
#define LOR ((bf16*)(AR + A_LOR))
#define LW ((float*)(AR + A_LW))
#define AA ((bf16*)(AR + A_AAZ))
#define GG ((bf16*)(AR + A_GG))
#define YG ((bf16*)(AR + A_YG))
        for (int e = F.gw * 64 + F.lane; e < T * 1024; e += F.NGW * 64) { const int t = e >> 10, c = e & 1023; float v = 0.f;
            if (DUMP == 1) v = bf1(HX[(size_t)t * 2048 + c]) + bf1(HX[(size_t)t * 2048 + 1024 + c]);
            if (DUMP == 2) v = bf1(RKV[(size_t)t * 3072 + c]) + bf1(RKV[(size_t)t * 3072 + 1024 + c]) + bf1(RKV[(size_t)t * 3072 + 2048 + c]) + bf1(LOR[(size_t)t * 256 + (c & 255)]);
            if (DUMP == 3) v = LW[(size_t)t * 1024 + c] + bf1(AA[(size_t)t * 1024 + c]) + bf1(GG[(size_t)t * 1024 + c]);
            if (DUMP == 4) v = bf1(YG[(size_t)t * 1024 + c]);
            if (DUMP == 5) v = ((size_t)e < (size_t)3328 * 2048) ? bf1(((const bf16*)(ws + WS_W))[WR_BIG + e]) : 0.f;
            F.X[e] = v; }
#undef HX
#undef RKV
#undef LOR
#undef LW
#undef AA
#undef GG
#undef YG
        return; }
#endif
#pragma unroll
    for (int s = 0; s < 2 * DEPTH; ++s) {
        const int layer = s >> 1, half = s & 1, kind = layer % 3, j = layer / 3;
        int hide_ = args.hide; asm volatile("" : "+s"(hide_));
        const bool pre = (layer >= 1 && (layer - 1) % 3 == 2) && hide_ != 0;
        if (half == 0) {
            if (!pre) {
            PH_BEGIN(0)
                if (layer == 0) prologue(F, in);
                conv_layer(F, in, layer, F.gw, F.NGW, false);
            PH_END(0)
            }
        } else if (kind == 0) {
#define LAT ((bf16*)(AR + A_LAT))
#define Q ((bf16*)(AR + A_Q))
#define KV ((bf16*)(AR + A_KV))
#define O ((bf16*)(AR + A_O))
#define KPE ((bf16*)(AR + A_KPE))
            PH_BEGIN(1)
                int g_ = F.G; asm volatile("" : "+s"(g_)); const bool staged = (g_ == 256); RstdPre PR; PR.issue(F.SS, F.tid);
                EpiMlaA E{F.SS, LAT, SSQ, SSKV, KPE, COS, SIN, staged ? (const LAS float*)(F.lds + RSTD_LDS_OFF) : nullptr, ((int)blockIdx.x & 7) * 2048};
                run_gemm(F, F.XB, D, WB + WM_A, 1024, 1024, 1024, E, PR);
            PH_END(1)
            PH_BEGIN(2)
                int g_ = F.G; asm volatile("" : "+s"(g_)); const bool staged = (g_ == 256);
                const LAS float* rl_ = staged ? (const LAS float*)(F.lds + RSTD_LDS_OFF) : nullptr; const int rb_ = ((int)blockIdx.x & 7) * 2048;
                { RstdPreN<8> PR; PR.issue(SSQ, F.tid, 1.f / QRANK); EpiMlaQ E{SSQ, Q, COS, SIN, 0.07216878364870322f * 1.4426950408889634f, rl_, rb_};
                  run_gemm_tail(F, LAT, 1024, WB + WM_QB, 512, 1536, 512, E, 256, PR); }
                { RstdPreN<4> PR; PR.issue(SSKV, F.tid, 1.f / KVRANK); EpiMlaKV E{SSKV, KV, rl_, rb_};
                  run_gemm(F, LAT + 512, 1024, WB + WM_KVB, 256, 2048, 256, E, PR); }
            PH_END(2)
            PH_BEGIN(3)
                for (int it = (int)blockIdx.x; it < BATCH * MLA_H * 16; it += F.G) { int it2 = ((it & 7) << 5) | (it >> 3); asm volatile("" : "+s"(it2)); const int bh = it2 >> 4, xq = it2 & 15;
                    att::attn_unit(F.wave, bh >> 3, bh & 7, xq, Q, KV, KPE, O, (LAS char*)F.lds);
                    att::attn_unit(F.wave, bh >> 3, bh & 7, 31 - xq, Q, KV, KPE, O, (LAS char*)F.lds); }
            PH_END(3)
            PH_BEGIN(4)
                EpiResidual E{F.X, F.XB, F.SS, REP_LAST ? 1.0f : 0.f};
                run_gemm(F, O, 1024, WB + WM_O, 1024, 1024, 1024, E);
            PH_END(4)
        } else if (kind == 1) {
#define P ((bf16*)(AR + A_P))
#define GATES ((float*)(AR + A_GATES))
#define HM ((bf16*)(AR + A_HM))
            PH_BEGIN(5)
                int g_ = F.G; asm volatile("" : "+s"(g_)); const bool staged = (g_ == 256); RstdPre PR; PR.issue(F.SS, F.tid);
                EpiMlIn E{F.SS, P, GATES, staged ? (const LAS float*)(F.lds + RSTD_LDS_OFF) : nullptr, ((int)blockIdx.x & 7) * 2048};
                run_gemm_tail(F, F.XB, D, WB + WL_IN, 1024, 3328, 1024, E, 768, PR);
            PH_END(5)
            PH_BEGIN(6)
                mlc::conv_phase(F, in, j);
            PH_END(6)
            PH_BEGIN(7)
                mlc::xa_phase(F);
            PH_END(7)
            PH_BEGIN(8)
                mlc::xb_phase(F);
            PH_END(8)
            PH_BEGIN(19)
                mlc::xc_phase(F, in, j);
            PH_END(19)
            PH_BEGIN(9)
                EpiResidual E{F.X, F.XB, F.SS, REP_LAST ? 1.0f : 0.f};
                run_gemm(F, (bf16*)(AR + mlc::A_HM2), 1024, WB + WL_O, 1024, 1024, 1024, E);
            PH_END(9)
        } else {
#define HX ((bf16*)(AR + A_HX))
#define RKV ((bf16*)(AR + A_RKV))
#define LOR ((bf16*)(AR + A_LOR))
#define LW ((float*)(AR + A_LW))
#define AA ((bf16*)(AR + A_AAZ))
#define GG ((bf16*)(AR + A_GG))
#define YG ((bf16*)(AR + A_YG))
            PH_BEGIN(10)
                rw_shift_phase(F, in, j);
            PH_END(10)
            PH_BEGIN(11)
                { EpiRwBig E{RKV, LOR, 0}; pg8::Gemm g{HX, WB + WR_BIG, T, 3072, 1024, 4096, 1024, F.wave}; RwOrder S; S.S.init(T, 3072, F.G, (int)blockIdx.x);
                  pg8::gemm_phase<EpiRwBig, RwOrder, true, true>(F.lds, g, S, E); }
                { EpiRwBig E{RKV, LOR, 12}; pg8::Gemm g{HX + 2048, WB + WR_LORA, T, 256, 2048, 4096, 2048, F.wave}; pg8::StaticOrder S; S.init(T, 256, F.G, (int)blockIdx.x);
                  int g_ = F.G; asm volatile("" : "+s"(g_));
                  if (g_ == 256) { pg8::TailOrder TO{S, 0}; pg8::gemm_phase<EpiRwBig, pg8::TailOrder, true, true, true>(F.lds, g, TO, E); }
                  else pg8::gemm_phase<EpiRwBig, pg8::StaticOrder, true, true>(F.lds, g, S, E); }
            PH_END(11)
            PH_BEGIN(12)
                EpiRwUp E{LW, AA, GG, in.rw_w0 + (size_t)j * 1024, in.rw_a0 + (size_t)j * 1024};
                run_gemm(F, LOR, 256, WB + WR_UP, 256, 3072, 256, E);
            PH_END(12)
            PH_BEGIN(13)
                rwc::ra_phase(F, in, j);
            PH_END(13)
            PH_BEGIN(14)
                if (hide_ != 0 && layer + 1 < DEPTH && (int)blockIdx.x >= BATCH * RW_H * 4) conv_layer(F, in, layer + 1, ((int)blockIdx.x - BATCH * RW_H * 4) * NWAVES + F.wave, (F.G - BATCH * RW_H * 4) * NWAVES, true);
                else rwc::rb_phase(F);
            PH_END(14)
            PH_BEGIN(20)
                rwc::rc_phase(F, in, j);
            PH_END(20)
            PH_BEGIN(15)
                EpiResidual E{F.X, F.XB, F.SS, REP_LAST ? 1.0f : 0.f};
                run_gemm(F, YG, 1024, WB + WR_O, 1024, 1024, 1024, E);
            PH_END(15)
        }
#define ACT ((bf16*)(AR + A_ACT))
        PH_BEGIN(16)
            { int g_ = F.G; asm volatile("" : "+s"(g_)); const bool staged = (g_ == 256); RstdPre PR; PR.issue(F.SS, F.tid);
              EpiSwiGLU E{F.SS, ACT, staged ? (const LAS float*)(F.lds + RSTD_LDS_OFF) : nullptr, ((int)blockIdx.x & 7) * 2048};
              pg8::Gemm g{F.XB, WB + (half ? (pre ? WO_GU1A : WO_GU1) : WO_GU0), T, 2 * FF, D, D, D, F.wave}; pg8::StaticOrder S; S.init(T, 2 * FF, F.G, (int)blockIdx.x);
              const bool tail = staged;
              if (tail) S.lim = 5 * 256;
              pg8::gemm_phase<EpiSwiGLU, pg8::StaticOrder, true, true, false, RstdPre>(F.lds, g, S, E, PR);
              if (tail) { pg8::TailOrder TO{S, 5 * 256}; pg8::gemm_phase<EpiSwiGLU, pg8::TailOrder, true, true, true, pg8::NoPre, true>(F.lds, g, TO, E); } }
        PH_END(16)
        PH_BEGIN(17)
            EpiResidual E{F.X, F.XB, F.SS, REP_LAST ? 0.5f : 0.f};
            run_gemm(F, ACT, FF, WB + (half ? (pre ? WO_D1A : WO_D1) : WO_D0), FF, D, FF, E);
        PH_END(17)
    }
    PH_BEGIN(18)
        final_norm_phase(F, in);
    PH_END(18)
}

extern "C" void kernel_launch(void* const* d_in, const int* in_sizes, int n_in, void* d_out, int out_size, void* d_ws, size_t ws_size, hipStream_t stream) {
    static int grid = 0;
    if (grid == 0) {
        if (n_in != 38 || in_sizes[0] != T * D || out_size != T * D || ws_size < WS_END) { fprintf(stderr, "kernel_launch: unexpected shapes (n_in %d, in0 %d, out %d, ws %zu)\n", n_in, n_in > 0 ? in_sizes[0] : -1, out_size, ws_size); grid = -1; return; }
        int dev = 0, cus = 0, per_cu = 0;
        if (hipGetDevice(&dev) != hipSuccess || hipDeviceGetAttribute(&cus, hipDeviceAttributeMultiprocessorCount, dev) != hipSuccess) { grid = -1; return; }
        if (hipFuncSetAttribute((const void*)fwd, hipFuncAttributeMaxDynamicSharedMemorySize, LDS_BYTES) != hipSuccess) { fprintf(stderr, "kernel_launch: hipFuncSetAttribute failed\n"); grid = -1; return; }
        if (hipOccupancyMaxActiveBlocksPerMultiprocessor(&per_cu, (const void*)fwd, NWAVES * 64, LDS_BYTES) != hipSuccess || per_cu < 1)
            fprintf(stderr, "kernel_launch: occupancy query reports %d workgroups per CU\n", per_cu);
        (void)hipGetLastError();
        grid = cus;
    }
    if (grid < 0) return;
    if (hipMemsetAsync((char*)d_ws + WS_CTL, 0, CTL_ZERO_BYTES, stream) != hipSuccess) return;
    Args a{};
    const void** ip = (const void**)&a.in;
    for (int i = 0; i < 38; ++i) ip[i] = d_in[i];
    a.out = (float*)d_out; a.ws = (unsigned char*)d_ws;
    a.hide = (grid == 256 && ws_size >= WS_END_ALT && DEPTH == 4) ? 1 : 0;
#if MK_ONE_LAUNCH
    a.ph_lo = 0; a.ph_hi = NPH - a.hide;
    hipLaunchKernelGGL(fwd, dim3(grid), dim3(NWAVES * 64), LDS_BYTES, stream, a);
#else
#ifdef DUMP
    for (int p = 0; p <= DUMP_LAST; ++p) { a.ph_lo = p; a.ph_hi = p + 1;
        hipLaunchKernelGGL(fwd, dim3(grid), dim3(NWAVES * 64), LDS_BYTES, stream, a); }
    a.ph_lo = 1000; a.ph_hi = 1001;
    hipLaunchKernelGGL(fwd, dim3(grid), dim3(NWAVES * 64), LDS_BYTES, stream, a);
#else
    for (int p = 0; p < NPH; ++p) { a.ph_lo = p; a.ph_hi = p + 1;
        hipLaunchKernelGGL(fwd, dim3(grid), dim3(NWAVES * 64), LDS_BYTES, stream, a); }
#endif
#endif
}
```
